# Optimizing an MI355X kernel written in HIP

```python
import jax, jax.numpy as jnp
from jax import lax
import numpy as np

D_MODEL = 1024
BATCH = 8
SEQ = 2048
DEPTH = 2
DEC_BATCH = 128
DEC_SEQ = 4
PAST_LEN = 16384
PAGE_SIZE = 128

N_MIXERS = 2
N_GLA = (DEPTH + 1) // 2
N_HGRN = DEPTH // 2
CHUNK = 64
GLA_HEADS = 4
GLA_KEY_DIM = D_MODEL // 2
GLA_VAL_DIM = D_MODEL
GLA_DK = GLA_KEY_DIM // GLA_HEADS
GLA_DV = GLA_VAL_DIM // GLA_HEADS
GLA_GATE_RANK = 16
GLA_GATE_NORM = 16.0
HGRN_EXPAND = 128
HGRN_HEADS = D_MODEL // HGRN_EXPAND
HGRN_F_DIM = D_MODEL
HGRN_I_DIM = D_MODEL
HGRN_DF = HGRN_F_DIM // HGRN_HEADS
HGRN_DI = HGRN_I_DIM // HGRN_HEADS
D_FF = 2816
PLE_DIM = 256
RMS_EPS = 1e-6

kernel_name = 'hybrid_gla_hgrn2_macaron_step'


def rms_norm(x, w):
    xf = x.astype(jnp.float32)
    y = xf * lax.rsqrt(jnp.mean(xf * xf, axis=-1, keepdims=True) + RMS_EPS)
    return (y * w.astype(jnp.float32)).astype(x.dtype)


def swiglu(h, w_gu, w_down):
    gate, up = jnp.split(h @ w_gu, 2, axis=-1)
    return (jax.nn.silu(gate) * up) @ w_down


def chunked_gated_linear_recurrence(q, k, v, g, s0, scale):
    B, T, H, K = q.shape
    V = v.shape[-1]
    c = min(CHUNK, T)
    n = -(-T // c)
    pad = n * c - T
    f32 = jnp.float32
    q, k, v, g = (a.astype(f32) for a in (q, k, v, g))
    if pad:
        pw = ((0, 0), (0, pad), (0, 0), (0, 0))
        q, k, v, g = (jnp.pad(a, pw) for a in (q, k, v, g))
    to_chunks = lambda a: jnp.moveaxis(a.reshape(B, n, c, H, a.shape[-1]), 1, 0)
    mask = jnp.tril(jnp.ones((c, c), dtype=bool))[None, :, :, None, None]

    def step(S, inp):
        qc, kc, vc, gc = inp
        b = jnp.cumsum(gc, axis=1)
        rel = b[:, :, None] - b[:, None, :]
        decay = jnp.exp(jnp.where(mask, rel, -jnp.inf))
        attn = jnp.einsum('bthk,bshk,btshk->bhts', qc, kc, decay) * scale
        o_intra = jnp.einsum('bhts,bshv->bthv', attn, vc)
        o_inter = jnp.einsum('bthk,bhkv->bthv', qc * jnp.exp(b), S) * scale
        b_last = b[:, -1]
        k_dec = kc * jnp.exp(b_last[:, None] - b)
        S_new = S * jnp.exp(b_last)[..., None] + jnp.einsum('bshk,bshv->bhkv', k_dec, vc)
        return S_new, o_intra + o_inter

    S, o = lax.scan(step, s0.astype(f32), (to_chunks(q), to_chunks(k), to_chunks(v), to_chunks(g)))
    o = jnp.moveaxis(o, 0, 1).reshape(B, n * c, H, V)[:, :T]
    return o, S.astype(s0.dtype)


def gla_mixer(u, w_in, w_gk_up, b_gk, gn, w_out, s0):
    B, T, _ = u.shape
    z = u @ w_in
    cuts = np.cumsum([GLA_KEY_DIM, GLA_KEY_DIM, GLA_VAL_DIM, GLA_VAL_DIM]).tolist()
    q, k, v, g, r = jnp.split(z, cuts, axis=-1)
    gk = jax.nn.log_sigmoid((r @ w_gk_up + b_gk).astype(jnp.float32)) / GLA_GATE_NORM
    heads = lambda a, d: a.reshape(B, T, GLA_HEADS, d)
    o, s = chunked_gated_linear_recurrence(heads(q, GLA_DK), heads(k, GLA_DK), heads(v, GLA_DV),
                                           heads(gk, GLA_DK), s0, GLA_DK ** -0.5)
    o = rms_norm(o.astype(u.dtype), gn) * jax.nn.silu(heads(g, GLA_DV))
    return o.reshape(B, T, GLA_VAL_DIM) @ w_out, s


def hgrn2_mixer(u, w_in, gn, w_out, lb, s0):
    B, T, _ = u.shape
    z = u @ w_in
    cuts = [HGRN_F_DIM, 2 * HGRN_F_DIM, 2 * HGRN_F_DIM + HGRN_I_DIM]
    q, f, i, g = jnp.split(z, cuts, axis=-1)
    q = jax.nn.silu(q)
    f = f.astype(jnp.float32)
    log_f = jnp.logaddexp(jnp.log(lb), jnp.log1p(-lb) + jax.nn.log_sigmoid(f))
    k = (1.0 - lb) * jax.nn.sigmoid(-f)
    heads = lambda a, d: a.reshape(B, T, HGRN_HEADS, d)
    o, s = chunked_gated_linear_recurrence(heads(q, HGRN_DF), heads(k, HGRN_DF), heads(i, HGRN_DI),
                                           heads(log_f, HGRN_DF), s0, 1.0)
    o = rms_norm(o.astype(u.dtype), gn) * jax.nn.silu(heads(g, HGRN_DI))
    return o.reshape(B, T, HGRN_I_DIM) @ w_out, s


def trunk(x, p, st_gla, st_hgrn, ffn1_norm, ffn1_w_gu, ffn1_w_down, mix_norm,
          gla_w_in, gla_w_gk_up, gla_b_gk, gla_gn, gla_w_out,
          hgrn_w_in, hgrn_gn, hgrn_w_out, hgrn_lower_bounds,
          ffn2_norm, ffn2_w_gu, ffn2_w_down, ple_norm, ple_w_gate, ple_w_proj, final_norm):
    lbs = jax.nn.softmax(hgrn_lower_bounds.astype(jnp.float32), axis=0)
    lbs = jnp.cumsum(lbs, axis=0) - lbs[0]
    new_gla, new_hgrn = [], []
    h = x
    for li in range(DEPTH):
        h = h + 0.5 * swiglu(rms_norm(h, ffn1_norm[li]), ffn1_w_gu[li], ffn1_w_down[li])
        u = rms_norm(h, mix_norm[li])
        j = li // N_MIXERS
        if li % N_MIXERS == 0:
            m, s = gla_mixer(u, gla_w_in[j], gla_w_gk_up[j], gla_b_gk[j], gla_gn[j], gla_w_out[j], st_gla[j])
            new_gla.append(s)
        else:
            m, s = hgrn2_mixer(u, hgrn_w_in[j], hgrn_gn[j], hgrn_w_out[j], lbs[li], st_hgrn[j])
            new_hgrn.append(s)
        h = h + m
        h = h + 0.5 * swiglu(rms_norm(h, ffn2_norm[li]), ffn2_w_gu[li], ffn2_w_down[li])
        gate = jax.nn.sigmoid(rms_norm(h, ple_norm[li]) @ ple_w_gate[li])
        h = h + gate * (p[li] @ ple_w_proj[li])
    return rms_norm(h, final_norm), jnp.stack(new_gla), jnp.stack(new_hgrn)


def setup_inputs(seed: int = 0) -> dict:
    key = jax.random.key(seed)
    ks = iter(jax.random.split(key, 40))
    nrm = lambda shape, scale: jax.random.normal(next(ks), shape, jnp.float32) * scale
    gain = lambda shape: 1.0 + nrm(shape, 0.02)
    D = D_MODEL
    gla_in_w = 2 * GLA_KEY_DIM + 2 * GLA_VAL_DIM + GLA_GATE_RANK
    hgrn_in_w = 2 * HGRN_F_DIM + 2 * HGRN_I_DIM
    return {
        'x_prompt': nrm((BATCH, SEQ, D), 1.0),
        'x_sample': nrm((DEC_BATCH, DEC_SEQ, D), 1.0),
        'state_gla': nrm((N_GLA, DEC_BATCH, GLA_HEADS, GLA_DK, GLA_DV), 0.5),
        'state_hgrn': nrm((N_HGRN, DEC_BATCH, HGRN_HEADS, HGRN_DF, HGRN_DI), 0.5),
        'p_prompt': nrm((DEPTH, BATCH, SEQ, PLE_DIM), 1.0),
        'p_sample': nrm((DEPTH, DEC_BATCH, DEC_SEQ, PLE_DIM), 1.0),
        'ffn1_norm': gain((DEPTH, D)),
        'ffn1_w_gu': nrm((DEPTH, D, 2 * D_FF), D ** -0.5),
        'ffn1_w_down': nrm((DEPTH, D_FF, D), D_FF ** -0.5),
        'mix_norm': gain((DEPTH, D)),
        'gla_w_in': nrm((N_GLA, D, gla_in_w), D ** -0.5),
        'gla_w_gk_up': nrm((N_GLA, GLA_GATE_RANK, GLA_KEY_DIM), GLA_GATE_RANK ** -0.5),
        'gla_b_gk': nrm((N_GLA, GLA_KEY_DIM), 0.1),
        'gla_gn': gain((N_GLA, GLA_DV)),
        'gla_w_out': nrm((N_GLA, GLA_VAL_DIM, D), GLA_VAL_DIM ** -0.5),
        'hgrn_w_in': nrm((N_HGRN, D, hgrn_in_w), D ** -0.5),
        'hgrn_gn': gain((N_HGRN, HGRN_DI)),
        'hgrn_w_out': nrm((N_HGRN, HGRN_I_DIM, D), HGRN_I_DIM ** -0.5),
        'hgrn_lower_bounds': nrm((DEPTH, HGRN_F_DIM), 0.1),
        'ffn2_norm': gain((DEPTH, D)),
        'ffn2_w_gu': nrm((DEPTH, D, 2 * D_FF), D ** -0.5),
        'ffn2_w_down': nrm((DEPTH, D_FF, D), D_FF ** -0.5),
        'ple_norm': gain((DEPTH, D)),
        'ple_w_gate': nrm((DEPTH, D, D), D ** -0.5),
        'ple_w_proj': nrm((DEPTH, PLE_DIM, D), PLE_DIM ** -0.5),
        'final_norm': gain((D,)),
    }


def reference(x_prompt, x_sample, state_gla, state_hgrn, p_prompt, p_sample,
              ffn1_norm, ffn1_w_gu, ffn1_w_down, mix_norm,
              gla_w_in, gla_w_gk_up, gla_b_gk, gla_gn, gla_w_out,
              hgrn_w_in, hgrn_gn, hgrn_w_out, hgrn_lower_bounds,
              ffn2_norm, ffn2_w_gu, ffn2_w_down, ple_norm, ple_w_gate, ple_w_proj, final_norm):
    weights = (ffn1_norm, ffn1_w_gu, ffn1_w_down, mix_norm,
               gla_w_in, gla_w_gk_up, gla_b_gk, gla_gn, gla_w_out,
               hgrn_w_in, hgrn_gn, hgrn_w_out, hgrn_lower_bounds,
               ffn2_norm, ffn2_w_gu, ffn2_w_down, ple_norm, ple_w_gate, ple_w_proj, final_norm)
    bp = x_prompt.shape[0]
    zero_gla = jnp.zeros((N_GLA, bp, GLA_HEADS, GLA_DK, GLA_DV), jnp.float32)
    zero_hgrn = jnp.zeros((N_HGRN, bp, HGRN_HEADS, HGRN_DF, HGRN_DI), jnp.float32)
    y_prompt, gla_prompt, hgrn_prompt = trunk(x_prompt, p_prompt, zero_gla, zero_hgrn, *weights)
    y_sample, gla_sample, hgrn_sample = trunk(x_sample, p_sample, state_gla, state_hgrn, *weights)
    return (y_prompt, y_sample, gla_prompt, gla_sample, hgrn_prompt, hgrn_sample)
```

```cpp
#include <hip/hip_runtime.h>
#include <cstdio>
#include <cstdint>
#ifndef MK_N_LAUNCHES
#define MK_N_LAUNCHES 1
#endif
namespace pg8 {
#define PG8_LAS __attribute__((address_space(3)))
typedef unsigned short bf16_t;
typedef short bf16x8 __attribute__((ext_vector_type(8)));
typedef float f32x4 __attribute__((ext_vector_type(4)));
typedef unsigned u32x4 __attribute__((ext_vector_type(4)));
constexpr int BM = 256, BK = 64, HALF = 128, HTB = HALF * BK * 2  , STAGE_BYTES = 8 * HTB, NXCD = 8, WGM = 8;

__host__ __device__ __forceinline__ int lds_byte(int r, int c) { const int st = (r >> 4) * 2 + (c >> 5), rr = r & 15, cc = c & 31, ob = rr * 64 + cc * 2; return st * 1024 + (ob ^ (((ob >> 9) & 1) << 5)); }
__host__ __device__ __forceinline__ void stage_rc(int b, int& R, int& C) { const int st = b / 1024, sb = b % 1024, swz = sb ^ (((sb >> 9) & 1) << 5); R = (st >> 1) * 16 + swz / 64; C = (st & 1) * 32 + (swz % 64) / 2; }
__host__ __device__ __forceinline__ int perm32(int rho) { const int n = rho >> 4, i = rho & 15; return 8 * (i >> 2) + 4 * n + (i & 3); }

struct Unit { int pm, pn; };
struct Gemm { const bf16_t* A; const bf16_t* Bt; int M, N, K; };

struct StaticOrder {
    int nM, nN, nwg, G, c;
    __host__ __device__ void init(int M, int N, int G_, int c_) { nM = M / BM; nN = N / BM; nwg = nM * nN; G = G_; c = c_; }
    __host__ __device__ bool next(int i, Unit& u) const {
        const long L = (long)i * G + c; if (L >= nwg) return false;
        int wgid = (int)L; { const int q = nwg / NXCD, r = nwg % NXCD, xcd = wgid % NXCD, off = wgid / NXCD; wgid = (xcd < r ? xcd * (q + 1) : r * (q + 1) + (xcd - r) * q) + off; }
        const int nig = WGM * nN, gid = wgid / nig, fm = gid * WGM, gsz = (nM - fm) < WGM ? (nM - fm) : WGM;
        u.pm = fm + ((wgid % nig) % gsz); u.pn = (wgid % nig) / gsz; return true;
    }
    __device__ __forceinline__ void a_ready(const Unit&) const {}
    __device__ __forceinline__ void done(const Unit&) const {}
};

__device__ __forceinline__ unsigned cvt_pk_bf16(float lo, float hi) { unsigned r; asm volatile("v_cvt_pk_bf16_f32 %0, %1, %2" : "=v"(r) : "v"(lo), "v"(hi)); return r; }
typedef float f32x2 __attribute__((ext_vector_type(2)));
typedef unsigned u32x2 __attribute__((ext_vector_type(2)));
__device__ __forceinline__ float row_scale(const float* rs, int row) {
    const f32x4* p = (const f32x4*)(rs + (size_t)row * 16);
    const f32x4 a = p[0], b = p[1], c = p[2], d = p[3];
    const float s = ((a[0] + a[1]) + (a[2] + a[3])) + ((b[0] + b[1]) + (b[2] + b[3])) + ((c[0] + c[1]) + (c[2] + c[3])) + ((d[0] + d[1]) + (d[2] + d[3]));
    return rsqrtf(s * (1.0f / 1024.0f) + 1e-6f);
}
__device__ __forceinline__ float sigm(float x) { return __builtin_amdgcn_rcpf(1.0f + __expf(-x)); }
struct EpiSwiglu {
    static constexpr bool PERM = true, AFTER_DRAIN = false;
    bf16_t* O; int ldc; const float* rs;
    __device__ __forceinline__ void operator()(const f32x4 (&acc)[2][2][4][2], const Unit& u, int wr, int wc, int fr_, int fq_) const {
        int ln_ = fr_ + 16 * fq_; asm volatile("" : "+v"(ln_)); const int fr = ln_ & 15, fq = ln_ >> 4;
        const int row0 = u.pm * BM + wr * 64 + fr, col0 = u.pn * HALF + wc * 32 + 8 * fq;
#pragma unroll
        for (int ai = 0; ai < 2; ++ai)
#pragma unroll
            for (int m = 0; m < 4; ++m) { const int row = row0 + ai * HALF + m * 16; const float s = row_scale(rs, row);
                float o[8];
#pragma unroll
                for (int n = 0; n < 2; ++n)
#pragma unroll
                    for (int i = 0; i < 4; ++i) { const float g = acc[ai][0][m][n][i] * s, up = acc[ai][1][m][n][i] * s; o[n * 4 + i] = g * sigm(g) * up; }
                u32x4 w; w.x = cvt_pk_bf16(o[0], o[1]); w.y = cvt_pk_bf16(o[2], o[3]); w.z = cvt_pk_bf16(o[4], o[5]); w.w = cvt_pk_bf16(o[6], o[7]);
                *(u32x4*)(O + (size_t)row * ldc + col0) = w; }
    }
};
struct EpiZ {
    static constexpr bool PERM = true, AFTER_DRAIN = false;
    bf16_t* Z; int ldz; const float* rs; float* R; int r_tile;
    __device__ __forceinline__ void operator()(const f32x4 (&acc)[2][2][4][2], const Unit& u, int wr, int wc, int fr_, int fq_) const {
        int ln_ = fr_ + 16 * fq_; asm volatile("" : "+v"(ln_)); const int fr = ln_ & 15, fq = ln_ >> 4;
        const int row0 = u.pm * BM + wr * 64 + fr, col0 = u.pn * BM + wc * 32 + 8 * fq;
        if (u.pn == r_tile) {
            if (wc == 0 && fq < 2) {
#pragma unroll
                for (int ai = 0; ai < 2; ++ai)
#pragma unroll
                    for (int m = 0; m < 4; ++m) { const int row = row0 + ai * HALF + m * 16; const float s = row_scale(rs, row);
#pragma unroll
                        for (int n = 0; n < 2; ++n) *(f32x4*)(R + (size_t)row * 16 + 8 * fq + 4 * n) = acc[ai][0][m][n] * s; }
            }
            return;
        }
#pragma unroll
        for (int ai = 0; ai < 2; ++ai)
#pragma unroll
            for (int m = 0; m < 4; ++m) { const int row = row0 + ai * HALF + m * 16; const float s = row_scale(rs, row);
#pragma unroll
                for (int bj = 0; bj < 2; ++bj) { const f32x4 v0 = acc[ai][bj][m][0] * s, v1 = acc[ai][bj][m][1] * s;
                    u32x4 w; w.x = cvt_pk_bf16(v0[0], v0[1]); w.y = cvt_pk_bf16(v0[2], v0[3]); w.z = cvt_pk_bf16(v1[0], v1[1]); w.w = cvt_pk_bf16(v1[2], v1[3]);
                    *(u32x4*)(Z + (size_t)row * ldz + col0 + bj * HALF) = w; } }
    }
};
struct EpiResid {
    static constexpr bool PERM = false, AFTER_DRAIN = false;
    float* h; bf16_t* hb; float* rs_out; float alpha;
    __device__ __forceinline__ void operator()(const f32x4 (&acc)[2][2][4][2], const Unit& u, int wr, int wc, int fr_, int fq_) const {
        int ln_ = fr_ + 16 * fq_; asm volatile("" : "+v"(ln_)); const int fr = ln_ & 15, fq = ln_ >> 4;
        const int row0 = u.pm * BM + wr * 64 + fr, col0 = u.pn * BM + wc * 32 + 4 * fq;
#pragma unroll
        for (int ai = 0; ai < 2; ++ai)
#pragma unroll
            for (int m = 0; m < 4; ++m) { const int row = row0 + ai * HALF + m * 16; float ss = 0.f;
#pragma unroll
                for (int bj = 0; bj < 2; ++bj)
#pragma unroll
                    for (int n = 0; n < 2; ++n) { const size_t off = (size_t)row * 1024 + col0 + bj * HALF + n * 16;
                        const f32x4 o = *(const f32x4*)(h + off) + acc[ai][bj][m][n] * alpha; *(f32x4*)(h + off) = o;
                        ss += (o[0] * o[0] + o[1] * o[1]) + (o[2] * o[2] + o[3] * o[3]);
                        u32x2 w; w.x = cvt_pk_bf16(o[0], o[1]); w.y = cvt_pk_bf16(o[2], o[3]); *(u32x2*)(hb + off) = w; }
                ss += __shfl_xor(ss, 16); ss += __shfl_xor(ss, 32);
                if (fq == 0) rs_out[(size_t)row * 16 + u.pn * 4 + wc] = ss; }
    }
};
struct EpiStoreF32 {
    static constexpr bool PERM = false, AFTER_DRAIN = false;
    float* O;
    __device__ __forceinline__ void operator()(const f32x4 (&acc)[2][2][4][2], const Unit& u, int wr, int wc, int fr_, int fq_) const {
        int ln_ = fr_ + 16 * fq_; asm volatile("" : "+v"(ln_)); const int fr = ln_ & 15, fq = ln_ >> 4;
        const int row0 = u.pm * BM + wr * 64 + fr, col0 = u.pn * BM + wc * 32 + 4 * fq;
#pragma unroll
        for (int ai = 0; ai < 2; ++ai)
#pragma unroll
            for (int m = 0; m < 4; ++m)
#pragma unroll
                for (int bj = 0; bj < 2; ++bj)
#pragma unroll
                    for (int n = 0; n < 2; ++n) *(f32x4*)(O + (size_t)(row0 + ai * HALF + m * 16) * 1024 + col0 + bj * HALF + n * 16) = acc[ai][bj][m][n];
    }
};
struct EpiPle {
    static constexpr bool PERM = false, AFTER_DRAIN = false;
    float* h; bf16_t* hb; const float* rs_in; float* rs_out; const float* pp;
    __device__ __forceinline__ void operator()(const f32x4 (&acc)[2][2][4][2], const Unit& u, int wr, int wc, int fr_, int fq_) const {
        int ln_ = fr_ + 16 * fq_; asm volatile("" : "+v"(ln_)); const int fr = ln_ & 15, fq = ln_ >> 4;
        const int row0 = u.pm * BM + wr * 64 + fr, col0 = u.pn * BM + wc * 32 + 4 * fq;
#pragma unroll
        for (int ai = 0; ai < 2; ++ai)
#pragma unroll
            for (int m = 0; m < 4; ++m) { const int row = row0 + ai * HALF + m * 16; const float s = row_scale(rs_in, row); float ss = 0.f;
#pragma unroll
                for (int bj = 0; bj < 2; ++bj)
#pragma unroll
                    for (int n = 0; n < 2; ++n) { const size_t off = (size_t)row * 1024 + col0 + bj * HALF + n * 16;
                        const f32x4 a = acc[ai][bj][m][n] * s, p = *(const f32x4*)(pp + off); f32x4 o = *(const f32x4*)(h + off);
                        o[0] += sigm(a[0]) * p[0]; o[1] += sigm(a[1]) * p[1]; o[2] += sigm(a[2]) * p[2]; o[3] += sigm(a[3]) * p[3];
                        *(f32x4*)(h + off) = o; ss += (o[0] * o[0] + o[1] * o[1]) + (o[2] * o[2] + o[3] * o[3]);
                        u32x2 w; w.x = cvt_pk_bf16(o[0], o[1]); w.y = cvt_pk_bf16(o[2], o[3]); *(u32x2*)(hb + off) = w; }
                ss += __shfl_xor(ss, 16); ss += __shfl_xor(ss, 32);
                if (fq == 0) rs_out[(size_t)row * 16 + u.pn * 4 + wc] = ss; }
    }
};
template <class Epi, class Sched, bool ALIGN_EPI = false, bool SP2 = false>
__device__ __forceinline__ void gemm_phase(PG8_LAS unsigned char* lds, const Gemm g, const Sched& S, const Epi& E, const int tid) {
    const int wid = __builtin_amdgcn_readfirstlane(tid >> 6), lane = tid & 63, wr = wid >> 2, wc = wid & 3, fr = lane & 15, fq = lane >> 4;
    const int K = g.K, nt = K / BK;
    unsigned voffA[2], voffB[2];
#pragma unroll
    for (int i = 0; i < 2; ++i) { int R, C; stage_rc(tid * 16 + i * 8192, R, C); const int Rb = Epi::PERM ? ((R & ~31) + perm32(R & 31)) : R;
        voffA[i] = (unsigned)(R * K + C) * 2u; voffB[i] = (unsigned)(Rb * K + C) * 2u; }
    const size_t kstep = (size_t)(BK * 2);
    const size_t hstep = (size_t)HALF * K * 2;
    const size_t tstep = 2 * hstep;
    const unsigned ldsw = (unsigned)wid * 1024u;
    const int aoff = lds_byte(wr * 64 + fr, fq * 8), boff = lds_byte(wc * 32 + fr, fq * 8);
#define PG8_SA(b, h) (((b) * 2 + (h)) * HTB)
#define PG8_SB(b, h) ((4 + (b) * 2 + (h)) * HTB)
#define PG8_STAGE(bufoff, gbase, voff) do { _Pragma("unroll") for (int _i = 0; _i < 2; ++_i) \
        __builtin_amdgcn_global_load_lds((const unsigned*)((const char*)(gbase) + (voff)[_i]), (PG8_LAS unsigned*)(lds + (bufoff) + ldsw + _i * 8192), 16, 0, 0); } while (0)
#define PG8_LDA(dst, b, h) do { _Pragma("unroll") for (int m = 0; m < 4; ++m) _Pragma("unroll") for (int k = 0; k < 2; ++k) dst[m][k] = *(const PG8_LAS bf16x8*)(lds + PG8_SA(b, h) + aoff + m * 2048 + k * 1024); } while (0)
#define PG8_LDB(dst, b, h) do { _Pragma("unroll") for (int n = 0; n < 2; ++n) _Pragma("unroll") for (int k = 0; k < 2; ++k) dst[n][k] = *(const PG8_LAS bf16x8*)(lds + PG8_SB(b, h) + boff + n * 2048 + k * 1024); } while (0)
#define PG8_MMA(ai, bj, At, Bt) do { __builtin_amdgcn_s_setprio(1); _Pragma("unroll") for (int m = 0; m < 4; ++m) _Pragma("unroll") for (int n = 0; n < 2; ++n) _Pragma("unroll") for (int k = 0; k < 2; ++k) \
        acc[ai][bj][m][n] = __builtin_amdgcn_mfma_f32_16x16x32_bf16(Bt[n][k], At[m][k], acc[ai][bj][m][n], 0, 0, 0); __builtin_amdgcn_s_setprio(0); } while (0)
#define PG8_WAIT_V(n) asm volatile("s_waitcnt vmcnt(" #n ")" ::: "memory")
#define PG8_WAIT_L(n) asm volatile("s_waitcnt lgkmcnt(" #n ")" ::: "memory")
#define PG8_BAR __builtin_amdgcn_s_barrier()
#define PG8_SCHED __builtin_amdgcn_sched_barrier(0)
    Unit cur, nxt; int ui = 0;
    if (!S.next(0, cur)) return;
    f32x4 acc[2][2][4][2];
#pragma unroll
    for (int a = 0; a < 2; ++a)
#pragma unroll
        for (int b = 0; b < 2; ++b)
#pragma unroll
            for (int m = 0; m < 4; ++m)
#pragma unroll
                for (int n = 0; n < 2; ++n) acc[a][b][m][n] = (f32x4){0.f, 0.f, 0.f, 0.f};
    bf16x8 At[4][2], B0[2][2], B1[2][2];
    const char* cA = (const char*)g.A + (size_t)cur.pm * tstep; const char* cB = (const char*)g.Bt + (size_t)cur.pn * tstep;
    S.a_ready(cur);
    if constexpr (SP2) {
        PG8_STAGE(PG8_SB(0, 0), cB, voffB); PG8_STAGE(PG8_SB(0, 1), cB + hstep, voffB); PG8_STAGE(PG8_SA(0, 0), cA, voffA); PG8_STAGE(PG8_SA(0, 1), cA + hstep, voffA);
        if (wr == 1) PG8_BAR;
        PG8_WAIT_V(2); PG8_BAR;
        PG8_STAGE(PG8_SB(1, 0), cB + kstep, voffB); PG8_STAGE(PG8_SA(1, 0), cA + kstep, voffA); PG8_STAGE(PG8_SB(1, 1), cB + hstep + kstep, voffB);
        PG8_WAIT_V(6); PG8_BAR;
    } else {
        PG8_STAGE(PG8_SB(0, 0), cB, voffB); PG8_STAGE(PG8_SA(0, 0), cA, voffA); PG8_STAGE(PG8_SB(0, 1), cB + hstep, voffB); PG8_STAGE(PG8_SA(0, 1), cA + hstep, voffA);
        if (wr == 1) PG8_BAR;
        PG8_WAIT_V(4); PG8_BAR;
        PG8_STAGE(PG8_SB(1, 0), cB + kstep, voffB); PG8_STAGE(PG8_SA(1, 0), cA + kstep, voffA); PG8_STAGE(PG8_SB(1, 1), cB + hstep + kstep, voffB);
        PG8_WAIT_V(6); PG8_BAR;
    }
    for (;;) {
        const bool has_next = S.next(ui + 1, nxt);
        const char* nA = has_next ? (const char*)g.A + (size_t)nxt.pm * tstep : cA; const char* nB = has_next ? (const char*)g.Bt + (size_t)nxt.pn * tstep : cB;
        for (int t = 0; t < nt; t += 2) {
            const bool last = (t == nt - 2);
            const char* a1 = cA + (size_t)(t + 1) * kstep;
            const char* a2 = last ? nA : cA + (size_t)(t + 2) * kstep; const char* b2 = last ? nB : cB + (size_t)(t + 2) * kstep;
            const char* a3 = a2 + kstep; const char* b3 = b2 + kstep;
            if (last && has_next) S.a_ready(nxt);
            if constexpr (SP2) {
            PG8_LDB(B0, 0, 0); PG8_LDB(B1, 0, 1); PG8_SCHED; PG8_LDA(At, 0, 0); PG8_STAGE(PG8_SA(1, 1), a1 + hstep, voffA);
            PG8_WAIT_V(8); PG8_WAIT_L(0); PG8_BAR; PG8_MMA(0, 0, At, B0); PG8_MMA(0, 1, At, B1); PG8_BAR; PG8_SCHED;
            PG8_LDA(At, 0, 1); PG8_STAGE(PG8_SB(0, 0), b2, voffB); PG8_STAGE(PG8_SB(0, 1), b2 + hstep, voffB); PG8_STAGE(PG8_SA(0, 0), a2, voffA);
            PG8_WAIT_V(8); PG8_WAIT_L(0); PG8_BAR; PG8_MMA(1, 0, At, B0); PG8_MMA(1, 1, At, B1); PG8_BAR; PG8_SCHED;
            PG8_LDB(B0, 1, 0); PG8_LDB(B1, 1, 1); PG8_SCHED; PG8_LDA(At, 1, 0); PG8_STAGE(PG8_SA(0, 1), a2 + hstep, voffA);
            PG8_WAIT_V(8); PG8_WAIT_L(0); PG8_BAR; PG8_MMA(0, 0, At, B0); PG8_MMA(0, 1, At, B1); PG8_BAR; PG8_SCHED;
            PG8_LDA(At, 1, 1); PG8_STAGE(PG8_SB(1, 0), b3, voffB); PG8_STAGE(PG8_SB(1, 1), b3 + hstep, voffB); PG8_STAGE(PG8_SA(1, 0), a3, voffA);
            PG8_WAIT_V(8); PG8_WAIT_L(0); PG8_BAR; PG8_MMA(1, 0, At, B0); PG8_MMA(1, 1, At, B1); PG8_BAR; PG8_SCHED;
            } else {
            PG8_LDB(B0, 0, 0); PG8_SCHED; PG8_LDA(At, 0, 0); PG8_STAGE(PG8_SA(1, 1), a1 + hstep, voffA);
            PG8_WAIT_L(8); PG8_BAR; PG8_WAIT_L(0); PG8_MMA(0, 0, At, B0); PG8_BAR; PG8_SCHED;
            PG8_LDB(B1, 0, 1); PG8_STAGE(PG8_SB(0, 0), b2, voffB);
            PG8_BAR; PG8_WAIT_L(0); PG8_MMA(0, 1, At, B1); PG8_BAR;
            PG8_LDA(At, 0, 1); PG8_STAGE(PG8_SA(0, 0), a2, voffA);
            PG8_BAR; PG8_WAIT_L(0); PG8_MMA(1, 0, At, B0); PG8_BAR; PG8_SCHED;
            PG8_STAGE(PG8_SB(0, 1), b2 + hstep, voffB);
            PG8_WAIT_V(6); PG8_BAR; PG8_MMA(1, 1, At, B1); PG8_BAR;
            PG8_LDB(B0, 1, 0); PG8_SCHED; PG8_LDA(At, 1, 0); PG8_STAGE(PG8_SA(0, 1), a2 + hstep, voffA);
            PG8_WAIT_L(8); PG8_BAR; PG8_WAIT_L(0); PG8_MMA(0, 0, At, B0); PG8_BAR; PG8_SCHED;
            PG8_LDB(B1, 1, 1); PG8_STAGE(PG8_SB(1, 0), b3, voffB);
            PG8_BAR; PG8_WAIT_L(0); PG8_MMA(0, 1, At, B1); PG8_BAR;
            PG8_LDA(At, 1, 1); PG8_STAGE(PG8_SA(1, 0), a3, voffA);
            PG8_BAR; PG8_WAIT_L(0); PG8_MMA(1, 0, At, B0); PG8_BAR; PG8_SCHED;
            PG8_STAGE(PG8_SB(1, 1), b3 + hstep, voffB);
            PG8_WAIT_V(6); PG8_BAR; PG8_MMA(1, 1, At, B1); PG8_BAR;
            }
        }
        if constexpr (ALIGN_EPI) { if (wr == 0) PG8_BAR; }
        if constexpr (!Epi::AFTER_DRAIN) { E(acc, cur, wr, wc, fr, fq); S.done(cur); }
        if (!has_next) break;
#pragma unroll
        for (int a = 0; a < 2; ++a)
#pragma unroll
            for (int b = 0; b < 2; ++b)
#pragma unroll
                for (int m = 0; m < 4; ++m)
#pragma unroll
                    for (int n = 0; n < 2; ++n) acc[a][b][m][n] = (f32x4){0.f, 0.f, 0.f, 0.f};
        cur = nxt; cA = nA; cB = nB; ++ui;
        if constexpr (ALIGN_EPI) { if (wr == 1) PG8_BAR; }
    }
    PG8_WAIT_V(0);
    if constexpr (!ALIGN_EPI) { if (wr == 0) PG8_BAR; }
    PG8_BAR;
    if constexpr (Epi::AFTER_DRAIN) { E.fused(acc, cur, wr, wc, fr, fq, lds, wid, lane); S.done(cur); }
#undef PG8_SA
#undef PG8_SB
#undef PG8_STAGE
#undef PG8_LDA
#undef PG8_LDB
#undef PG8_MMA
#undef PG8_WAIT_V
#undef PG8_WAIT_L
#undef PG8_BAR
#undef PG8_SCHED
}
}
#include <hip/hip_cooperative_groups.h>
namespace cg = cooperative_groups;
#define LAS __attribute__((address_space(3)))
typedef unsigned short bf16;
typedef float f32x4 __attribute__((ext_vector_type(4)));
typedef short bf16x8 __attribute__((ext_vector_type(8)));
typedef unsigned v4u __attribute__((ext_vector_type(4)));
typedef unsigned v2u __attribute__((ext_vector_type(2)));
constexpr int D = 1024, NPR = 16384, NSM = 512, M = NPR + NSM, SEQ = 2048, NB = 8, DB = 128, FF = 2816, PLE = 256, NCH = 32;
constexpr int NWAVES = 8, LDS_BYTES = 147456, NPH = 22;
constexpr size_t WGU_SZ = (size_t)5632 * 1024 * 2, WDN_SZ = (size_t)1024 * 2816 * 2, WSQ_SZ = (size_t)1024 * 1024 * 2, WPP_SZ = (size_t)1024 * 256 * 2;
constexpr size_t OFF_WGU = 0, OFF_WDN = OFF_WGU + 4 * WGU_SZ, OFF_WGIN = OFF_WDN + 4 * WDN_SZ, OFF_WHIN = OFF_WGIN + (size_t)3328 * 1024 * 2,
    OFF_WOUT = OFF_WHIN + (size_t)4096 * 1024 * 2, OFF_WPG = OFF_WOUT + 2 * WSQ_SZ, OFF_WPP = OFF_WPG + 2 * WSQ_SZ, OFF_HB = OFF_WPP + 2 * WPP_SZ;
constexpr size_t HB_SZ = (size_t)M * 1024 * 2;
constexpr size_t OFF_BIG = OFF_HB + 2 * HB_SZ, OFF_PB = OFF_BIG + (size_t)M * 4096 * 2, PB_SZ = (size_t)M * 256 * 2, OFF_AB = OFF_PB + 2 * PB_SZ,
    OFF_DB = OFF_AB + (size_t)2048 * 4096 * 2, OFF_RS = OFF_DB + (size_t)2048 * 128 * 4, RS_SZ = (size_t)M * 16 * 4, OFF_R = OFF_RS + 2 * RS_SZ, WS_END = OFF_R + RS_SZ;
constexpr size_t OUT_YS = (size_t)NPR * D, OUT_GP = (size_t)M * D, OUT_GS = OUT_GP + 1048576, OUT_HP = OUT_GS + 16777216, OUT_HS = OUT_HP + 1048576, OUT_END = OUT_HS + 16777216;

__device__ __forceinline__ float bf2f(unsigned short u) { return __uint_as_float((unsigned)u << 16); }
__device__ __forceinline__ float bflo(unsigned u) { return __uint_as_float(u << 16); }
__device__ __forceinline__ float bfhi(unsigned u) { return __uint_as_float(u & 0xffff0000u); }
__device__ __forceinline__ unsigned pk2(float lo, float hi) { return pg8::cvt_pk_bf16(lo, hi); }
__device__ __forceinline__ float sigm(float x) { return __builtin_amdgcn_rcpf(1.0f + __expf(-x)); }
__device__ __forceinline__ float logsig(float x) { return fminf(x, 0.f) - __logf(1.0f + __expf(-fabsf(x))); }
__device__ __forceinline__ float wave_sum(float v) {
#pragma unroll
    for (int o = 1; o < 64; o <<= 1) v += __shfl_xor(v, o);
    return v;
}
#define LDS_WAIT() asm volatile("s_waitcnt lgkmcnt(0)" ::: "memory")

__device__ __forceinline__ void tr_item(const float* W, int Nsrc, int K, bf16* WT, const float* sk, int item, int nblk, int mode, int nvalid, LAS float* scr, int lane) {
    const int kb = item / nblk, nb = item % nblk, k0 = 64 * kb, n0 = 32 * nb;
    int src0 = n0, valid = 32;
    if (mode == 1) { const int pn = n0 >> 8, within = n0 & 255, half = within >> 7, j = within & 127; src0 = half * FF + 128 * pn + j; }
    if (mode == 2) { valid = nvalid - n0; valid = valid < 0 ? 0 : (valid > 32 ? 32 : valid); }
    const int c = lane & 31;
#pragma unroll 8
    for (int i = 0; i < 32; ++i) { const int kk = 2 * i + (lane >> 5); float v = 0.f; if (c < valid) v = W[(size_t)(k0 + kk) * Nsrc + src0 + c]; if (sk) v *= sk[k0 + kk]; scr[kk * 33 + c] = v; }
    LDS_WAIT();
    const int ch = lane & 7;
#pragma unroll
    for (int j = 0; j < 4; ++j) { const int n = (lane >> 3) + 8 * j; const LAS float* s = scr + (8 * ch) * 33 + n;
        v4u o; o.x = pk2(s[0 * 33], s[1 * 33]); o.y = pk2(s[2 * 33], s[3 * 33]); o.z = pk2(s[4 * 33], s[5 * 33]); o.w = pk2(s[6 * 33], s[7 * 33]);
        *(v4u*)(WT + (size_t)(n0 + n) * K + k0 + 8 * ch) = o; }
    LDS_WAIT();
}
struct Args { const float* in[26]; float* out; unsigned char* ws; int ph_lo, ph_hi; };
typedef const Args __attribute__((address_space(4))) CArgs;

__device__ __forceinline__ void prologue(CArgs* a, unsigned char* ws, float* outp, LAS unsigned char* lds, int tid, int bid, int G) {
    const int lane = tid & 63, wave = tid >> 6;
    LAS float* scr = (LAS float*)(lds + wave * 16384);
    const int gw = bid * NWAVES + wave, NGW = G * NWAVES;
    constexpr int I_GU = 16 * 176, I_DN = 44 * 32, I_GIN = 16 * 104, I_HIN = 16 * 128, I_SQ = 16 * 32, I_PP = 4 * 32;
    constexpr int NITEMS = 4 * I_GU + 4 * I_DN + I_GIN + I_HIN + 4 * I_SQ + 2 * I_PP;
    for (int it = gw; it < NITEMS; it += NGW) {
        int r = it;
        if (r < 4 * I_GU) { const int q = r / I_GU, li = q >> 1, f = q & 1; r -= q * I_GU;
            tr_item((f ? a->in[20] : a->in[7]) + (size_t)li * 1024 * 5632, 5632, 1024, (bf16*)(ws + OFF_WGU + q * WGU_SZ), (f ? a->in[19] : a->in[6]) + li * 1024, r, 176, 1, 0, scr, lane); continue; }
        r -= 4 * I_GU;
        if (r < 4 * I_DN) { const int q = r / I_DN, li = q >> 1, f = q & 1; r -= q * I_DN;
            tr_item((f ? a->in[21] : a->in[8]) + (size_t)li * 2816 * 1024, 1024, 2816, (bf16*)(ws + OFF_WDN + q * WDN_SZ), nullptr, r, 32, 0, 0, scr, lane); continue; }
        r -= 4 * I_DN;
        if (r < I_GIN) { tr_item(a->in[10], 3088, 1024, (bf16*)(ws + OFF_WGIN), a->in[9], r, 104, 2, 3088, scr, lane); continue; }
        r -= I_GIN;
        if (r < I_HIN) { tr_item(a->in[15], 4096, 1024, (bf16*)(ws + OFF_WHIN), a->in[9] + 1024, r, 128, 0, 0, scr, lane); continue; }
        r -= I_HIN;
        if (r < I_SQ) { tr_item(a->in[14], 1024, 1024, (bf16*)(ws + OFF_WOUT), nullptr, r, 32, 0, 0, scr, lane); continue; }
        r -= I_SQ;
        if (r < I_SQ) { tr_item(a->in[17], 1024, 1024, (bf16*)(ws + OFF_WOUT + WSQ_SZ), nullptr, r, 32, 0, 0, scr, lane); continue; }
        r -= I_SQ;
        if (r < 2 * I_SQ) { const int li = r / I_SQ; r -= li * I_SQ;
            tr_item(a->in[23] + (size_t)li * 1024 * 1024, 1024, 1024, (bf16*)(ws + OFF_WPG + li * WSQ_SZ), a->in[22] + li * 1024, r, 32, 0, 0, scr, lane); continue; }
        r -= 2 * I_SQ;
        { const int li = r / I_PP; r -= li * I_PP;
            tr_item(a->in[24] + (size_t)li * 256 * 1024, 1024, 256, (bf16*)(ws + OFF_WPP + li * WPP_SZ), nullptr, r, 32, 0, 0, scr, lane); }
    }
    bf16* hb = (bf16*)(ws + OFF_HB); float* rs = (float*)(ws + OFF_RS);
    for (int m = gw; m < M; m += NGW) {
        const float* xr = m < NPR ? a->in[0] + (size_t)m * D : a->in[1] + (size_t)(m - NPR) * D;
        float ss = 0.f;
#pragma unroll
        for (int j = 0; j < 4; ++j) { const f32x4 v = *((const f32x4*)xr + lane + 64 * j); ss += (v[0] * v[0] + v[1] * v[1]) + (v[2] * v[2] + v[3] * v[3]);
            *((f32x4*)(outp + (size_t)m * D) + lane + 64 * j) = v; v2u w; w.x = pk2(v[0], v[1]); w.y = pk2(v[2], v[3]); *((v2u*)(hb + (size_t)m * D) + lane + 64 * j) = w; }
        ss = wave_sum(ss);
        if (lane < 16) rs[(size_t)m * 16 + lane] = lane == 0 ? ss : 0.f;
    }
    const int gt = bid * (NWAVES * 64) + tid, NGT = G * NWAVES * 64;
    for (int e = gt; e < 2 * M * 32; e += NGT) { const int li = e / (M * 32), rem = e % (M * 32), m = rem >> 5, c8 = (rem & 31) * 8;
        const float* src = m < NPR ? a->in[4] + ((size_t)li * NPR + m) * 256 + c8 : a->in[5] + ((size_t)li * NSM + (m - NPR)) * 256 + c8;
        const f32x4 v0 = *(const f32x4*)src, v1 = *(const f32x4*)(src + 4);
        v4u w; w.x = pk2(v0[0], v0[1]); w.y = pk2(v0[2], v0[3]); w.z = pk2(v1[0], v1[1]); w.w = pk2(v1[2], v1[3]);
        *(v4u*)((bf16*)(ws + OFF_PB + li * PB_SZ) + (size_t)m * 256 + c8) = w; }
}
template <bool HG> struct MX {
    static constexpr int H = HG ? 8 : 4, DV = HG ? 128 : 256, LDZ = HG ? 4096 : 3328, KC = HG ? 1024 : 512, VC = HG ? 2048 : 1024, GC = HG ? 3072 : 2048, VR = DV / 64, NVG = DV / 16, NVR = DV / 64;
    static constexpr float scale = HG ? 1.0f : 0.08838834764831845f;
};
template <bool HG> __device__ __forceinline__ void prep_phase(LAS unsigned char* lds, bf16* Z, const float* R, const float* wup, const float* bgk, const float* lowb, bf16* AB, float* DBUF, int tid, int bid, int G) {
    typedef MX<HG> C; constexpr int H = C::H, DV = C::DV, LDZ = C::LDZ, KC = C::KC, VC = C::VC, VR = C::VR, VP = DV + 8, QP = 136;
    LAS float* gl = (LAS float*)lds; LAS float* segs = (LAS float*)(lds + 32768);
    LAS bf16* qe_s = (LAS bf16*)(lds + 34816); LAS bf16* kn_s = (LAS bf16*)(lds + 52224); LAS bf16* kd_s = (LAS bf16*)(lds + 69632); LAS bf16* v_s = (LAS bf16*)(lds + 87040);
    const int t = tid >> 3, cs = tid & 7, j0 = cs * 16, lane = tid & 63, w = tid >> 6;
    for (int unit = bid; unit < NB * H * NCH; unit += G) {
        const int n = unit % NCH, bh = unit / NCH, h = bh % H, b = bh / H;
        const size_t tok0 = (size_t)b * SEQ + 64 * n, m = tok0 + t;
        __syncthreads();
        float lbc[16];
        {
            float g[16];
            if constexpr (!HG) {
                f32x4 r4[4];
#pragma unroll
                for (int i = 0; i < 4; ++i) r4[i] = *(const f32x4*)(R + m * 16 + 4 * i);
#pragma unroll
                for (int q = 0; q < 4; ++q) { const f32x4 bv = *(const f32x4*)(bgk + h * 128 + j0 + 4 * q); g[4 * q] = bv[0]; g[4 * q + 1] = bv[1]; g[4 * q + 2] = bv[2]; g[4 * q + 3] = bv[3]; }
#pragma unroll
                for (int i = 0; i < 16; ++i) { const float ri = r4[i >> 2][i & 3]; const float* wp = wup + i * 512 + h * 128 + j0;
#pragma unroll
                    for (int q = 0; q < 4; ++q) { const f32x4 wv = *(const f32x4*)(wp + 4 * q); g[4 * q] += ri * wv[0]; g[4 * q + 1] += ri * wv[1]; g[4 * q + 2] += ri * wv[2]; g[4 * q + 3] += ri * wv[3]; } }
#pragma unroll
                for (int jj = 0; jj < 16; ++jj) { g[jj] = logsig(g[jj]) * (1.0f / 16.0f); lbc[jj] = 0.f; }
            } else {
                const v4u f0 = *(const v4u*)(Z + m * LDZ + KC + h * 128 + j0), f1 = *(const v4u*)(Z + m * LDZ + KC + h * 128 + j0 + 8);
                const unsigned fw[8] = {f0.x, f0.y, f0.z, f0.w, f1.x, f1.y, f1.z, f1.w};
#pragma unroll
                for (int jj = 0; jj < 16; ++jj) { const float f = (jj & 1) ? bfhi(fw[jj >> 1]) : bflo(fw[jj >> 1]);
                    const float x0 = lowb[h * 128 + j0 + jj], x1 = lowb[1024 + h * 128 + j0 + jj];
                    const float a = logsig(x1 - x0), b2 = logsig(x0 - x1) + logsig(f), mx = fmaxf(a, b2);
                    g[jj] = mx + __logf(1.0f + __expf(-fabsf(a - b2))); lbc[jj] = sigm(x0 - x1); }
            }
#pragma unroll
            for (int q = 0; q < 4; ++q) *(LAS f32x4*)(gl + t * 128 + j0 + 4 * q) = (f32x4){g[4 * q], g[4 * q + 1], g[4 * q + 2], g[4 * q + 3]};
        }
        __syncthreads();
        {
            const int j = tid & 127, sg = tid >> 7; float acc = 0.f;
#pragma unroll
            for (int i = 0; i < 16; ++i) { acc += gl[(16 * sg + i) * 128 + j]; gl[(16 * sg + i) * 128 + j] = acc; }
            segs[sg * 128 + j] = acc;
            __syncthreads();
            float off = 0.f;
            for (int s2 = 0; s2 < sg; ++s2) off += segs[s2 * 128 + j];
            if (sg) {
#pragma unroll
                for (int i = 0; i < 16; ++i) gl[(16 * sg + i) * 128 + j] += off; }
        }
        __syncthreads();
        {
            bf16* qp = Z + m * LDZ + h * 128 + j0; const bf16* kp = Z + m * LDZ + KC + h * 128 + j0;
            const v4u q0 = *(const v4u*)qp, q1 = *(const v4u*)(qp + 8), k0 = *(const v4u*)kp, k1 = *(const v4u*)(kp + 8);
            const unsigned qw[8] = {q0.x, q0.y, q0.z, q0.w, q1.x, q1.y, q1.z, q1.w}, kw[8] = {k0.x, k0.y, k0.z, k0.w, k1.x, k1.y, k1.z, k1.w};
            float bb[16], bl[16];
#pragma unroll
            for (int q = 0; q < 4; ++q) { const f32x4 x = *(const LAS f32x4*)(gl + t * 128 + j0 + 4 * q), y = *(const LAS f32x4*)(gl + 63 * 128 + j0 + 4 * q);
                bb[4 * q] = x[0]; bb[4 * q + 1] = x[1]; bb[4 * q + 2] = x[2]; bb[4 * q + 3] = x[3]; bl[4 * q] = y[0]; bl[4 * q + 1] = y[1]; bl[4 * q + 2] = y[2]; bl[4 * q + 3] = y[3]; }
            float qe[16], kn[16], kd[16];
#pragma unroll
            for (int jj = 0; jj < 16; ++jj) { float qv = (jj & 1) ? bfhi(qw[jj >> 1]) : bflo(qw[jj >> 1]); float kv = (jj & 1) ? bfhi(kw[jj >> 1]) : bflo(kw[jj >> 1]);
                if constexpr (HG) { qv = qv * sigm(qv); kv = lbc[jj] * sigm(-kv); }
                qe[jj] = qv * __expf(bb[jj]) * C::scale; kn[jj] = kv * __expf(-bb[jj]); kd[jj] = kv * __expf(bl[jj] - bb[jj]); }
            v4u o0, o1;
            o0.x = pk2(qe[0], qe[1]); o0.y = pk2(qe[2], qe[3]); o0.z = pk2(qe[4], qe[5]); o0.w = pk2(qe[6], qe[7]); o1.x = pk2(qe[8], qe[9]); o1.y = pk2(qe[10], qe[11]); o1.z = pk2(qe[12], qe[13]); o1.w = pk2(qe[14], qe[15]);
            *(v4u*)qp = o0; *(v4u*)(qp + 8) = o1; *(LAS v4u*)(qe_s + t * QP + j0) = o0; *(LAS v4u*)(qe_s + t * QP + j0 + 8) = o1;
            o0.x = pk2(kn[0], kn[1]); o0.y = pk2(kn[2], kn[3]); o0.z = pk2(kn[4], kn[5]); o0.w = pk2(kn[6], kn[7]); o1.x = pk2(kn[8], kn[9]); o1.y = pk2(kn[10], kn[11]); o1.z = pk2(kn[12], kn[13]); o1.w = pk2(kn[14], kn[15]);
            *(LAS v4u*)(kn_s + t * QP + j0) = o0; *(LAS v4u*)(kn_s + t * QP + j0 + 8) = o1;
            o0.x = pk2(kd[0], kd[1]); o0.y = pk2(kd[2], kd[3]); o0.z = pk2(kd[4], kd[5]); o0.w = pk2(kd[6], kd[7]); o1.x = pk2(kd[8], kd[9]); o1.y = pk2(kd[10], kd[11]); o1.z = pk2(kd[12], kd[13]); o1.w = pk2(kd[14], kd[15]);
            *(LAS v4u*)(kd_s + t * QP + j0) = o0; *(LAS v4u*)(kd_s + t * QP + j0 + 8) = o1;
            if (t == 63) {
#pragma unroll
                for (int q = 0; q < 4; ++q) *(f32x4*)(DBUF + (size_t)unit * 128 + j0 + 4 * q) = (f32x4){__expf(bl[4 * q]), __expf(bl[4 * q + 1]), __expf(bl[4 * q + 2]), __expf(bl[4 * q + 3])}; }
            const bf16* vp = Z + m * LDZ + VC + h * DV + cs * (DV / 8);
#pragma unroll
            for (int q = 0; q < DV / 64; ++q) *(LAS v4u*)(v_s + t * VP + cs * (DV / 8) + 8 * q) = *(const v4u*)(vp + 8 * q);
        }
        __syncthreads();
        {
            const int r = lane & 15, quad = lane >> 4, tb = w >> 1;
#pragma unroll
            for (int e = 0; e < 2; ++e) { const int sb = 2 * (w & 1) + e; f32x4 c = {0.f, 0.f, 0.f, 0.f};
                if (sb <= tb) {
#pragma unroll
                    for (int ks = 0; ks < 4; ++ks) { const bf16x8 av = *(const LAS bf16x8*)(kn_s + (16 * sb + r) * QP + 32 * ks + 8 * quad), bv = *(const LAS bf16x8*)(qe_s + (16 * tb + r) * QP + 32 * ks + 8 * quad);
                        c = __builtin_amdgcn_mfma_f32_16x16x32_bf16(av, bv, c, 0, 0, 0); } }
                const int tc = 16 * tb + r, s0 = 16 * sb + 4 * quad;
                v2u o; o.x = pk2(s0 <= tc ? c[0] : 0.f, s0 + 1 <= tc ? c[1] : 0.f); o.y = pk2(s0 + 2 <= tc ? c[2] : 0.f, s0 + 3 <= tc ? c[3] : 0.f);
                *(v2u*)(AB + (size_t)unit * 4096 + tc * 64 + s0) = o; }
        }
        {
            const int j = tid >> 2, sq = tid & 3; unsigned pw[8];
#pragma unroll
            for (int i = 0; i < 8; ++i) pw[i] = (unsigned)kd_s[(16 * sq + 2 * i) * QP + j] | ((unsigned)kd_s[(16 * sq + 2 * i + 1) * QP + j] << 16);
            bf16* dst = Z + (tok0 + (j >> 1)) * LDZ + KC + h * 128 + (j & 1) * 64 + 16 * sq;
            *(v4u*)dst = (v4u){pw[0], pw[1], pw[2], pw[3]}; *(v4u*)(dst + 8) = (v4u){pw[4], pw[5], pw[6], pw[7]};
        }
        for (int c = tid; c < DV * 4; c += NWAVES * 64) { const int v = c >> 2, sq = c & 3; unsigned pw[8];
#pragma unroll
            for (int i = 0; i < 8; ++i) pw[i] = (unsigned)v_s[(16 * sq + 2 * i) * VP + v] | ((unsigned)v_s[(16 * sq + 2 * i + 1) * VP + v] << 16);
            bf16* dst = Z + (tok0 + v / VR) * LDZ + VC + h * DV + (v % VR) * 64 + 16 * sq;
            *(v4u*)dst = (v4u){pw[0], pw[1], pw[2], pw[3]}; *(v4u*)(dst + 8) = (v4u){pw[4], pw[5], pw[6], pw[7]}; }
    }
}
template <bool HG> __device__ __forceinline__ void scan_stream(const bf16* Z, const bf16* AB, const float* DBUF, bf16* O, float* Sout, int sid, int lane) {
    typedef MX<HG> C; constexpr int H = C::H, DV = C::DV, LDZ = C::LDZ, KC = C::KC, VC = C::VC, VR = C::VR, NVG = C::NVG;
    const int vg = sid % NVG, bh = sid / NVG, h = bh % H, b = bh / H, r = lane & 15, quad = lane >> 4;
    f32x4 S[8];
#pragma unroll
    for (int i = 0; i < 8; ++i) S[i] = (f32x4){0.f, 0.f, 0.f, 0.f};
    const int v = 16 * vg + r;
    for (int n = 0; n < NCH; ++n) {
        const int unit = bh * NCH + n; const size_t tok0 = (size_t)b * SEQ + 64 * n;
        const bf16* vtp = Z + (tok0 + v / VR) * LDZ + VC + h * DV + (v % VR) * 64 + 8 * quad;
        const bf16x8 vb0 = *(const bf16x8*)vtp, vb1 = *(const bf16x8*)(vtp + 32);
        v2u qlo[4][4], qhi[4][4]; bf16x8 af[4][2], kf[8][2]; f32x4 dv[8];
#pragma unroll
        for (int tb = 0; tb < 4; ++tb) { const bf16* qp = Z + (tok0 + 16 * tb + r) * LDZ + h * 128 + 4 * quad;
#pragma unroll
            for (int ks = 0; ks < 4; ++ks) { qlo[tb][ks] = *(const v2u*)(qp + 32 * ks); qhi[tb][ks] = *(const v2u*)(qp + 32 * ks + 16); }
            const bf16* ap = AB + (size_t)unit * 4096 + (16 * tb + r) * 64 + 8 * quad;
            af[tb][0] = *(const bf16x8*)ap; af[tb][1] = *(const bf16x8*)(ap + 32); }
        __builtin_amdgcn_sched_barrier(0);
        bf16x8 sb[4];
#pragma unroll
        for (int ks = 0; ks < 4; ++ks) { v4u p; p.x = pk2(S[2 * ks][0], S[2 * ks][1]); p.y = pk2(S[2 * ks][2], S[2 * ks][3]); p.z = pk2(S[2 * ks + 1][0], S[2 * ks + 1][1]); p.w = pk2(S[2 * ks + 1][2], S[2 * ks + 1][3]);
            sb[ks] = __builtin_bit_cast(bf16x8, p); }
        f32x4 o[4];
#pragma unroll
        for (int tb = 0; tb < 4; ++tb) { o[tb] = (f32x4){0.f, 0.f, 0.f, 0.f};
#pragma unroll
            for (int ks = 0; ks < 4; ++ks)
                o[tb] = __builtin_amdgcn_mfma_f32_16x16x32_bf16(__builtin_bit_cast(bf16x8, ((v4u){qlo[tb][ks].x, qlo[tb][ks].y, qhi[tb][ks].x, qhi[tb][ks].y})), sb[ks], o[tb], 0, 0, 0);
            o[tb] = __builtin_amdgcn_mfma_f32_16x16x32_bf16(af[tb][0], vb0, o[tb], 0, 0, 0);
            o[tb] = __builtin_amdgcn_mfma_f32_16x16x32_bf16(af[tb][1], vb1, o[tb], 0, 0, 0); }
        __builtin_amdgcn_sched_barrier(0);
#pragma unroll
        for (int kb = 0; kb < 8; ++kb) { const int k = 16 * kb + r; const bf16* kp = Z + (tok0 + (k >> 1)) * LDZ + KC + h * 128 + (k & 1) * 64 + 8 * quad;
            kf[kb][0] = *(const bf16x8*)kp; kf[kb][1] = *(const bf16x8*)(kp + 32); }
#pragma unroll
        for (int kb = 0; kb < 8; ++kb) dv[kb] = *(const f32x4*)(DBUF + (size_t)unit * 128 + 16 * kb + 4 * quad);
        __builtin_amdgcn_sched_barrier(0);
#pragma unroll
        for (int tb = 0; tb < 4; ++tb) { bf16* op = O + (tok0 + 16 * tb + 4 * quad) * 1024 + h * DV + 16 * vg + r;
            const unsigned p01 = pk2(o[tb][0], o[tb][1]), p23 = pk2(o[tb][2], o[tb][3]);
            op[0] = (bf16)(p01 & 0xffffu); op[1024] = (bf16)(p01 >> 16); op[2048] = (bf16)(p23 & 0xffffu); op[3072] = (bf16)(p23 >> 16); }
#pragma unroll
        for (int kb = 0; kb < 8; ++kb) { S[kb] = S[kb] * dv[kb];
            S[kb] = __builtin_amdgcn_mfma_f32_16x16x32_bf16(kf[kb][0], vb0, S[kb], 0, 0, 0);
            S[kb] = __builtin_amdgcn_mfma_f32_16x16x32_bf16(kf[kb][1], vb1, S[kb], 0, 0, 0); }
    }
#pragma unroll
    for (int kb = 0; kb < 8; ++kb)
#pragma unroll
        for (int j = 0; j < 4; ++j) Sout[((size_t)bh * 128 + 16 * kb + 4 * quad + j) * DV + v] = S[kb][j];
}
template <bool HG> __device__ __forceinline__ void sample_unit(LAS float* wl, const bf16* Z, const float* R, const float* wup, const float* bgk, const float* lowb, const float* S0, float* Sout, bf16* O, int u, int lane) {
    typedef MX<HG> C; constexpr int H = C::H, DV = C::DV, LDZ = C::LDZ, KC = C::KC, VC = C::VC, NVR = C::NVR;
    const int vr = u % NVR, bh = u / NVR, h = bh % H, b = bh / H; const size_t m0 = (size_t)NPR + 4 * b;
    float pa[10];
#pragma unroll
    for (int i = 0; i < 10; ++i) pa[i] = 0.f;
#pragma unroll
    for (int kk = 0; kk < 2; ++kk) { const int k = lane + 64 * kk, hk = h * 128 + k; float g[4], q[4], kv[4];
#pragma unroll
        for (int t = 0; t < 4; ++t) { const bf16* zr = Z + (m0 + t) * LDZ; q[t] = bf2f(zr[hk]); const float kz = bf2f(zr[KC + hk]);
            if constexpr (!HG) { float x = bgk[hk];
#pragma unroll
                for (int i = 0; i < 16; ++i) x += R[(m0 + t) * 16 + i] * wup[i * 512 + hk];
                g[t] = logsig(x) * (1.0f / 16.0f); kv[t] = kz;
            } else { const float x0 = lowb[hk], x1 = lowb[1024 + hk]; const float a = logsig(x1 - x0), b2 = logsig(x0 - x1) + logsig(kz), mx = fmaxf(a, b2);
                g[t] = mx + __logf(1.0f + __expf(-fabsf(a - b2))); kv[t] = sigm(x0 - x1) * sigm(-kz); q[t] = q[t] * sigm(q[t]); } }
        float bb[4]; bb[0] = g[0]; bb[1] = bb[0] + g[1]; bb[2] = bb[1] + g[2]; bb[3] = bb[2] + g[3];
        float qe[4], kn[4];
#pragma unroll
        for (int t = 0; t < 4; ++t) { qe[t] = q[t] * __expf(bb[t]) * C::scale; kn[t] = kv[t] * __expf(-bb[t]); wl[k * 12 + t] = qe[t]; wl[k * 12 + 4 + t] = kv[t] * __expf(bb[3] - bb[t]); }
        wl[k * 12 + 8] = __expf(bb[3]);
        int idx = 0;
#pragma unroll
        for (int t = 0; t < 4; ++t)
#pragma unroll
            for (int s = 0; s <= t; ++s) pa[idx++] += qe[t] * kn[s];
    }
#pragma unroll
    for (int i = 0; i < 10; ++i) pa[i] = wave_sum(pa[i]);
    float vv[4], o[4];
#pragma unroll
    for (int s = 0; s < 4; ++s) vv[s] = bf2f(Z[(m0 + s) * LDZ + VC + h * DV + 64 * vr + lane]);
    { int idx = 0;
#pragma unroll
        for (int t = 0; t < 4; ++t) { o[t] = 0.f;
#pragma unroll
            for (int s = 0; s <= t; ++s) o[t] += pa[idx++] * vv[s]; } }
    LDS_WAIT();
    const float* sp = S0 + ((size_t)bh * 128) * DV + 64 * vr + lane; float* dp = Sout + ((size_t)bh * 128) * DV + 64 * vr + lane;
#pragma unroll 8
    for (int k = 0; k < 128; ++k) { const float s0 = sp[(size_t)k * DV]; const f32x4 q4 = *(const LAS f32x4*)(wl + k * 12), k4 = *(const LAS f32x4*)(wl + k * 12 + 4); const float d = wl[k * 12 + 8];
        o[0] += q4[0] * s0; o[1] += q4[1] * s0; o[2] += q4[2] * s0; o[3] += q4[3] * s0;
        dp[(size_t)k * DV] = d * s0 + ((k4[0] * vv[0] + k4[1] * vv[1]) + (k4[2] * vv[2] + k4[3] * vv[3])); }
#pragma unroll
    for (int t = 0; t < 4; ++t) O[(m0 + t) * 1024 + h * DV + 64 * vr + lane] = (bf16)(pk2(o[t], 0.f) & 0xffffu);
    LDS_WAIT();
}
template <bool HG> __device__ __forceinline__ void gate_phase(const bf16* Z, bf16* O, const float* gn, int gw, int ngw, int lane) {
    typedef MX<HG> C; constexpr int H = C::H, DV = C::DV, LDZ = C::LDZ, GC = C::GC, E = DV / 64;
    for (int task = gw; task < M * H; task += ngw) { const int m = task / H, h = task % H;
        bf16* op = O + (size_t)m * 1024 + h * DV + E * lane; const bf16* gp = Z + (size_t)m * LDZ + GC + h * DV + E * lane;
        float x[E], g[E];
        if constexpr (E == 4) { const v2u xo = *(const v2u*)op, go = *(const v2u*)gp; x[0] = bflo(xo.x); x[1] = bfhi(xo.x); x[2] = bflo(xo.y); x[3] = bfhi(xo.y); g[0] = bflo(go.x); g[1] = bfhi(go.x); g[2] = bflo(go.y); g[3] = bfhi(go.y); }
        else { const unsigned xo = *(const unsigned*)op, go = *(const unsigned*)gp; x[0] = bflo(xo); x[1] = bfhi(xo); g[0] = bflo(go); g[1] = bfhi(go); }
        float ss = 0.f;
#pragma unroll
        for (int e = 0; e < E; ++e) ss += x[e] * x[e];
        ss = wave_sum(ss); const float rinv = rsqrtf(ss * (1.0f / DV) + 1e-6f);
        float y[E];
#pragma unroll
        for (int e = 0; e < E; ++e) y[e] = x[e] * rinv * gn[E * lane + e] * (g[e] * sigm(g[e]));
        if constexpr (E == 4) { v2u w; w.x = pk2(y[0], y[1]); w.y = pk2(y[2], y[3]); *(v2u*)op = w; } else { *(unsigned*)op = pk2(y[0], y[1]); }
    }
}
#define MK_TID() int wave = wave_s; asm volatile("" : "+s"(wave)); unsigned ones_ = ~0u; asm volatile("" : "+s"(ones_)); \
    const int lane = (int)__builtin_amdgcn_mbcnt_hi(ones_, __builtin_amdgcn_mbcnt_lo(ones_, 0u)); const int tid = wave * 64 + lane; const int gw = bid * NWAVES + wave, NGW = G * NWAVES; (void)gw; (void)NGW; (void)tid; (void)lane
__global__ void __launch_bounds__(NWAVES * 64, 2) fwd_kernel(Args a) {
    extern __shared__ __attribute__((aligned(16))) unsigned char lds_raw[];
    LAS unsigned char* lds = (LAS unsigned char*)lds_raw;
    cg::grid_group grid = cg::this_grid();
    const int wave_s = __builtin_amdgcn_readfirstlane((int)threadIdx.x >> 6);
    const int ph_lo = a.ph_lo, ph_hi = a.ph_hi;
    for (int ph = ph_lo; ph < ph_hi; ++ph) {
        CArgs* ap = (CArgs*)__builtin_amdgcn_kernarg_segment_ptr(); asm volatile("" : "+s"(ap));
        int bid = blockIdx.x; asm volatile("" : "+s"(bid));
        int G = gridDim.x; asm volatile("" : "+s"(G));
        unsigned char* ws = ap->ws; float* hbuf = ap->out;
        if (ph == 0) { MK_TID(); prologue(ap, ws, hbuf, lds, tid, bid, G); }
        else if (ph == NPH - 1) {
            MK_TID(); const float* fw = ap->in[25];
            for (int m = gw; m < M; m += NGW) { f32x4* hr = (f32x4*)(hbuf + (size_t)m * D); f32x4 v[4]; float ss = 0.f;
#pragma unroll
                for (int j = 0; j < 4; ++j) { v[j] = hr[lane + 64 * j]; ss += (v[j][0] * v[j][0] + v[j][1] * v[j][1]) + (v[j][2] * v[j][2] + v[j][3] * v[j][3]); }
                ss = wave_sum(ss); const float rinv = rsqrtf(ss * (1.0f / D) + 1e-6f);
#pragma unroll
                for (int j = 0; j < 4; ++j) { const f32x4 wv = *((const f32x4*)fw + lane + 64 * j); hr[lane + 64 * j] = v[j] * rinv * wv; } }
        } else {
            const int li = (ph - 1) / 10, k = (ph - 1) % 10, cur = li;
            bf16* hb = (bf16*)(ws + OFF_HB + cur * HB_SZ); bf16* ob = (bf16*)(ws + OFF_HB + (cur ^ 1) * HB_SZ);
            float* rs0 = (float*)(ws + OFF_RS); float* rs1 = (float*)(ws + OFF_RS + RS_SZ); float* Rb = (float*)(ws + OFF_R);
            bf16* big = (bf16*)(ws + OFF_BIG);
            if (k == 0 || k == 7) { MK_TID();
                const int f = k == 7; pg8::Gemm g{hb, (const bf16*)(ws + OFF_WGU + (li * 2 + f) * WGU_SZ), M, 2 * FF, D};
                pg8::StaticOrder S; S.init(M, 2 * FF, G, bid); pg8::EpiSwiglu E{big, FF, rs0};
                pg8::gemm_phase<pg8::EpiSwiglu, pg8::StaticOrder, true, true>(lds, g, S, E, tid);
            } else if (k == 1 || k == 8 || k == 6) { MK_TID();
                pg8::Gemm g; float alpha; float* rso;
                if (k == 6) { g = pg8::Gemm{ob, (const bf16*)(ws + OFF_WOUT + li * WSQ_SZ), M, D, D}; alpha = 1.0f; rso = rs0; }
                else { const int f = k == 8; g = pg8::Gemm{big, (const bf16*)(ws + OFF_WDN + (li * 2 + f) * WDN_SZ), M, D, FF}; alpha = 0.5f; rso = rs1; }
                pg8::StaticOrder S; S.init(M, D, G, bid); pg8::EpiResid E{hbuf, hb, rso, alpha};
                pg8::gemm_phase<pg8::EpiResid, pg8::StaticOrder, true, true>(lds, g, S, E, tid);
            } else if (k == 2) { MK_TID();
                const int N = li ? 4096 : 3328; pg8::Gemm g{hb, (const bf16*)(ws + (li ? OFF_WHIN : OFF_WGIN)), M, N, D};
                pg8::StaticOrder S; S.init(M, N, G, bid); pg8::EpiZ E{big, N, rs1, Rb, li ? -1 : 12};
                pg8::gemm_phase<pg8::EpiZ, pg8::StaticOrder, true, true>(lds, g, S, E, tid);
            } else if (k == 3) { MK_TID();
                if (li == 0) prep_phase<false>(lds, big, Rb, ap->in[11], ap->in[12], ap->in[18], (bf16*)(ws + OFF_AB), (float*)(ws + OFF_DB), tid, bid, G);
                else prep_phase<true>(lds, big, Rb, ap->in[11], ap->in[12], ap->in[18], (bf16*)(ws + OFF_AB), (float*)(ws + OFF_DB), tid, bid, G);
            } else if (k == 4) { MK_TID();
                if (wave < 2) {
                    for (int sid = bid * 2 + wave; sid < 512; sid += G * 2) {
                        if (li == 0) scan_stream<false>(big, (const bf16*)(ws + OFF_AB), (const float*)(ws + OFF_DB), ob, hbuf + OUT_GP, sid, lane);
                        else scan_stream<true>(big, (const bf16*)(ws + OFF_AB), (const float*)(ws + OFF_DB), ob, hbuf + OUT_HP, sid, lane);
                    }
                } else {
                    LAS float* wl = (LAS float*)(lds + wave * 8192);
                    for (int u = bid * 6 + (wave - 2); u < 2048; u += G * 6) {
                        if (li == 0) sample_unit<false>(wl, big, Rb, ap->in[11], ap->in[12], ap->in[18], ap->in[2], hbuf + OUT_GS, ob, u, lane);
                        else sample_unit<true>(wl, big, Rb, ap->in[11], ap->in[12], ap->in[18], ap->in[3], hbuf + OUT_HS, ob, u, lane);
                    }
                }
            } else if (k == 5) { MK_TID();
                if (li == 0) gate_phase<false>(big, ob, ap->in[13], gw, NGW, lane); else gate_phase<true>(big, ob, ap->in[16], gw, NGW, lane);
            } else { MK_TID();
                float* pp = (float*)(ws + OFF_BIG);
                { pg8::Gemm g{(const bf16*)(ws + OFF_PB + li * PB_SZ), (const bf16*)(ws + OFF_WPP + li * WPP_SZ), M, D, PLE};
                  pg8::StaticOrder S; S.init(M, D, G, bid); pg8::EpiStoreF32 E{pp};
                  pg8::gemm_phase<pg8::EpiStoreF32, pg8::StaticOrder, true, true>(lds, g, S, E, tid); }
                { int tid2 = tid; asm volatile("" : "+v"(tid2));
                  pg8::Gemm g{hb, (const bf16*)(ws + OFF_WPG + li * WSQ_SZ), M, D, D};
                  pg8::StaticOrder S; S.init(M, D, G, bid); pg8::EpiPle E{hbuf, ob, rs1, rs0, pp};
                  pg8::gemm_phase<pg8::EpiPle, pg8::StaticOrder, true, true>(lds, g, S, E, tid2); }
            }
        }
        if (ph + 1 < ph_hi) grid.sync();
    }
}

extern "C" void kernel_launch(void* const* d_in, const int* in_sizes, int n_in, void* d_out, int out_size, void* d_ws, size_t ws_size, hipStream_t stream) {
    static int grid = 0;
    if (grid == 0) {
        if (n_in != 26 || (size_t)out_size != OUT_END || ws_size < WS_END) { fprintf(stderr, "kernel_launch: unexpected shapes (n_in %d out %d ws %zu need %zu); nothing launched\n", n_in, out_size, ws_size, (size_t)WS_END); grid = -1; return; }
        int dev = 0, cus = 0, per_cu = 0;
        if (hipGetDevice(&dev) != hipSuccess || hipDeviceGetAttribute(&cus, hipDeviceAttributeMultiprocessorCount, dev) != hipSuccess) { grid = -1; return; }
        if (hipFuncSetAttribute((const void*)fwd_kernel, hipFuncAttributeMaxDynamicSharedMemorySize, LDS_BYTES) != hipSuccess) { fprintf(stderr, "kernel_launch: hipFuncSetAttribute failed\n"); grid = -1; return; }
        if (hipOccupancyMaxActiveBlocksPerMultiprocessor(&per_cu, (const void*)fwd_kernel, NWAVES * 64, LDS_BYTES) != hipSuccess || per_cu < 1) per_cu = 1;
        (void)hipGetLastError();
        grid = cus * per_cu;
    }
    if (grid < 0) return;
    Args a{};
    for (int i = 0; i < 26; ++i) a.in[i] = (const float*)d_in[i];
    a.out = (float*)d_out; a.ws = (unsigned char*)d_ws;
#if MK_N_LAUNCHES == 1
    a.ph_lo = 0; a.ph_hi = NPH;
    void* args[] = {&a};
    hipError_t e = hipLaunchCooperativeKernel((const void*)fwd_kernel, dim3(grid), dim3(NWAVES * 64), args, LDS_BYTES, stream);
    if (e != hipSuccess) fprintf(stderr, "kernel_launch: cooperative launch failed: %s (grid %d)\n", hipGetErrorString(e), grid);
#else
    for (int ph = 0; ph < NPH; ++ph) { a.ph_lo = ph; a.ph_hi = ph + 1; hipLaunchKernelGGL(fwd_kernel, dim3(grid), dim3(NWAVES * 64), LDS_BYTES, stream, a); }
#endif
}
```

```cpp
#include <hip/hip_runtime.h>
#include <cstdio>
#include <cstdint>
#ifndef MK_N_LAUNCHES
#define MK_N_LAUNCHES 1
#endif
#ifndef PROBE_MODE
#define PROBE_MODE 0
#endif
namespace pg8 {
#define PG8_LAS __attribute__((address_space(3)))
typedef unsigned short bf16_t;
typedef short bf16x8 __attribute__((ext_vector_type(8)));
typedef float f32x4 __attribute__((ext_vector_type(4)));
typedef unsigned u32x4 __attribute__((ext_vector_type(4)));
constexpr int BM = 256, BK = 64, HALF = 128, HTB = HALF * BK * 2  , STAGE_BYTES = 8 * HTB, NXCD = 8, WGM = 8;

__host__ __device__ __forceinline__ int lds_byte(int r, int c) { const int st = (r >> 4) * 2 + (c >> 5), rr = r & 15, cc = c & 31, ob = rr * 64 + cc * 2; return st * 1024 + (ob ^ (((ob >> 9) & 1) << 5)); }
__host__ __device__ __forceinline__ void stage_rc(int b, int& R, int& C) { const int st = b / 1024, sb = b % 1024, swz = sb ^ (((sb >> 9) & 1) << 5); R = (st >> 1) * 16 + swz / 64; C = (st & 1) * 32 + (swz % 64) / 2; }
__host__ __device__ __forceinline__ int perm32(int rho) { const int n = rho >> 4, i = rho & 15; return 8 * (i >> 2) + 4 * n + (i & 3); }

struct Unit { int pm, pn; };
struct Gemm { const bf16_t* A; const bf16_t* Bt; int M, N, K; };

struct StaticOrder {
    int nM, nN, nwg, G, c;
    __host__ __device__ void init(int M, int N, int G_, int c_) { nM = M / BM; nN = N / BM; nwg = nM * nN; G = G_; c = c_; }
    __host__ __device__ bool next(int i, Unit& u) const {
        const long L = (long)i * G + c; if (L >= nwg) return false;
        int wgid = (int)L; { const int q = nwg / NXCD, r = nwg % NXCD, xcd = wgid % NXCD, off = wgid / NXCD; wgid = (xcd < r ? xcd * (q + 1) : r * (q + 1) + (xcd - r) * q) + off; }
        const int nig = WGM * nN, gid = wgid / nig, fm = gid * WGM, gsz = (nM - fm) < WGM ? (nM - fm) : WGM;
        u.pm = fm + ((wgid % nig) % gsz); u.pn = (wgid % nig) / gsz; return true;
    }
    __device__ __forceinline__ void a_ready(const Unit&) const {}
    __device__ __forceinline__ void done(const Unit&) const {}
};

__device__ __forceinline__ unsigned cvt_pk_bf16(float lo, float hi) { unsigned r; asm volatile("v_cvt_pk_bf16_f32 %0, %1, %2" : "=v"(r) : "v"(lo), "v"(hi)); return r; }
typedef float f32x2 __attribute__((ext_vector_type(2)));
typedef unsigned u32x2 __attribute__((ext_vector_type(2)));
__device__ __forceinline__ float row_scale(const float* rs, int row) {
    const f32x4* p = (const f32x4*)(rs + (size_t)row * 16);
    const f32x4 a = p[0], b = p[1], c = p[2], d = p[3];
    const float s = ((a[0] + a[1]) + (a[2] + a[3])) + ((b[0] + b[1]) + (b[2] + b[3])) + ((c[0] + c[1]) + (c[2] + c[3])) + ((d[0] + d[1]) + (d[2] + d[3]));
    return rsqrtf(s * (1.0f / 1024.0f) + 1e-6f);
}
__device__ __forceinline__ float sigm(float x) { return __builtin_amdgcn_rcpf(1.0f + __expf(-x)); }
struct EpiSwiglu {
    static constexpr bool PERM = true, AFTER_DRAIN = false;
    bf16_t* O; int ldc; const float* rs;
    __device__ __forceinline__ void operator()(const f32x4 (&acc)[2][2][4][2], const Unit& u, int wr, int wc, int fr_, int fq_) const {
        int ln_ = fr_ + 16 * fq_; asm volatile("" : "+v"(ln_)); const int fr = ln_ & 15, fq = ln_ >> 4;
        const int row0 = u.pm * BM + wr * 64 + fr, col0 = u.pn * HALF + wc * 32 + 8 * fq;
#pragma unroll
        for (int ai = 0; ai < 2; ++ai)
#pragma unroll
            for (int m = 0; m < 4; ++m) { const int row = row0 + ai * HALF + m * 16; const float s = row_scale(rs, row);
                float o[8];
#pragma unroll
                for (int n = 0; n < 2; ++n)
#pragma unroll
                    for (int i = 0; i < 4; ++i) { const float g = acc[ai][0][m][n][i] * s, up = acc[ai][1][m][n][i] * s; o[n * 4 + i] = g * sigm(g) * up; }
                u32x4 w; w.x = cvt_pk_bf16(o[0], o[1]); w.y = cvt_pk_bf16(o[2], o[3]); w.z = cvt_pk_bf16(o[4], o[5]); w.w = cvt_pk_bf16(o[6], o[7]);
                *(u32x4*)(O + (size_t)row * ldc + col0) = w; }
    }
};
struct EpiZ {
    static constexpr bool PERM = true, AFTER_DRAIN = false;
    bf16_t* Z; int ldz; const float* rs; float* R; int r_tile;
    __device__ __forceinline__ void operator()(const f32x4 (&acc)[2][2][4][2], const Unit& u, int wr, int wc, int fr_, int fq_) const {
        int ln_ = fr_ + 16 * fq_; asm volatile("" : "+v"(ln_)); const int fr = ln_ & 15, fq = ln_ >> 4;
        const int row0 = u.pm * BM + wr * 64 + fr, col0 = u.pn * BM + wc * 32 + 8 * fq;
        if (u.pn == r_tile) {
            if (wc == 0 && fq < 2) {
#pragma unroll
                for (int ai = 0; ai < 2; ++ai)
#pragma unroll
                    for (int m = 0; m < 4; ++m) { const int row = row0 + ai * HALF + m * 16; const float s = row_scale(rs, row);
#pragma unroll
                        for (int n = 0; n < 2; ++n) *(f32x4*)(R + (size_t)row * 16 + 8 * fq + 4 * n) = acc[ai][0][m][n] * s; }
            }
            return;
        }
#pragma unroll
        for (int ai = 0; ai < 2; ++ai)
#pragma unroll
            for (int m = 0; m < 4; ++m) { const int row = row0 + ai * HALF + m * 16; const float s = row_scale(rs, row);
#pragma unroll
                for (int bj = 0; bj < 2; ++bj) { const f32x4 v0 = acc[ai][bj][m][0] * s, v1 = acc[ai][bj][m][1] * s;
                    u32x4 w; w.x = cvt_pk_bf16(v0[0], v0[1]); w.y = cvt_pk_bf16(v0[2], v0[3]); w.z = cvt_pk_bf16(v1[0], v1[1]); w.w = cvt_pk_bf16(v1[2], v1[3]);
                    *(u32x4*)(Z + (size_t)row * ldz + col0 + bj * HALF) = w; } }
    }
};
struct EpiResid {
    static constexpr bool PERM = false, AFTER_DRAIN = false;
    float* h; bf16_t* hb; float* rs_out; float alpha;
    __device__ __forceinline__ void operator()(const f32x4 (&acc)[2][2][4][2], const Unit& u, int wr, int wc, int fr_, int fq_) const {
        int ln_ = fr_ + 16 * fq_; asm volatile("" : "+v"(ln_)); const int fr = ln_ & 15, fq = ln_ >> 4;
        const int row0 = u.pm * BM + wr * 64 + fr, col0 = u.pn * BM + wc * 32 + 4 * fq;
#pragma unroll
        for (int ai = 0; ai < 2; ++ai)
#pragma unroll
            for (int m = 0; m < 4; ++m) { const int row = row0 + ai * HALF + m * 16; float ss = 0.f;
#pragma unroll
                for (int bj = 0; bj < 2; ++bj)
#pragma unroll
                    for (int n = 0; n < 2; ++n) { const size_t off = (size_t)row * 1024 + col0 + bj * HALF + n * 16;
                        const f32x4 o = *(const f32x4*)(h + off) + acc[ai][bj][m][n] * alpha; *(f32x4*)(h + off) = o;
                        ss += (o[0] * o[0] + o[1] * o[1]) + (o[2] * o[2] + o[3] * o[3]);
                        u32x2 w; w.x = cvt_pk_bf16(o[0], o[1]); w.y = cvt_pk_bf16(o[2], o[3]); *(u32x2*)(hb + off) = w; }
                ss += __shfl_xor(ss, 16); ss += __shfl_xor(ss, 32);
                if (fq == 0) rs_out[(size_t)row * 16 + u.pn * 4 + wc] = ss; }
    }
};
struct EpiStoreF32 {
    static constexpr bool PERM = false, AFTER_DRAIN = false;
    float* O;
    __device__ __forceinline__ void operator()(const f32x4 (&acc)[2][2][4][2], const Unit& u, int wr, int wc, int fr_, int fq_) const {
        int ln_ = fr_ + 16 * fq_; asm volatile("" : "+v"(ln_)); const int fr = ln_ & 15, fq = ln_ >> 4;
        const int row0 = u.pm * BM + wr * 64 + fr, col0 = u.pn * BM + wc * 32 + 4 * fq;
#pragma unroll
        for (int ai = 0; ai < 2; ++ai)
#pragma unroll
            for (int m = 0; m < 4; ++m)
#pragma unroll
                for (int bj = 0; bj < 2; ++bj)
#pragma unroll
                    for (int n = 0; n < 2; ++n) *(f32x4*)(O + (size_t)(row0 + ai * HALF + m * 16) * 1024 + col0 + bj * HALF + n * 16) = acc[ai][bj][m][n];
    }
};
struct EpiPle {
    static constexpr bool PERM = false, AFTER_DRAIN = false;
    float* h; bf16_t* hb; const float* rs_in; float* rs_out; const float* pp;
    __device__ __forceinline__ void operator()(const f32x4 (&acc)[2][2][4][2], const Unit& u, int wr, int wc, int fr_, int fq_) const {
        int ln_ = fr_ + 16 * fq_; asm volatile("" : "+v"(ln_)); const int fr = ln_ & 15, fq = ln_ >> 4;
        const int row0 = u.pm * BM + wr * 64 + fr, col0 = u.pn * BM + wc * 32 + 4 * fq;
#pragma unroll
        for (int ai = 0; ai < 2; ++ai)
#pragma unroll
            for (int m = 0; m < 4; ++m) { const int row = row0 + ai * HALF + m * 16; const float s = row_scale(rs_in, row); float ss = 0.f;
#pragma unroll
                for (int bj = 0; bj < 2; ++bj)
#pragma unroll
                    for (int n = 0; n < 2; ++n) { const size_t off = (size_t)row * 1024 + col0 + bj * HALF + n * 16;
                        const f32x4 a = acc[ai][bj][m][n] * s, p = *(const f32x4*)(pp + off); f32x4 o = *(const f32x4*)(h + off);
                        o[0] += sigm(a[0]) * p[0]; o[1] += sigm(a[1]) * p[1]; o[2] += sigm(a[2]) * p[2]; o[3] += sigm(a[3]) * p[3];
                        *(f32x4*)(h + off) = o; ss += (o[0] * o[0] + o[1] * o[1]) + (o[2] * o[2] + o[3] * o[3]);
                        u32x2 w; w.x = cvt_pk_bf16(o[0], o[1]); w.y = cvt_pk_bf16(o[2], o[3]); *(u32x2*)(hb + off) = w; }
                ss += __shfl_xor(ss, 16); ss += __shfl_xor(ss, 32);
                if (fq == 0) rs_out[(size_t)row * 16 + u.pn * 4 + wc] = ss; }
    }
};
template <class Epi, class Sched, bool ALIGN_EPI = false, bool SP2 = false>
__device__ __forceinline__ void gemm_phase(PG8_LAS unsigned char* lds, const Gemm g, const Sched& S, const Epi& E, const int tid) {
    const int wid = __builtin_amdgcn_readfirstlane(tid >> 6), lane = tid & 63, wr = wid >> 2, wc = wid & 3, fr = lane & 15, fq = lane >> 4;
    const int K = g.K, nt = K / BK;
    unsigned voffA[2], voffB[2];
#pragma unroll
    for (int i = 0; i < 2; ++i) { int R, C; stage_rc(tid * 16 + i * 8192, R, C); const int Rb = Epi::PERM ? ((R & ~31) + perm32(R & 31)) : R;
        voffA[i] = (unsigned)(R * K + C) * 2u; voffB[i] = (unsigned)(Rb * K + C) * 2u; }
    const size_t kstep = (size_t)(BK * 2);
    const size_t hstep = (size_t)HALF * K * 2;
    const size_t tstep = 2 * hstep;
    const unsigned ldsw = (unsigned)wid * 1024u;
    const int aoff = lds_byte(wr * 64 + fr, fq * 8), boff = lds_byte(wc * 32 + fr, fq * 8);
#define PG8_SA(b, h) (((b) * 2 + (h)) * HTB)
#define PG8_SB(b, h) ((4 + (b) * 2 + (h)) * HTB)
#define PG8_STAGE(bufoff, gbase, voff) do { _Pragma("unroll") for (int _i = 0; _i < 2; ++_i) \
        __builtin_amdgcn_global_load_lds((const unsigned*)((const char*)(gbase) + (voff)[_i]), (PG8_LAS unsigned*)(lds + (bufoff) + ldsw + _i * 8192), 16, 0, 0); } while (0)
#define PG8_LDA(dst, b, h) do { _Pragma("unroll") for (int m = 0; m < 4; ++m) _Pragma("unroll") for (int k = 0; k < 2; ++k) dst[m][k] = *(const PG8_LAS bf16x8*)(lds + PG8_SA(b, h) + aoff + m * 2048 + k * 1024); } while (0)
#define PG8_LDB(dst, b, h) do { _Pragma("unroll") for (int n = 0; n < 2; ++n) _Pragma("unroll") for (int k = 0; k < 2; ++k) dst[n][k] = *(const PG8_LAS bf16x8*)(lds + PG8_SB(b, h) + boff + n * 2048 + k * 1024); } while (0)
#define PG8_MMA(ai, bj, At, Bt) do { __builtin_amdgcn_s_setprio(1); _Pragma("unroll") for (int m = 0; m < 4; ++m) _Pragma("unroll") for (int n = 0; n < 2; ++n) _Pragma("unroll") for (int k = 0; k < 2; ++k) \
        acc[ai][bj][m][n] = __builtin_amdgcn_mfma_f32_16x16x32_bf16(Bt[n][k], At[m][k], acc[ai][bj][m][n], 0, 0, 0); __builtin_amdgcn_s_setprio(0); } while (0)
#define PG8_WAIT_V(n) asm volatile("s_waitcnt vmcnt(" #n ")" ::: "memory")
#define PG8_WAIT_L(n) asm volatile("s_waitcnt lgkmcnt(" #n ")" ::: "memory")
#define PG8_BAR __builtin_amdgcn_s_barrier()
#define PG8_SCHED __builtin_amdgcn_sched_barrier(0)
    Unit cur, nxt; int ui = 0;
    if (!S.next(0, cur)) return;
    f32x4 acc[2][2][4][2];
#pragma unroll
    for (int a = 0; a < 2; ++a)
#pragma unroll
        for (int b = 0; b < 2; ++b)
#pragma unroll
            for (int m = 0; m < 4; ++m)
#pragma unroll
                for (int n = 0; n < 2; ++n) acc[a][b][m][n] = (f32x4){0.f, 0.f, 0.f, 0.f};
    bf16x8 At[4][2], B0[2][2], B1[2][2];
    const char* cA = (const char*)g.A + (size_t)cur.pm * tstep; const char* cB = (const char*)g.Bt + (size_t)cur.pn * tstep;
    S.a_ready(cur);
    if constexpr (SP2) {
        PG8_STAGE(PG8_SB(0, 0), cB, voffB); PG8_STAGE(PG8_SB(0, 1), cB + hstep, voffB); PG8_STAGE(PG8_SA(0, 0), cA, voffA); PG8_STAGE(PG8_SA(0, 1), cA + hstep, voffA);
        if (wr == 1) PG8_BAR;
        PG8_WAIT_V(2); PG8_BAR;
        PG8_STAGE(PG8_SB(1, 0), cB + kstep, voffB); PG8_STAGE(PG8_SA(1, 0), cA + kstep, voffA); PG8_STAGE(PG8_SB(1, 1), cB + hstep + kstep, voffB);
        PG8_WAIT_V(6); PG8_BAR;
    } else {
        PG8_STAGE(PG8_SB(0, 0), cB, voffB); PG8_STAGE(PG8_SA(0, 0), cA, voffA); PG8_STAGE(PG8_SB(0, 1), cB + hstep, voffB); PG8_STAGE(PG8_SA(0, 1), cA + hstep, voffA);
        if (wr == 1) PG8_BAR;
        PG8_WAIT_V(4); PG8_BAR;
        PG8_STAGE(PG8_SB(1, 0), cB + kstep, voffB); PG8_STAGE(PG8_SA(1, 0), cA + kstep, voffA); PG8_STAGE(PG8_SB(1, 1), cB + hstep + kstep, voffB);
        PG8_WAIT_V(6); PG8_BAR;
    }
    for (;;) {
        const bool has_next = S.next(ui + 1, nxt);
        const char* nA = has_next ? (const char*)g.A + (size_t)nxt.pm * tstep : cA; const char* nB = has_next ? (const char*)g.Bt + (size_t)nxt.pn * tstep : cB;
        for (int t = 0; t < nt; t += 2) {
            const bool last = (t == nt - 2);
            const char* a1 = cA + (size_t)(t + 1) * kstep;
            const char* a2 = last ? nA : cA + (size_t)(t + 2) * kstep; const char* b2 = last ? nB : cB + (size_t)(t + 2) * kstep;
            const char* a3 = a2 + kstep; const char* b3 = b2 + kstep;
            if (last && has_next) S.a_ready(nxt);
            if constexpr (SP2) {
            PG8_LDB(B0, 0, 0); PG8_LDB(B1, 0, 1); PG8_SCHED; PG8_LDA(At, 0, 0); PG8_STAGE(PG8_SA(1, 1), a1 + hstep, voffA);
            PG8_WAIT_V(8); PG8_WAIT_L(0); PG8_BAR; PG8_MMA(0, 0, At, B0); PG8_MMA(0, 1, At, B1); PG8_BAR; PG8_SCHED;
            PG8_LDA(At, 0, 1); PG8_STAGE(PG8_SB(0, 0), b2, voffB); PG8_STAGE(PG8_SB(0, 1), b2 + hstep, voffB); PG8_STAGE(PG8_SA(0, 0), a2, voffA);
            PG8_WAIT_V(8); PG8_WAIT_L(0); PG8_BAR; PG8_MMA(1, 0, At, B0); PG8_MMA(1, 1, At, B1); PG8_BAR; PG8_SCHED;
            PG8_LDB(B0, 1, 0); PG8_LDB(B1, 1, 1); PG8_SCHED; PG8_LDA(At, 1, 0); PG8_STAGE(PG8_SA(0, 1), a2 + hstep, voffA);
            PG8_WAIT_V(8); PG8_WAIT_L(0); PG8_BAR; PG8_MMA(0, 0, At, B0); PG8_MMA(0, 1, At, B1); PG8_BAR; PG8_SCHED;
            PG8_LDA(At, 1, 1); PG8_STAGE(PG8_SB(1, 0), b3, voffB); PG8_STAGE(PG8_SB(1, 1), b3 + hstep, voffB); PG8_STAGE(PG8_SA(1, 0), a3, voffA);
            PG8_WAIT_V(8); PG8_WAIT_L(0); PG8_BAR; PG8_MMA(1, 0, At, B0); PG8_MMA(1, 1, At, B1); PG8_BAR; PG8_SCHED;
            } else {
            PG8_LDB(B0, 0, 0); PG8_SCHED; PG8_LDA(At, 0, 0); PG8_STAGE(PG8_SA(1, 1), a1 + hstep, voffA);
            PG8_WAIT_L(8); PG8_BAR; PG8_WAIT_L(0); PG8_MMA(0, 0, At, B0); PG8_BAR; PG8_SCHED;
            PG8_LDB(B1, 0, 1); PG8_STAGE(PG8_SB(0, 0), b2, voffB);
            PG8_BAR; PG8_WAIT_L(0); PG8_MMA(0, 1, At, B1); PG8_BAR;
            PG8_LDA(At, 0, 1); PG8_STAGE(PG8_SA(0, 0), a2, voffA);
            PG8_BAR; PG8_WAIT_L(0); PG8_MMA(1, 0, At, B0); PG8_BAR; PG8_SCHED;
            PG8_STAGE(PG8_SB(0, 1), b2 + hstep, voffB);
            PG8_WAIT_V(6); PG8_BAR; PG8_MMA(1, 1, At, B1); PG8_BAR;
            PG8_LDB(B0, 1, 0); PG8_SCHED; PG8_LDA(At, 1, 0); PG8_STAGE(PG8_SA(0, 1), a2 + hstep, voffA);
            PG8_WAIT_L(8); PG8_BAR; PG8_WAIT_L(0); PG8_MMA(0, 0, At, B0); PG8_BAR; PG8_SCHED;
            PG8_LDB(B1, 1, 1); PG8_STAGE(PG8_SB(1, 0), b3, voffB);
            PG8_BAR; PG8_WAIT_L(0); PG8_MMA(0, 1, At, B1); PG8_BAR;
            PG8_LDA(At, 1, 1); PG8_STAGE(PG8_SA(1, 0), a3, voffA);
            PG8_BAR; PG8_WAIT_L(0); PG8_MMA(1, 0, At, B0); PG8_BAR; PG8_SCHED;
            PG8_STAGE(PG8_SB(1, 1), b3 + hstep, voffB);
            PG8_WAIT_V(6); PG8_BAR; PG8_MMA(1, 1, At, B1); PG8_BAR;
            }
        }
        if constexpr (ALIGN_EPI) { if (wr == 0) PG8_BAR; }
        if constexpr (!Epi::AFTER_DRAIN) { E(acc, cur, wr, wc, fr, fq); S.done(cur); }
        if (!has_next) break;
#pragma unroll
        for (int a = 0; a < 2; ++a)
#pragma unroll
            for (int b = 0; b < 2; ++b)
#pragma unroll
                for (int m = 0; m < 4; ++m)
#pragma unroll
                    for (int n = 0; n < 2; ++n) acc[a][b][m][n] = (f32x4){0.f, 0.f, 0.f, 0.f};
        cur = nxt; cA = nA; cB = nB; ++ui;
        if constexpr (ALIGN_EPI) { if (wr == 1) PG8_BAR; }
    }
    PG8_WAIT_V(0);
    if constexpr (!ALIGN_EPI) { if (wr == 0) PG8_BAR; }
    PG8_BAR;
    if constexpr (Epi::AFTER_DRAIN) { E.fused(acc, cur, wr, wc, fr, fq, lds, wid, lane); S.done(cur); }
#undef PG8_SA
#undef PG8_SB
#undef PG8_STAGE
#undef PG8_LDA
#undef PG8_LDB
#undef PG8_MMA
#undef PG8_WAIT_V
#undef PG8_WAIT_L
#undef PG8_BAR
#undef PG8_SCHED
}
}
#include <hip/hip_cooperative_groups.h>
namespace cg = cooperative_groups;
#define LAS __attribute__((address_space(3)))
typedef unsigned short bf16;
typedef float f32x4 __attribute__((ext_vector_type(4)));
typedef short bf16x8 __attribute__((ext_vector_type(8)));
typedef unsigned v4u __attribute__((ext_vector_type(4)));
typedef unsigned v2u __attribute__((ext_vector_type(2)));
constexpr int D = 1024, NPR = 16384, NSM = 512, M = NPR + NSM, SEQ = 2048, NB = 8, DB = 128, FF = 2816, PLE = 256, NCH = 32;
constexpr int NWAVES = 8, LDS_BYTES = 147456, NPH = 22;
constexpr size_t WGU_SZ = (size_t)5632 * 1024 * 2, WDN_SZ = (size_t)1024 * 2816 * 2, WSQ_SZ = (size_t)1024 * 1024 * 2, WPP_SZ = (size_t)1024 * 256 * 2;
constexpr size_t OFF_WGU = 0, OFF_WDN = OFF_WGU + 4 * WGU_SZ, OFF_WGIN = OFF_WDN + 4 * WDN_SZ, OFF_WHIN = OFF_WGIN + (size_t)3328 * 1024 * 2,
    OFF_WOUT = OFF_WHIN + (size_t)4096 * 1024 * 2, OFF_WPG = OFF_WOUT + 2 * WSQ_SZ, OFF_WPP = OFF_WPG + 2 * WSQ_SZ, OFF_HB = OFF_WPP + 2 * WPP_SZ;
constexpr size_t HB_SZ = (size_t)M * 1024 * 2;
constexpr size_t OFF_BIG = OFF_HB + 2 * HB_SZ, OFF_PB = OFF_BIG + (size_t)M * 4096 * 2, PB_SZ = (size_t)M * 256 * 2, OFF_AB = OFF_PB + 2 * PB_SZ,
    OFF_DB = OFF_AB + (size_t)2048 * 4096 * 2, OFF_RS = OFF_DB + (size_t)2048 * 128 * 4, RS_SZ = (size_t)M * 16 * 4, OFF_R = OFF_RS + 2 * RS_SZ, WS_END = OFF_R + RS_SZ;
constexpr size_t OUT_YS = (size_t)NPR * D, OUT_GP = (size_t)M * D, OUT_GS = OUT_GP + 1048576, OUT_HP = OUT_GS + 16777216, OUT_HS = OUT_HP + 1048576, OUT_END = OUT_HS + 16777216;

__device__ __forceinline__ float bf2f(unsigned short u) { return __uint_as_float((unsigned)u << 16); }
__device__ __forceinline__ float bflo(unsigned u) { return __uint_as_float(u << 16); }
__device__ __forceinline__ float bfhi(unsigned u) { return __uint_as_float(u & 0xffff0000u); }
__device__ __forceinline__ unsigned pk2(float lo, float hi) { return pg8::cvt_pk_bf16(lo, hi); }
__device__ __forceinline__ float sigm(float x) { return __builtin_amdgcn_rcpf(1.0f + __expf(-x)); }
__device__ __forceinline__ float logsig(float x) { return fminf(x, 0.f) - __logf(1.0f + __expf(-fabsf(x))); }
__device__ __forceinline__ float wave_sum(float v) {
#pragma unroll
    for (int o = 1; o < 64; o <<= 1) v += __shfl_xor(v, o);
    return v;
}
#define LDS_WAIT() asm volatile("s_waitcnt lgkmcnt(0)" ::: "memory")

__device__ __forceinline__ void tr_item(const float* W, int Nsrc, int K, bf16* WT, const float* sk, int item, int nblk, int mode, int nvalid, LAS float* scr, int lane) {
    const int kb = item / nblk, nb = item % nblk, k0 = 64 * kb, n0 = 32 * nb;
    int src0 = n0, valid = 32;
    if (mode == 1) { const int pn = n0 >> 8, within = n0 & 255, half = within >> 7, j = within & 127; src0 = half * FF + 128 * pn + j; }
    if (mode == 2) { valid = nvalid - n0; valid = valid < 0 ? 0 : (valid > 32 ? 32 : valid); }
    const int c = lane & 31;
#pragma unroll
    for (int i = 0; i < 32; ++i) { const int kk = 2 * i + (lane >> 5); float v = 0.f; if (c < valid) v = W[(size_t)(k0 + kk) * Nsrc + src0 + c]; if (sk) v *= sk[k0 + kk]; scr[kk * 33 + c] = v; }
    LDS_WAIT();
    const int ch = lane & 7;
#pragma unroll
    for (int j = 0; j < 4; ++j) { const int n = (lane >> 3) + 8 * j; const LAS float* s = scr + (8 * ch) * 33 + n;
        v4u o; o.x = pk2(s[0 * 33], s[1 * 33]); o.y = pk2(s[2 * 33], s[3 * 33]); o.z = pk2(s[4 * 33], s[5 * 33]); o.w = pk2(s[6 * 33], s[7 * 33]);
        *(v4u*)(WT + (size_t)(n0 + n) * K + k0 + 8 * ch) = o; }
    LDS_WAIT();
}
struct Args { const float* in[26]; float* out; unsigned char* ws; int ph_lo, ph_hi; };
typedef const Args __attribute__((address_space(4))) CArgs;

__device__ __forceinline__ void prologue(CArgs* a, unsigned char* ws, float* outp, LAS unsigned char* lds, int tid, int bid, int G) {
    const int lane = tid & 63, wave = tid >> 6;
    LAS float* scr = (LAS float*)(lds + wave * 16384);
    const int gw = bid * NWAVES + wave, NGW = G * NWAVES;
    constexpr int I_GU = 16 * 176, I_DN = 44 * 32, I_GIN = 16 * 104, I_HIN = 16 * 128, I_SQ = 16 * 32, I_PP = 4 * 32;
    constexpr int NITEMS = 4 * I_GU + 4 * I_DN + I_GIN + I_HIN + 4 * I_SQ + 2 * I_PP;
    for (int it = gw; it < NITEMS; it += NGW) {
        int r = it;
        if (r < 4 * I_GU) { const int q = r / I_GU, li = q >> 1, f = q & 1; r -= q * I_GU;
            tr_item((f ? a->in[20] : a->in[7]) + (size_t)li * 1024 * 5632, 5632, 1024, (bf16*)(ws + OFF_WGU + q * WGU_SZ), (f ? a->in[19] : a->in[6]) + li * 1024, r, 176, 1, 0, scr, lane); continue; }
        r -= 4 * I_GU;
        if (r < 4 * I_DN) { const int q = r / I_DN, li = q >> 1, f = q & 1; r -= q * I_DN;
            tr_item((f ? a->in[21] : a->in[8]) + (size_t)li * 2816 * 1024, 1024, 2816, (bf16*)(ws + OFF_WDN + q * WDN_SZ), nullptr, r, 32, 0, 0, scr, lane); continue; }
        r -= 4 * I_DN;
        if (r < I_GIN) { tr_item(a->in[10], 3088, 1024, (bf16*)(ws + OFF_WGIN), a->in[9], r, 104, 2, 3088, scr, lane); continue; }
        r -= I_GIN;
        if (r < I_HIN) { tr_item(a->in[15], 4096, 1024, (bf16*)(ws + OFF_WHIN), a->in[9] + 1024, r, 128, 0, 0, scr, lane); continue; }
        r -= I_HIN;
        if (r < I_SQ) { tr_item(a->in[14], 1024, 1024, (bf16*)(ws + OFF_WOUT), nullptr, r, 32, 0, 0, scr, lane); continue; }
        r -= I_SQ;
        if (r < I_SQ) { tr_item(a->in[17], 1024, 1024, (bf16*)(ws + OFF_WOUT + WSQ_SZ), nullptr, r, 32, 0, 0, scr, lane); continue; }
        r -= I_SQ;
        if (r < 2 * I_SQ) { const int li = r / I_SQ; r -= li * I_SQ;
            tr_item(a->in[23] + (size_t)li * 1024 * 1024, 1024, 1024, (bf16*)(ws + OFF_WPG + li * WSQ_SZ), a->in[22] + li * 1024, r, 32, 0, 0, scr, lane); continue; }
        r -= 2 * I_SQ;
        { const int li = r / I_PP; r -= li * I_PP;
            tr_item(a->in[24] + (size_t)li * 256 * 1024, 1024, 256, (bf16*)(ws + OFF_WPP + li * WPP_SZ), nullptr, r, 32, 0, 0, scr, lane); }
    }
    bf16* hb = (bf16*)(ws + OFF_HB); float* rs = (float*)(ws + OFF_RS);
    for (int m = gw; m < M; m += NGW) {
        const float* xr = m < NPR ? a->in[0] + (size_t)m * D : a->in[1] + (size_t)(m - NPR) * D;
        float ss = 0.f;
#pragma unroll
        for (int j = 0; j < 4; ++j) { const f32x4 v = *((const f32x4*)xr + lane + 64 * j); ss += (v[0] * v[0] + v[1] * v[1]) + (v[2] * v[2] + v[3] * v[3]);
            *((f32x4*)(outp + (size_t)m * D) + lane + 64 * j) = v; v2u w; w.x = pk2(v[0], v[1]); w.y = pk2(v[2], v[3]); *((v2u*)(hb + (size_t)m * D) + lane + 64 * j) = w; }
        ss = wave_sum(ss);
        if (lane < 16) rs[(size_t)m * 16 + lane] = lane == 0 ? ss : 0.f;
    }
    const int gt = bid * (NWAVES * 64) + tid, NGT = G * NWAVES * 64;
    for (int e = gt; e < 2 * M * 32; e += NGT) { const int li = e / (M * 32), rem = e % (M * 32), m = rem >> 5, c8 = (rem & 31) * 8;
        const float* src = m < NPR ? a->in[4] + ((size_t)li * NPR + m) * 256 + c8 : a->in[5] + ((size_t)li * NSM + (m - NPR)) * 256 + c8;
        const f32x4 v0 = *(const f32x4*)src, v1 = *(const f32x4*)(src + 4);
        v4u w; w.x = pk2(v0[0], v0[1]); w.y = pk2(v0[2], v0[3]); w.z = pk2(v1[0], v1[1]); w.w = pk2(v1[2], v1[3]);
        *(v4u*)((bf16*)(ws + OFF_PB + li * PB_SZ) + (size_t)m * 256 + c8) = w; }
}
template <bool HG> struct MX {
    static constexpr int H = HG ? 8 : 4, DV = HG ? 128 : 256, LDZ = HG ? 4096 : 3328, KC = HG ? 1024 : 512, VC = HG ? 2048 : 1024, GC = HG ? 3072 : 2048, VR = DV / 64, NVG = DV / 16, NVR = DV / 64;
    static constexpr float scale = HG ? 1.0f : 0.08838834764831845f;
};
template <bool HG> __device__ __forceinline__ void prep_phase(LAS unsigned char* lds, bf16* Z, const float* R, const float* wup, const float* bgk, const float* lowb, bf16* AB, float* DBUF, int tid, int bid, int G) {
    typedef MX<HG> C; constexpr int H = C::H, DV = C::DV, LDZ = C::LDZ, KC = C::KC, VC = C::VC, VR = C::VR, VP = DV + 8, QP = 136;
    LAS float* gl = (LAS float*)lds; LAS float* segs = (LAS float*)(lds + 32768);
    LAS bf16* qe_s = (LAS bf16*)(lds + 34816); LAS bf16* kn_s = (LAS bf16*)(lds + 52224); LAS bf16* kd_s = (LAS bf16*)(lds + 69632); LAS bf16* v_s = (LAS bf16*)(lds + 87040);
    const int t = tid >> 3, cs = tid & 7, j0 = cs * 16, lane = tid & 63, w = tid >> 6;
    for (int unit = bid; unit < NB * H * NCH; unit += G) {
        const int n = unit % NCH, bh = unit / NCH, h = bh % H, b = bh / H;
        const size_t tok0 = (size_t)b * SEQ + 64 * n, m = tok0 + t;
        __syncthreads();
        float lbc[16];
        {
            float g[16];
            if constexpr (!HG) {
                f32x4 r4[4];
#pragma unroll
                for (int i = 0; i < 4; ++i) r4[i] = *(const f32x4*)(R + m * 16 + 4 * i);
#pragma unroll
                for (int q = 0; q < 4; ++q) { const f32x4 bv = *(const f32x4*)(bgk + h * 128 + j0 + 4 * q); g[4 * q] = bv[0]; g[4 * q + 1] = bv[1]; g[4 * q + 2] = bv[2]; g[4 * q + 3] = bv[3]; }
#pragma unroll
                for (int i = 0; i < 16; ++i) { const float ri = r4[i >> 2][i & 3]; const float* wp = wup + i * 512 + h * 128 + j0;
#pragma unroll
                    for (int q = 0; q < 4; ++q) { const f32x4 wv = *(const f32x4*)(wp + 4 * q); g[4 * q] += ri * wv[0]; g[4 * q + 1] += ri * wv[1]; g[4 * q + 2] += ri * wv[2]; g[4 * q + 3] += ri * wv[3]; } }
#pragma unroll
                for (int jj = 0; jj < 16; ++jj) { g[jj] = logsig(g[jj]) * (1.0f / 16.0f); lbc[jj] = 0.f; }
            } else {
                const v4u f0 = *(const v4u*)(Z + m * LDZ + KC + h * 128 + j0), f1 = *(const v4u*)(Z + m * LDZ + KC + h * 128 + j0 + 8);
                const unsigned fw[8] = {f0.x, f0.y, f0.z, f0.w, f1.x, f1.y, f1.z, f1.w};
#pragma unroll
                for (int jj = 0; jj < 16; ++jj) { const float f = (jj & 1) ? bfhi(fw[jj >> 1]) : bflo(fw[jj >> 1]);
                    const float x0 = lowb[h * 128 + j0 + jj], x1 = lowb[1024 + h * 128 + j0 + jj];
                    const float a = logsig(x1 - x0), b2 = logsig(x0 - x1) + logsig(f), mx = fmaxf(a, b2);
                    g[jj] = mx + __logf(1.0f + __expf(-fabsf(a - b2))); lbc[jj] = sigm(x0 - x1); }
            }
#pragma unroll
            for (int q = 0; q < 4; ++q) *(LAS f32x4*)(gl + t * 128 + j0 + 4 * q) = (f32x4){g[4 * q], g[4 * q + 1], g[4 * q + 2], g[4 * q + 3]};
        }
        __syncthreads();
        {
            const int j = tid & 127, sg = tid >> 7; float acc = 0.f;
#pragma unroll
            for (int i = 0; i < 16; ++i) { acc += gl[(16 * sg + i) * 128 + j]; gl[(16 * sg + i) * 128 + j] = acc; }
            segs[sg * 128 + j] = acc;
            __syncthreads();
            float off = 0.f;
            for (int s2 = 0; s2 < sg; ++s2) off += segs[s2 * 128 + j];
            if (sg) {
#pragma unroll
                for (int i = 0; i < 16; ++i) gl[(16 * sg + i) * 128 + j] += off; }
        }
        __syncthreads();
        {
            bf16* qp = Z + m * LDZ + h * 128 + j0; const bf16* kp = Z + m * LDZ + KC + h * 128 + j0;
            const v4u q0 = *(const v4u*)qp, q1 = *(const v4u*)(qp + 8), k0 = *(const v4u*)kp, k1 = *(const v4u*)(kp + 8);
            const unsigned qw[8] = {q0.x, q0.y, q0.z, q0.w, q1.x, q1.y, q1.z, q1.w}, kw[8] = {k0.x, k0.y, k0.z, k0.w, k1.x, k1.y, k1.z, k1.w};
            float bb[16], bl[16];
#pragma unroll
            for (int q = 0; q < 4; ++q) { const f32x4 x = *(const LAS f32x4*)(gl + t * 128 + j0 + 4 * q), y = *(const LAS f32x4*)(gl + 63 * 128 + j0 + 4 * q);
                bb[4 * q] = x[0]; bb[4 * q + 1] = x[1]; bb[4 * q + 2] = x[2]; bb[4 * q + 3] = x[3]; bl[4 * q] = y[0]; bl[4 * q + 1] = y[1]; bl[4 * q + 2] = y[2]; bl[4 * q + 3] = y[3]; }
            float qe[16], kn[16], kd[16];
#pragma unroll
            for (int jj = 0; jj < 16; ++jj) { float qv = (jj & 1) ? bfhi(qw[jj >> 1]) : bflo(qw[jj >> 1]); float kv = (jj & 1) ? bfhi(kw[jj >> 1]) : bflo(kw[jj >> 1]);
                if constexpr (HG) { qv = qv * sigm(qv); kv = lbc[jj] * sigm(-kv); }
                qe[jj] = qv * __expf(bb[jj]) * C::scale; kn[jj] = kv * __expf(-bb[jj]); kd[jj] = kv * __expf(bl[jj] - bb[jj]); }
            v4u o0, o1;
            o0.x = pk2(qe[0], qe[1]); o0.y = pk2(qe[2], qe[3]); o0.z = pk2(qe[4], qe[5]); o0.w = pk2(qe[6], qe[7]); o1.x = pk2(qe[8], qe[9]); o1.y = pk2(qe[10], qe[11]); o1.z = pk2(qe[12], qe[13]); o1.w = pk2(qe[14], qe[15]);
            *(v4u*)qp = o0; *(v4u*)(qp + 8) = o1; *(LAS v4u*)(qe_s + t * QP + j0) = o0; *(LAS v4u*)(qe_s + t * QP + j0 + 8) = o1;
            o0.x = pk2(kn[0], kn[1]); o0.y = pk2(kn[2], kn[3]); o0.z = pk2(kn[4], kn[5]); o0.w = pk2(kn[6], kn[7]); o1.x = pk2(kn[8], kn[9]); o1.y = pk2(kn[10], kn[11]); o1.z = pk2(kn[12], kn[13]); o1.w = pk2(kn[14], kn[15]);
            *(LAS v4u*)(kn_s + t * QP + j0) = o0; *(LAS v4u*)(kn_s + t * QP + j0 + 8) = o1;
            o0.x = pk2(kd[0], kd[1]); o0.y = pk2(kd[2], kd[3]); o0.z = pk2(kd[4], kd[5]); o0.w = pk2(kd[6], kd[7]); o1.x = pk2(kd[8], kd[9]); o1.y = pk2(kd[10], kd[11]); o1.z = pk2(kd[12], kd[13]); o1.w = pk2(kd[14], kd[15]);
            *(LAS v4u*)(kd_s + t * QP + j0) = o0; *(LAS v4u*)(kd_s + t * QP + j0 + 8) = o1;
            if (t == 63) {
#pragma unroll
                for (int q = 0; q < 4; ++q) *(f32x4*)(DBUF + (size_t)unit * 128 + j0 + 4 * q) = (f32x4){__expf(bl[4 * q]), __expf(bl[4 * q + 1]), __expf(bl[4 * q + 2]), __expf(bl[4 * q + 3])}; }
            const bf16* vp = Z + m * LDZ + VC + h * DV + cs * (DV / 8);
#pragma unroll
            for (int q = 0; q < DV / 64; ++q) *(LAS v4u*)(v_s + t * VP + cs * (DV / 8) + 8 * q) = *(const v4u*)(vp + 8 * q);
        }
        __syncthreads();
        {
            const int r = lane & 15, quad = lane >> 4, tb = w >> 1;
#pragma unroll
            for (int e = 0; e < 2; ++e) { const int sb = 2 * (w & 1) + e; f32x4 c = {0.f, 0.f, 0.f, 0.f};
                if (sb <= tb) {
#pragma unroll
                    for (int ks = 0; ks < 4; ++ks) { const bf16x8 av = *(const LAS bf16x8*)(kn_s + (16 * sb + r) * QP + 32 * ks + 8 * quad), bv = *(const LAS bf16x8*)(qe_s + (16 * tb + r) * QP + 32 * ks + 8 * quad);
                        c = __builtin_amdgcn_mfma_f32_16x16x32_bf16(av, bv, c, 0, 0, 0); } }
                const int tc = 16 * tb + r, s0 = 16 * sb + 4 * quad;
                v2u o; o.x = pk2(s0 <= tc ? c[0] : 0.f, s0 + 1 <= tc ? c[1] : 0.f); o.y = pk2(s0 + 2 <= tc ? c[2] : 0.f, s0 + 3 <= tc ? c[3] : 0.f);
                *(v2u*)(AB + (size_t)unit * 4096 + tc * 64 + s0) = o; }
        }
        {
            const int j = tid >> 2, sq = tid & 3; unsigned pw[8];
#pragma unroll
            for (int i = 0; i < 8; ++i) pw[i] = (unsigned)kd_s[(16 * sq + 2 * i) * QP + j] | ((unsigned)kd_s[(16 * sq + 2 * i + 1) * QP + j] << 16);
            bf16* dst = Z + (tok0 + (j >> 1)) * LDZ + KC + h * 128 + (j & 1) * 64 + 16 * sq;
            *(v4u*)dst = (v4u){pw[0], pw[1], pw[2], pw[3]}; *(v4u*)(dst + 8) = (v4u){pw[4], pw[5], pw[6], pw[7]};
        }
        for (int c = tid; c < DV * 4; c += NWAVES * 64) { const int v = c >> 2, sq = c & 3; unsigned pw[8];
#pragma unroll
            for (int i = 0; i < 8; ++i) pw[i] = (unsigned)v_s[(16 * sq + 2 * i) * VP + v] | ((unsigned)v_s[(16 * sq + 2 * i + 1) * VP + v] << 16);
            bf16* dst = Z + (tok0 + v / VR) * LDZ + VC + h * DV + (v % VR) * 64 + 16 * sq;
            *(v4u*)dst = (v4u){pw[0], pw[1], pw[2], pw[3]}; *(v4u*)(dst + 8) = (v4u){pw[4], pw[5], pw[6], pw[7]}; }
    }
}
template <bool HG> __device__ __forceinline__ void scan_stream(const bf16* Z, const bf16* AB, const float* DBUF, bf16* O, float* Sout, int sid, int lane) {
    typedef MX<HG> C; constexpr int H = C::H, DV = C::DV, LDZ = C::LDZ, KC = C::KC, VC = C::VC, VR = C::VR, NVG = C::NVG;
    const int vg = sid % NVG, bh = sid / NVG, h = bh % H, b = bh / H, r = lane & 15, quad = lane >> 4;
    f32x4 S[8];
#pragma unroll
    for (int i = 0; i < 8; ++i) S[i] = (f32x4){0.f, 0.f, 0.f, 0.f};
    const int v = 16 * vg + r;
    for (int n = 0; n < NCH; ++n) {
        const int unit = bh * NCH + n; const size_t tok0 = (size_t)b * SEQ + 64 * n;
        const bf16* vtp = Z + (tok0 + v / VR) * LDZ + VC + h * DV + (v % VR) * 64 + 8 * quad;
        const bf16x8 vb0 = *(const bf16x8*)vtp, vb1 = *(const bf16x8*)(vtp + 32);
        v2u qlo[4][4], qhi[4][4]; bf16x8 af[4][2], kf[8][2]; f32x4 dv[8];
#pragma unroll
        for (int tb = 0; tb < 4; ++tb) { const bf16* qp = Z + (tok0 + 16 * tb + r) * LDZ + h * 128 + 4 * quad;
#pragma unroll
            for (int ks = 0; ks < 4; ++ks) { qlo[tb][ks] = *(const v2u*)(qp + 32 * ks); qhi[tb][ks] = *(const v2u*)(qp + 32 * ks + 16); }
            const bf16* ap = AB + (size_t)unit * 4096 + (16 * tb + r) * 64 + 8 * quad;
            af[tb][0] = *(const bf16x8*)ap; af[tb][1] = *(const bf16x8*)(ap + 32); }
        __builtin_amdgcn_sched_barrier(0);
        bf16x8 sb[4];
#pragma unroll
        for (int ks = 0; ks < 4; ++ks) { v4u p; p.x = pk2(S[2 * ks][0], S[2 * ks][1]); p.y = pk2(S[2 * ks][2], S[2 * ks][3]); p.z = pk2(S[2 * ks + 1][0], S[2 * ks + 1][1]); p.w = pk2(S[2 * ks + 1][2], S[2 * ks + 1][3]);
            sb[ks] = __builtin_bit_cast(bf16x8, p); }
        f32x4 o[4];
#pragma unroll
        for (int tb = 0; tb < 4; ++tb) { o[tb] = (f32x4){0.f, 0.f, 0.f, 0.f};
#pragma unroll
            for (int ks = 0; ks < 4; ++ks)
                o[tb] = __builtin_amdgcn_mfma_f32_16x16x32_bf16(__builtin_bit_cast(bf16x8, ((v4u){qlo[tb][ks].x, qlo[tb][ks].y, qhi[tb][ks].x, qhi[tb][ks].y})), sb[ks], o[tb], 0, 0, 0);
            o[tb] = __builtin_amdgcn_mfma_f32_16x16x32_bf16(af[tb][0], vb0, o[tb], 0, 0, 0);
            o[tb] = __builtin_amdgcn_mfma_f32_16x16x32_bf16(af[tb][1], vb1, o[tb], 0, 0, 0); }
        __builtin_amdgcn_sched_barrier(0);
#pragma unroll
        for (int kb = 0; kb < 8; ++kb) { const int k = 16 * kb + r; const bf16* kp = Z + (tok0 + (k >> 1)) * LDZ + KC + h * 128 + (k & 1) * 64 + 8 * quad;
            kf[kb][0] = *(const bf16x8*)kp; kf[kb][1] = *(const bf16x8*)(kp + 32); }
#pragma unroll
        for (int kb = 0; kb < 8; ++kb) dv[kb] = *(const f32x4*)(DBUF + (size_t)unit * 128 + 16 * kb + 4 * quad);
        __builtin_amdgcn_sched_barrier(0);
#pragma unroll
        for (int tb = 0; tb < 4; ++tb) { bf16* op = O + (tok0 + 16 * tb + 4 * quad) * 1024 + h * DV + 16 * vg + r;
            const unsigned p01 = pk2(o[tb][0], o[tb][1]), p23 = pk2(o[tb][2], o[tb][3]);
            op[0] = (bf16)(p01 & 0xffffu); op[1024] = (bf16)(p01 >> 16); op[2048] = (bf16)(p23 & 0xffffu); op[3072] = (bf16)(p23 >> 16); }
#pragma unroll
        for (int kb = 0; kb < 8; ++kb) { S[kb] = S[kb] * dv[kb];
            S[kb] = __builtin_amdgcn_mfma_f32_16x16x32_bf16(kf[kb][0], vb0, S[kb], 0, 0, 0);
            S[kb] = __builtin_amdgcn_mfma_f32_16x16x32_bf16(kf[kb][1], vb1, S[kb], 0, 0, 0); }
    }
#pragma unroll
    for (int kb = 0; kb < 8; ++kb)
#pragma unroll
        for (int j = 0; j < 4; ++j) Sout[((size_t)bh * 128 + 16 * kb + 4 * quad + j) * DV + v] = S[kb][j];
}
template <bool HG> __device__ __forceinline__ void sample_unit(LAS float* wl, const bf16* Z, const float* R, const float* wup, const float* bgk, const float* lowb, const float* S0, float* Sout, bf16* O, int u, int lane) {
    typedef MX<HG> C; constexpr int H = C::H, DV = C::DV, LDZ = C::LDZ, KC = C::KC, VC = C::VC, NVR = C::NVR;
    const int vr = u % NVR, bh = u / NVR, h = bh % H, b = bh / H; const size_t m0 = (size_t)NPR + 4 * b;
    float pa[10];
#pragma unroll
    for (int i = 0; i < 10; ++i) pa[i] = 0.f;
#pragma unroll
    for (int kk = 0; kk < 2; ++kk) { const int k = lane + 64 * kk, hk = h * 128 + k; float g[4], q[4], kv[4];
#pragma unroll
        for (int t = 0; t < 4; ++t) { const bf16* zr = Z + (m0 + t) * LDZ; q[t] = bf2f(zr[hk]); const float kz = bf2f(zr[KC + hk]);
            if constexpr (!HG) { float x = bgk[hk];
#pragma unroll
                for (int i = 0; i < 16; ++i) x += R[(m0 + t) * 16 + i] * wup[i * 512 + hk];
                g[t] = logsig(x) * (1.0f / 16.0f); kv[t] = kz;
            } else { const float x0 = lowb[hk], x1 = lowb[1024 + hk]; const float a = logsig(x1 - x0), b2 = logsig(x0 - x1) + logsig(kz), mx = fmaxf(a, b2);
                g[t] = mx + __logf(1.0f + __expf(-fabsf(a - b2))); kv[t] = sigm(x0 - x1) * sigm(-kz); q[t] = q[t] * sigm(q[t]); } }
        float bb[4]; bb[0] = g[0]; bb[1] = bb[0] + g[1]; bb[2] = bb[1] + g[2]; bb[3] = bb[2] + g[3];
        float qe[4], kn[4];
#pragma unroll
        for (int t = 0; t < 4; ++t) { qe[t] = q[t] * __expf(bb[t]) * C::scale; kn[t] = kv[t] * __expf(-bb[t]); wl[k * 12 + t] = qe[t]; wl[k * 12 + 4 + t] = kv[t] * __expf(bb[3] - bb[t]); }
        wl[k * 12 + 8] = __expf(bb[3]);
        int idx = 0;
#pragma unroll
        for (int t = 0; t < 4; ++t)
#pragma unroll
            for (int s = 0; s <= t; ++s) pa[idx++] += qe[t] * kn[s];
    }
#pragma unroll
    for (int i = 0; i < 10; ++i) pa[i] = wave_sum(pa[i]);
    float vv[4], o[4];
#pragma unroll
    for (int s = 0; s < 4; ++s) vv[s] = bf2f(Z[(m0 + s) * LDZ + VC + h * DV + 64 * vr + lane]);
    { int idx = 0;
#pragma unroll
        for (int t = 0; t < 4; ++t) { o[t] = 0.f;
#pragma unroll
            for (int s = 0; s <= t; ++s) o[t] += pa[idx++] * vv[s]; } }
    LDS_WAIT();
    const float* sp = S0 + ((size_t)bh * 128) * DV + 64 * vr + lane; float* dp = Sout + ((size_t)bh * 128) * DV + 64 * vr + lane;
#pragma unroll 8
    for (int k = 0; k < 128; ++k) { const float s0 = sp[(size_t)k * DV]; const f32x4 q4 = *(const LAS f32x4*)(wl + k * 12), k4 = *(const LAS f32x4*)(wl + k * 12 + 4); const float d = wl[k * 12 + 8];
        o[0] += q4[0] * s0; o[1] += q4[1] * s0; o[2] += q4[2] * s0; o[3] += q4[3] * s0;
        dp[(size_t)k * DV] = d * s0 + ((k4[0] * vv[0] + k4[1] * vv[1]) + (k4[2] * vv[2] + k4[3] * vv[3])); }
#pragma unroll
    for (int t = 0; t < 4; ++t) O[(m0 + t) * 1024 + h * DV + 64 * vr + lane] = (bf16)(pk2(o[t], 0.f) & 0xffffu);
    LDS_WAIT();
}
template <bool HG> __device__ __forceinline__ void gate_phase(const bf16* Z, bf16* O, const float* gn, int gw, int ngw, int lane) {
    typedef MX<HG> C; constexpr int H = C::H, DV = C::DV, LDZ = C::LDZ, GC = C::GC, E = DV / 64;
    for (int task = gw; task < M * H; task += ngw) { const int m = task / H, h = task % H;
        bf16* op = O + (size_t)m * 1024 + h * DV + E * lane; const bf16* gp = Z + (size_t)m * LDZ + GC + h * DV + E * lane;
        float x[E], g[E];
        if constexpr (E == 4) { const v2u xo = *(const v2u*)op, go = *(const v2u*)gp; x[0] = bflo(xo.x); x[1] = bfhi(xo.x); x[2] = bflo(xo.y); x[3] = bfhi(xo.y); g[0] = bflo(go.x); g[1] = bfhi(go.x); g[2] = bflo(go.y); g[3] = bfhi(go.y); }
        else { const unsigned xo = *(const unsigned*)op, go = *(const unsigned*)gp; x[0] = bflo(xo); x[1] = bfhi(xo); g[0] = bflo(go); g[1] = bfhi(go); }
        float ss = 0.f;
#pragma unroll
        for (int e = 0; e < E; ++e) ss += x[e] * x[e];
        ss = wave_sum(ss); const float rinv = rsqrtf(ss * (1.0f / DV) + 1e-6f);
        float y[E];
#pragma unroll
        for (int e = 0; e < E; ++e) y[e] = x[e] * rinv * gn[E * lane + e] * (g[e] * sigm(g[e]));
        if constexpr (E == 4) { v2u w; w.x = pk2(y[0], y[1]); w.y = pk2(y[2], y[3]); *(v2u*)op = w; } else { *(unsigned*)op = pk2(y[0], y[1]); }
    }
}
template <int NKS> __device__ __forceinline__ void mini_acc(f32x4 (&acc)[2][4], const bf16* ap, size_t lda, const bf16* bp, size_t ldb) {
#pragma unroll
    for (int c = 0; c < NKS; c += 4) {
        bf16x8 af[4][2], bfr[4][4];
#pragma unroll
        for (int ks = 0; ks < 4; ++ks) if (c + ks < NKS) {
#pragma unroll
            for (int rb = 0; rb < 2; ++rb) af[ks][rb] = *(const bf16x8*)(ap + (size_t)(16 * rb) * lda + 32 * (c + ks));
#pragma unroll
            for (int cb = 0; cb < 4; ++cb) bfr[ks][cb] = *(const bf16x8*)(bp + (size_t)(16 * cb) * ldb + 32 * (c + ks)); }
        __builtin_amdgcn_sched_barrier(0);
#pragma unroll
        for (int ks = 0; ks < 4; ++ks) if (c + ks < NKS) {
#pragma unroll
            for (int rb = 0; rb < 2; ++rb)
#pragma unroll
                for (int cb = 0; cb < 4; ++cb) acc[rb][cb] = __builtin_amdgcn_mfma_f32_16x16x32_bf16(bfr[ks][cb], af[ks][rb], acc[rb][cb], 0, 0, 0); }
        __builtin_amdgcn_sched_barrier(0);
    }
}
template <int MODE, int K> __device__ __forceinline__ void mini_gemm(LAS unsigned char* lds, const bf16* A, const bf16* Bt, const bf16* A2, const bf16* Bt2, float* h, bf16* hb_out, const float* rs_in, float* rs_out, float alpha, int tid, int bid, int G) {
    const int lane = tid & 63, w = tid >> 6, r = lane & 15, quad = lane >> 4;
    LAS float* P = (LAS float*)lds; LAS float* P2 = (LAS float*)(lds + 65536);
    for (int mt = bid; mt < 256; mt += G) {
        const int rt = mt >> 4, ct = mt & 15, row0 = NPR + 32 * rt, col0 = 64 * ct;
        f32x4 acc[2][4];
#pragma unroll
        for (int rb = 0; rb < 2; ++rb)
#pragma unroll
            for (int cb = 0; cb < 4; ++cb) acc[rb][cb] = (f32x4){0.f, 0.f, 0.f, 0.f};
        constexpr int KW = K / 8;
        mini_acc<KW / 32>(acc, A + (size_t)(row0 + r) * K + w * KW + 8 * quad, K, Bt + (size_t)(col0 + r) * K + w * KW + 8 * quad, K);
#pragma unroll
        for (int rb = 0; rb < 2; ++rb)
#pragma unroll
            for (int cb = 0; cb < 4; ++cb) *(LAS f32x4*)(P + (w * 32 + 16 * rb + r) * 64 + 16 * cb + 4 * quad) = acc[rb][cb];
        if constexpr (MODE == 1) {
#pragma unroll
            for (int rb = 0; rb < 2; ++rb)
#pragma unroll
                for (int cb = 0; cb < 4; ++cb) acc[rb][cb] = (f32x4){0.f, 0.f, 0.f, 0.f};
            mini_acc<1>(acc, A2 + (size_t)(row0 + r) * 256 + w * 32 + 8 * quad, 256, Bt2 + (size_t)(col0 + r) * 256 + w * 32 + 8 * quad, 256);
#pragma unroll
            for (int rb = 0; rb < 2; ++rb)
#pragma unroll
                for (int cb = 0; cb < 4; ++cb) *(LAS f32x4*)(P2 + (w * 32 + 16 * rb + r) * 64 + 16 * cb + 4 * quad) = acc[rb][cb];
        }
        __syncthreads();
        const int row = tid >> 4, c4 = (tid & 15) * 4; f32x4 v = {0.f, 0.f, 0.f, 0.f}, v2 = {0.f, 0.f, 0.f, 0.f};
#pragma unroll
        for (int ww = 0; ww < 8; ++ww) { v += *(const LAS f32x4*)(P + (ww * 32 + row) * 64 + c4); if constexpr (MODE == 1) v2 += *(const LAS f32x4*)(P2 + (ww * 32 + row) * 64 + c4); }
        const int grow = row0 + row; const size_t off = (size_t)grow * 1024 + col0 + c4;
        f32x4 o = *(const f32x4*)(h + off);
        if constexpr (MODE == 0) o += v * alpha;
        else { const float s = pg8::row_scale(rs_in, grow); o[0] += sigm(v[0] * s) * v2[0]; o[1] += sigm(v[1] * s) * v2[1]; o[2] += sigm(v[2] * s) * v2[2]; o[3] += sigm(v[3] * s) * v2[3]; }
        *(f32x4*)(h + off) = o; v2u pw; pw.x = pk2(o[0], o[1]); pw.y = pk2(o[2], o[3]); *(v2u*)(hb_out + off) = pw;
        float ss = (o[0] * o[0] + o[1] * o[1]) + (o[2] * o[2] + o[3] * o[3]);
        ss += __shfl_xor(ss, 1); ss += __shfl_xor(ss, 2); ss += __shfl_xor(ss, 4); ss += __shfl_xor(ss, 8);
        if ((tid & 15) == 0) rs_out[(size_t)grow * 16 + ct] = ss;
        __syncthreads();
    }
}
#define MK_TID() int wave = wave_s; asm volatile("" : "+s"(wave)); unsigned ones_ = ~0u; asm volatile("" : "+s"(ones_)); \
    const int lane = (int)__builtin_amdgcn_mbcnt_hi(ones_, __builtin_amdgcn_mbcnt_lo(ones_, 0u)); const int tid = wave * 64 + lane; const int gw = bid * NWAVES + wave, NGW = G * NWAVES; (void)gw; (void)NGW; (void)tid; (void)lane
__global__ void __launch_bounds__(NWAVES * 64, 2) fwd_kernel(Args a) {
    extern __shared__ __attribute__((aligned(16))) unsigned char lds_raw[];
    LAS unsigned char* lds = (LAS unsigned char*)lds_raw;
    cg::grid_group grid = cg::this_grid();
    const int wave_s = __builtin_amdgcn_readfirstlane((int)threadIdx.x >> 6);
    const int ph_lo = a.ph_lo, ph_hi = a.ph_hi;
    for (int ph_ = ph_lo; ph_ < ph_hi; ++ph_) {
#if PROBE_MODE
      const int kk_ = (ph_ - 1) % 10; const bool mid_ = ph_ > 0 && ph_ < NPH - 1;
      const int nrep = (PROBE_MODE == 1 && ph_ == 0) || (PROBE_MODE == 2 && mid_ && (kk_ == 0 || kk_ == 7)) || (PROBE_MODE == 3 && mid_ && kk_ == 2) || (PROBE_MODE == 4 && mid_ && kk_ == 4) ? 2 : 1;
      for (int rep = 0; rep < nrep; ++rep) {
#else
      {
#endif
        int ph = ph_; asm volatile("" : "+s"(ph));
        CArgs* ap = (CArgs*)__builtin_amdgcn_kernarg_segment_ptr(); asm volatile("" : "+s"(ap));
        int bid = blockIdx.x; asm volatile("" : "+s"(bid));
        int G = gridDim.x; asm volatile("" : "+s"(G));
        unsigned char* ws = ap->ws; float* hbuf = ap->out;
        if (ph == 0) { MK_TID(); prologue(ap, ws, hbuf, lds, tid, bid, G); }
        else if (ph == NPH - 1) {
            MK_TID(); const float* fw = ap->in[25];
            for (int m = gw; m < M; m += NGW) { f32x4* hr = (f32x4*)(hbuf + (size_t)m * D); f32x4 v[4]; float ss = 0.f;
#pragma unroll
                for (int j = 0; j < 4; ++j) { v[j] = hr[lane + 64 * j]; ss += (v[j][0] * v[j][0] + v[j][1] * v[j][1]) + (v[j][2] * v[j][2] + v[j][3] * v[j][3]); }
                ss = wave_sum(ss); const float rinv = rsqrtf(ss * (1.0f / D) + 1e-6f);
#pragma unroll
                for (int j = 0; j < 4; ++j) { const f32x4 wv = *((const f32x4*)fw + lane + 64 * j); hr[lane + 64 * j] = v[j] * rinv * wv; } }
        } else {
            const int li = (ph - 1) / 10, k = (ph - 1) % 10, cur = li;
            bf16* hb = (bf16*)(ws + OFF_HB + cur * HB_SZ); bf16* ob = (bf16*)(ws + OFF_HB + (cur ^ 1) * HB_SZ);
            float* rs0 = (float*)(ws + OFF_RS); float* rs1 = (float*)(ws + OFF_RS + RS_SZ); float* Rb = (float*)(ws + OFF_R);
            bf16* big = (bf16*)(ws + OFF_BIG);
            if (k == 0 || k == 7) { MK_TID();
                const int f = k == 7; pg8::Gemm g{hb, (const bf16*)(ws + OFF_WGU + (li * 2 + f) * WGU_SZ), M, 2 * FF, D};
                pg8::StaticOrder S; S.init(M, 2 * FF, G, bid); pg8::EpiSwiglu E{big, FF, rs0};
                pg8::gemm_phase<pg8::EpiSwiglu, pg8::StaticOrder, true, true>(lds, g, S, E, tid);
            } else if (k == 1 || k == 8 || k == 6) { MK_TID();
                pg8::Gemm g; float alpha; float* rso;
                if (k == 6) { g = pg8::Gemm{ob, (const bf16*)(ws + OFF_WOUT + li * WSQ_SZ), M, D, D}; alpha = 1.0f; rso = rs0; }
                else { const int f = k == 8; g = pg8::Gemm{big, (const bf16*)(ws + OFF_WDN + (li * 2 + f) * WDN_SZ), M, D, FF}; alpha = 0.5f; rso = rs1; }
                g.M = NPR; pg8::StaticOrder S; S.init(NPR, D, G, bid); pg8::EpiResid E{hbuf, hb, rso, alpha};
                pg8::gemm_phase<pg8::EpiResid, pg8::StaticOrder, true, true>(lds, g, S, E, tid);
                int tid2 = tid; asm volatile("" : "+v"(tid2));
                if (k == 6) mini_gemm<0, D>(lds, g.A, g.Bt, nullptr, nullptr, hbuf, hb, nullptr, rso, alpha, tid2, bid, G);
                else mini_gemm<0, FF>(lds, g.A, g.Bt, nullptr, nullptr, hbuf, hb, nullptr, rso, alpha, tid2, bid, G);
            } else if (k == 2) { MK_TID();
                const int N = li ? 4096 : 3328; pg8::Gemm g{hb, (const bf16*)(ws + (li ? OFF_WHIN : OFF_WGIN)), M, N, D};
                pg8::StaticOrder S; S.init(M, N, G, bid); pg8::EpiZ E{big, N, rs1, Rb, li ? -1 : 12};
                pg8::gemm_phase<pg8::EpiZ, pg8::StaticOrder, true, true>(lds, g, S, E, tid);
            } else if (k == 3) { MK_TID();
                if (li == 0) prep_phase<false>(lds, big, Rb, ap->in[11], ap->in[12], ap->in[18], (bf16*)(ws + OFF_AB), (float*)(ws + OFF_DB), tid, bid, G);
                else prep_phase<true>(lds, big, Rb, ap->in[11], ap->in[12], ap->in[18], (bf16*)(ws + OFF_AB), (float*)(ws + OFF_DB), tid, bid, G);
            } else if (k == 4) { MK_TID();
                if (wave < 2) {
                    for (int sid = bid * 2 + wave; sid < 512; sid += G * 2) {
                        if (li == 0) scan_stream<false>(big, (const bf16*)(ws + OFF_AB), (const float*)(ws + OFF_DB), ob, hbuf + OUT_GP, sid, lane);
                        else scan_stream<true>(big, (const bf16*)(ws + OFF_AB), (const float*)(ws + OFF_DB), ob, hbuf + OUT_HP, sid, lane);
                    }
                } else {
                    LAS float* wl = (LAS float*)(lds + wave * 8192);
                    for (int u = bid * 6 + (wave - 2); u < 2048; u += G * 6) {
                        if (li == 0) sample_unit<false>(wl, big, Rb, ap->in[11], ap->in[12], ap->in[18], ap->in[2], hbuf + OUT_GS, ob, u, lane);
                        else sample_unit<true>(wl, big, Rb, ap->in[11], ap->in[12], ap->in[18], ap->in[3], hbuf + OUT_HS, ob, u, lane);
                    }
                }
            } else if (k == 5) { MK_TID();
                if (li == 0) gate_phase<false>(big, ob, ap->in[13], gw, NGW, lane); else gate_phase<true>(big, ob, ap->in[16], gw, NGW, lane);
            } else { MK_TID();
                float* pp = (float*)(ws + OFF_BIG);
                { pg8::Gemm g{(const bf16*)(ws + OFF_PB + li * PB_SZ), (const bf16*)(ws + OFF_WPP + li * WPP_SZ), NPR, D, PLE};
                  pg8::StaticOrder S; S.init(NPR, D, G, bid); pg8::EpiStoreF32 E{pp};
                  pg8::gemm_phase<pg8::EpiStoreF32, pg8::StaticOrder, true, true>(lds, g, S, E, tid); }
                { int tid2 = tid; asm volatile("" : "+v"(tid2));
                  pg8::Gemm g{hb, (const bf16*)(ws + OFF_WPG + li * WSQ_SZ), NPR, D, D};
                  pg8::StaticOrder S; S.init(NPR, D, G, bid); pg8::EpiPle E{hbuf, ob, rs1, rs0, pp};
                  pg8::gemm_phase<pg8::EpiPle, pg8::StaticOrder, true, true>(lds, g, S, E, tid2); }
                { int tid3 = tid; asm volatile("" : "+v"(tid3));
                  mini_gemm<1, D>(lds, hb, (const bf16*)(ws + OFF_WPG + li * WSQ_SZ), (const bf16*)(ws + OFF_PB + li * PB_SZ), (const bf16*)(ws + OFF_WPP + li * WPP_SZ), hbuf, ob, rs1, rs0, 0.f, tid3, bid, G); }
            }
        }
#if PROBE_MODE
        if (ph_ + 1 < ph_hi || rep + 1 < nrep) grid.sync();
#else
        if (ph_ + 1 < ph_hi) grid.sync();
#endif
      }
    }
}

extern "C" void kernel_launch(void* const* d_in, const int* in_sizes, int n_in, void* d_out, int out_size, void* d_ws, size_t ws_size, hipStream_t stream) {
    static int grid = 0;
    if (grid == 0) {
        if (n_in != 26 || (size_t)out_size != OUT_END || ws_size < WS_END) { fprintf(stderr, "kernel_launch: unexpected shapes (n_in %d out %d ws %zu need %zu); nothing launched\n", n_in, out_size, ws_size, (size_t)WS_END); grid = -1; return; }
        int dev = 0, cus = 0, per_cu = 0;
        if (hipGetDevice(&dev) != hipSuccess || hipDeviceGetAttribute(&cus, hipDeviceAttributeMultiprocessorCount, dev) != hipSuccess) { grid = -1; return; }
        if (hipFuncSetAttribute((const void*)fwd_kernel, hipFuncAttributeMaxDynamicSharedMemorySize, LDS_BYTES) != hipSuccess) { fprintf(stderr, "kernel_launch: hipFuncSetAttribute failed\n"); grid = -1; return; }
        if (hipOccupancyMaxActiveBlocksPerMultiprocessor(&per_cu, (const void*)fwd_kernel, NWAVES * 64, LDS_BYTES) != hipSuccess || per_cu < 1) per_cu = 1;
        (void)hipGetLastError();
        grid = cus * per_cu;
    }
    if (grid < 0) return;
    Args a{};
    for (int i = 0; i < 26; ++i) a.in[i] = (const float*)d_in[i];
    a.out = (float*)d_out; a.ws = (unsigned char*)d_ws;
#if MK_N_LAUNCHES == 1
    a.ph_lo = 0; a.ph_hi = NPH;
    void* args[] = {&a};
    hipError_t e = hipLaunchCooperativeKernel((const void*)fwd_kernel, dim3(grid), dim3(NWAVES * 64), args, LDS_BYTES, stream);
    if (e != hipSuccess) fprintf(stderr, "kernel_launch: cooperative launch failed: %s (grid %d)\n", hipGetErrorString(e), grid);
#else
    for (int ph = 0; ph < NPH; ++ph) { a.ph_lo = ph; a.ph_hi = ph + 1; hipLaunchKernelGGL(fwd_kernel, dim3(grid), dim3(NWAVES * 64), LDS_BYTES, stream, a); }
#endif
}
```

```cpp
#include <hip/hip_runtime.h>
#include <cstdio>
#include <cstdint>
#ifndef MK_N_LAUNCHES
#define MK_N_LAUNCHES 1
#endif
#ifndef PROBE_MODE
#define PROBE_MODE 0
#endif
#ifndef EXTRA_SYNCS
#define EXTRA_SYNCS 0
#endif
namespace pg8 {
#define PG8_LAS __attribute__((address_space(3)))
typedef unsigned short bf16_t;
typedef short bf16x8 __attribute__((ext_vector_type(8)));
typedef float f32x4 __attribute__((ext_vector_type(4)));
typedef unsigned u32x4 __attribute__((ext_vector_type(4)));
constexpr int BM = 256, BK = 64, HALF = 128, HTB = HALF * BK * 2  , STAGE_BYTES = 8 * HTB, NXCD = 8, WGM = 8;

__host__ __device__ __forceinline__ int lds_byte(int r, int c) { const int st = (r >> 4) * 2 + (c >> 5), rr = r & 15, cc = c & 31, ob = rr * 64 + cc * 2; return st * 1024 + (ob ^ (((ob >> 9) & 1) << 5)); }
__host__ __device__ __forceinline__ void stage_rc(int b, int& R, int& C) { const int st = b / 1024, sb = b % 1024, swz = sb ^ (((sb >> 9) & 1) << 5); R = (st >> 1) * 16 + swz / 64; C = (st & 1) * 32 + (swz % 64) / 2; }
__host__ __device__ __forceinline__ int perm32(int rho) { const int n = rho >> 4, i = rho & 15; return 8 * (i >> 2) + 4 * n + (i & 3); }

struct Unit { int pm, pn; };
struct Gemm { const bf16_t* A; const bf16_t* Bt; int M, N, K; };

struct StaticOrder {
    int nM, nN, nwg, G, c;
    __host__ __device__ void init(int M, int N, int G_, int c_) { nM = M / BM; nN = N / BM; nwg = nM * nN; G = G_; c = c_; }
    __host__ __device__ bool next(int i, Unit& u) const {
        const long L = (long)i * G + c; if (L >= nwg) return false;
        int wgid = (int)L; { const int q = nwg / NXCD, r = nwg % NXCD, xcd = wgid % NXCD, off = wgid / NXCD; wgid = (xcd < r ? xcd * (q + 1) : r * (q + 1) + (xcd - r) * q) + off; }
        const int nig = WGM * nN, gid = wgid / nig, fm = gid * WGM, gsz = (nM - fm) < WGM ? (nM - fm) : WGM;
        u.pm = fm + ((wgid % nig) % gsz); u.pn = (wgid % nig) / gsz; return true;
    }
    __device__ __forceinline__ void a_ready(const Unit&) const {}
    __device__ __forceinline__ void done(const Unit&) const {}
};

__device__ __forceinline__ unsigned cvt_pk_bf16(float lo, float hi) { unsigned r; asm volatile("v_cvt_pk_bf16_f32 %0, %1, %2" : "=v"(r) : "v"(lo), "v"(hi)); return r; }
typedef float f32x2 __attribute__((ext_vector_type(2)));
typedef unsigned u32x2 __attribute__((ext_vector_type(2)));
__device__ __forceinline__ float row_scale(const float* rs, int row) {
    const f32x4* p = (const f32x4*)(rs + (size_t)row * 16);
    const f32x4 a = p[0], b = p[1], c = p[2], d = p[3];
    const float s = ((a[0] + a[1]) + (a[2] + a[3])) + ((b[0] + b[1]) + (b[2] + b[3])) + ((c[0] + c[1]) + (c[2] + c[3])) + ((d[0] + d[1]) + (d[2] + d[3]));
    return rsqrtf(s * (1.0f / 1024.0f) + 1e-6f);
}
__device__ __forceinline__ float sigm(float x) { return __builtin_amdgcn_rcpf(1.0f + __expf(-x)); }
struct EpiSwiglu {
    static constexpr bool PERM = true, AFTER_DRAIN = false;
    bf16_t* O; int ldc; const float* rs;
    __device__ __forceinline__ void operator()(const f32x4 (&acc)[2][2][4][2], const Unit& u, int wr, int wc, int fr_, int fq_) const {
        int ln_ = fr_ + 16 * fq_; asm volatile("" : "+v"(ln_)); const int fr = ln_ & 15, fq = ln_ >> 4;
        const int row0 = u.pm * BM + wr * 64 + fr, col0 = u.pn * HALF + wc * 32 + 8 * fq;
#pragma unroll
        for (int ai = 0; ai < 2; ++ai)
#pragma unroll
            for (int m = 0; m < 4; ++m) { const int row = row0 + ai * HALF + m * 16; const float s = row_scale(rs, row);
                float o[8];
#pragma unroll
                for (int n = 0; n < 2; ++n)
#pragma unroll
                    for (int i = 0; i < 4; ++i) { const float g = acc[ai][0][m][n][i] * s, up = acc[ai][1][m][n][i] * s; o[n * 4 + i] = g * sigm(g) * up; }
                u32x4 w; w.x = cvt_pk_bf16(o[0], o[1]); w.y = cvt_pk_bf16(o[2], o[3]); w.z = cvt_pk_bf16(o[4], o[5]); w.w = cvt_pk_bf16(o[6], o[7]);
                *(u32x4*)(O + (size_t)row * ldc + col0) = w; }
    }
};
struct EpiZ {
    static constexpr bool PERM = true, AFTER_DRAIN = false;
    bf16_t* Z; int ldz; const float* rs; float* R; int r_tile;
    __device__ __forceinline__ void operator()(const f32x4 (&acc)[2][2][4][2], const Unit& u, int wr, int wc, int fr_, int fq_) const {
        int ln_ = fr_ + 16 * fq_; asm volatile("" : "+v"(ln_)); const int fr = ln_ & 15, fq = ln_ >> 4;
        const int row0 = u.pm * BM + wr * 64 + fr, col0 = u.pn * BM + wc * 32 + 8 * fq;
        if (u.pn == r_tile) {
            if (wc == 0 && fq < 2) {
#pragma unroll
                for (int ai = 0; ai < 2; ++ai)
#pragma unroll
                    for (int m = 0; m < 4; ++m) { const int row = row0 + ai * HALF + m * 16; const float s = row_scale(rs, row);
#pragma unroll
                        for (int n = 0; n < 2; ++n) *(f32x4*)(R + (size_t)row * 16 + 8 * fq + 4 * n) = acc[ai][0][m][n] * s; }
            }
            return;
        }
#pragma unroll
        for (int ai = 0; ai < 2; ++ai)
#pragma unroll
            for (int m = 0; m < 4; ++m) { const int row = row0 + ai * HALF + m * 16; const float s = row_scale(rs, row);
#pragma unroll
                for (int bj = 0; bj < 2; ++bj) { const f32x4 v0 = acc[ai][bj][m][0] * s, v1 = acc[ai][bj][m][1] * s;
                    u32x4 w; w.x = cvt_pk_bf16(v0[0], v0[1]); w.y = cvt_pk_bf16(v0[2], v0[3]); w.z = cvt_pk_bf16(v1[0], v1[1]); w.w = cvt_pk_bf16(v1[2], v1[3]);
                    *(u32x4*)(Z + (size_t)row * ldz + col0 + bj * HALF) = w; } }
    }
};
struct EpiResid {
    static constexpr bool PERM = false, AFTER_DRAIN = false;
    float* h; bf16_t* hb; float* rs_out; float alpha;
    __device__ __forceinline__ void operator()(const f32x4 (&acc)[2][2][4][2], const Unit& u, int wr, int wc, int fr_, int fq_) const {
        int ln_ = fr_ + 16 * fq_; asm volatile("" : "+v"(ln_)); const int fr = ln_ & 15, fq = ln_ >> 4;
        const int row0 = u.pm * BM + wr * 64 + fr, col0 = u.pn * BM + wc * 32 + 4 * fq;
#pragma unroll
        for (int ai = 0; ai < 2; ++ai)
#pragma unroll
            for (int m = 0; m < 4; ++m) { const int row = row0 + ai * HALF + m * 16; float ss = 0.f;
#pragma unroll
                for (int bj = 0; bj < 2; ++bj)
#pragma unroll
                    for (int n = 0; n < 2; ++n) { const size_t off = (size_t)row * 1024 + col0 + bj * HALF + n * 16;
                        const f32x4 o = *(const f32x4*)(h + off) + acc[ai][bj][m][n] * alpha; *(f32x4*)(h + off) = o;
                        ss += (o[0] * o[0] + o[1] * o[1]) + (o[2] * o[2] + o[3] * o[3]);
                        u32x2 w; w.x = cvt_pk_bf16(o[0], o[1]); w.y = cvt_pk_bf16(o[2], o[3]); *(u32x2*)(hb + off) = w; }
                ss += __shfl_xor(ss, 16); ss += __shfl_xor(ss, 32);
                if (fq == 0) rs_out[(size_t)row * 16 + u.pn * 4 + wc] = ss; }
    }
};
struct EpiStoreF32 {
    static constexpr bool PERM = false, AFTER_DRAIN = false;
    float* O;
    __device__ __forceinline__ void operator()(const f32x4 (&acc)[2][2][4][2], const Unit& u, int wr, int wc, int fr_, int fq_) const {
        int ln_ = fr_ + 16 * fq_; asm volatile("" : "+v"(ln_)); const int fr = ln_ & 15, fq = ln_ >> 4;
        const int row0 = u.pm * BM + wr * 64 + fr, col0 = u.pn * BM + wc * 32 + 4 * fq;
#pragma unroll
        for (int ai = 0; ai < 2; ++ai)
#pragma unroll
            for (int m = 0; m < 4; ++m)
#pragma unroll
                for (int bj = 0; bj < 2; ++bj)
#pragma unroll
                    for (int n = 0; n < 2; ++n) *(f32x4*)(O + (size_t)(row0 + ai * HALF + m * 16) * 1024 + col0 + bj * HALF + n * 16) = acc[ai][bj][m][n];
    }
};
struct EpiPle {
    static constexpr bool PERM = false, AFTER_DRAIN = false;
    float* h; bf16_t* hb; const float* rs_in; float* rs_out; const float* pp;
    __device__ __forceinline__ void operator()(const f32x4 (&acc)[2][2][4][2], const Unit& u, int wr, int wc, int fr_, int fq_) const {
        int ln_ = fr_ + 16 * fq_; asm volatile("" : "+v"(ln_)); const int fr = ln_ & 15, fq = ln_ >> 4;
        const int row0 = u.pm * BM + wr * 64 + fr, col0 = u.pn * BM + wc * 32 + 4 * fq;
#pragma unroll
        for (int ai = 0; ai < 2; ++ai)
#pragma unroll
            for (int m = 0; m < 4; ++m) { const int row = row0 + ai * HALF + m * 16; const float s = row_scale(rs_in, row); float ss = 0.f;
#pragma unroll
                for (int bj = 0; bj < 2; ++bj)
#pragma unroll
                    for (int n = 0; n < 2; ++n) { const size_t off = (size_t)row * 1024 + col0 + bj * HALF + n * 16;
                        const f32x4 a = acc[ai][bj][m][n] * s, p = *(const f32x4*)(pp + off); f32x4 o = *(const f32x4*)(h + off);
                        o[0] += sigm(a[0]) * p[0]; o[1] += sigm(a[1]) * p[1]; o[2] += sigm(a[2]) * p[2]; o[3] += sigm(a[3]) * p[3];
                        *(f32x4*)(h + off) = o; ss += (o[0] * o[0] + o[1] * o[1]) + (o[2] * o[2] + o[3] * o[3]);
                        u32x2 w; w.x = cvt_pk_bf16(o[0], o[1]); w.y = cvt_pk_bf16(o[2], o[3]); *(u32x2*)(hb + off) = w; }
                ss += __shfl_xor(ss, 16); ss += __shfl_xor(ss, 32);
                if (fq == 0) rs_out[(size_t)row * 16 + u.pn * 4 + wc] = ss; }
    }
};
template <class Epi, class Sched, bool ALIGN_EPI = false, bool SP2 = false>
__device__ __forceinline__ void gemm_phase(PG8_LAS unsigned char* lds, const Gemm g, const Sched& S, const Epi& E, const int tid) {
    const int wid = __builtin_amdgcn_readfirstlane(tid >> 6), lane = tid & 63, wr = wid >> 2, wc = wid & 3, fr = lane & 15, fq = lane >> 4;
    const int K = g.K, nt = K / BK;
    unsigned voffA[2], voffB[2];
#pragma unroll
    for (int i = 0; i < 2; ++i) { int R, C; stage_rc(tid * 16 + i * 8192, R, C); const int Rb = Epi::PERM ? ((R & ~31) + perm32(R & 31)) : R;
        voffA[i] = (unsigned)(R * K + C) * 2u; voffB[i] = (unsigned)(Rb * K + C) * 2u; }
    const size_t kstep = (size_t)(BK * 2);
    const size_t hstep = (size_t)HALF * K * 2;
    const size_t tstep = 2 * hstep;
    const unsigned ldsw = (unsigned)wid * 1024u;
    const int aoff = lds_byte(wr * 64 + fr, fq * 8), boff = lds_byte(wc * 32 + fr, fq * 8);
#define PG8_SA(b, h) (((b) * 2 + (h)) * HTB)
#define PG8_SB(b, h) ((4 + (b) * 2 + (h)) * HTB)
#define PG8_STAGE(bufoff, gbase, voff) do { _Pragma("unroll") for (int _i = 0; _i < 2; ++_i) \
        __builtin_amdgcn_global_load_lds((const unsigned*)((const char*)(gbase) + (voff)[_i]), (PG8_LAS unsigned*)(lds + (bufoff) + ldsw + _i * 8192), 16, 0, 0); } while (0)
#define PG8_LDA(dst, b, h) do { _Pragma("unroll") for (int m = 0; m < 4; ++m) _Pragma("unroll") for (int k = 0; k < 2; ++k) dst[m][k] = *(const PG8_LAS bf16x8*)(lds + PG8_SA(b, h) + aoff + m * 2048 + k * 1024); } while (0)
#define PG8_LDB(dst, b, h) do { _Pragma("unroll") for (int n = 0; n < 2; ++n) _Pragma("unroll") for (int k = 0; k < 2; ++k) dst[n][k] = *(const PG8_LAS bf16x8*)(lds + PG8_SB(b, h) + boff + n * 2048 + k * 1024); } while (0)
#define PG8_MMA(ai, bj, At, Bt) do { __builtin_amdgcn_s_setprio(1); _Pragma("unroll") for (int m = 0; m < 4; ++m) _Pragma("unroll") for (int n = 0; n < 2; ++n) _Pragma("unroll") for (int k = 0; k < 2; ++k) \
        acc[ai][bj][m][n] = __builtin_amdgcn_mfma_f32_16x16x32_bf16(Bt[n][k], At[m][k], acc[ai][bj][m][n], 0, 0, 0); __builtin_amdgcn_s_setprio(0); } while (0)
#define PG8_WAIT_V(n) asm volatile("s_waitcnt vmcnt(" #n ")" ::: "memory")
#define PG8_WAIT_L(n) asm volatile("s_waitcnt lgkmcnt(" #n ")" ::: "memory")
#define PG8_BAR __builtin_amdgcn_s_barrier()
#define PG8_SCHED __builtin_amdgcn_sched_barrier(0)
    Unit cur, nxt; int ui = 0;
    if (!S.next(0, cur)) return;
    f32x4 acc[2][2][4][2];
#pragma unroll
    for (int a = 0; a < 2; ++a)
#pragma unroll
        for (int b = 0; b < 2; ++b)
#pragma unroll
            for (int m = 0; m < 4; ++m)
#pragma unroll
                for (int n = 0; n < 2; ++n) acc[a][b][m][n] = (f32x4){0.f, 0.f, 0.f, 0.f};
    bf16x8 At[4][2], B0[2][2], B1[2][2];
    const char* cA = (const char*)g.A + (size_t)cur.pm * tstep; const char* cB = (const char*)g.Bt + (size_t)cur.pn * tstep;
    S.a_ready(cur);
    if constexpr (SP2) {
        PG8_STAGE(PG8_SB(0, 0), cB, voffB); PG8_STAGE(PG8_SB(0, 1), cB + hstep, voffB); PG8_STAGE(PG8_SA(0, 0), cA, voffA); PG8_STAGE(PG8_SA(0, 1), cA + hstep, voffA);
        if (wr == 1) PG8_BAR;
        PG8_WAIT_V(2); PG8_BAR;
        PG8_STAGE(PG8_SB(1, 0), cB + kstep, voffB); PG8_STAGE(PG8_SA(1, 0), cA + kstep, voffA); PG8_STAGE(PG8_SB(1, 1), cB + hstep + kstep, voffB);
        PG8_WAIT_V(6); PG8_BAR;
    } else {
        PG8_STAGE(PG8_SB(0, 0), cB, voffB); PG8_STAGE(PG8_SA(0, 0), cA, voffA); PG8_STAGE(PG8_SB(0, 1), cB + hstep, voffB); PG8_STAGE(PG8_SA(0, 1), cA + hstep, voffA);
        if (wr == 1) PG8_BAR;
        PG8_WAIT_V(4); PG8_BAR;
        PG8_STAGE(PG8_SB(1, 0), cB + kstep, voffB); PG8_STAGE(PG8_SA(1, 0), cA + kstep, voffA); PG8_STAGE(PG8_SB(1, 1), cB + hstep + kstep, voffB);
        PG8_WAIT_V(6); PG8_BAR;
    }
    for (;;) {
        const bool has_next = S.next(ui + 1, nxt);
        const char* nA = has_next ? (const char*)g.A + (size_t)nxt.pm * tstep : cA; const char* nB = has_next ? (const char*)g.Bt + (size_t)nxt.pn * tstep : cB;
        for (int t = 0; t < nt; t += 2) {
            const bool last = (t == nt - 2);
            const char* a1 = cA + (size_t)(t + 1) * kstep;
            const char* a2 = last ? nA : cA + (size_t)(t + 2) * kstep; const char* b2 = last ? nB : cB + (size_t)(t + 2) * kstep;
            const char* a3 = a2 + kstep; const char* b3 = b2 + kstep;
            if (last && has_next) S.a_ready(nxt);
            if constexpr (SP2) {
            PG8_LDB(B0, 0, 0); PG8_LDB(B1, 0, 1); PG8_SCHED; PG8_LDA(At, 0, 0); PG8_STAGE(PG8_SA(1, 1), a1 + hstep, voffA);
            PG8_WAIT_V(8); PG8_WAIT_L(0); PG8_BAR; PG8_MMA(0, 0, At, B0); PG8_MMA(0, 1, At, B1); PG8_BAR; PG8_SCHED;
            PG8_LDA(At, 0, 1); PG8_STAGE(PG8_SB(0, 0), b2, voffB); PG8_STAGE(PG8_SB(0, 1), b2 + hstep, voffB); PG8_STAGE(PG8_SA(0, 0), a2, voffA);
            PG8_WAIT_V(8); PG8_WAIT_L(0); PG8_BAR; PG8_MMA(1, 0, At, B0); PG8_MMA(1, 1, At, B1); PG8_BAR; PG8_SCHED;
            PG8_LDB(B0, 1, 0); PG8_LDB(B1, 1, 1); PG8_SCHED; PG8_LDA(At, 1, 0); PG8_STAGE(PG8_SA(0, 1), a2 + hstep, voffA);
            PG8_WAIT_V(8); PG8_WAIT_L(0); PG8_BAR; PG8_MMA(0, 0, At, B0); PG8_MMA(0, 1, At, B1); PG8_BAR; PG8_SCHED;
            PG8_LDA(At, 1, 1); PG8_STAGE(PG8_SB(1, 0), b3, voffB); PG8_STAGE(PG8_SB(1, 1), b3 + hstep, voffB); PG8_STAGE(PG8_SA(1, 0), a3, voffA);
            PG8_WAIT_V(8); PG8_WAIT_L(0); PG8_BAR; PG8_MMA(1, 0, At, B0); PG8_MMA(1, 1, At, B1); PG8_BAR; PG8_SCHED;
            } else {
            PG8_LDB(B0, 0, 0); PG8_SCHED; PG8_LDA(At, 0, 0); PG8_STAGE(PG8_SA(1, 1), a1 + hstep, voffA);
            PG8_WAIT_L(8); PG8_BAR; PG8_WAIT_L(0); PG8_MMA(0, 0, At, B0); PG8_BAR; PG8_SCHED;
            PG8_LDB(B1, 0, 1); PG8_STAGE(PG8_SB(0, 0), b2, voffB);
            PG8_BAR; PG8_WAIT_L(0); PG8_MMA(0, 1, At, B1); PG8_BAR;
            PG8_LDA(At, 0, 1); PG8_STAGE(PG8_SA(0, 0), a2, voffA);
            PG8_BAR; PG8_WAIT_L(0); PG8_MMA(1, 0, At, B0); PG8_BAR; PG8_SCHED;
            PG8_STAGE(PG8_SB(0, 1), b2 + hstep, voffB);
            PG8_WAIT_V(6); PG8_BAR; PG8_MMA(1, 1, At, B1); PG8_BAR;
            PG8_LDB(B0, 1, 0); PG8_SCHED; PG8_LDA(At, 1, 0); PG8_STAGE(PG8_SA(0, 1), a2 + hstep, voffA);
            PG8_WAIT_L(8); PG8_BAR; PG8_WAIT_L(0); PG8_MMA(0, 0, At, B0); PG8_BAR; PG8_SCHED;
            PG8_LDB(B1, 1, 1); PG8_STAGE(PG8_SB(1, 0), b3, voffB);
            PG8_BAR; PG8_WAIT_L(0); PG8_MMA(0, 1, At, B1); PG8_BAR;
            PG8_LDA(At, 1, 1); PG8_STAGE(PG8_SA(1, 0), a3, voffA);
            PG8_BAR; PG8_WAIT_L(0); PG8_MMA(1, 0, At, B0); PG8_BAR; PG8_SCHED;
            PG8_STAGE(PG8_SB(1, 1), b3 + hstep, voffB);
            PG8_WAIT_V(6); PG8_BAR; PG8_MMA(1, 1, At, B1); PG8_BAR;
            }
        }
        if constexpr (ALIGN_EPI) { if (wr == 0) PG8_BAR; }
        if constexpr (!Epi::AFTER_DRAIN) { E(acc, cur, wr, wc, fr, fq); S.done(cur); }
        if (!has_next) break;
#pragma unroll
        for (int a = 0; a < 2; ++a)
#pragma unroll
            for (int b = 0; b < 2; ++b)
#pragma unroll
                for (int m = 0; m < 4; ++m)
#pragma unroll
                    for (int n = 0; n < 2; ++n) acc[a][b][m][n] = (f32x4){0.f, 0.f, 0.f, 0.f};
        cur = nxt; cA = nA; cB = nB; ++ui;
        if constexpr (ALIGN_EPI) { if (wr == 1) PG8_BAR; }
    }
    PG8_WAIT_V(0);
    if constexpr (!ALIGN_EPI) { if (wr == 0) PG8_BAR; }
    PG8_BAR;
    if constexpr (Epi::AFTER_DRAIN) { E.fused(acc, cur, wr, wc, fr, fq, lds, wid, lane); S.done(cur); }
#undef PG8_SA
#undef PG8_SB
#undef PG8_STAGE
#undef PG8_LDA
#undef PG8_LDB
#undef PG8_MMA
#undef PG8_WAIT_V
#undef PG8_WAIT_L
#undef PG8_BAR
#undef PG8_SCHED
}
}
#include <hip/hip_cooperative_groups.h>
namespace cg = cooperative_groups;
#define LAS __attribute__((address_space(3)))
typedef unsigned short bf16;
typedef float f32x4 __attribute__((ext_vector_type(4)));
typedef short bf16x8 __attribute__((ext_vector_type(8)));
typedef unsigned v4u __attribute__((ext_vector_type(4)));
typedef unsigned v2u __attribute__((ext_vector_type(2)));
constexpr int D = 1024, NPR = 16384, NSM = 512, M = NPR + NSM, SEQ = 2048, NB = 8, DB = 128, FF = 2816, PLE = 256, NCH = 32;
constexpr int NWAVES = 8, LDS_BYTES = 147456, NPH = 22;
constexpr size_t WGU_SZ = (size_t)5632 * 1024 * 2, WDN_SZ = (size_t)1024 * 2816 * 2, WSQ_SZ = (size_t)1024 * 1024 * 2, WPP_SZ = (size_t)1024 * 256 * 2;
constexpr size_t OFF_WGU = 0, OFF_WDN = OFF_WGU + 4 * WGU_SZ, OFF_WGIN = OFF_WDN + 4 * WDN_SZ, OFF_WHIN = OFF_WGIN + (size_t)3328 * 1024 * 2,
    OFF_WOUT = OFF_WHIN + (size_t)4096 * 1024 * 2, OFF_WPG = OFF_WOUT + 2 * WSQ_SZ, OFF_WPP = OFF_WPG + 2 * WSQ_SZ, OFF_HB = OFF_WPP + 2 * WPP_SZ;
constexpr size_t HB_SZ = (size_t)M * 1024 * 2;
constexpr size_t OFF_BIG = OFF_HB + 2 * HB_SZ, OFF_PB = OFF_BIG + (size_t)M * 4096 * 2, PB_SZ = (size_t)M * 256 * 2, OFF_AB = OFF_PB + 2 * PB_SZ,
    OFF_DB = OFF_AB + (size_t)2048 * 4096 * 2, OFF_RS = OFF_DB + (size_t)2048 * 128 * 4, RS_SZ = (size_t)M * 16 * 4, OFF_R = OFF_RS + 2 * RS_SZ, WS_END = OFF_R + RS_SZ, OFF_CTL = WS_END, CTL_BYTES = 16384, WS_TOTAL = OFF_CTL + CTL_BYTES;
constexpr size_t OUT_YS = (size_t)NPR * D, OUT_GP = (size_t)M * D, OUT_GS = OUT_GP + 1048576, OUT_HP = OUT_GS + 16777216, OUT_HS = OUT_HP + 1048576, OUT_END = OUT_HS + 16777216;

__device__ __forceinline__ float bf2f(unsigned short u) { return __uint_as_float((unsigned)u << 16); }
__device__ __forceinline__ float bflo(unsigned u) { return __uint_as_float(u << 16); }
__device__ __forceinline__ float bfhi(unsigned u) { return __uint_as_float(u & 0xffff0000u); }
__device__ __forceinline__ unsigned pk2(float lo, float hi) { return pg8::cvt_pk_bf16(lo, hi); }
__device__ __forceinline__ float sigm(float x) { return __builtin_amdgcn_rcpf(1.0f + __expf(-x)); }
__device__ __forceinline__ float logsig(float x) { return fminf(x, 0.f) - __logf(1.0f + __expf(-fabsf(x))); }
__device__ __forceinline__ float wave_sum(float v) {
#pragma unroll
    for (int o = 1; o < 64; o <<= 1) v += __shfl_xor(v, o);
    return v;
}
#define LDS_WAIT() asm volatile("s_waitcnt lgkmcnt(0)" ::: "memory")

__device__ __forceinline__ void tr_item(const float* W, int Nsrc, int K, bf16* WT, const float* sk, int item, int nblk, int mode, int nvalid, LAS float* scr, int lane) {
    const int kb = item / nblk, nb = item % nblk, k0 = 64 * kb, n0 = 32 * nb;
    int src0 = n0, valid = 32;
    if (mode == 1) { const int pn = n0 >> 8, within = n0 & 255, half = within >> 7, j = within & 127; src0 = half * FF + 128 * pn + j; }
    if (mode == 2) { valid = nvalid - n0; valid = valid < 0 ? 0 : (valid > 32 ? 32 : valid); }
    const int c = lane & 31;
#pragma unroll
    for (int i = 0; i < 32; ++i) { const int kk = 2 * i + (lane >> 5); float v = 0.f; if (c < valid) v = W[(size_t)(k0 + kk) * Nsrc + src0 + c]; if (sk) v *= sk[k0 + kk]; scr[kk * 33 + c] = v; }
    LDS_WAIT();
    const int ch = lane & 7;
#pragma unroll
    for (int j = 0; j < 4; ++j) { const int n = (lane >> 3) + 8 * j; const LAS float* s = scr + (8 * ch) * 33 + n;
        v4u o; o.x = pk2(s[0 * 33], s[1 * 33]); o.y = pk2(s[2 * 33], s[3 * 33]); o.z = pk2(s[4 * 33], s[5 * 33]); o.w = pk2(s[6 * 33], s[7 * 33]);
        *(v4u*)(WT + (size_t)(n0 + n) * K + k0 + 8 * ch) = o; }
    LDS_WAIT();
}
struct Args { const float* in[26]; float* out; unsigned char* ws; int ph_lo, ph_hi; };
typedef const Args __attribute__((address_space(4))) CArgs;

__device__ __forceinline__ void prologue(CArgs* a, unsigned char* ws, float* outp, LAS unsigned char* lds, int tid, int bid, int G) {
    const int lane = tid & 63, wave = tid >> 6;
    LAS float* scr = (LAS float*)(lds + wave * 16384);
    const int gw = bid * NWAVES + wave, NGW = G * NWAVES;
    constexpr int I_GU = 16 * 176, I_DN = 44 * 32, I_GIN = 16 * 104, I_HIN = 16 * 128, I_SQ = 16 * 32, I_PP = 4 * 32;
    constexpr int NITEMS = 4 * I_GU + 4 * I_DN + I_GIN + I_HIN + 4 * I_SQ + 2 * I_PP;
    for (int it = gw; it < NITEMS; it += NGW) {
        int r = it;
        if (r < 4 * I_GU) { const int q = r / I_GU, li = q >> 1, f = q & 1; r -= q * I_GU;
            tr_item((f ? a->in[20] : a->in[7]) + (size_t)li * 1024 * 5632, 5632, 1024, (bf16*)(ws + OFF_WGU + q * WGU_SZ), (f ? a->in[19] : a->in[6]) + li * 1024, r, 176, 1, 0, scr, lane); continue; }
        r -= 4 * I_GU;
        if (r < 4 * I_DN) { const int q = r / I_DN, li = q >> 1, f = q & 1; r -= q * I_DN;
            tr_item((f ? a->in[21] : a->in[8]) + (size_t)li * 2816 * 1024, 1024, 2816, (bf16*)(ws + OFF_WDN + q * WDN_SZ), nullptr, r, 32, 0, 0, scr, lane); continue; }
        r -= 4 * I_DN;
        if (r < I_GIN) { tr_item(a->in[10], 3088, 1024, (bf16*)(ws + OFF_WGIN), a->in[9], r, 104, 2, 3088, scr, lane); continue; }
        r -= I_GIN;
        if (r < I_HIN) { tr_item(a->in[15], 4096, 1024, (bf16*)(ws + OFF_WHIN), a->in[9] + 1024, r, 128, 0, 0, scr, lane); continue; }
        r -= I_HIN;
        if (r < I_SQ) { tr_item(a->in[14], 1024, 1024, (bf16*)(ws + OFF_WOUT), nullptr, r, 32, 0, 0, scr, lane); continue; }
        r -= I_SQ;
        if (r < I_SQ) { tr_item(a->in[17], 1024, 1024, (bf16*)(ws + OFF_WOUT + WSQ_SZ), nullptr, r, 32, 0, 0, scr, lane); continue; }
        r -= I_SQ;
        if (r < 2 * I_SQ) { const int li = r / I_SQ; r -= li * I_SQ;
            tr_item(a->in[23] + (size_t)li * 1024 * 1024, 1024, 1024, (bf16*)(ws + OFF_WPG + li * WSQ_SZ), a->in[22] + li * 1024, r, 32, 0, 0, scr, lane); continue; }
        r -= 2 * I_SQ;
        { const int li = r / I_PP; r -= li * I_PP;
            tr_item(a->in[24] + (size_t)li * 256 * 1024, 1024, 256, (bf16*)(ws + OFF_WPP + li * WPP_SZ), nullptr, r, 32, 0, 0, scr, lane); }
    }
    bf16* hb = (bf16*)(ws + OFF_HB); float* rs = (float*)(ws + OFF_RS);
    for (int m = gw; m < M; m += NGW) {
        const float* xr = m < NPR ? a->in[0] + (size_t)m * D : a->in[1] + (size_t)(m - NPR) * D;
        float ss = 0.f;
#pragma unroll
        for (int j = 0; j < 4; ++j) { const f32x4 v = *((const f32x4*)xr + lane + 64 * j); ss += (v[0] * v[0] + v[1] * v[1]) + (v[2] * v[2] + v[3] * v[3]);
            *((f32x4*)(outp + (size_t)m * D) + lane + 64 * j) = v; v2u w; w.x = pk2(v[0], v[1]); w.y = pk2(v[2], v[3]); *((v2u*)(hb + (size_t)m * D) + lane + 64 * j) = w; }
        ss = wave_sum(ss);
        if (lane < 16) rs[(size_t)m * 16 + lane] = lane == 0 ? ss : 0.f;
    }
    const int gt = bid * (NWAVES * 64) + tid, NGT = G * NWAVES * 64;
    for (int e = gt; e < 2 * M * 32; e += NGT) { const int li = e / (M * 32), rem = e % (M * 32), m = rem >> 5, c8 = (rem & 31) * 8;
        const float* src = m < NPR ? a->in[4] + ((size_t)li * NPR + m) * 256 + c8 : a->in[5] + ((size_t)li * NSM + (m - NPR)) * 256 + c8;
        const f32x4 v0 = *(const f32x4*)src, v1 = *(const f32x4*)(src + 4);
        v4u w; w.x = pk2(v0[0], v0[1]); w.y = pk2(v0[2], v0[3]); w.z = pk2(v1[0], v1[1]); w.w = pk2(v1[2], v1[3]);
        *(v4u*)((bf16*)(ws + OFF_PB + li * PB_SZ) + (size_t)m * 256 + c8) = w; }
}
template <bool HG> struct MX {
    static constexpr int H = HG ? 8 : 4, DV = HG ? 128 : 256, LDZ = HG ? 4096 : 3328, KC = HG ? 1024 : 512, VC = HG ? 2048 : 1024, GC = HG ? 3072 : 2048, VR = DV / 64, NVG = DV / 16, NVR = DV / 64;
    static constexpr float scale = HG ? 1.0f : 0.08838834764831845f;
};
template <bool HG> __device__ __forceinline__ void prep_phase(LAS unsigned char* lds, bf16* Z, const float* R, const float* wup, const float* bgk, const float* lowb, bf16* AB, float* DBUF, int tid, int bid, int G) {
    typedef MX<HG> C; constexpr int H = C::H, DV = C::DV, LDZ = C::LDZ, KC = C::KC, VC = C::VC, VR = C::VR, VP = DV + 8, QP = 136;
    LAS float* gl = (LAS float*)lds; LAS float* segs = (LAS float*)(lds + 32768);
    LAS bf16* qe_s = (LAS bf16*)(lds + 34816); LAS bf16* kn_s = (LAS bf16*)(lds + 52224); LAS bf16* kd_s = (LAS bf16*)(lds + 69632); LAS bf16* v_s = (LAS bf16*)(lds + 87040);
    const int t = tid >> 3, cs = tid & 7, j0 = cs * 16, lane = tid & 63, w = tid >> 6;
    for (int unit = bid; unit < NB * H * NCH; unit += G) {
        const int n = unit % NCH, bh = unit / NCH, h = bh % H, b = bh / H;
        const size_t tok0 = (size_t)b * SEQ + 64 * n, m = tok0 + t;
        __syncthreads();
        float lbc[16];
        {
            float g[16];
            if constexpr (!HG) {
                f32x4 r4[4];
#pragma unroll
                for (int i = 0; i < 4; ++i) r4[i] = *(const f32x4*)(R + m * 16 + 4 * i);
#pragma unroll
                for (int q = 0; q < 4; ++q) { const f32x4 bv = *(const f32x4*)(bgk + h * 128 + j0 + 4 * q); g[4 * q] = bv[0]; g[4 * q + 1] = bv[1]; g[4 * q + 2] = bv[2]; g[4 * q + 3] = bv[3]; }
#pragma unroll
                for (int i = 0; i < 16; ++i) { const float ri = r4[i >> 2][i & 3]; const float* wp = wup + i * 512 + h * 128 + j0;
#pragma unroll
                    for (int q = 0; q < 4; ++q) { const f32x4 wv = *(const f32x4*)(wp + 4 * q); g[4 * q] += ri * wv[0]; g[4 * q + 1] += ri * wv[1]; g[4 * q + 2] += ri * wv[2]; g[4 * q + 3] += ri * wv[3]; } }
#pragma unroll
                for (int jj = 0; jj < 16; ++jj) { g[jj] = logsig(g[jj]) * (1.0f / 16.0f); lbc[jj] = 0.f; }
            } else {
                const v4u f0 = *(const v4u*)(Z + m * LDZ + KC + h * 128 + j0), f1 = *(const v4u*)(Z + m * LDZ + KC + h * 128 + j0 + 8);
                const unsigned fw[8] = {f0.x, f0.y, f0.z, f0.w, f1.x, f1.y, f1.z, f1.w};
#pragma unroll
                for (int jj = 0; jj < 16; ++jj) { const float f = (jj & 1) ? bfhi(fw[jj >> 1]) : bflo(fw[jj >> 1]);
                    const float x0 = lowb[h * 128 + j0 + jj], x1 = lowb[1024 + h * 128 + j0 + jj];
                    const float a = logsig(x1 - x0), b2 = logsig(x0 - x1) + logsig(f), mx = fmaxf(a, b2);
                    g[jj] = mx + __logf(1.0f + __expf(-fabsf(a - b2))); lbc[jj] = sigm(x0 - x1); }
            }
#pragma unroll
            for (int q = 0; q < 4; ++q) *(LAS f32x4*)(gl + t * 128 + j0 + 4 * q) = (f32x4){g[4 * q], g[4 * q + 1], g[4 * q + 2], g[4 * q + 3]};
        }
        __syncthreads();
        {
            const int j = tid & 127, sg = tid >> 7; float acc = 0.f;
#pragma unroll
            for (int i = 0; i < 16; ++i) { acc += gl[(16 * sg + i) * 128 + j]; gl[(16 * sg + i) * 128 + j] = acc; }
            segs[sg * 128 + j] = acc;
            __syncthreads();
            float off = 0.f;
            for (int s2 = 0; s2 < sg; ++s2) off += segs[s2 * 128 + j];
            if (sg) {
#pragma unroll
                for (int i = 0; i < 16; ++i) gl[(16 * sg + i) * 128 + j] += off; }
        }
        __syncthreads();
        {
            bf16* qp = Z + m * LDZ + h * 128 + j0; const bf16* kp = Z + m * LDZ + KC + h * 128 + j0;
            const v4u q0 = *(const v4u*)qp, q1 = *(const v4u*)(qp + 8), k0 = *(const v4u*)kp, k1 = *(const v4u*)(kp + 8);
            const unsigned qw[8] = {q0.x, q0.y, q0.z, q0.w, q1.x, q1.y, q1.z, q1.w}, kw[8] = {k0.x, k0.y, k0.z, k0.w, k1.x, k1.y, k1.z, k1.w};
            float bb[16], bl[16];
#pragma unroll
            for (int q = 0; q < 4; ++q) { const f32x4 x = *(const LAS f32x4*)(gl + t * 128 + j0 + 4 * q), y = *(const LAS f32x4*)(gl + 63 * 128 + j0 + 4 * q);
                bb[4 * q] = x[0]; bb[4 * q + 1] = x[1]; bb[4 * q + 2] = x[2]; bb[4 * q + 3] = x[3]; bl[4 * q] = y[0]; bl[4 * q + 1] = y[1]; bl[4 * q + 2] = y[2]; bl[4 * q + 3] = y[3]; }
            float qe[16], kn[16], kd[16];
#pragma unroll
            for (int jj = 0; jj < 16; ++jj) { float qv = (jj & 1) ? bfhi(qw[jj >> 1]) : bflo(qw[jj >> 1]); float kv = (jj & 1) ? bfhi(kw[jj >> 1]) : bflo(kw[jj >> 1]);
                if constexpr (HG) { qv = qv * sigm(qv); kv = lbc[jj] * sigm(-kv); }
                qe[jj] = qv * __expf(bb[jj]) * C::scale; kn[jj] = kv * __expf(-bb[jj]); kd[jj] = kv * __expf(bl[jj] - bb[jj]); }
            v4u o0, o1;
            o0.x = pk2(qe[0], qe[1]); o0.y = pk2(qe[2], qe[3]); o0.z = pk2(qe[4], qe[5]); o0.w = pk2(qe[6], qe[7]); o1.x = pk2(qe[8], qe[9]); o1.y = pk2(qe[10], qe[11]); o1.z = pk2(qe[12], qe[13]); o1.w = pk2(qe[14], qe[15]);
            *(v4u*)qp = o0; *(v4u*)(qp + 8) = o1; *(LAS v4u*)(qe_s + t * QP + j0) = o0; *(LAS v4u*)(qe_s + t * QP + j0 + 8) = o1;
            o0.x = pk2(kn[0], kn[1]); o0.y = pk2(kn[2], kn[3]); o0.z = pk2(kn[4], kn[5]); o0.w = pk2(kn[6], kn[7]); o1.x = pk2(kn[8], kn[9]); o1.y = pk2(kn[10], kn[11]); o1.z = pk2(kn[12], kn[13]); o1.w = pk2(kn[14], kn[15]);
            *(LAS v4u*)(kn_s + t * QP + j0) = o0; *(LAS v4u*)(kn_s + t * QP + j0 + 8) = o1;
            o0.x = pk2(kd[0], kd[1]); o0.y = pk2(kd[2], kd[3]); o0.z = pk2(kd[4], kd[5]); o0.w = pk2(kd[6], kd[7]); o1.x = pk2(kd[8], kd[9]); o1.y = pk2(kd[10], kd[11]); o1.z = pk2(kd[12], kd[13]); o1.w = pk2(kd[14], kd[15]);
            *(LAS v4u*)(kd_s + t * QP + j0) = o0; *(LAS v4u*)(kd_s + t * QP + j0 + 8) = o1;
            if (t == 63) {
#pragma unroll
                for (int q = 0; q < 4; ++q) *(f32x4*)(DBUF + (size_t)unit * 128 + j0 + 4 * q) = (f32x4){__expf(bl[4 * q]), __expf(bl[4 * q + 1]), __expf(bl[4 * q + 2]), __expf(bl[4 * q + 3])}; }
            const bf16* vp = Z + m * LDZ + VC + h * DV + cs * (DV / 8);
#pragma unroll
            for (int q = 0; q < DV / 64; ++q) *(LAS v4u*)(v_s + t * VP + cs * (DV / 8) + 8 * q) = *(const v4u*)(vp + 8 * q);
        }
        __syncthreads();
        {
            const int r = lane & 15, quad = lane >> 4, tb = w >> 1;
#pragma unroll
            for (int e = 0; e < 2; ++e) { const int sb = 2 * (w & 1) + e; f32x4 c = {0.f, 0.f, 0.f, 0.f};
                if (sb <= tb) {
#pragma unroll
                    for (int ks = 0; ks < 4; ++ks) { const bf16x8 av = *(const LAS bf16x8*)(kn_s + (16 * sb + r) * QP + 32 * ks + 8 * quad), bv = *(const LAS bf16x8*)(qe_s + (16 * tb + r) * QP + 32 * ks + 8 * quad);
                        c = __builtin_amdgcn_mfma_f32_16x16x32_bf16(av, bv, c, 0, 0, 0); } }
                const int tc = 16 * tb + r, s0 = 16 * sb + 4 * quad;
                v2u o; o.x = pk2(s0 <= tc ? c[0] : 0.f, s0 + 1 <= tc ? c[1] : 0.f); o.y = pk2(s0 + 2 <= tc ? c[2] : 0.f, s0 + 3 <= tc ? c[3] : 0.f);
                *(v2u*)(AB + (size_t)unit * 4096 + tc * 64 + s0) = o; }
        }
        {
            const int j = tid >> 2, sq = tid & 3; unsigned pw[8];
#pragma unroll
            for (int i = 0; i < 8; ++i) pw[i] = (unsigned)kd_s[(16 * sq + 2 * i) * QP + j] | ((unsigned)kd_s[(16 * sq + 2 * i + 1) * QP + j] << 16);
            bf16* dst = Z + (tok0 + (j >> 1)) * LDZ + KC + h * 128 + (j & 1) * 64 + 16 * sq;
            *(v4u*)dst = (v4u){pw[0], pw[1], pw[2], pw[3]}; *(v4u*)(dst + 8) = (v4u){pw[4], pw[5], pw[6], pw[7]};
        }
        for (int c = tid; c < DV * 4; c += NWAVES * 64) { const int v = c >> 2, sq = c & 3; unsigned pw[8];
#pragma unroll
            for (int i = 0; i < 8; ++i) pw[i] = (unsigned)v_s[(16 * sq + 2 * i) * VP + v] | ((unsigned)v_s[(16 * sq + 2 * i + 1) * VP + v] << 16);
            bf16* dst = Z + (tok0 + v / VR) * LDZ + VC + h * DV + (v % VR) * 64 + 16 * sq;
            *(v4u*)dst = (v4u){pw[0], pw[1], pw[2], pw[3]}; *(v4u*)(dst + 8) = (v4u){pw[4], pw[5], pw[6], pw[7]}; }
    }
}
template <bool HG> __device__ __forceinline__ void scan_stream(const bf16* Z, const bf16* AB, const float* DBUF, bf16* O, float* Sout, int sid, int lane) {
    typedef MX<HG> C; constexpr int H = C::H, DV = C::DV, LDZ = C::LDZ, KC = C::KC, VC = C::VC, VR = C::VR, NVG = C::NVG;
    const int vg = sid % NVG, bh = sid / NVG, h = bh % H, b = bh / H, r = lane & 15, quad = lane >> 4;
    f32x4 S[8];
#pragma unroll
    for (int i = 0; i < 8; ++i) S[i] = (f32x4){0.f, 0.f, 0.f, 0.f};
    const int v = 16 * vg + r;
    for (int n = 0; n < NCH; ++n) {
        const int unit = bh * NCH + n; const size_t tok0 = (size_t)b * SEQ + 64 * n;
        const bf16* vtp = Z + (tok0 + v / VR) * LDZ + VC + h * DV + (v % VR) * 64 + 8 * quad;
        const bf16x8 vb0 = *(const bf16x8*)vtp, vb1 = *(const bf16x8*)(vtp + 32);
        v2u qlo[4][4], qhi[4][4]; bf16x8 af[4][2], kf[8][2]; f32x4 dv[8];
#pragma unroll
        for (int tb = 0; tb < 4; ++tb) { const bf16* qp = Z + (tok0 + 16 * tb + r) * LDZ + h * 128 + 4 * quad;
#pragma unroll
            for (int ks = 0; ks < 4; ++ks) { qlo[tb][ks] = *(const v2u*)(qp + 32 * ks); qhi[tb][ks] = *(const v2u*)(qp + 32 * ks + 16); }
            const bf16* ap = AB + (size_t)unit * 4096 + (16 * tb + r) * 64 + 8 * quad;
            af[tb][0] = *(const bf16x8*)ap; af[tb][1] = *(const bf16x8*)(ap + 32); }
        __builtin_amdgcn_sched_barrier(0);
        bf16x8 sb[4];
#pragma unroll
        for (int ks = 0; ks < 4; ++ks) { v4u p; p.x = pk2(S[2 * ks][0], S[2 * ks][1]); p.y = pk2(S[2 * ks][2], S[2 * ks][3]); p.z = pk2(S[2 * ks + 1][0], S[2 * ks + 1][1]); p.w = pk2(S[2 * ks + 1][2], S[2 * ks + 1][3]);
            sb[ks] = __builtin_bit_cast(bf16x8, p); }
        f32x4 o[4];
#pragma unroll
        for (int tb = 0; tb < 4; ++tb) { o[tb] = (f32x4){0.f, 0.f, 0.f, 0.f};
#pragma unroll
            for (int ks = 0; ks < 4; ++ks)
                o[tb] = __builtin_amdgcn_mfma_f32_16x16x32_bf16(__builtin_bit_cast(bf16x8, ((v4u){qlo[tb][ks].x, qlo[tb][ks].y, qhi[tb][ks].x, qhi[tb][ks].y})), sb[ks], o[tb], 0, 0, 0);
            o[tb] = __builtin_amdgcn_mfma_f32_16x16x32_bf16(af[tb][0], vb0, o[tb], 0, 0, 0);
            o[tb] = __builtin_amdgcn_mfma_f32_16x16x32_bf16(af[tb][1], vb1, o[tb], 0, 0, 0); }
        __builtin_amdgcn_sched_barrier(0);
#pragma unroll
        for (int kb = 0; kb < 8; ++kb) { const int k = 16 * kb + r; const bf16* kp = Z + (tok0 + (k >> 1)) * LDZ + KC + h * 128 + (k & 1) * 64 + 8 * quad;
            kf[kb][0] = *(const bf16x8*)kp; kf[kb][1] = *(const bf16x8*)(kp + 32); }
#pragma unroll
        for (int kb = 0; kb < 8; ++kb) dv[kb] = *(const f32x4*)(DBUF + (size_t)unit * 128 + 16 * kb + 4 * quad);
        __builtin_amdgcn_sched_barrier(0);
#pragma unroll
        for (int tb = 0; tb < 4; ++tb) { bf16* op = O + (tok0 + 16 * tb + 4 * quad) * 1024 + h * DV + 16 * vg + r;
            const unsigned p01 = pk2(o[tb][0], o[tb][1]), p23 = pk2(o[tb][2], o[tb][3]);
            op[0] = (bf16)(p01 & 0xffffu); op[1024] = (bf16)(p01 >> 16); op[2048] = (bf16)(p23 & 0xffffu); op[3072] = (bf16)(p23 >> 16); }
#pragma unroll
        for (int kb = 0; kb < 8; ++kb) { S[kb] = S[kb] * dv[kb];
            S[kb] = __builtin_amdgcn_mfma_f32_16x16x32_bf16(kf[kb][0], vb0, S[kb], 0, 0, 0);
            S[kb] = __builtin_amdgcn_mfma_f32_16x16x32_bf16(kf[kb][1], vb1, S[kb], 0, 0, 0); }
    }
#pragma unroll
    for (int kb = 0; kb < 8; ++kb)
#pragma unroll
        for (int j = 0; j < 4; ++j) Sout[((size_t)bh * 128 + 16 * kb + 4 * quad + j) * DV + v] = S[kb][j];
}
template <bool HG> __device__ __forceinline__ void sample_unit(LAS float* wl, const bf16* Z, const float* R, const float* wup, const float* bgk, const float* lowb, const float* S0, float* Sout, bf16* O, int u, int lane) {
    typedef MX<HG> C; constexpr int H = C::H, DV = C::DV, LDZ = C::LDZ, KC = C::KC, VC = C::VC, NVR = C::NVR;
    const int vr = u % NVR, bh = u / NVR, h = bh % H, b = bh / H; const size_t m0 = (size_t)NPR + 4 * b;
    float pa[10];
#pragma unroll
    for (int i = 0; i < 10; ++i) pa[i] = 0.f;
#pragma unroll
    for (int kk = 0; kk < 2; ++kk) { const int k = lane + 64 * kk, hk = h * 128 + k; float g[4], q[4], kv[4];
#pragma unroll
        for (int t = 0; t < 4; ++t) { const bf16* zr = Z + (m0 + t) * LDZ; q[t] = bf2f(zr[hk]); const float kz = bf2f(zr[KC + hk]);
            if constexpr (!HG) { float x = bgk[hk];
#pragma unroll
                for (int i = 0; i < 16; ++i) x += R[(m0 + t) * 16 + i] * wup[i * 512 + hk];
                g[t] = logsig(x) * (1.0f / 16.0f); kv[t] = kz;
            } else { const float x0 = lowb[hk], x1 = lowb[1024 + hk]; const float a = logsig(x1 - x0), b2 = logsig(x0 - x1) + logsig(kz), mx = fmaxf(a, b2);
                g[t] = mx + __logf(1.0f + __expf(-fabsf(a - b2))); kv[t] = sigm(x0 - x1) * sigm(-kz); q[t] = q[t] * sigm(q[t]); } }
        float bb[4]; bb[0] = g[0]; bb[1] = bb[0] + g[1]; bb[2] = bb[1] + g[2]; bb[3] = bb[2] + g[3];
        float qe[4], kn[4];
#pragma unroll
        for (int t = 0; t < 4; ++t) { qe[t] = q[t] * __expf(bb[t]) * C::scale; kn[t] = kv[t] * __expf(-bb[t]); wl[k * 12 + t] = qe[t]; wl[k * 12 + 4 + t] = kv[t] * __expf(bb[3] - bb[t]); }
        wl[k * 12 + 8] = __expf(bb[3]);
        int idx = 0;
#pragma unroll
        for (int t = 0; t < 4; ++t)
#pragma unroll
            for (int s = 0; s <= t; ++s) pa[idx++] += qe[t] * kn[s];
    }
#pragma unroll
    for (int i = 0; i < 10; ++i) pa[i] = wave_sum(pa[i]);
    float vv[4], o[4];
#pragma unroll
    for (int s = 0; s < 4; ++s) vv[s] = bf2f(Z[(m0 + s) * LDZ + VC + h * DV + 64 * vr + lane]);
    { int idx = 0;
#pragma unroll
        for (int t = 0; t < 4; ++t) { o[t] = 0.f;
#pragma unroll
            for (int s = 0; s <= t; ++s) o[t] += pa[idx++] * vv[s]; } }
    LDS_WAIT();
    const float* sp = S0 + ((size_t)bh * 128) * DV + 64 * vr + lane; float* dp = Sout + ((size_t)bh * 128) * DV + 64 * vr + lane;
#pragma unroll 8
    for (int k = 0; k < 128; ++k) { const float s0 = sp[(size_t)k * DV]; const f32x4 q4 = *(const LAS f32x4*)(wl + k * 12), k4 = *(const LAS f32x4*)(wl + k * 12 + 4); const float d = wl[k * 12 + 8];
        o[0] += q4[0] * s0; o[1] += q4[1] * s0; o[2] += q4[2] * s0; o[3] += q4[3] * s0;
        dp[(size_t)k * DV] = d * s0 + ((k4[0] * vv[0] + k4[1] * vv[1]) + (k4[2] * vv[2] + k4[3] * vv[3])); }
#pragma unroll
    for (int t = 0; t < 4; ++t) O[(m0 + t) * 1024 + h * DV + 64 * vr + lane] = (bf16)(pk2(o[t], 0.f) & 0xffffu);
    LDS_WAIT();
}
template <bool HG> __device__ __forceinline__ void gate_phase(const bf16* Z, bf16* O, const float* gn, int gw, int ngw, int lane) {
    typedef MX<HG> C; constexpr int H = C::H, DV = C::DV, LDZ = C::LDZ, GC = C::GC, E = DV / 64;
    for (int task = gw; task < M * H; task += ngw) { const int m = task / H, h = task % H;
        bf16* op = O + (size_t)m * 1024 + h * DV + E * lane; const bf16* gp = Z + (size_t)m * LDZ + GC + h * DV + E * lane;
        float x[E], g[E];
        if constexpr (E == 4) { const v2u xo = *(const v2u*)op, go = *(const v2u*)gp; x[0] = bflo(xo.x); x[1] = bfhi(xo.x); x[2] = bflo(xo.y); x[3] = bfhi(xo.y); g[0] = bflo(go.x); g[1] = bfhi(go.x); g[2] = bflo(go.y); g[3] = bfhi(go.y); }
        else { const unsigned xo = *(const unsigned*)op, go = *(const unsigned*)gp; x[0] = bflo(xo); x[1] = bfhi(xo); g[0] = bflo(go); g[1] = bfhi(go); }
        float ss = 0.f;
#pragma unroll
        for (int e = 0; e < E; ++e) ss += x[e] * x[e];
        ss = wave_sum(ss); const float rinv = rsqrtf(ss * (1.0f / DV) + 1e-6f);
        float y[E];
#pragma unroll
        for (int e = 0; e < E; ++e) y[e] = x[e] * rinv * gn[E * lane + e] * (g[e] * sigm(g[e]));
        if constexpr (E == 4) { v2u w; w.x = pk2(y[0], y[1]); w.y = pk2(y[2], y[3]); *(v2u*)op = w; } else { *(unsigned*)op = pk2(y[0], y[1]); }
    }
}
template <int NKS> __device__ __forceinline__ void mini_acc(f32x4 (&acc)[2][4], const bf16* ap, size_t lda, const bf16* bp, size_t ldb) {
#pragma unroll
    for (int c = 0; c < NKS; c += 4) {
        bf16x8 af[4][2], bfr[4][4];
#pragma unroll
        for (int ks = 0; ks < 4; ++ks) if (c + ks < NKS) {
#pragma unroll
            for (int rb = 0; rb < 2; ++rb) af[ks][rb] = *(const bf16x8*)(ap + (size_t)(16 * rb) * lda + 32 * (c + ks));
#pragma unroll
            for (int cb = 0; cb < 4; ++cb) bfr[ks][cb] = *(const bf16x8*)(bp + (size_t)(16 * cb) * ldb + 32 * (c + ks)); }
        __builtin_amdgcn_sched_barrier(0);
#pragma unroll
        for (int ks = 0; ks < 4; ++ks) if (c + ks < NKS) {
#pragma unroll
            for (int rb = 0; rb < 2; ++rb)
#pragma unroll
                for (int cb = 0; cb < 4; ++cb) acc[rb][cb] = __builtin_amdgcn_mfma_f32_16x16x32_bf16(bfr[ks][cb], af[ks][rb], acc[rb][cb], 0, 0, 0); }
        __builtin_amdgcn_sched_barrier(0);
    }
}
template <int MODE, int K> __device__ __forceinline__ void mini_gemm(LAS unsigned char* lds, const bf16* A, const bf16* Bt, const bf16* A2, const bf16* Bt2, float* h, bf16* hb_out, const float* rs_in, float* rs_out, float alpha, int tid, int bid, int G) {
    const int lane = tid & 63, w = tid >> 6, r = lane & 15, quad = lane >> 4;
    LAS float* P = (LAS float*)lds; LAS float* P2 = (LAS float*)(lds + 65536);
    for (int mt = bid; mt < 256; mt += G) {
        const int rt = mt >> 4, ct = mt & 15, row0 = NPR + 32 * rt, col0 = 64 * ct;
        f32x4 acc[2][4];
#pragma unroll
        for (int rb = 0; rb < 2; ++rb)
#pragma unroll
            for (int cb = 0; cb < 4; ++cb) acc[rb][cb] = (f32x4){0.f, 0.f, 0.f, 0.f};
        constexpr int KW = K / 8;
        mini_acc<KW / 32>(acc, A + (size_t)(row0 + r) * K + w * KW + 8 * quad, K, Bt + (size_t)(col0 + r) * K + w * KW + 8 * quad, K);
#pragma unroll
        for (int rb = 0; rb < 2; ++rb)
#pragma unroll
            for (int cb = 0; cb < 4; ++cb) *(LAS f32x4*)(P + (w * 32 + 16 * rb + r) * 64 + 16 * cb + 4 * quad) = acc[rb][cb];
        if constexpr (MODE == 1) {
#pragma unroll
            for (int rb = 0; rb < 2; ++rb)
#pragma unroll
                for (int cb = 0; cb < 4; ++cb) acc[rb][cb] = (f32x4){0.f, 0.f, 0.f, 0.f};
            mini_acc<1>(acc, A2 + (size_t)(row0 + r) * 256 + w * 32 + 8 * quad, 256, Bt2 + (size_t)(col0 + r) * 256 + w * 32 + 8 * quad, 256);
#pragma unroll
            for (int rb = 0; rb < 2; ++rb)
#pragma unroll
                for (int cb = 0; cb < 4; ++cb) *(LAS f32x4*)(P2 + (w * 32 + 16 * rb + r) * 64 + 16 * cb + 4 * quad) = acc[rb][cb];
        }
        __syncthreads();
        const int row = tid >> 4, c4 = (tid & 15) * 4; f32x4 v = {0.f, 0.f, 0.f, 0.f}, v2 = {0.f, 0.f, 0.f, 0.f};
#pragma unroll
        for (int ww = 0; ww < 8; ++ww) { v += *(const LAS f32x4*)(P + (ww * 32 + row) * 64 + c4); if constexpr (MODE == 1) v2 += *(const LAS f32x4*)(P2 + (ww * 32 + row) * 64 + c4); }
        const int grow = row0 + row; const size_t off = (size_t)grow * 1024 + col0 + c4;
        f32x4 o = *(const f32x4*)(h + off);
        if constexpr (MODE == 0) o += v * alpha;
        else { const float s = pg8::row_scale(rs_in, grow); o[0] += sigm(v[0] * s) * v2[0]; o[1] += sigm(v[1] * s) * v2[1]; o[2] += sigm(v[2] * s) * v2[2]; o[3] += sigm(v[3] * s) * v2[3]; }
        *(f32x4*)(h + off) = o; v2u pw; pw.x = pk2(o[0], o[1]); pw.y = pk2(o[2], o[3]); *(v2u*)(hb_out + off) = pw;
        float ss = (o[0] * o[0] + o[1] * o[1]) + (o[2] * o[2] + o[3] * o[3]);
        ss += __shfl_xor(ss, 1); ss += __shfl_xor(ss, 2); ss += __shfl_xor(ss, 4); ss += __shfl_xor(ss, 8);
        if ((tid & 15) == 0) rs_out[(size_t)grow * 16 + ct] = ss;
        __syncthreads();
    }
}
#define XB_TMO      128
#define XB_XCNT(j)  (256  + 64 * (j))
#define XB_XSUB(j)  (1280 + 64 * (j))
#define XB_XGEN(j)  (2304 + 64 * (j))
#define XB_TOP      3328
#define XB_TOPGEN   3392
#define XCD_BAR_WORDS 3456
#define XB_SPIN_CAP (1u << 18)

__device__ __forceinline__ unsigned xb_ld(unsigned* p)              { return __hip_atomic_load(p, __ATOMIC_RELAXED, __HIP_MEMORY_SCOPE_AGENT); }
__device__ __forceinline__ unsigned xb_add(unsigned* p, unsigned v) { return __hip_atomic_fetch_add(p, v, __ATOMIC_RELAXED, __HIP_MEMORY_SCOPE_AGENT); }
__device__ __forceinline__ unsigned xb_xcc_id() { return (unsigned)__builtin_amdgcn_s_getreg((3 << 11) | 20) & 0xFu; }
#define XB_SPIN(cond, bar) do { unsigned _sp = 0; while (cond) { __builtin_amdgcn_s_sleep(1); \
    if ((++_sp & 255u) == 0u) { if (xb_ld(&(bar)[XB_TMO])) break; if (_sp > XB_SPIN_CAP) { atomicAdd(&(bar)[XB_TMO], 1u); break; } } } } while (0)

struct XcdBarrier {
    unsigned* bar; unsigned x;
    volatile LAS unsigned* st;
};

__device__ __forceinline__ XcdBarrier xcd_barrier_post(unsigned* bar, volatile LAS unsigned* st) {
    XcdBarrier b; b.bar = bar; b.x = xb_xcc_id(); b.st = st;
    if (threadIdx.x == 0) (void)xb_add(&bar[XB_XCNT(b.x)], 1u);
    return b;
}
__device__ __forceinline__ void xcd_barrier_complete(unsigned* bar, unsigned x, unsigned& nloc, unsigned& nx) {
    const unsigned G = gridDim.x * gridDim.y * gridDim.z;
    unsigned sum, cnt, mine, sp = 0u;
    for (;;) {
        sum = 0u; cnt = 0u; mine = 0u;
#pragma unroll
        for (unsigned j = 0; j < 16; ++j) { const unsigned c = xb_ld(&bar[XB_XCNT(j)]); sum += c; cnt += (c > 0u) ? 1u : 0u; mine = (j == x) ? c : mine; }
        if (sum == G) break;
        __builtin_amdgcn_s_sleep(1);
        if ((++sp & 255u) == 0u) { if (xb_ld(&bar[XB_TMO])) break; if (sp > XB_SPIN_CAP) { atomicAdd(&bar[XB_TMO], 1u); break; } }
    }
    nloc = mine > 0u ? mine : 1u; nx = cnt > 0u ? cnt : 1u;
}

__device__ __forceinline__ void xcd_barrier(const XcdBarrier& b) {
    asm volatile("s_waitcnt vmcnt(0)" ::: "memory");
    __syncthreads();
    if (threadIdx.x == 0) {
        unsigned* bar = b.bar;
        __builtin_amdgcn_s_waitcnt(0);
        unsigned nloc = b.st[0], nx = b.st[1];
        if (nloc == 0u) { xcd_barrier_complete(bar, b.x, nloc, nx); b.st[0] = nloc; b.st[1] = nx; }
        const unsigned old = xb_add(&bar[XB_XSUB(b.x)], 1u);
        const unsigned gen = old / nloc;
        if (old + 1u == (gen + 1u) * nloc) {
            __builtin_amdgcn_fence(__ATOMIC_RELEASE, "agent");
            asm volatile("s_waitcnt vmcnt(0)" ::: "memory");
            const unsigned og = xb_add(&bar[XB_TOP], 1u);
            const unsigned tg = og / nx;
            if (og + 1u == (tg + 1u) * nx) xb_add(&bar[XB_TOPGEN], 1u);
            else XB_SPIN(xb_ld(&bar[XB_TOPGEN]) == tg, bar);
            __builtin_amdgcn_fence(__ATOMIC_ACQUIRE, "agent");
            xb_add(&bar[XB_XGEN(b.x)], 1u);
            asm volatile("s_waitcnt vmcnt(0)" ::: "memory");
        } else {
            XB_SPIN(xb_ld(&bar[XB_XGEN(b.x)]) == gen, bar);
            __builtin_amdgcn_fence(__ATOMIC_ACQUIRE, "agent");
            asm volatile("s_waitcnt vmcnt(0)" ::: "memory");
        }
    }
    __syncthreads();
}

#define MK_TID() int wave = wave_s; asm volatile("" : "+s"(wave)); unsigned ones_ = ~0u; asm volatile("" : "+s"(ones_)); \
    const int lane = (int)__builtin_amdgcn_mbcnt_hi(ones_, __builtin_amdgcn_mbcnt_lo(ones_, 0u)); const int tid = wave * 64 + lane; const int gw = bid * NWAVES + wave, NGW = G * NWAVES; (void)gw; (void)NGW; (void)tid; (void)lane
__global__ void __launch_bounds__(NWAVES * 64, 2) fwd_kernel(Args a) {
    extern __shared__ __attribute__((aligned(16))) unsigned char lds_raw[];
    LAS unsigned char* lds = (LAS unsigned char*)lds_raw;
    cg::grid_group grid = cg::this_grid();
    const int wave_s = __builtin_amdgcn_readfirstlane((int)threadIdx.x >> 6);
    volatile LAS unsigned* bst = (volatile LAS unsigned*)(lds + 131072 + 256);
    if (threadIdx.x < 2) bst[threadIdx.x] = 0u;
    __syncthreads();
    const XcdBarrier xbar = xcd_barrier_post((unsigned*)(a.ws + OFF_CTL), bst);
    const int ph_lo = a.ph_lo, ph_hi = a.ph_hi;
    for (int ph_ = ph_lo; ph_ < ph_hi; ++ph_) {
#if PROBE_MODE
      const int kk_ = (ph_ - 1) % 10; const bool mid_ = ph_ > 0 && ph_ < NPH - 1;
      const int nrep = (PROBE_MODE == 1 && ph_ == 0) || (PROBE_MODE == 2 && mid_ && (kk_ == 0 || kk_ == 7)) || (PROBE_MODE == 3 && mid_ && kk_ == 2) || (PROBE_MODE == 4 && mid_ && kk_ == 4) ? 2 : 1;
      for (int rep = 0; rep < nrep; ++rep) {
#else
      {
#endif
        int ph = ph_; asm volatile("" : "+s"(ph));
        CArgs* ap = (CArgs*)__builtin_amdgcn_kernarg_segment_ptr(); asm volatile("" : "+s"(ap));
        int bid = blockIdx.x; asm volatile("" : "+s"(bid));
        int G = gridDim.x; asm volatile("" : "+s"(G));
        unsigned char* ws = ap->ws; float* hbuf = ap->out;
        if (ph == 0) { MK_TID(); prologue(ap, ws, hbuf, lds, tid, bid, G); }
        else if (ph == NPH - 1) {
            MK_TID(); const float* fw = ap->in[25];
            for (int m = gw; m < M; m += NGW) { f32x4* hr = (f32x4*)(hbuf + (size_t)m * D); f32x4 v[4]; float ss = 0.f;
#pragma unroll
                for (int j = 0; j < 4; ++j) { v[j] = hr[lane + 64 * j]; ss += (v[j][0] * v[j][0] + v[j][1] * v[j][1]) + (v[j][2] * v[j][2] + v[j][3] * v[j][3]); }
                ss = wave_sum(ss); const float rinv = rsqrtf(ss * (1.0f / D) + 1e-6f);
#pragma unroll
                for (int j = 0; j < 4; ++j) { const f32x4 wv = *((const f32x4*)fw + lane + 64 * j); hr[lane + 64 * j] = v[j] * rinv * wv; } }
        } else {
            const int li = (ph - 1) / 10, k = (ph - 1) % 10, cur = li;
            bf16* hb = (bf16*)(ws + OFF_HB + cur * HB_SZ); bf16* ob = (bf16*)(ws + OFF_HB + (cur ^ 1) * HB_SZ);
            float* rs0 = (float*)(ws + OFF_RS); float* rs1 = (float*)(ws + OFF_RS + RS_SZ); float* Rb = (float*)(ws + OFF_R);
            bf16* big = (bf16*)(ws + OFF_BIG);
            if (k == 0 || k == 7) { MK_TID();
                const int f = k == 7; pg8::Gemm g{hb, (const bf16*)(ws + OFF_WGU + (li * 2 + f) * WGU_SZ), M, 2 * FF, D};
                pg8::StaticOrder S; S.init(M, 2 * FF, G, bid); pg8::EpiSwiglu E{big, FF, rs0};
                pg8::gemm_phase<pg8::EpiSwiglu, pg8::StaticOrder, true, true>(lds, g, S, E, tid);
            } else if (k == 1 || k == 8 || k == 6) { MK_TID();
                pg8::Gemm g; float alpha; float* rso;
                if (k == 6) { g = pg8::Gemm{ob, (const bf16*)(ws + OFF_WOUT + li * WSQ_SZ), M, D, D}; alpha = 1.0f; rso = rs0; }
                else { const int f = k == 8; g = pg8::Gemm{big, (const bf16*)(ws + OFF_WDN + (li * 2 + f) * WDN_SZ), M, D, FF}; alpha = 0.5f; rso = rs1; }
                g.M = NPR; pg8::StaticOrder S; S.init(NPR, D, G, bid); pg8::EpiResid E{hbuf, hb, rso, alpha};
                pg8::gemm_phase<pg8::EpiResid, pg8::StaticOrder, true, true>(lds, g, S, E, tid);
                int tid2 = tid; asm volatile("" : "+v"(tid2));
                if (k == 6) mini_gemm<0, D>(lds, g.A, g.Bt, nullptr, nullptr, hbuf, hb, nullptr, rso, alpha, tid2, bid, G);
                else mini_gemm<0, FF>(lds, g.A, g.Bt, nullptr, nullptr, hbuf, hb, nullptr, rso, alpha, tid2, bid, G);
            } else if (k == 2) { MK_TID();
                const int N = li ? 4096 : 3328; pg8::Gemm g{hb, (const bf16*)(ws + (li ? OFF_WHIN : OFF_WGIN)), M, N, D};
                pg8::StaticOrder S; S.init(M, N, G, bid); pg8::EpiZ E{big, N, rs1, Rb, li ? -1 : 12};
                pg8::gemm_phase<pg8::EpiZ, pg8::StaticOrder, true, true>(lds, g, S, E, tid);
            } else if (k == 3) { MK_TID();
                if (li == 0) prep_phase<false>(lds, big, Rb, ap->in[11], ap->in[12], ap->in[18], (bf16*)(ws + OFF_AB), (float*)(ws + OFF_DB), tid, bid, G);
                else prep_phase<true>(lds, big, Rb, ap->in[11], ap->in[12], ap->in[18], (bf16*)(ws + OFF_AB), (float*)(ws + OFF_DB), tid, bid, G);
            } else if (k == 4) { MK_TID();
                if (wave < 2) {
                    for (int sid = bid * 2 + wave; sid < 512; sid += G * 2) {
                        if (li == 0) scan_stream<false>(big, (const bf16*)(ws + OFF_AB), (const float*)(ws + OFF_DB), ob, hbuf + OUT_GP, sid, lane);
                        else scan_stream<true>(big, (const bf16*)(ws + OFF_AB), (const float*)(ws + OFF_DB), ob, hbuf + OUT_HP, sid, lane);
                    }
                } else {
                    LAS float* wl = (LAS float*)(lds + wave * 8192);
                    for (int u = bid * 6 + (wave - 2); u < 2048; u += G * 6) {
                        if (li == 0) sample_unit<false>(wl, big, Rb, ap->in[11], ap->in[12], ap->in[18], ap->in[2], hbuf + OUT_GS, ob, u, lane);
                        else sample_unit<true>(wl, big, Rb, ap->in[11], ap->in[12], ap->in[18], ap->in[3], hbuf + OUT_HS, ob, u, lane);
                    }
                }
            } else if (k == 5) { MK_TID();
                if (li == 0) gate_phase<false>(big, ob, ap->in[13], gw, NGW, lane); else gate_phase<true>(big, ob, ap->in[16], gw, NGW, lane);
            } else { MK_TID();
                float* pp = (float*)(ws + OFF_BIG);
                { pg8::Gemm g{(const bf16*)(ws + OFF_PB + li * PB_SZ), (const bf16*)(ws + OFF_WPP + li * WPP_SZ), NPR, D, PLE};
                  pg8::StaticOrder S; S.init(NPR, D, G, bid); pg8::EpiStoreF32 E{pp};
                  pg8::gemm_phase<pg8::EpiStoreF32, pg8::StaticOrder, true, true>(lds, g, S, E, tid); }
                { int tid2 = tid; asm volatile("" : "+v"(tid2));
                  pg8::Gemm g{hb, (const bf16*)(ws + OFF_WPG + li * WSQ_SZ), NPR, D, D};
                  pg8::StaticOrder S; S.init(NPR, D, G, bid); pg8::EpiPle E{hbuf, ob, rs1, rs0, pp};
                  pg8::gemm_phase<pg8::EpiPle, pg8::StaticOrder, true, true>(lds, g, S, E, tid2); }
                { int tid3 = tid; asm volatile("" : "+v"(tid3));
                  mini_gemm<1, D>(lds, hb, (const bf16*)(ws + OFF_WPG + li * WSQ_SZ), (const bf16*)(ws + OFF_PB + li * PB_SZ), (const bf16*)(ws + OFF_WPP + li * WPP_SZ), hbuf, ob, rs1, rs0, 0.f, tid3, bid, G); }
            }
        }
#if PROBE_MODE
        if (ph_ + 1 < ph_hi || rep + 1 < nrep) grid.sync();
#else
        if (ph_ + 1 < ph_hi) {
            if (ph_ == 0) grid.sync(); else xcd_barrier(xbar);
#if EXTRA_SYNCS
            for (int es = 0; es < EXTRA_SYNCS; ++es) xcd_barrier(xbar);
#endif
        }
#endif
      }
    }
}

extern "C" void kernel_launch(void* const* d_in, const int* in_sizes, int n_in, void* d_out, int out_size, void* d_ws, size_t ws_size, hipStream_t stream) {
    static int grid = 0;
    if (grid == 0) {
        if (n_in != 26 || (size_t)out_size != OUT_END || ws_size < WS_TOTAL) { fprintf(stderr, "kernel_launch: unexpected shapes (n_in %d out %d ws %zu need %zu); nothing launched\n", n_in, out_size, ws_size, (size_t)WS_TOTAL); grid = -1; return; }
        int dev = 0, cus = 0, per_cu = 0;
        if (hipGetDevice(&dev) != hipSuccess || hipDeviceGetAttribute(&cus, hipDeviceAttributeMultiprocessorCount, dev) != hipSuccess) { grid = -1; return; }
        if (hipFuncSetAttribute((const void*)fwd_kernel, hipFuncAttributeMaxDynamicSharedMemorySize, LDS_BYTES) != hipSuccess) { fprintf(stderr, "kernel_launch: hipFuncSetAttribute failed\n"); grid = -1; return; }
        if (hipOccupancyMaxActiveBlocksPerMultiprocessor(&per_cu, (const void*)fwd_kernel, NWAVES * 64, LDS_BYTES) != hipSuccess || per_cu < 1) per_cu = 1;
        (void)hipGetLastError();
        grid = cus * per_cu;
    }
    if (grid < 0) return;
    if (hipMemsetAsync((char*)d_ws + OFF_CTL, 0, CTL_BYTES, stream) != hipSuccess) { fprintf(stderr, "kernel_launch: memset of the barrier words failed\n"); return; }
    Args a{};
    for (int i = 0; i < 26; ++i) a.in[i] = (const float*)d_in[i];
    a.out = (float*)d_out; a.ws = (unsigned char*)d_ws;
#if MK_N_LAUNCHES == 1
    a.ph_lo = 0; a.ph_hi = NPH;
    void* args[] = {&a};
    hipError_t e = hipLaunchCooperativeKernel((const void*)fwd_kernel, dim3(grid), dim3(NWAVES * 64), args, LDS_BYTES, stream);
    if (e != hipSuccess) fprintf(stderr, "kernel_launch: cooperative launch failed: %s (grid %d)\n", hipGetErrorString(e), grid);
#else
    for (int ph = 0; ph < NPH; ++ph) { a.ph_lo = ph; a.ph_hi = ph + 1; hipLaunchKernelGGL(fwd_kernel, dim3(grid), dim3(NWAVES * 64), LDS_BYTES, stream, a); }
#endif
}
```

```cpp
#include <hip/hip_runtime.h>
#include <cstdio>
#include <cstdint>
#ifndef MK_N_LAUNCHES
#define MK_N_LAUNCHES 1
#endif
#ifndef PROBE_MODE
#define PROBE_MODE 0
#endif
#ifndef EXTRA_SYNCS
#define EXTRA_SYNCS 0
#endif
namespace pg8 {
#define PG8_LAS __attribute__((address_space(3)))
typedef unsigned short bf16_t;
typedef short bf16x8 __attribute__((ext_vector_type(8)));
typedef float f32x4 __attribute__((ext_vector_type(4)));
typedef unsigned u32x4 __attribute__((ext_vector_type(4)));
constexpr int BM = 256, BK = 64, HALF = 128, HTB = HALF * BK * 2  , STAGE_BYTES = 8 * HTB, NXCD = 8, WGM = 8;

__host__ __device__ __forceinline__ int lds_byte(int r, int c) { const int st = (r >> 4) * 2 + (c >> 5), rr = r & 15, cc = c & 31, ob = rr * 64 + cc * 2; return st * 1024 + (ob ^ (((ob >> 9) & 1) << 5)); }
__host__ __device__ __forceinline__ void stage_rc(int b, int& R, int& C) { const int st = b / 1024, sb = b % 1024, swz = sb ^ (((sb >> 9) & 1) << 5); R = (st >> 1) * 16 + swz / 64; C = (st & 1) * 32 + (swz % 64) / 2; }
__host__ __device__ __forceinline__ int perm32(int rho) { const int n = rho >> 4, i = rho & 15; return 8 * (i >> 2) + 4 * n + (i & 3); }

struct Unit { int pm, pn; };
struct Gemm { const bf16_t* A; const bf16_t* Bt; int M, N, K; };

struct StaticOrder {
    int nM, nN, nwg, G, c;
    __host__ __device__ void init(int M, int N, int G_, int c_) { nM = M / BM; nN = N / BM; nwg = nM * nN; G = G_; c = c_; }
    __host__ __device__ bool next(int i, Unit& u) const {
        const long L = (long)i * G + c; if (L >= nwg) return false;
        int wgid = (int)L; { const int q = nwg / NXCD, r = nwg % NXCD, xcd = wgid % NXCD, off = wgid / NXCD; wgid = (xcd < r ? xcd * (q + 1) : r * (q + 1) + (xcd - r) * q) + off; }
        const int nig = WGM * nN, gid = wgid / nig, fm = gid * WGM, gsz = (nM - fm) < WGM ? (nM - fm) : WGM;
        u.pm = fm + ((wgid % nig) % gsz); u.pn = (wgid % nig) / gsz; return true;
    }
    __device__ __forceinline__ void a_ready(const Unit&) const {}
    __device__ __forceinline__ void done(const Unit&) const {}
};

__device__ __forceinline__ unsigned cvt_pk_bf16(float lo, float hi) { unsigned r; asm volatile("v_cvt_pk_bf16_f32 %0, %1, %2" : "=v"(r) : "v"(lo), "v"(hi)); return r; }
typedef float f32x2 __attribute__((ext_vector_type(2)));
typedef unsigned u32x2 __attribute__((ext_vector_type(2)));
__device__ __forceinline__ float row_scale(const float* rs, int row) {
    const f32x4* p = (const f32x4*)(rs + (size_t)row * 16);
    const f32x4 a = p[0], b = p[1], c = p[2], d = p[3];
    const float s = ((a[0] + a[1]) + (a[2] + a[3])) + ((b[0] + b[1]) + (b[2] + b[3])) + ((c[0] + c[1]) + (c[2] + c[3])) + ((d[0] + d[1]) + (d[2] + d[3]));
    return rsqrtf(s * (1.0f / 1024.0f) + 1e-6f);
}
__device__ __forceinline__ float sigm(float x) { return __builtin_amdgcn_rcpf(1.0f + __expf(-x)); }
struct EpiSwiglu {
    static constexpr bool PERM = true, AFTER_DRAIN = false;
    bf16_t* O; int ldc; const float* rs;
    __device__ __forceinline__ void operator()(const f32x4 (&acc)[2][2][4][2], const Unit& u, int wr, int wc, int fr_, int fq_) const {
        int ln_ = fr_ + 16 * fq_; asm volatile("" : "+v"(ln_)); const int fr = ln_ & 15, fq = ln_ >> 4;
        const int row0 = u.pm * BM + wr * 64 + fr, col0 = u.pn * HALF + wc * 32 + 8 * fq;
#pragma unroll
        for (int ai = 0; ai < 2; ++ai)
#pragma unroll
            for (int m = 0; m < 4; ++m) { const int row = row0 + ai * HALF + m * 16; const float s = row_scale(rs, row);
                float o[8];
#pragma unroll
                for (int n = 0; n < 2; ++n)
#pragma unroll
                    for (int i = 0; i < 4; ++i) { const float g = acc[ai][0][m][n][i] * s, up = acc[ai][1][m][n][i] * s; o[n * 4 + i] = g * sigm(g) * up; }
                u32x4 w; w.x = cvt_pk_bf16(o[0], o[1]); w.y = cvt_pk_bf16(o[2], o[3]); w.z = cvt_pk_bf16(o[4], o[5]); w.w = cvt_pk_bf16(o[6], o[7]);
                *(u32x4*)(O + (size_t)row * ldc + col0) = w; }
    }
};
struct EpiZ {
    static constexpr bool PERM = true, AFTER_DRAIN = false;
    bf16_t* Z; int ldz; const float* rs; float* R; int r_tile;
    __device__ __forceinline__ void operator()(const f32x4 (&acc)[2][2][4][2], const Unit& u, int wr, int wc, int fr_, int fq_) const {
        int ln_ = fr_ + 16 * fq_; asm volatile("" : "+v"(ln_)); const int fr = ln_ & 15, fq = ln_ >> 4;
        const int row0 = u.pm * BM + wr * 64 + fr, col0 = u.pn * BM + wc * 32 + 8 * fq;
        if (u.pn == r_tile) {
            if (wc == 0 && fq < 2) {
#pragma unroll
                for (int ai = 0; ai < 2; ++ai)
#pragma unroll
                    for (int m = 0; m < 4; ++m) { const int row = row0 + ai * HALF + m * 16; const float s = row_scale(rs, row);
#pragma unroll
                        for (int n = 0; n < 2; ++n) *(f32x4*)(R + (size_t)row * 16 + 8 * fq + 4 * n) = acc[ai][0][m][n] * s; }
            }
            return;
        }
#pragma unroll
        for (int ai = 0; ai < 2; ++ai)
#pragma unroll
            for (int m = 0; m < 4; ++m) { const int row = row0 + ai * HALF + m * 16; const float s = row_scale(rs, row);
#pragma unroll
                for (int bj = 0; bj < 2; ++bj) { const f32x4 v0 = acc[ai][bj][m][0] * s, v1 = acc[ai][bj][m][1] * s;
                    u32x4 w; w.x = cvt_pk_bf16(v0[0], v0[1]); w.y = cvt_pk_bf16(v0[2], v0[3]); w.z = cvt_pk_bf16(v1[0], v1[1]); w.w = cvt_pk_bf16(v1[2], v1[3]);
                    *(u32x4*)(Z + (size_t)row * ldz + col0 + bj * HALF) = w; } }
    }
};
struct EpiResid {
    static constexpr bool PERM = false, AFTER_DRAIN = false;
    float* h; bf16_t* hb; float* rs_out; float alpha;
    __device__ __forceinline__ void operator()(const f32x4 (&acc)[2][2][4][2], const Unit& u, int wr, int wc, int fr_, int fq_) const {
        int ln_ = fr_ + 16 * fq_; asm volatile("" : "+v"(ln_)); const int fr = ln_ & 15, fq = ln_ >> 4;
        const int row0 = u.pm * BM + wr * 64 + fr, col0 = u.pn * BM + wc * 32 + 4 * fq;
#pragma unroll
        for (int ai = 0; ai < 2; ++ai)
#pragma unroll
            for (int m = 0; m < 4; ++m) { const int row = row0 + ai * HALF + m * 16; float ss = 0.f;
#pragma unroll
                for (int bj = 0; bj < 2; ++bj)
#pragma unroll
                    for (int n = 0; n < 2; ++n) { const size_t off = (size_t)row * 1024 + col0 + bj * HALF + n * 16;
                        const f32x4 o = *(const f32x4*)(h + off) + acc[ai][bj][m][n] * alpha; *(f32x4*)(h + off) = o;
                        ss += (o[0] * o[0] + o[1] * o[1]) + (o[2] * o[2] + o[3] * o[3]);
                        u32x2 w; w.x = cvt_pk_bf16(o[0], o[1]); w.y = cvt_pk_bf16(o[2], o[3]); *(u32x2*)(hb + off) = w; }
                ss += __shfl_xor(ss, 16); ss += __shfl_xor(ss, 32);
                if (fq == 0) rs_out[(size_t)row * 16 + u.pn * 4 + wc] = ss; }
    }
};
struct EpiStoreF32 {
    static constexpr bool PERM = false, AFTER_DRAIN = false;
    float* O;
    __device__ __forceinline__ void operator()(const f32x4 (&acc)[2][2][4][2], const Unit& u, int wr, int wc, int fr_, int fq_) const {
        int ln_ = fr_ + 16 * fq_; asm volatile("" : "+v"(ln_)); const int fr = ln_ & 15, fq = ln_ >> 4;
        const int row0 = u.pm * BM + wr * 64 + fr, col0 = u.pn * BM + wc * 32 + 4 * fq;
#pragma unroll
        for (int ai = 0; ai < 2; ++ai)
#pragma unroll
            for (int m = 0; m < 4; ++m)
#pragma unroll
                for (int bj = 0; bj < 2; ++bj)
#pragma unroll
                    for (int n = 0; n < 2; ++n) *(f32x4*)(O + (size_t)(row0 + ai * HALF + m * 16) * 1024 + col0 + bj * HALF + n * 16) = acc[ai][bj][m][n];
    }
};
struct EpiPle {
    static constexpr bool PERM = false, AFTER_DRAIN = false;
    float* h; bf16_t* hb; const float* rs_in; float* rs_out; const float* pp;
    __device__ __forceinline__ void operator()(const f32x4 (&acc)[2][2][4][2], const Unit& u, int wr, int wc, int fr_, int fq_) const {
        int ln_ = fr_ + 16 * fq_; asm volatile("" : "+v"(ln_)); const int fr = ln_ & 15, fq = ln_ >> 4;
        const int row0 = u.pm * BM + wr * 64 + fr, col0 = u.pn * BM + wc * 32 + 4 * fq;
#pragma unroll
        for (int ai = 0; ai < 2; ++ai)
#pragma unroll
            for (int m = 0; m < 4; ++m) { const int row = row0 + ai * HALF + m * 16; const float s = row_scale(rs_in, row); float ss = 0.f;
#pragma unroll
                for (int bj = 0; bj < 2; ++bj)
#pragma unroll
                    for (int n = 0; n < 2; ++n) { const size_t off = (size_t)row * 1024 + col0 + bj * HALF + n * 16;
                        const f32x4 a = acc[ai][bj][m][n] * s, p = *(const f32x4*)(pp + off); f32x4 o = *(const f32x4*)(h + off);
                        o[0] += sigm(a[0]) * p[0]; o[1] += sigm(a[1]) * p[1]; o[2] += sigm(a[2]) * p[2]; o[3] += sigm(a[3]) * p[3];
                        *(f32x4*)(h + off) = o; ss += (o[0] * o[0] + o[1] * o[1]) + (o[2] * o[2] + o[3] * o[3]);
                        u32x2 w; w.x = cvt_pk_bf16(o[0], o[1]); w.y = cvt_pk_bf16(o[2], o[3]); *(u32x2*)(hb + off) = w; }
                ss += __shfl_xor(ss, 16); ss += __shfl_xor(ss, 32);
                if (fq == 0) rs_out[(size_t)row * 16 + u.pn * 4 + wc] = ss; }
    }
};
template <class Epi, class Sched, bool ALIGN_EPI = false, bool SP2 = false>
__device__ __forceinline__ void gemm_phase(PG8_LAS unsigned char* lds, const Gemm g, const Sched& S, const Epi& E, const int tid) {
    const int wid = __builtin_amdgcn_readfirstlane(tid >> 6), lane = tid & 63, wr = wid >> 2, wc = wid & 3, fr = lane & 15, fq = lane >> 4;
    const int K = g.K, nt = K / BK;
    unsigned voffA[2], voffB[2];
#pragma unroll
    for (int i = 0; i < 2; ++i) { int R, C; stage_rc(tid * 16 + i * 8192, R, C); const int Rb = Epi::PERM ? ((R & ~31) + perm32(R & 31)) : R;
        voffA[i] = (unsigned)(R * K + C) * 2u; voffB[i] = (unsigned)(Rb * K + C) * 2u; }
    const size_t kstep = (size_t)(BK * 2);
    const size_t hstep = (size_t)HALF * K * 2;
    const size_t tstep = 2 * hstep;
    const unsigned ldsw = (unsigned)wid * 1024u;
    const int aoff = lds_byte(wr * 64 + fr, fq * 8), boff = lds_byte(wc * 32 + fr, fq * 8);
#define PG8_SA(b, h) (((b) * 2 + (h)) * HTB)
#define PG8_SB(b, h) ((4 + (b) * 2 + (h)) * HTB)
#define PG8_STAGE(bufoff, gbase, voff) do { _Pragma("unroll") for (int _i = 0; _i < 2; ++_i) \
        __builtin_amdgcn_global_load_lds((const unsigned*)((const char*)(gbase) + (voff)[_i]), (PG8_LAS unsigned*)(lds + (bufoff) + ldsw + _i * 8192), 16, 0, 0); } while (0)
#define PG8_LDA(dst, b, h) do { _Pragma("unroll") for (int m = 0; m < 4; ++m) _Pragma("unroll") for (int k = 0; k < 2; ++k) dst[m][k] = *(const PG8_LAS bf16x8*)(lds + PG8_SA(b, h) + aoff + m * 2048 + k * 1024); } while (0)
#define PG8_LDB(dst, b, h) do { _Pragma("unroll") for (int n = 0; n < 2; ++n) _Pragma("unroll") for (int k = 0; k < 2; ++k) dst[n][k] = *(const PG8_LAS bf16x8*)(lds + PG8_SB(b, h) + boff + n * 2048 + k * 1024); } while (0)
#define PG8_MMA(ai, bj, At, Bt) do { __builtin_amdgcn_s_setprio(1); _Pragma("unroll") for (int m = 0; m < 4; ++m) _Pragma("unroll") for (int n = 0; n < 2; ++n) _Pragma("unroll") for (int k = 0; k < 2; ++k) \
        acc[ai][bj][m][n] = __builtin_amdgcn_mfma_f32_16x16x32_bf16(Bt[n][k], At[m][k], acc[ai][bj][m][n], 0, 0, 0); __builtin_amdgcn_s_setprio(0); } while (0)
#define PG8_WAIT_V(n) asm volatile("s_waitcnt vmcnt(" #n ")" ::: "memory")
#define PG8_WAIT_L(n) asm volatile("s_waitcnt lgkmcnt(" #n ")" ::: "memory")
#define PG8_BAR __builtin_amdgcn_s_barrier()
#define PG8_SCHED __builtin_amdgcn_sched_barrier(0)
    Unit cur, nxt; int ui = 0;
    if (!S.next(0, cur)) return;
    f32x4 acc[2][2][4][2];
#pragma unroll
    for (int a = 0; a < 2; ++a)
#pragma unroll
        for (int b = 0; b < 2; ++b)
#pragma unroll
            for (int m = 0; m < 4; ++m)
#pragma unroll
                for (int n = 0; n < 2; ++n) acc[a][b][m][n] = (f32x4){0.f, 0.f, 0.f, 0.f};
    bf16x8 At[4][2], B0[2][2], B1[2][2];
    const char* cA = (const char*)g.A + (size_t)cur.pm * tstep; const char* cB = (const char*)g.Bt + (size_t)cur.pn * tstep;
    S.a_ready(cur);
    if constexpr (SP2) {
        PG8_STAGE(PG8_SB(0, 0), cB, voffB); PG8_STAGE(PG8_SB(0, 1), cB + hstep, voffB); PG8_STAGE(PG8_SA(0, 0), cA, voffA); PG8_STAGE(PG8_SA(0, 1), cA + hstep, voffA);
        if (wr == 1) PG8_BAR;
        PG8_WAIT_V(2); PG8_BAR;
        PG8_STAGE(PG8_SB(1, 0), cB + kstep, voffB); PG8_STAGE(PG8_SA(1, 0), cA + kstep, voffA); PG8_STAGE(PG8_SB(1, 1), cB + hstep + kstep, voffB);
        PG8_WAIT_V(6); PG8_BAR;
    } else {
        PG8_STAGE(PG8_SB(0, 0), cB, voffB); PG8_STAGE(PG8_SA(0, 0), cA, voffA); PG8_STAGE(PG8_SB(0, 1), cB + hstep, voffB); PG8_STAGE(PG8_SA(0, 1), cA + hstep, voffA);
        if (wr == 1) PG8_BAR;
        PG8_WAIT_V(4); PG8_BAR;
        PG8_STAGE(PG8_SB(1, 0), cB + kstep, voffB); PG8_STAGE(PG8_SA(1, 0), cA + kstep, voffA); PG8_STAGE(PG8_SB(1, 1), cB + hstep + kstep, voffB);
        PG8_WAIT_V(6); PG8_BAR;
    }
    for (;;) {
        const bool has_next = S.next(ui + 1, nxt);
        const char* nA = has_next ? (const char*)g.A + (size_t)nxt.pm * tstep : cA; const char* nB = has_next ? (const char*)g.Bt + (size_t)nxt.pn * tstep : cB;
        for (int t = 0; t < nt; t += 2) {
            const bool last = (t == nt - 2);
            const char* a1 = cA + (size_t)(t + 1) * kstep;
            const char* a2 = last ? nA : cA + (size_t)(t + 2) * kstep; const char* b2 = last ? nB : cB + (size_t)(t + 2) * kstep;
            const char* a3 = a2 + kstep; const char* b3 = b2 + kstep;
            if (last && has_next) S.a_ready(nxt);
            if constexpr (SP2) {
            PG8_LDB(B0, 0, 0); PG8_LDB(B1, 0, 1); PG8_SCHED; PG8_LDA(At, 0, 0); PG8_STAGE(PG8_SA(1, 1), a1 + hstep, voffA);
            PG8_WAIT_V(8); PG8_WAIT_L(0); PG8_BAR; PG8_MMA(0, 0, At, B0); PG8_MMA(0, 1, At, B1); PG8_BAR; PG8_SCHED;
            PG8_LDA(At, 0, 1); PG8_STAGE(PG8_SB(0, 0), b2, voffB); PG8_STAGE(PG8_SB(0, 1), b2 + hstep, voffB); PG8_STAGE(PG8_SA(0, 0), a2, voffA);
            PG8_WAIT_V(8); PG8_WAIT_L(0); PG8_BAR; PG8_MMA(1, 0, At, B0); PG8_MMA(1, 1, At, B1); PG8_BAR; PG8_SCHED;
            PG8_LDB(B0, 1, 0); PG8_LDB(B1, 1, 1); PG8_SCHED; PG8_LDA(At, 1, 0); PG8_STAGE(PG8_SA(0, 1), a2 + hstep, voffA);
            PG8_WAIT_V(8); PG8_WAIT_L(0); PG8_BAR; PG8_MMA(0, 0, At, B0); PG8_MMA(0, 1, At, B1); PG8_BAR; PG8_SCHED;
            PG8_LDA(At, 1, 1); PG8_STAGE(PG8_SB(1, 0), b3, voffB); PG8_STAGE(PG8_SB(1, 1), b3 + hstep, voffB); PG8_STAGE(PG8_SA(1, 0), a3, voffA);
            PG8_WAIT_V(8); PG8_WAIT_L(0); PG8_BAR; PG8_MMA(1, 0, At, B0); PG8_MMA(1, 1, At, B1); PG8_BAR; PG8_SCHED;
            } else {
            PG8_LDB(B0, 0, 0); PG8_SCHED; PG8_LDA(At, 0, 0); PG8_STAGE(PG8_SA(1, 1), a1 + hstep, voffA);
            PG8_WAIT_L(8); PG8_BAR; PG8_WAIT_L(0); PG8_MMA(0, 0, At, B0); PG8_BAR; PG8_SCHED;
            PG8_LDB(B1, 0, 1); PG8_STAGE(PG8_SB(0, 0), b2, voffB);
            PG8_BAR; PG8_WAIT_L(0); PG8_MMA(0, 1, At, B1); PG8_BAR;
            PG8_LDA(At, 0, 1); PG8_STAGE(PG8_SA(0, 0), a2, voffA);
            PG8_BAR; PG8_WAIT_L(0); PG8_MMA(1, 0, At, B0); PG8_BAR; PG8_SCHED;
            PG8_STAGE(PG8_SB(0, 1), b2 + hstep, voffB);
            PG8_WAIT_V(6); PG8_BAR; PG8_MMA(1, 1, At, B1); PG8_BAR;
            PG8_LDB(B0, 1, 0); PG8_SCHED; PG8_LDA(At, 1, 0); PG8_STAGE(PG8_SA(0, 1), a2 + hstep, voffA);
            PG8_WAIT_L(8); PG8_BAR; PG8_WAIT_L(0); PG8_MMA(0, 0, At, B0); PG8_BAR; PG8_SCHED;
            PG8_LDB(B1, 1, 1); PG8_STAGE(PG8_SB(1, 0), b3, voffB);
            PG8_BAR; PG8_WAIT_L(0); PG8_MMA(0, 1, At, B1); PG8_BAR;
            PG8_LDA(At, 1, 1); PG8_STAGE(PG8_SA(1, 0), a3, voffA);
            PG8_BAR; PG8_WAIT_L(0); PG8_MMA(1, 0, At, B0); PG8_BAR; PG8_SCHED;
            PG8_STAGE(PG8_SB(1, 1), b3 + hstep, voffB);
            PG8_WAIT_V(6); PG8_BAR; PG8_MMA(1, 1, At, B1); PG8_BAR;
            }
        }
        if constexpr (ALIGN_EPI) { if (wr == 0) PG8_BAR; }
        if constexpr (!Epi::AFTER_DRAIN) { E(acc, cur, wr, wc, fr, fq); S.done(cur); }
        if (!has_next) break;
#pragma unroll
        for (int a = 0; a < 2; ++a)
#pragma unroll
            for (int b = 0; b < 2; ++b)
#pragma unroll
                for (int m = 0; m < 4; ++m)
#pragma unroll
                    for (int n = 0; n < 2; ++n) acc[a][b][m][n] = (f32x4){0.f, 0.f, 0.f, 0.f};
        cur = nxt; cA = nA; cB = nB; ++ui;
        if constexpr (ALIGN_EPI) { if (wr == 1) PG8_BAR; }
    }
    PG8_WAIT_V(0);
    if constexpr (!ALIGN_EPI) { if (wr == 0) PG8_BAR; }
    PG8_BAR;
    if constexpr (Epi::AFTER_DRAIN) { E.fused(acc, cur, wr, wc, fr, fq, lds, wid, lane); S.done(cur); }
#undef PG8_SA
#undef PG8_SB
#undef PG8_STAGE
#undef PG8_LDA
#undef PG8_LDB
#undef PG8_MMA
#undef PG8_WAIT_V
#undef PG8_WAIT_L
#undef PG8_BAR
#undef PG8_SCHED
}
}
#include <hip/hip_cooperative_groups.h>
namespace cg = cooperative_groups;
#define LAS __attribute__((address_space(3)))
typedef unsigned short bf16;
typedef float f32x4 __attribute__((ext_vector_type(4)));
typedef short bf16x8 __attribute__((ext_vector_type(8)));
typedef unsigned v4u __attribute__((ext_vector_type(4)));
typedef unsigned v2u __attribute__((ext_vector_type(2)));
constexpr int D = 1024, NPR = 16384, NSM = 512, M = NPR + NSM, SEQ = 2048, NB = 8, DB = 128, FF = 2816, PLE = 256, NCH = 32;
constexpr int NWAVES = 8, LDS_BYTES = 147456, NPH = 20;
constexpr size_t WGU_SZ = (size_t)5632 * 1024 * 2, WDN_SZ = (size_t)1024 * 2816 * 2, WSQ_SZ = (size_t)1024 * 1024 * 2, WPP_SZ = (size_t)1024 * 256 * 2;
constexpr size_t OFF_WGU = 0, OFF_WDN = OFF_WGU + 4 * WGU_SZ, OFF_WGIN = OFF_WDN + 4 * WDN_SZ, OFF_WHIN = OFF_WGIN + (size_t)3328 * 1024 * 2,
    OFF_WOUT = OFF_WHIN + (size_t)4096 * 1024 * 2, OFF_WPG = OFF_WOUT + 2 * WSQ_SZ, OFF_WPP = OFF_WPG + 2 * WSQ_SZ, OFF_HB = OFF_WPP + 2 * WPP_SZ;
constexpr size_t HB_SZ = (size_t)M * 1024 * 2;
constexpr size_t OFF_BIG = OFF_HB + 2 * HB_SZ, OFF_PB = OFF_BIG + (size_t)M * 4096 * 2, PB_SZ = (size_t)M * 256 * 2, OFF_AB = OFF_PB + 2 * PB_SZ,
    OFF_DB = OFF_AB + (size_t)2048 * 4096 * 2, OFF_RS = OFF_DB + (size_t)2048 * 128 * 4, RS_SZ = (size_t)M * 16 * 4, OFF_R = OFF_RS + 2 * RS_SZ, WS_END = OFF_R + RS_SZ, OFF_CTL = WS_END, CTL_BYTES = 16384, WS_TOTAL = OFF_CTL + CTL_BYTES;
constexpr size_t OUT_YS = (size_t)NPR * D, OUT_GP = (size_t)M * D, OUT_GS = OUT_GP + 1048576, OUT_HP = OUT_GS + 16777216, OUT_HS = OUT_HP + 1048576, OUT_END = OUT_HS + 16777216;

__device__ __forceinline__ float bf2f(unsigned short u) { return __uint_as_float((unsigned)u << 16); }
__device__ __forceinline__ float bflo(unsigned u) { return __uint_as_float(u << 16); }
__device__ __forceinline__ float bfhi(unsigned u) { return __uint_as_float(u & 0xffff0000u); }
__device__ __forceinline__ unsigned pk2(float lo, float hi) { return pg8::cvt_pk_bf16(lo, hi); }
__device__ __forceinline__ float sigm(float x) { return __builtin_amdgcn_rcpf(1.0f + __expf(-x)); }
__device__ __forceinline__ float logsig(float x) { return fminf(x, 0.f) - __logf(1.0f + __expf(-fabsf(x))); }
__device__ __forceinline__ float wave_sum(float v) {
#pragma unroll
    for (int o = 1; o < 64; o <<= 1) v += __shfl_xor(v, o);
    return v;
}
#define LDS_WAIT() asm volatile("s_waitcnt lgkmcnt(0)" ::: "memory")

__device__ __forceinline__ void tr_item(const float* W, int Nsrc, int K, bf16* WT, const float* sk, int item, int nblk, int mode, int nvalid, LAS float* scr, int lane) {
    const int kb = item / nblk, nb = item % nblk, k0 = 64 * kb, n0 = 32 * nb;
    int src0 = n0, valid = 32;
    if (mode == 1) { const int pn = n0 >> 8, within = n0 & 255, half = within >> 7, j = within & 127; src0 = half * FF + 128 * pn + j; }
    if (mode == 2) { valid = nvalid - n0; valid = valid < 0 ? 0 : (valid > 32 ? 32 : valid); }
    const int c = lane & 31;
#pragma unroll
    for (int i = 0; i < 32; ++i) { const int kk = 2 * i + (lane >> 5); float v = 0.f; if (c < valid) v = W[(size_t)(k0 + kk) * Nsrc + src0 + c]; if (sk) v *= sk[k0 + kk]; scr[kk * 33 + c] = v; }
    LDS_WAIT();
    const int ch = lane & 7;
#pragma unroll
    for (int j = 0; j < 4; ++j) { const int n = (lane >> 3) + 8 * j; const LAS float* s = scr + (8 * ch) * 33 + n;
        v4u o; o.x = pk2(s[0 * 33], s[1 * 33]); o.y = pk2(s[2 * 33], s[3 * 33]); o.z = pk2(s[4 * 33], s[5 * 33]); o.w = pk2(s[6 * 33], s[7 * 33]);
        *(v4u*)(WT + (size_t)(n0 + n) * K + k0 + 8 * ch) = o; }
    LDS_WAIT();
}
struct Args { const float* in[26]; float* out; unsigned char* ws; int ph_lo, ph_hi; };
typedef const Args __attribute__((address_space(4))) CArgs;

__device__ __forceinline__ void prologue(CArgs* a, unsigned char* ws, float* outp, LAS unsigned char* lds, int tid, int bid, int G) {
    const int lane = tid & 63, wave = tid >> 6;
    LAS float* scr = (LAS float*)(lds + wave * 16384);
    const int gw = bid * NWAVES + wave, NGW = G * NWAVES;
    constexpr int I_GU = 16 * 176, I_DN = 44 * 32, I_GIN = 16 * 104, I_HIN = 16 * 128, I_SQ = 16 * 32, I_PP = 4 * 32;
    constexpr int NITEMS = 4 * I_GU + 4 * I_DN + I_GIN + I_HIN + 4 * I_SQ + 2 * I_PP;
    for (int it = gw; it < NITEMS; it += NGW) {
        int r = it;
        if (r < 4 * I_GU) { const int q = r / I_GU, li = q >> 1, f = q & 1; r -= q * I_GU;
            tr_item((f ? a->in[20] : a->in[7]) + (size_t)li * 1024 * 5632, 5632, 1024, (bf16*)(ws + OFF_WGU + q * WGU_SZ), (f ? a->in[19] : a->in[6]) + li * 1024, r, 176, 1, 0, scr, lane); continue; }
        r -= 4 * I_GU;
        if (r < 4 * I_DN) { const int q = r / I_DN, li = q >> 1, f = q & 1; r -= q * I_DN;
            tr_item((f ? a->in[21] : a->in[8]) + (size_t)li * 2816 * 1024, 1024, 2816, (bf16*)(ws + OFF_WDN + q * WDN_SZ), nullptr, r, 32, 0, 0, scr, lane); continue; }
        r -= 4 * I_DN;
        if (r < I_GIN) { tr_item(a->in[10], 3088, 1024, (bf16*)(ws + OFF_WGIN), a->in[9], r, 104, 2, 3088, scr, lane); continue; }
        r -= I_GIN;
        if (r < I_HIN) { tr_item(a->in[15], 4096, 1024, (bf16*)(ws + OFF_WHIN), a->in[9] + 1024, r, 128, 0, 0, scr, lane); continue; }
        r -= I_HIN;
        if (r < I_SQ) { tr_item(a->in[14], 1024, 1024, (bf16*)(ws + OFF_WOUT), nullptr, r, 32, 0, 0, scr, lane); continue; }
        r -= I_SQ;
        if (r < I_SQ) { tr_item(a->in[17], 1024, 1024, (bf16*)(ws + OFF_WOUT + WSQ_SZ), nullptr, r, 32, 0, 0, scr, lane); continue; }
        r -= I_SQ;
        if (r < 2 * I_SQ) { const int li = r / I_SQ; r -= li * I_SQ;
            tr_item(a->in[23] + (size_t)li * 1024 * 1024, 1024, 1024, (bf16*)(ws + OFF_WPG + li * WSQ_SZ), a->in[22] + li * 1024, r, 32, 0, 0, scr, lane); continue; }
        r -= 2 * I_SQ;
        { const int li = r / I_PP; r -= li * I_PP;
            tr_item(a->in[24] + (size_t)li * 256 * 1024, 1024, 256, (bf16*)(ws + OFF_WPP + li * WPP_SZ), nullptr, r, 32, 0, 0, scr, lane); }
    }
    bf16* hb = (bf16*)(ws + OFF_HB); float* rs = (float*)(ws + OFF_RS);
    for (int m = gw; m < M; m += NGW) {
        const float* xr = m < NPR ? a->in[0] + (size_t)m * D : a->in[1] + (size_t)(m - NPR) * D;
        float ss = 0.f;
#pragma unroll
        for (int j = 0; j < 4; ++j) { const f32x4 v = *((const f32x4*)xr + lane + 64 * j); ss += (v[0] * v[0] + v[1] * v[1]) + (v[2] * v[2] + v[3] * v[3]);
            *((f32x4*)(outp + (size_t)m * D) + lane + 64 * j) = v; v2u w; w.x = pk2(v[0], v[1]); w.y = pk2(v[2], v[3]); *((v2u*)(hb + (size_t)m * D) + lane + 64 * j) = w; }
        ss = wave_sum(ss);
        if (lane < 16) rs[(size_t)m * 16 + lane] = lane == 0 ? ss : 0.f;
    }
    const int gt = bid * (NWAVES * 64) + tid, NGT = G * NWAVES * 64;
    for (int e = gt; e < 2 * M * 32; e += NGT) { const int li = e / (M * 32), rem = e % (M * 32), m = rem >> 5, c8 = (rem & 31) * 8;
        const float* src = m < NPR ? a->in[4] + ((size_t)li * NPR + m) * 256 + c8 : a->in[5] + ((size_t)li * NSM + (m - NPR)) * 256 + c8;
        const f32x4 v0 = *(const f32x4*)src, v1 = *(const f32x4*)(src + 4);
        v4u w; w.x = pk2(v0[0], v0[1]); w.y = pk2(v0[2], v0[3]); w.z = pk2(v1[0], v1[1]); w.w = pk2(v1[2], v1[3]);
        *(v4u*)((bf16*)(ws + OFF_PB + li * PB_SZ) + (size_t)m * 256 + c8) = w; }
}
template <bool HG> struct MX {
    static constexpr int H = HG ? 8 : 4, DV = HG ? 128 : 256, LDZ = HG ? 4096 : 3328, KC = HG ? 1024 : 512, VC = HG ? 2048 : 1024, GC = HG ? 3072 : 2048, VR = DV / 64, NVG = DV / 16, NVR = DV / 64;
    static constexpr float scale = HG ? 1.0f : 0.08838834764831845f;
};
template <bool HG> __device__ __forceinline__ void prep_phase(LAS unsigned char* lds, bf16* Z, const float* R, const float* wup, const float* bgk, const float* lowb, bf16* AB, float* DBUF, int tid, int bid, int G) {
    typedef MX<HG> C; constexpr int H = C::H, DV = C::DV, LDZ = C::LDZ, KC = C::KC, VC = C::VC, VR = C::VR, VP = DV + 8, QP = 136;
    LAS float* gl = (LAS float*)lds; LAS float* segs = (LAS float*)(lds + 32768);
    LAS bf16* qe_s = (LAS bf16*)(lds + 34816); LAS bf16* kn_s = (LAS bf16*)(lds + 52224); LAS bf16* kd_s = (LAS bf16*)(lds + 69632); LAS bf16* v_s = (LAS bf16*)(lds + 87040);
    const int t = tid >> 3, cs = tid & 7, j0 = cs * 16, lane = tid & 63, w = tid >> 6;
    for (int unit = bid; unit < NB * H * NCH; unit += G) {
        const int n = unit % NCH, bh = unit / NCH, h = bh % H, b = bh / H;
        const size_t tok0 = (size_t)b * SEQ + 64 * n, m = tok0 + t;
        __syncthreads();
        float lbc[16];
        {
            float g[16];
            if constexpr (!HG) {
                f32x4 r4[4];
#pragma unroll
                for (int i = 0; i < 4; ++i) r4[i] = *(const f32x4*)(R + m * 16 + 4 * i);
#pragma unroll
                for (int q = 0; q < 4; ++q) { const f32x4 bv = *(const f32x4*)(bgk + h * 128 + j0 + 4 * q); g[4 * q] = bv[0]; g[4 * q + 1] = bv[1]; g[4 * q + 2] = bv[2]; g[4 * q + 3] = bv[3]; }
#pragma unroll
                for (int i = 0; i < 16; ++i) { const float ri = r4[i >> 2][i & 3]; const float* wp = wup + i * 512 + h * 128 + j0;
#pragma unroll
                    for (int q = 0; q < 4; ++q) { const f32x4 wv = *(const f32x4*)(wp + 4 * q); g[4 * q] += ri * wv[0]; g[4 * q + 1] += ri * wv[1]; g[4 * q + 2] += ri * wv[2]; g[4 * q + 3] += ri * wv[3]; } }
#pragma unroll
                for (int jj = 0; jj < 16; ++jj) { g[jj] = logsig(g[jj]) * (1.0f / 16.0f); lbc[jj] = 0.f; }
            } else {
                const v4u f0 = *(const v4u*)(Z + m * LDZ + KC + h * 128 + j0), f1 = *(const v4u*)(Z + m * LDZ + KC + h * 128 + j0 + 8);
                const unsigned fw[8] = {f0.x, f0.y, f0.z, f0.w, f1.x, f1.y, f1.z, f1.w};
#pragma unroll
                for (int jj = 0; jj < 16; ++jj) { const float f = (jj & 1) ? bfhi(fw[jj >> 1]) : bflo(fw[jj >> 1]);
                    const float x0 = lowb[h * 128 + j0 + jj], x1 = lowb[1024 + h * 128 + j0 + jj];
                    const float a = logsig(x1 - x0), b2 = logsig(x0 - x1) + logsig(f), mx = fmaxf(a, b2);
                    g[jj] = mx + __logf(1.0f + __expf(-fabsf(a - b2))); lbc[jj] = sigm(x0 - x1); }
            }
#pragma unroll
            for (int q = 0; q < 4; ++q) *(LAS f32x4*)(gl + t * 128 + j0 + 4 * q) = (f32x4){g[4 * q], g[4 * q + 1], g[4 * q + 2], g[4 * q + 3]};
        }
        __syncthreads();
        {
            const int j = tid & 127, sg = tid >> 7; float acc = 0.f;
#pragma unroll
            for (int i = 0; i < 16; ++i) { acc += gl[(16 * sg + i) * 128 + j]; gl[(16 * sg + i) * 128 + j] = acc; }
            segs[sg * 128 + j] = acc;
            __syncthreads();
            float off = 0.f;
            for (int s2 = 0; s2 < sg; ++s2) off += segs[s2 * 128 + j];
            if (sg) {
#pragma unroll
                for (int i = 0; i < 16; ++i) gl[(16 * sg + i) * 128 + j] += off; }
        }
        __syncthreads();
        {
            bf16* qp = Z + m * LDZ + h * 128 + j0; const bf16* kp = Z + m * LDZ + KC + h * 128 + j0;
            const v4u q0 = *(const v4u*)qp, q1 = *(const v4u*)(qp + 8), k0 = *(const v4u*)kp, k1 = *(const v4u*)(kp + 8);
            const unsigned qw[8] = {q0.x, q0.y, q0.z, q0.w, q1.x, q1.y, q1.z, q1.w}, kw[8] = {k0.x, k0.y, k0.z, k0.w, k1.x, k1.y, k1.z, k1.w};
            float bb[16], bl[16];
#pragma unroll
            for (int q = 0; q < 4; ++q) { const f32x4 x = *(const LAS f32x4*)(gl + t * 128 + j0 + 4 * q), y = *(const LAS f32x4*)(gl + 63 * 128 + j0 + 4 * q);
                bb[4 * q] = x[0]; bb[4 * q + 1] = x[1]; bb[4 * q + 2] = x[2]; bb[4 * q + 3] = x[3]; bl[4 * q] = y[0]; bl[4 * q + 1] = y[1]; bl[4 * q + 2] = y[2]; bl[4 * q + 3] = y[3]; }
            float qe[16], kn[16], kd[16];
#pragma unroll
            for (int jj = 0; jj < 16; ++jj) { float qv = (jj & 1) ? bfhi(qw[jj >> 1]) : bflo(qw[jj >> 1]); float kv = (jj & 1) ? bfhi(kw[jj >> 1]) : bflo(kw[jj >> 1]);
                if constexpr (HG) { qv = qv * sigm(qv); kv = lbc[jj] * sigm(-kv); }
                qe[jj] = qv * __expf(bb[jj]) * C::scale; kn[jj] = kv * __expf(-bb[jj]); kd[jj] = kv * __expf(bl[jj] - bb[jj]); }
            v4u o0, o1;
            o0.x = pk2(qe[0], qe[1]); o0.y = pk2(qe[2], qe[3]); o0.z = pk2(qe[4], qe[5]); o0.w = pk2(qe[6], qe[7]); o1.x = pk2(qe[8], qe[9]); o1.y = pk2(qe[10], qe[11]); o1.z = pk2(qe[12], qe[13]); o1.w = pk2(qe[14], qe[15]);
            *(v4u*)qp = o0; *(v4u*)(qp + 8) = o1; *(LAS v4u*)(qe_s + t * QP + j0) = o0; *(LAS v4u*)(qe_s + t * QP + j0 + 8) = o1;
            o0.x = pk2(kn[0], kn[1]); o0.y = pk2(kn[2], kn[3]); o0.z = pk2(kn[4], kn[5]); o0.w = pk2(kn[6], kn[7]); o1.x = pk2(kn[8], kn[9]); o1.y = pk2(kn[10], kn[11]); o1.z = pk2(kn[12], kn[13]); o1.w = pk2(kn[14], kn[15]);
            *(LAS v4u*)(kn_s + t * QP + j0) = o0; *(LAS v4u*)(kn_s + t * QP + j0 + 8) = o1;
            o0.x = pk2(kd[0], kd[1]); o0.y = pk2(kd[2], kd[3]); o0.z = pk2(kd[4], kd[5]); o0.w = pk2(kd[6], kd[7]); o1.x = pk2(kd[8], kd[9]); o1.y = pk2(kd[10], kd[11]); o1.z = pk2(kd[12], kd[13]); o1.w = pk2(kd[14], kd[15]);
            *(LAS v4u*)(kd_s + t * QP + j0) = o0; *(LAS v4u*)(kd_s + t * QP + j0 + 8) = o1;
            if (t == 63) {
#pragma unroll
                for (int q = 0; q < 4; ++q) *(f32x4*)(DBUF + (size_t)unit * 128 + j0 + 4 * q) = (f32x4){__expf(bl[4 * q]), __expf(bl[4 * q + 1]), __expf(bl[4 * q + 2]), __expf(bl[4 * q + 3])}; }
            const bf16* vp = Z + m * LDZ + VC + h * DV + cs * (DV / 8);
#pragma unroll
            for (int q = 0; q < DV / 64; ++q) *(LAS v4u*)(v_s + t * VP + cs * (DV / 8) + 8 * q) = *(const v4u*)(vp + 8 * q);
        }
        __syncthreads();
        {
            const int r = lane & 15, quad = lane >> 4, tb = w >> 1;
#pragma unroll
            for (int e = 0; e < 2; ++e) { const int sb = 2 * (w & 1) + e; f32x4 c = {0.f, 0.f, 0.f, 0.f};
                if (sb <= tb) {
#pragma unroll
                    for (int ks = 0; ks < 4; ++ks) { const bf16x8 av = *(const LAS bf16x8*)(kn_s + (16 * sb + r) * QP + 32 * ks + 8 * quad), bv = *(const LAS bf16x8*)(qe_s + (16 * tb + r) * QP + 32 * ks + 8 * quad);
                        c = __builtin_amdgcn_mfma_f32_16x16x32_bf16(av, bv, c, 0, 0, 0); } }
                const int tc = 16 * tb + r, s0 = 16 * sb + 4 * quad;
                v2u o; o.x = pk2(s0 <= tc ? c[0] : 0.f, s0 + 1 <= tc ? c[1] : 0.f); o.y = pk2(s0 + 2 <= tc ? c[2] : 0.f, s0 + 3 <= tc ? c[3] : 0.f);
                *(v2u*)(AB + (size_t)unit * 4096 + tc * 64 + s0) = o; }
        }
        {
            const int j = tid >> 2, sq = tid & 3; unsigned pw[8];
#pragma unroll
            for (int i = 0; i < 8; ++i) pw[i] = (unsigned)kd_s[(16 * sq + 2 * i) * QP + j] | ((unsigned)kd_s[(16 * sq + 2 * i + 1) * QP + j] << 16);
            bf16* dst = Z + (tok0 + (j >> 1)) * LDZ + KC + h * 128 + (j & 1) * 64 + 16 * sq;
            *(v4u*)dst = (v4u){pw[0], pw[1], pw[2], pw[3]}; *(v4u*)(dst + 8) = (v4u){pw[4], pw[5], pw[6], pw[7]};
        }
        for (int c = tid; c < DV * 4; c += NWAVES * 64) { const int v = c >> 2, sq = c & 3; unsigned pw[8];
#pragma unroll
            for (int i = 0; i < 8; ++i) pw[i] = (unsigned)v_s[(16 * sq + 2 * i) * VP + v] | ((unsigned)v_s[(16 * sq + 2 * i + 1) * VP + v] << 16);
            bf16* dst = Z + (tok0 + v / VR) * LDZ + VC + h * DV + (v % VR) * 64 + 16 * sq;
            *(v4u*)dst = (v4u){pw[0], pw[1], pw[2], pw[3]}; *(v4u*)(dst + 8) = (v4u){pw[4], pw[5], pw[6], pw[7]}; }
    }
}
template <bool HG> __device__ __forceinline__ void scan_block(LAS unsigned char* lds, const bf16* Z, const bf16* AB, const float* DBUF, bf16* OG, const float* gn, float* Sout, int bh, int tid, int w) {
    typedef MX<HG> C; constexpr int H = C::H, DV = C::DV, LDZ = C::LDZ, KC = C::KC, VC = C::VC, GC = C::GC, VR = C::VR, VW = DV / 8, NG = VW / 16;
    constexpr int QP = 136, KP = 72, AP = 72, OFF_QE = 0, OFF_KT = 64 * QP * 2, OFF_AA = OFF_KT + 128 * KP * 2, OFF_DD = OFF_AA + 64 * AP * 2, BUFSZ = OFF_DD + 512, OFF_SS = 2 * BUFSZ;
    static_assert(OFF_SS + 2 * 64 * 8 * 4 <= 131072, "scan LDS map");
    const int lane = tid & 63, r = lane & 15, quad = lane >> 4, h = bh % H, b = bh / H, vbase = w * VW;
    f32x4 S[NG][8];
#pragma unroll
    for (int vg = 0; vg < NG; ++vg)
#pragma unroll
        for (int i = 0; i < 8; ++i) S[vg][i] = (f32x4){0.f, 0.f, 0.f, 0.f};
    f32x4 gnv[NG];
#pragma unroll
    for (int vg = 0; vg < NG; ++vg) gnv[vg] = *(const f32x4*)(gn + vbase + 16 * vg + 4 * quad);
    unsigned oq[2], ov[NG];
#pragma unroll
    for (int i = 0; i < 2; ++i) { const int p = tid + 512 * i, row = p >> 4, c16 = p & 15; oq[i] = (unsigned)(row * LDZ + 8 * c16) * 2u; }
#pragma unroll
    for (int vg = 0; vg < NG; ++vg) { const int v = vbase + 16 * vg + r; ov[vg] = (unsigned)((v / VR) * LDZ + (v % VR) * 64 + 8 * quad) * 2u; }
    unsigned oa = (unsigned)tid * 16u, og = (unsigned)(r * LDZ + 4 * quad) * 2u, oo = (unsigned)(r * 1024 + 4 * quad) * 2u;
    const char* zq0 = (const char*)(Z + (size_t)b * SEQ * LDZ + h * 128);
    const char* zv0 = (const char*)(Z + (size_t)b * SEQ * LDZ + VC + h * DV);
    const char* zg0 = (const char*)(Z + (size_t)b * SEQ * LDZ + GC + h * DV + vbase);
    const char* ab0 = (const char*)(AB + (size_t)bh * NCH * 4096);
    const char* db0 = (const char*)(DBUF + (size_t)bh * NCH * 128);
    char* og0 = (char*)(OG + (size_t)b * SEQ * 1024 + h * DV + vbase);
    constexpr size_t ZSTEP = (size_t)64 * LDZ * 2;
    unsigned lq = (unsigned)(r * QP + 4 * quad) * 2u, la = (unsigned)(r * AP + 8 * quad) * 2u, lk = (unsigned)(r * KP + 8 * quad) * 2u, ld = (unsigned)quad * 16u;
    unsigned sq[2], sk[2];
#pragma unroll
    for (int i = 0; i < 2; ++i) { const int p = tid + 512 * i, row = p >> 4, c16 = p & 15; sq[i] = (unsigned)(row * QP + 8 * c16) * 2u; sk[i] = (unsigned)((2 * row + (c16 >> 3)) * KP + 8 * (c16 & 7)) * 2u; }
    unsigned sa = (unsigned)((tid >> 3) * AP + 8 * (tid & 7)) * 2u;
    v4u pq[2], pk[2], pa, pd = {0u, 0u, 0u, 0u}; bf16x8 vb[NG][2], vbn[NG][2];
#define SC_ISSUE(n_) do { const char* zq_ = zq0 + (size_t)(n_) * ZSTEP; const char* zv_ = zv0 + (size_t)(n_) * ZSTEP; \
        _Pragma("unroll") for (int i = 0; i < 2; ++i) { pq[i] = *(const v4u*)(zq_ + oq[i]); pk[i] = *(const v4u*)(zq_ + KC * 2 + oq[i]); } \
        pa = *(const v4u*)(ab0 + (size_t)(n_) * 8192 + oa); if (tid < 32) pd = *(const v4u*)(db0 + (size_t)(n_) * 512 + oa); \
        _Pragma("unroll") for (int vg = 0; vg < NG; ++vg) { vbn[vg][0] = *(const bf16x8*)(zv_ + ov[vg]); vbn[vg][1] = *(const bf16x8*)(zv_ + ov[vg] + 64); } } while (0)
#define SC_STAGE(buf_) do { LAS unsigned char* bs_ = lds + (buf_) * BUFSZ; \
        _Pragma("unroll") for (int i = 0; i < 2; ++i) { *(LAS v4u*)(bs_ + OFF_QE + sq[i]) = pq[i]; *(LAS v4u*)(bs_ + OFF_KT + sk[i]) = pk[i]; } \
        *(LAS v4u*)(bs_ + OFF_AA + sa) = pa; if (tid < 32) *(LAS v4u*)(bs_ + OFF_DD + oa) = pd; } while (0)
    SC_ISSUE(0); SC_STAGE(0);
#pragma unroll
    for (int vg = 0; vg < NG; ++vg) { vb[vg][0] = vbn[vg][0]; vb[vg][1] = vbn[vg][1]; }
    __syncthreads();
    for (int n = 0; n < NCH; ++n) {
        asm volatile("" : "+v"(oq[0]), "+v"(oq[1]), "+v"(oa), "+v"(og), "+v"(oo), "+v"(lq), "+v"(la), "+v"(lk), "+v"(ld), "+v"(sq[0]), "+v"(sq[1]), "+v"(sk[0]), "+v"(sk[1]), "+v"(sa));
#pragma unroll
        for (int vg = 0; vg < NG; ++vg) asm volatile("" : "+v"(ov[vg]));
        if (n + 1 < NCH) SC_ISSUE(n + 1);
        const LAS unsigned char* bs = lds + (n & 1) * BUFSZ;
        f32x4 o[NG][4];
#pragma unroll
        for (int vg = 0; vg < NG; ++vg)
#pragma unroll
            for (int tb = 0; tb < 4; ++tb) o[vg][tb] = (f32x4){0.f, 0.f, 0.f, 0.f};
#pragma unroll
        for (int ks = 0; ks < 4; ++ks) { bf16x8 sb[NG];
#pragma unroll
            for (int vg = 0; vg < NG; ++vg) { v4u p; p.x = pk2(S[vg][2 * ks][0], S[vg][2 * ks][1]); p.y = pk2(S[vg][2 * ks][2], S[vg][2 * ks][3]); p.z = pk2(S[vg][2 * ks + 1][0], S[vg][2 * ks + 1][1]); p.w = pk2(S[vg][2 * ks + 1][2], S[vg][2 * ks + 1][3]);
                sb[vg] = __builtin_bit_cast(bf16x8, p); }
#pragma unroll
            for (int tb = 0; tb < 4; ++tb) { const LAS unsigned char* qa = bs + OFF_QE + lq + (16 * tb * QP + 32 * ks) * 2;
                const v2u lo = *(const LAS v2u*)qa, hi = *(const LAS v2u*)(qa + 32); const bf16x8 qf = __builtin_bit_cast(bf16x8, ((v4u){lo.x, lo.y, hi.x, hi.y}));
#pragma unroll
                for (int vg = 0; vg < NG; ++vg) o[vg][tb] = __builtin_amdgcn_mfma_f32_16x16x32_bf16(sb[vg], qf, o[vg][tb], 0, 0, 0); } }
#pragma unroll
        for (int tb = 0; tb < 4; ++tb) { const LAS unsigned char* aa = bs + OFF_AA + la + 16 * tb * AP * 2; const bf16x8 a0 = *(const LAS bf16x8*)aa, a1 = *(const LAS bf16x8*)(aa + 64);
#pragma unroll
            for (int vg = 0; vg < NG; ++vg) { o[vg][tb] = __builtin_amdgcn_mfma_f32_16x16x32_bf16(vb[vg][0], a0, o[vg][tb], 0, 0, 0); o[vg][tb] = __builtin_amdgcn_mfma_f32_16x16x32_bf16(vb[vg][1], a1, o[vg][tb], 0, 0, 0); } }
#pragma unroll
        for (int kb = 0; kb < 8; ++kb) { const f32x4 dv = *(const LAS f32x4*)(bs + OFF_DD + ld + 64 * kb);
            const LAS unsigned char* ka = bs + OFF_KT + lk + 16 * kb * KP * 2; const bf16x8 k0 = *(const LAS bf16x8*)ka, k1 = *(const LAS bf16x8*)(ka + 64);
#pragma unroll
            for (int vg = 0; vg < NG; ++vg) { S[vg][kb] = S[vg][kb] * dv; S[vg][kb] = __builtin_amdgcn_mfma_f32_16x16x32_bf16(k0, vb[vg][0], S[vg][kb], 0, 0, 0); S[vg][kb] = __builtin_amdgcn_mfma_f32_16x16x32_bf16(k1, vb[vg][1], S[vg][kb], 0, 0, 0); } }
        LAS float* ssb = (LAS float*)(lds + OFF_SS + (n & 1) * 2048);
#pragma unroll
        for (int tb = 0; tb < 4; ++tb) { float p = 0.f;
#pragma unroll
            for (int vg = 0; vg < NG; ++vg) p += (o[vg][tb][0] * o[vg][tb][0] + o[vg][tb][1] * o[vg][tb][1]) + (o[vg][tb][2] * o[vg][tb][2] + o[vg][tb][3] * o[vg][tb][3]);
            p += __shfl_xor(p, 16); p += __shfl_xor(p, 32);
            if (quad == 0) ssb[(16 * tb + r) * 8 + w] = p; }
        const char* zg = zg0 + (size_t)n * ZSTEP;
        v2u gq[NG][4];
#pragma unroll
        for (int tb = 0; tb < 4; ++tb) { const char* zgt = zg + (size_t)tb * 16 * LDZ * 2;
#pragma unroll
            for (int vg = 0; vg < NG; ++vg) gq[vg][tb] = *(const v2u*)(zgt + og + 32 * vg); }
        if (n + 1 < NCH) { SC_STAGE((n + 1) & 1);
#pragma unroll
            for (int vg = 0; vg < NG; ++vg) { vb[vg][0] = vbn[vg][0]; vb[vg][1] = vbn[vg][1]; } }
        __syncthreads();
        char* ogn = og0 + (size_t)n * 64 * 1024 * 2;
#pragma unroll
        for (int tb = 0; tb < 4; ++tb) { const f32x4 s0 = *(const LAS f32x4*)(ssb + (16 * tb + r) * 8), s1 = *(const LAS f32x4*)(ssb + (16 * tb + r) * 8 + 4);
            const float tot = ((s0[0] + s0[1]) + (s0[2] + s0[3])) + ((s1[0] + s1[1]) + (s1[2] + s1[3])); const float rinv = rsqrtf(tot * (1.0f / DV) + 1e-6f);
            char* ogt = ogn + (size_t)tb * 16 * 1024 * 2;
#pragma unroll
            for (int vg = 0; vg < NG; ++vg) { const float g0 = bflo(gq[vg][tb].x), g1 = bfhi(gq[vg][tb].x), g2 = bflo(gq[vg][tb].y), g3 = bfhi(gq[vg][tb].y);
                const f32x4 y = o[vg][tb] * rinv * gnv[vg]; v2u pw; pw.x = pk2(y[0] * g0 * sigm(g0), y[1] * g1 * sigm(g1)); pw.y = pk2(y[2] * g2 * sigm(g2), y[3] * g3 * sigm(g3));
                *(v2u*)(ogt + oo + 32 * vg) = pw; } }
    }
#undef SC_ISSUE
#undef SC_STAGE
    int ln2 = lane; asm volatile("" : "+v"(ln2));
    float* so = Sout + (size_t)bh * 128 * DV + vbase; const unsigned os = (unsigned)((4 * (ln2 >> 4)) * DV + (ln2 & 15));
#pragma unroll
    for (int vg = 0; vg < NG; ++vg)
#pragma unroll
        for (int kb = 0; kb < 8; ++kb)
#pragma unroll
            for (int j = 0; j < 4; ++j) so[os + (16 * kb + j) * DV + 16 * vg] = S[vg][kb][j];
}
template <bool HG> __device__ __forceinline__ void sample_head(LAS float* wl, const bf16* Z, const float* R, const float* wup, const float* bgk, const float* lowb, const float* gn, const float* S0, float* Sout, bf16* OG, int bh, int lane) {
    typedef MX<HG> C; constexpr int H = C::H, DV = C::DV, LDZ = C::LDZ, KC = C::KC, VC = C::VC, GC = C::GC, E = DV / 64;
    const int h = bh % H, b = bh / H; const size_t m0 = (size_t)NPR + 4 * b;
    float pa[10];
#pragma unroll
    for (int i = 0; i < 10; ++i) pa[i] = 0.f;
#pragma unroll
    for (int kk = 0; kk < 2; ++kk) { const int k = lane + 64 * kk, hk = h * 128 + k; float g[4], q[4], kv[4];
#pragma unroll
        for (int t = 0; t < 4; ++t) { const bf16* zr = Z + (m0 + t) * LDZ; q[t] = bf2f(zr[hk]); const float kz = bf2f(zr[KC + hk]);
            if constexpr (!HG) { float x = bgk[hk];
#pragma unroll
                for (int i = 0; i < 16; ++i) x += R[(m0 + t) * 16 + i] * wup[i * 512 + hk];
                g[t] = logsig(x) * (1.0f / 16.0f); kv[t] = kz;
            } else { const float x0 = lowb[hk], x1 = lowb[1024 + hk]; const float a = logsig(x1 - x0), b2 = logsig(x0 - x1) + logsig(kz), mx = fmaxf(a, b2);
                g[t] = mx + __logf(1.0f + __expf(-fabsf(a - b2))); kv[t] = sigm(x0 - x1) * sigm(-kz); q[t] = q[t] * sigm(q[t]); } }
        float bb[4]; bb[0] = g[0]; bb[1] = bb[0] + g[1]; bb[2] = bb[1] + g[2]; bb[3] = bb[2] + g[3];
        float qe[4], kn[4];
#pragma unroll
        for (int t = 0; t < 4; ++t) { qe[t] = q[t] * __expf(bb[t]) * C::scale; kn[t] = kv[t] * __expf(-bb[t]); wl[k * 12 + t] = qe[t]; wl[k * 12 + 4 + t] = kv[t] * __expf(bb[3] - bb[t]); }
        wl[k * 12 + 8] = __expf(bb[3]);
        int idx = 0;
#pragma unroll
        for (int t = 0; t < 4; ++t)
#pragma unroll
            for (int s = 0; s <= t; ++s) pa[idx++] += qe[t] * kn[s];
    }
#pragma unroll
    for (int i = 0; i < 10; ++i) pa[i] = wave_sum(pa[i]);
    float vv[4][E], o[4][E], gg[4][E];
#pragma unroll
    for (int s = 0; s < 4; ++s) { const bf16* zr = Z + (m0 + s) * LDZ + h * DV + E * lane;
        if constexpr (E == 4) { const v2u x = *(const v2u*)(zr + VC), y = *(const v2u*)(zr + GC); vv[s][0] = bflo(x.x); vv[s][1] = bfhi(x.x); vv[s][2] = bflo(x.y); vv[s][3] = bfhi(x.y); gg[s][0] = bflo(y.x); gg[s][1] = bfhi(y.x); gg[s][2] = bflo(y.y); gg[s][3] = bfhi(y.y); }
        else { const unsigned x = *(const unsigned*)(zr + VC), y = *(const unsigned*)(zr + GC); vv[s][0] = bflo(x); vv[s][1] = bfhi(x); gg[s][0] = bflo(y); gg[s][1] = bfhi(y); } }
    { int idx = 0;
#pragma unroll
        for (int t = 0; t < 4; ++t) {
#pragma unroll
            for (int e = 0; e < E; ++e) o[t][e] = 0.f;
#pragma unroll
            for (int s = 0; s <= t; ++s) { const float p = pa[idx++];
#pragma unroll
                for (int e = 0; e < E; ++e) o[t][e] += p * vv[s][e]; } } }
    LDS_WAIT();
    const float* sp = S0 + ((size_t)bh * 128) * DV + E * lane; float* dp = Sout + ((size_t)bh * 128) * DV + E * lane;
#pragma unroll 8
    for (int k = 0; k < 128; ++k) { const f32x4 q4 = *(const LAS f32x4*)(wl + k * 12), k4 = *(const LAS f32x4*)(wl + k * 12 + 4); const float d = wl[k * 12 + 8];
        float s0[E];
        if constexpr (E == 4) { const f32x4 x = *(const f32x4*)(sp + (size_t)k * DV); s0[0] = x[0]; s0[1] = x[1]; s0[2] = x[2]; s0[3] = x[3]; }
        else { const v2u x = *(const v2u*)(sp + (size_t)k * DV); s0[0] = __uint_as_float(x.x); s0[1] = __uint_as_float(x.y); }
        float sn[E];
#pragma unroll
        for (int e = 0; e < E; ++e) { o[0][e] += q4[0] * s0[e]; o[1][e] += q4[1] * s0[e]; o[2][e] += q4[2] * s0[e]; o[3][e] += q4[3] * s0[e];
            sn[e] = d * s0[e] + ((k4[0] * vv[0][e] + k4[1] * vv[1][e]) + (k4[2] * vv[2][e] + k4[3] * vv[3][e])); }
        if constexpr (E == 4) *(f32x4*)(dp + (size_t)k * DV) = (f32x4){sn[0], sn[1], sn[2], sn[3]};
        else { v2u x; x.x = __float_as_uint(sn[0]); x.y = __float_as_uint(sn[1]); *(v2u*)(dp + (size_t)k * DV) = x; } }
    float gv[E];
#pragma unroll
    for (int e = 0; e < E; ++e) gv[e] = gn[E * lane + e];
#pragma unroll
    for (int t = 0; t < 4; ++t) { float ss = 0.f;
#pragma unroll
        for (int e = 0; e < E; ++e) ss += o[t][e] * o[t][e];
        ss = wave_sum(ss); const float rinv = rsqrtf(ss * (1.0f / DV) + 1e-6f); float y[E];
#pragma unroll
        for (int e = 0; e < E; ++e) y[e] = o[t][e] * rinv * gv[e] * (gg[t][e] * sigm(gg[t][e]));
        bf16* op = OG + (m0 + t) * 1024 + h * DV + E * lane;
        if constexpr (E == 4) { v2u pw; pw.x = pk2(y[0], y[1]); pw.y = pk2(y[2], y[3]); *(v2u*)op = pw; } else { *(unsigned*)op = pk2(y[0], y[1]); } }
    LDS_WAIT();
}
template <int NKS> __device__ __forceinline__ void mini_acc(f32x4 (&acc)[2][4], const bf16* ap, size_t lda, const bf16* bp, size_t ldb) {
#pragma unroll
    for (int c = 0; c < NKS; c += 4) {
        bf16x8 af[4][2], bfr[4][4];
#pragma unroll
        for (int ks = 0; ks < 4; ++ks) if (c + ks < NKS) {
#pragma unroll
            for (int rb = 0; rb < 2; ++rb) af[ks][rb] = *(const bf16x8*)(ap + (size_t)(16 * rb) * lda + 32 * (c + ks));
#pragma unroll
            for (int cb = 0; cb < 4; ++cb) bfr[ks][cb] = *(const bf16x8*)(bp + (size_t)(16 * cb) * ldb + 32 * (c + ks)); }
        __builtin_amdgcn_sched_barrier(0);
#pragma unroll
        for (int ks = 0; ks < 4; ++ks) if (c + ks < NKS) {
#pragma unroll
            for (int rb = 0; rb < 2; ++rb)
#pragma unroll
                for (int cb = 0; cb < 4; ++cb) acc[rb][cb] = __builtin_amdgcn_mfma_f32_16x16x32_bf16(bfr[ks][cb], af[ks][rb], acc[rb][cb], 0, 0, 0); }
        __builtin_amdgcn_sched_barrier(0);
    }
}
template <int MODE, int K> __device__ __forceinline__ void mini_gemm(LAS unsigned char* lds, const bf16* A, const bf16* Bt, const bf16* A2, const bf16* Bt2, float* h, bf16* hb_out, const float* rs_in, float* rs_out, float alpha, int tid, int bid, int G) {
    const int lane = tid & 63, w = tid >> 6, r = lane & 15, quad = lane >> 4;
    LAS float* P = (LAS float*)lds; LAS float* P2 = (LAS float*)(lds + 65536);
    for (int mt = bid; mt < 256; mt += G) {
        const int rt = mt >> 4, ct = mt & 15, row0 = NPR + 32 * rt, col0 = 64 * ct;
        f32x4 acc[2][4];
#pragma unroll
        for (int rb = 0; rb < 2; ++rb)
#pragma unroll
            for (int cb = 0; cb < 4; ++cb) acc[rb][cb] = (f32x4){0.f, 0.f, 0.f, 0.f};
        constexpr int KW = K / 8;
        mini_acc<KW / 32>(acc, A + (size_t)(row0 + r) * K + w * KW + 8 * quad, K, Bt + (size_t)(col0 + r) * K + w * KW + 8 * quad, K);
#pragma unroll
        for (int rb = 0; rb < 2; ++rb)
#pragma unroll
            for (int cb = 0; cb < 4; ++cb) *(LAS f32x4*)(P + (w * 32 + 16 * rb + r) * 64 + 16 * cb + 4 * quad) = acc[rb][cb];
        if constexpr (MODE == 1) {
#pragma unroll
            for (int rb = 0; rb < 2; ++rb)
#pragma unroll
                for (int cb = 0; cb < 4; ++cb) acc[rb][cb] = (f32x4){0.f, 0.f, 0.f, 0.f};
            mini_acc<1>(acc, A2 + (size_t)(row0 + r) * 256 + w * 32 + 8 * quad, 256, Bt2 + (size_t)(col0 + r) * 256 + w * 32 + 8 * quad, 256);
#pragma unroll
            for (int rb = 0; rb < 2; ++rb)
#pragma unroll
                for (int cb = 0; cb < 4; ++cb) *(LAS f32x4*)(P2 + (w * 32 + 16 * rb + r) * 64 + 16 * cb + 4 * quad) = acc[rb][cb];
        }
        __syncthreads();
        const int row = tid >> 4, c4 = (tid & 15) * 4; f32x4 v = {0.f, 0.f, 0.f, 0.f}, v2 = {0.f, 0.f, 0.f, 0.f};
#pragma unroll
        for (int ww = 0; ww < 8; ++ww) { v += *(const LAS f32x4*)(P + (ww * 32 + row) * 64 + c4); if constexpr (MODE == 1) v2 += *(const LAS f32x4*)(P2 + (ww * 32 + row) * 64 + c4); }
        const int grow = row0 + row; const size_t off = (size_t)grow * 1024 + col0 + c4;
        f32x4 o = *(const f32x4*)(h + off);
        if constexpr (MODE == 0) o += v * alpha;
        else { const float s = pg8::row_scale(rs_in, grow); o[0] += sigm(v[0] * s) * v2[0]; o[1] += sigm(v[1] * s) * v2[1]; o[2] += sigm(v[2] * s) * v2[2]; o[3] += sigm(v[3] * s) * v2[3]; }
        *(f32x4*)(h + off) = o; v2u pw; pw.x = pk2(o[0], o[1]); pw.y = pk2(o[2], o[3]); *(v2u*)(hb_out + off) = pw;
        float ss = (o[0] * o[0] + o[1] * o[1]) + (o[2] * o[2] + o[3] * o[3]);
        ss += __shfl_xor(ss, 1); ss += __shfl_xor(ss, 2); ss += __shfl_xor(ss, 4); ss += __shfl_xor(ss, 8);
        if ((tid & 15) == 0) rs_out[(size_t)grow * 16 + ct] = ss;
        __syncthreads();
    }
}
#define XB_TMO      128
#define XB_XCNT(j)  (256  + 64 * (j))
#define XB_XSUB(j)  (1280 + 64 * (j))
#define XB_XGEN(j)  (2304 + 64 * (j))
#define XB_TOP      3328
#define XB_TOPGEN   3392
#define XCD_BAR_WORDS 3456
#define XB_SPIN_CAP (1u << 18)

__device__ __forceinline__ unsigned xb_ld(unsigned* p)              { return __hip_atomic_load(p, __ATOMIC_RELAXED, __HIP_MEMORY_SCOPE_AGENT); }
__device__ __forceinline__ unsigned xb_add(unsigned* p, unsigned v) { return __hip_atomic_fetch_add(p, v, __ATOMIC_RELAXED, __HIP_MEMORY_SCOPE_AGENT); }
__device__ __forceinline__ unsigned xb_xcc_id() { return (unsigned)__builtin_amdgcn_s_getreg((3 << 11) | 20) & 0xFu; }
#define XB_SPIN(cond, bar) do { unsigned _sp = 0; while (cond) { __builtin_amdgcn_s_sleep(1); \
    if ((++_sp & 255u) == 0u) { if (xb_ld(&(bar)[XB_TMO])) break; if (_sp > XB_SPIN_CAP) { atomicAdd(&(bar)[XB_TMO], 1u); break; } } } } while (0)

struct XcdBarrier {
    unsigned* bar; unsigned x;
    volatile LAS unsigned* st;
};

__device__ __forceinline__ XcdBarrier xcd_barrier_post(unsigned* bar, volatile LAS unsigned* st) {
    XcdBarrier b; b.bar = bar; b.x = xb_xcc_id(); b.st = st;
    if (threadIdx.x == 0) (void)xb_add(&bar[XB_XCNT(b.x)], 1u);
    return b;
}
__device__ __forceinline__ void xcd_barrier_complete(unsigned* bar, unsigned x, unsigned& nloc, unsigned& nx) {
    const unsigned G = gridDim.x * gridDim.y * gridDim.z;
    unsigned sum, cnt, mine, sp = 0u;
    for (;;) {
        sum = 0u; cnt = 0u; mine = 0u;
#pragma unroll
        for (unsigned j = 0; j < 16; ++j) { const unsigned c = xb_ld(&bar[XB_XCNT(j)]); sum += c; cnt += (c > 0u) ? 1u : 0u; mine = (j == x) ? c : mine; }
        if (sum == G) break;
        __builtin_amdgcn_s_sleep(1);
        if ((++sp & 255u) == 0u) { if (xb_ld(&bar[XB_TMO])) break; if (sp > XB_SPIN_CAP) { atomicAdd(&bar[XB_TMO], 1u); break; } }
    }
    nloc = mine > 0u ? mine : 1u; nx = cnt > 0u ? cnt : 1u;
}

__device__ __forceinline__ void xcd_barrier(const XcdBarrier& b) {
    asm volatile("s_waitcnt vmcnt(0)" ::: "memory");
    __syncthreads();
    if (threadIdx.x == 0) {
        unsigned* bar = b.bar;
        __builtin_amdgcn_s_waitcnt(0);
        unsigned nloc = b.st[0], nx = b.st[1];
        if (nloc == 0u) { xcd_barrier_complete(bar, b.x, nloc, nx); b.st[0] = nloc; b.st[1] = nx; }
        const unsigned old = xb_add(&bar[XB_XSUB(b.x)], 1u);
        const unsigned gen = old / nloc;
        if (old + 1u == (gen + 1u) * nloc) {
            __builtin_amdgcn_fence(__ATOMIC_RELEASE, "agent");
            asm volatile("s_waitcnt vmcnt(0)" ::: "memory");
            const unsigned og = xb_add(&bar[XB_TOP], 1u);
            const unsigned tg = og / nx;
            if (og + 1u == (tg + 1u) * nx) xb_add(&bar[XB_TOPGEN], 1u);
            else XB_SPIN(xb_ld(&bar[XB_TOPGEN]) == tg, bar);
            __builtin_amdgcn_fence(__ATOMIC_ACQUIRE, "agent");
            xb_add(&bar[XB_XGEN(b.x)], 1u);
            asm volatile("s_waitcnt vmcnt(0)" ::: "memory");
        } else {
            XB_SPIN(xb_ld(&bar[XB_XGEN(b.x)]) == gen, bar);
            __builtin_amdgcn_fence(__ATOMIC_ACQUIRE, "agent");
            asm volatile("s_waitcnt vmcnt(0)" ::: "memory");
        }
    }
    __syncthreads();
}

#define MK_TID() int wave = wave_s; asm volatile("" : "+s"(wave)); unsigned ones_ = ~0u; asm volatile("" : "+s"(ones_)); \
    const int lane = (int)__builtin_amdgcn_mbcnt_hi(ones_, __builtin_amdgcn_mbcnt_lo(ones_, 0u)); const int tid = wave * 64 + lane; const int gw = bid * NWAVES + wave, NGW = G * NWAVES; (void)gw; (void)NGW; (void)tid; (void)lane
__global__ void __launch_bounds__(NWAVES * 64, 2) fwd_kernel(Args a) {
    extern __shared__ __attribute__((aligned(16))) unsigned char lds_raw[];
    LAS unsigned char* lds = (LAS unsigned char*)lds_raw;
    cg::grid_group grid = cg::this_grid();
    const int wave_s = __builtin_amdgcn_readfirstlane((int)threadIdx.x >> 6);
    volatile LAS unsigned* bst = (volatile LAS unsigned*)(lds + 131072 + 256);
    if (threadIdx.x < 2) bst[threadIdx.x] = 0u;
    __syncthreads();
    const XcdBarrier xbar = xcd_barrier_post((unsigned*)(a.ws + OFF_CTL), bst);
    const int ph_lo = a.ph_lo, ph_hi = a.ph_hi;
    for (int ph_ = ph_lo; ph_ < ph_hi; ++ph_) {
#if PROBE_MODE
      const int kk_ = (ph_ - 1) % 9; const bool mid_ = ph_ > 0 && ph_ < NPH - 1;
      const int nrep = (PROBE_MODE == 1 && ph_ == 0) || (PROBE_MODE == 2 && mid_ && (kk_ == 0 || kk_ == 6)) || (PROBE_MODE == 3 && mid_ && kk_ == 2) || (PROBE_MODE == 4 && mid_ && kk_ == 4) ? 2 : 1;
      for (int rep = 0; rep < nrep; ++rep) {
#else
      {
#endif
        int ph = ph_; asm volatile("" : "+s"(ph));
        CArgs* ap = (CArgs*)__builtin_amdgcn_kernarg_segment_ptr(); asm volatile("" : "+s"(ap));
        int bid = blockIdx.x; asm volatile("" : "+s"(bid));
        int G = gridDim.x; asm volatile("" : "+s"(G));
        unsigned char* ws = ap->ws; float* hbuf = ap->out;
        if (ph == 0) { MK_TID(); prologue(ap, ws, hbuf, lds, tid, bid, G); }
        else if (ph == NPH - 1) {
            MK_TID(); const float* fw = ap->in[25];
            for (int m = gw; m < M; m += NGW) { f32x4* hr = (f32x4*)(hbuf + (size_t)m * D); f32x4 v[4]; float ss = 0.f;
#pragma unroll
                for (int j = 0; j < 4; ++j) { v[j] = hr[lane + 64 * j]; ss += (v[j][0] * v[j][0] + v[j][1] * v[j][1]) + (v[j][2] * v[j][2] + v[j][3] * v[j][3]); }
                ss = wave_sum(ss); const float rinv = rsqrtf(ss * (1.0f / D) + 1e-6f);
#pragma unroll
                for (int j = 0; j < 4; ++j) { const f32x4 wv = *((const f32x4*)fw + lane + 64 * j); hr[lane + 64 * j] = v[j] * rinv * wv; } }
        } else {
            const int li = (ph - 1) / 9, k = (ph - 1) % 9, cur = li;
            bf16* hb = (bf16*)(ws + OFF_HB + cur * HB_SZ); bf16* ob = (bf16*)(ws + OFF_HB + (cur ^ 1) * HB_SZ);
            float* rs0 = (float*)(ws + OFF_RS); float* rs1 = (float*)(ws + OFF_RS + RS_SZ); float* Rb = (float*)(ws + OFF_R);
            bf16* big = (bf16*)(ws + OFF_BIG);
            if (k == 0 || k == 6) { MK_TID();
                const int f = k == 6; pg8::Gemm g{hb, (const bf16*)(ws + OFF_WGU + (li * 2 + f) * WGU_SZ), M, 2 * FF, D};
                pg8::StaticOrder S; S.init(M, 2 * FF, G, bid); pg8::EpiSwiglu E{big, FF, rs0};
                pg8::gemm_phase<pg8::EpiSwiglu, pg8::StaticOrder, true, true>(lds, g, S, E, tid);
            } else if (k == 1 || k == 7 || k == 5) { MK_TID();
                pg8::Gemm g; float alpha; float* rso;
                if (k == 5) { g = pg8::Gemm{ob, (const bf16*)(ws + OFF_WOUT + li * WSQ_SZ), M, D, D}; alpha = 1.0f; rso = rs0; }
                else { const int f = k == 7; g = pg8::Gemm{big, (const bf16*)(ws + OFF_WDN + (li * 2 + f) * WDN_SZ), M, D, FF}; alpha = 0.5f; rso = rs1; }
                g.M = NPR; pg8::StaticOrder S; S.init(NPR, D, G, bid); pg8::EpiResid E{hbuf, hb, rso, alpha};
                pg8::gemm_phase<pg8::EpiResid, pg8::StaticOrder, true, true>(lds, g, S, E, tid);
                unsigned ones2_ = ~0u; asm volatile("" : "+s"(ones2_));
                const int tid2 = wave * 64 + (int)__builtin_amdgcn_mbcnt_hi(ones2_, __builtin_amdgcn_mbcnt_lo(ones2_, 0u));
                if (k == 5) mini_gemm<0, D>(lds, g.A, g.Bt, nullptr, nullptr, hbuf, hb, nullptr, rso, alpha, tid2, bid, G);
                else mini_gemm<0, FF>(lds, g.A, g.Bt, nullptr, nullptr, hbuf, hb, nullptr, rso, alpha, tid2, bid, G);
            } else if (k == 2) { MK_TID();
                const int N = li ? 4096 : 3328; pg8::Gemm g{hb, (const bf16*)(ws + (li ? OFF_WHIN : OFF_WGIN)), M, N, D};
                pg8::StaticOrder S; S.init(M, N, G, bid); pg8::EpiZ E{big, N, rs1, Rb, li ? -1 : 12};
                pg8::gemm_phase<pg8::EpiZ, pg8::StaticOrder, true, true>(lds, g, S, E, tid);
            } else if (k == 3) { MK_TID();
                if (li == 0) prep_phase<false>(lds, big, Rb, ap->in[11], ap->in[12], ap->in[18], (bf16*)(ws + OFF_AB), (float*)(ws + OFF_DB), tid, bid, G);
                else prep_phase<true>(lds, big, Rb, ap->in[11], ap->in[12], ap->in[18], (bf16*)(ws + OFF_AB), (float*)(ws + OFF_DB), tid, bid, G);
            } else if (k == 4) { MK_TID();
                const int NBH = li ? 64 : 32;
                if (bid < NBH || G <= NBH) {
                    for (int bh = bid; bh < NBH; bh += G) {
                        if (li == 0) scan_block<false>(lds, big, (const bf16*)(ws + OFF_AB), (const float*)(ws + OFF_DB), ob, ap->in[13], hbuf + OUT_GP, bh, tid, wave);
                        else scan_block<true>(lds, big, (const bf16*)(ws + OFF_AB), (const float*)(ws + OFF_DB), ob, ap->in[16], hbuf + OUT_HP, bh, tid, wave);
                        __syncthreads();
                    }
                }
                if (bid >= NBH || G <= NBH) {
                    LAS float* wl = (LAS float*)(lds + wave * 8192);
                    const int nsb = G <= NBH ? G : G - NBH, sb0 = G <= NBH ? bid : bid - NBH;
                    for (int u = sb0 * NWAVES + wave; u < DB * (li ? 8 : 4); u += nsb * NWAVES) {
                        if (li == 0) sample_head<false>(wl, big, Rb, ap->in[11], ap->in[12], ap->in[18], ap->in[13], ap->in[2], hbuf + OUT_GS, ob, u, lane);
                        else sample_head<true>(wl, big, Rb, ap->in[11], ap->in[12], ap->in[18], ap->in[16], ap->in[3], hbuf + OUT_HS, ob, u, lane);
                    }
                }
            } else { MK_TID();
                float* pp = (float*)(ws + OFF_BIG);
                { pg8::Gemm g{(const bf16*)(ws + OFF_PB + li * PB_SZ), (const bf16*)(ws + OFF_WPP + li * WPP_SZ), NPR, D, PLE};
                  pg8::StaticOrder S; S.init(NPR, D, G, bid); pg8::EpiStoreF32 E{pp};
                  pg8::gemm_phase<pg8::EpiStoreF32, pg8::StaticOrder, true, true>(lds, g, S, E, tid); }
                { unsigned ones2_ = ~0u; asm volatile("" : "+s"(ones2_)); const int tid2 = wave * 64 + (int)__builtin_amdgcn_mbcnt_hi(ones2_, __builtin_amdgcn_mbcnt_lo(ones2_, 0u));
                  pg8::Gemm g{hb, (const bf16*)(ws + OFF_WPG + li * WSQ_SZ), NPR, D, D};
                  pg8::StaticOrder S; S.init(NPR, D, G, bid); pg8::EpiPle E{hbuf, ob, rs1, rs0, pp};
                  pg8::gemm_phase<pg8::EpiPle, pg8::StaticOrder, true, true>(lds, g, S, E, tid2); }
                { unsigned ones3_ = ~0u; asm volatile("" : "+s"(ones3_)); const int tid3 = wave * 64 + (int)__builtin_amdgcn_mbcnt_hi(ones3_, __builtin_amdgcn_mbcnt_lo(ones3_, 0u));
                  mini_gemm<1, D>(lds, hb, (const bf16*)(ws + OFF_WPG + li * WSQ_SZ), (const bf16*)(ws + OFF_PB + li * PB_SZ), (const bf16*)(ws + OFF_WPP + li * WPP_SZ), hbuf, ob, rs1, rs0, 0.f, tid3, bid, G); }
            }
        }
#if PROBE_MODE
        if (ph_ + 1 < ph_hi || rep + 1 < nrep) grid.sync();
#else
        if (ph_ + 1 < ph_hi) {
            if (ph_ == 0) grid.sync(); else xcd_barrier(xbar);
#if EXTRA_SYNCS
            for (int es = 0; es < EXTRA_SYNCS; ++es) xcd_barrier(xbar);
#endif
        }
#endif
      }
    }
}

extern "C" void kernel_launch(void* const* d_in, const int* in_sizes, int n_in, void* d_out, int out_size, void* d_ws, size_t ws_size, hipStream_t stream) {
    static int grid = 0;
    if (grid == 0) {
        if (n_in != 26 || (size_t)out_size != OUT_END || ws_size < WS_TOTAL) { fprintf(stderr, "kernel_launch: unexpected shapes (n_in %d out %d ws %zu need %zu); nothing launched\n", n_in, out_size, ws_size, (size_t)WS_TOTAL); grid = -1; return; }
        int dev = 0, cus = 0, per_cu = 0;
        if (hipGetDevice(&dev) != hipSuccess || hipDeviceGetAttribute(&cus, hipDeviceAttributeMultiprocessorCount, dev) != hipSuccess) { grid = -1; return; }
        if (hipFuncSetAttribute((const void*)fwd_kernel, hipFuncAttributeMaxDynamicSharedMemorySize, LDS_BYTES) != hipSuccess) { fprintf(stderr, "kernel_launch: hipFuncSetAttribute failed\n"); grid = -1; return; }
        if (hipOccupancyMaxActiveBlocksPerMultiprocessor(&per_cu, (const void*)fwd_kernel, NWAVES * 64, LDS_BYTES) != hipSuccess || per_cu < 1) per_cu = 1;
        (void)hipGetLastError();
        grid = cus * per_cu;
    }
    if (grid < 0) return;
    if (hipMemsetAsync((char*)d_ws + OFF_CTL, 0, CTL_BYTES, stream) != hipSuccess) { fprintf(stderr, "kernel_launch: memset of the barrier words failed\n"); return; }
    Args a{};
    for (int i = 0; i < 26; ++i) a.in[i] = (const float*)d_in[i];
    a.out = (float*)d_out; a.ws = (unsigned char*)d_ws;
#if MK_N_LAUNCHES == 1
    a.ph_lo = 0; a.ph_hi = NPH;
    void* args[] = {&a};
    hipError_t e = hipLaunchCooperativeKernel((const void*)fwd_kernel, dim3(grid), dim3(NWAVES * 64), args, LDS_BYTES, stream);
    if (e != hipSuccess) fprintf(stderr, "kernel_launch: cooperative launch failed: %s (grid %d)\n", hipGetErrorString(e), grid);
#else
    for (int ph = 0; ph < NPH; ++ph) { a.ph_lo = ph; a.ph_hi = ph + 1; hipLaunchKernelGGL(fwd_kernel, dim3(grid), dim3(NWAVES * 64), LDS_BYTES, stream, a); }
#endif
}
```

```cpp
#include <hip/hip_runtime.h>
#include <cstdio>
#include <cstdint>
#ifndef MK_N_LAUNCHES
#define MK_N_LAUNCHES 1
#endif
#ifndef PROBE_MODE
#define PROBE_MODE 0
#endif
#ifndef EXTRA_SYNCS
#define EXTRA_SYNCS 0
#endif
namespace pg8 {
#define PG8_LAS __attribute__((address_space(3)))
typedef unsigned short bf16_t;
typedef short bf16x8 __attribute__((ext_vector_type(8)));
typedef float f32x4 __attribute__((ext_vector_type(4)));
typedef unsigned u32x4 __attribute__((ext_vector_type(4)));
constexpr int BM = 256, BK = 64, HALF = 128, HTB = HALF * BK * 2  , STAGE_BYTES = 8 * HTB, NXCD = 8, WGM = 8;

__host__ __device__ __forceinline__ int lds_byte(int r, int c) { const int st = (r >> 4) * 2 + (c >> 5), rr = r & 15, cc = c & 31, ob = rr * 64 + cc * 2; return st * 1024 + (ob ^ (((ob >> 9) & 1) << 5)); }
__host__ __device__ __forceinline__ void stage_rc(int b, int& R, int& C) { const int st = b / 1024, sb = b % 1024, swz = sb ^ (((sb >> 9) & 1) << 5); R = (st >> 1) * 16 + swz / 64; C = (st & 1) * 32 + (swz % 64) / 2; }
__host__ __device__ __forceinline__ int perm32(int rho) { const int n = rho >> 4, i = rho & 15; return 8 * (i >> 2) + 4 * n + (i & 3); }

struct Unit { int pm, pn; };
struct Gemm { const bf16_t* A; const bf16_t* Bt; int M, N, K; };

struct StaticOrder {
    int nM, nN, nwg, G, c;
    __host__ __device__ void init(int M, int N, int G_, int c_) { nM = M / BM; nN = N / BM; nwg = nM * nN; G = G_; c = c_; }
    __host__ __device__ bool next(int i, Unit& u) const {
        const long L = (long)i * G + c; if (L >= nwg) return false;
        int wgid = (int)L; { const int q = nwg / NXCD, r = nwg % NXCD, xcd = wgid % NXCD, off = wgid / NXCD; wgid = (xcd < r ? xcd * (q + 1) : r * (q + 1) + (xcd - r) * q) + off; }
        const int nig = WGM * nN, gid = wgid / nig, fm = gid * WGM, gsz = (nM - fm) < WGM ? (nM - fm) : WGM;
        u.pm = fm + ((wgid % nig) % gsz); u.pn = (wgid % nig) / gsz; return true;
    }
    __device__ __forceinline__ void a_ready(const Unit&) const {}
    __device__ __forceinline__ void done(const Unit&) const {}
};

typedef float f32x2_ __attribute__((ext_vector_type(2))); typedef __bf16 bf16x2_ __attribute__((ext_vector_type(2)));
__device__ __forceinline__ unsigned cvt_pk_bf16(float lo, float hi) { const f32x2_ v = {lo, hi}; return __builtin_bit_cast(unsigned, __builtin_convertvector(v, bf16x2_)); }
typedef float f32x2 __attribute__((ext_vector_type(2)));
typedef unsigned u32x2 __attribute__((ext_vector_type(2)));
__device__ __forceinline__ float row_scale(const float* rs, int row) {
    const f32x4* p = (const f32x4*)(rs + (size_t)row * 16);
    const f32x4 a = p[0], b = p[1], c = p[2], d = p[3];
    const float s = ((a[0] + a[1]) + (a[2] + a[3])) + ((b[0] + b[1]) + (b[2] + b[3])) + ((c[0] + c[1]) + (c[2] + c[3])) + ((d[0] + d[1]) + (d[2] + d[3]));
    return rsqrtf(s * (1.0f / 1024.0f) + 1e-6f);
}
__device__ __forceinline__ float sigm(float x) { return __builtin_amdgcn_rcpf(1.0f + __expf(-x)); }
struct EpiSwiglu {
    static constexpr bool PERM = true, AFTER_DRAIN = false;
    bf16_t* O; int ldc; const float* rs;
    __device__ __forceinline__ void operator()(const f32x4 (&acc)[2][2][4][2], const Unit& u, int wr, int wc, int fr_, int fq_) const {
        unsigned on_ = ~0u; asm volatile("" : "+s"(on_)); const int ln_ = (int)__builtin_amdgcn_mbcnt_hi(on_, __builtin_amdgcn_mbcnt_lo(on_, 0u)), fr = ln_ & 15, fq = ln_ >> 4; (void)fr_; (void)fq_;
        const int row0 = u.pm * BM + wr * 64 + fr, col0 = u.pn * HALF + wc * 32 + 8 * fq;
#pragma unroll
        for (int ai = 0; ai < 2; ++ai)
#pragma unroll
            for (int m = 0; m < 4; ++m) { const int row = row0 + ai * HALF + m * 16; const float s = row_scale(rs, row);
                float o[8];
#pragma unroll
                for (int n = 0; n < 2; ++n)
#pragma unroll
                    for (int i = 0; i < 4; ++i) { const float g = acc[ai][0][m][n][i] * s, up = acc[ai][1][m][n][i] * s; o[n * 4 + i] = g * sigm(g) * up; }
                u32x4 w; w.x = cvt_pk_bf16(o[0], o[1]); w.y = cvt_pk_bf16(o[2], o[3]); w.z = cvt_pk_bf16(o[4], o[5]); w.w = cvt_pk_bf16(o[6], o[7]);
                *(u32x4*)(O + (size_t)row * ldc + col0) = w; }
    }
};
struct EpiZ {
    static constexpr bool PERM = true, AFTER_DRAIN = false;
    bf16_t* Z; int ldz; const float* rs; float* R; int r_tile;
    __device__ __forceinline__ void operator()(const f32x4 (&acc)[2][2][4][2], const Unit& u, int wr, int wc, int fr_, int fq_) const {
        unsigned on_ = ~0u; asm volatile("" : "+s"(on_)); const int ln_ = (int)__builtin_amdgcn_mbcnt_hi(on_, __builtin_amdgcn_mbcnt_lo(on_, 0u)), fr = ln_ & 15, fq = ln_ >> 4; (void)fr_; (void)fq_;
        const int row0 = u.pm * BM + wr * 64 + fr, col0 = u.pn * BM + wc * 32 + 8 * fq;
        if (u.pn == r_tile) {
            if (wc == 0 && fq < 2) {
#pragma unroll
                for (int ai = 0; ai < 2; ++ai)
#pragma unroll
                    for (int m = 0; m < 4; ++m) { const int row = row0 + ai * HALF + m * 16; const float s = row_scale(rs, row);
#pragma unroll
                        for (int n = 0; n < 2; ++n) *(f32x4*)(R + (size_t)row * 16 + 8 * fq + 4 * n) = acc[ai][0][m][n] * s; }
            }
            return;
        }
#pragma unroll
        for (int ai = 0; ai < 2; ++ai)
#pragma unroll
            for (int m = 0; m < 4; ++m) { const int row = row0 + ai * HALF + m * 16; const float s = row_scale(rs, row);
#pragma unroll
                for (int bj = 0; bj < 2; ++bj) { const f32x4 v0 = acc[ai][bj][m][0] * s, v1 = acc[ai][bj][m][1] * s;
                    u32x4 w; w.x = cvt_pk_bf16(v0[0], v0[1]); w.y = cvt_pk_bf16(v0[2], v0[3]); w.z = cvt_pk_bf16(v1[0], v1[1]); w.w = cvt_pk_bf16(v1[2], v1[3]);
                    *(u32x4*)(Z + (size_t)row * ldz + col0 + bj * HALF) = w; } }
    }
};
struct EpiResid {
    static constexpr bool PERM = false, AFTER_DRAIN = false;
    float* h; bf16_t* hb; float* rs_out; float alpha;
    __device__ __forceinline__ void operator()(const f32x4 (&acc)[2][2][4][2], const Unit& u, int wr, int wc, int fr_, int fq_) const {
        unsigned on_ = ~0u; asm volatile("" : "+s"(on_)); const int ln_ = (int)__builtin_amdgcn_mbcnt_hi(on_, __builtin_amdgcn_mbcnt_lo(on_, 0u)), fr = ln_ & 15, fq = ln_ >> 4; (void)fr_; (void)fq_;
        const int row0 = u.pm * BM + wr * 64 + fr, col0 = u.pn * BM + wc * 32 + 4 * fq;
#pragma unroll
        for (int ai = 0; ai < 2; ++ai)
#pragma unroll
            for (int m = 0; m < 4; ++m) { const int row = row0 + ai * HALF + m * 16; float ss = 0.f;
#pragma unroll
                for (int bj = 0; bj < 2; ++bj)
#pragma unroll
                    for (int n = 0; n < 2; ++n) { const size_t off = (size_t)row * 1024 + col0 + bj * HALF + n * 16;
                        const f32x4 o = *(const f32x4*)(h + off) + acc[ai][bj][m][n] * alpha; *(f32x4*)(h + off) = o;
                        ss += (o[0] * o[0] + o[1] * o[1]) + (o[2] * o[2] + o[3] * o[3]);
                        u32x2 w; w.x = cvt_pk_bf16(o[0], o[1]); w.y = cvt_pk_bf16(o[2], o[3]); *(u32x2*)(hb + off) = w; }
                ss += __shfl_xor(ss, 16); ss += __shfl_xor(ss, 32);
                if (fq == 0) rs_out[(size_t)row * 16 + u.pn * 4 + wc] = ss; }
    }
};
struct EpiStoreF32 {
    static constexpr bool PERM = false, AFTER_DRAIN = false;
    float* O;
    __device__ __forceinline__ void operator()(const f32x4 (&acc)[2][2][4][2], const Unit& u, int wr, int wc, int fr_, int fq_) const {
        unsigned on_ = ~0u; asm volatile("" : "+s"(on_)); const int ln_ = (int)__builtin_amdgcn_mbcnt_hi(on_, __builtin_amdgcn_mbcnt_lo(on_, 0u)), fr = ln_ & 15, fq = ln_ >> 4; (void)fr_; (void)fq_;
        const int row0 = u.pm * BM + wr * 64 + fr, col0 = u.pn * BM + wc * 32 + 4 * fq;
#pragma unroll
        for (int ai = 0; ai < 2; ++ai)
#pragma unroll
            for (int m = 0; m < 4; ++m)
#pragma unroll
                for (int bj = 0; bj < 2; ++bj)
#pragma unroll
                    for (int n = 0; n < 2; ++n) *(f32x4*)(O + (size_t)(row0 + ai * HALF + m * 16) * 1024 + col0 + bj * HALF + n * 16) = acc[ai][bj][m][n];
    }
};
struct EpiPle {
    static constexpr bool PERM = false, AFTER_DRAIN = false;
    float* h; bf16_t* hb; const float* rs_in; float* rs_out; const float* pp;
    __device__ __forceinline__ void operator()(const f32x4 (&acc)[2][2][4][2], const Unit& u, int wr, int wc, int fr_, int fq_) const {
        unsigned on_ = ~0u; asm volatile("" : "+s"(on_)); const int ln_ = (int)__builtin_amdgcn_mbcnt_hi(on_, __builtin_amdgcn_mbcnt_lo(on_, 0u)), fr = ln_ & 15, fq = ln_ >> 4; (void)fr_; (void)fq_;
        const int row0 = u.pm * BM + wr * 64 + fr, col0 = u.pn * BM + wc * 32 + 4 * fq;
#pragma unroll
        for (int ai = 0; ai < 2; ++ai)
#pragma unroll
            for (int m = 0; m < 4; ++m) { const int row = row0 + ai * HALF + m * 16; const float s = row_scale(rs_in, row); float ss = 0.f;
#pragma unroll
                for (int bj = 0; bj < 2; ++bj)
#pragma unroll
                    for (int n = 0; n < 2; ++n) { const size_t off = (size_t)row * 1024 + col0 + bj * HALF + n * 16;
                        const f32x4 a = acc[ai][bj][m][n] * s, p = *(const f32x4*)(pp + off); f32x4 o = *(const f32x4*)(h + off);
                        o[0] += sigm(a[0]) * p[0]; o[1] += sigm(a[1]) * p[1]; o[2] += sigm(a[2]) * p[2]; o[3] += sigm(a[3]) * p[3];
                        *(f32x4*)(h + off) = o; ss += (o[0] * o[0] + o[1] * o[1]) + (o[2] * o[2] + o[3] * o[3]);
                        u32x2 w; w.x = cvt_pk_bf16(o[0], o[1]); w.y = cvt_pk_bf16(o[2], o[3]); *(u32x2*)(hb + off) = w; }
                ss += __shfl_xor(ss, 16); ss += __shfl_xor(ss, 32);
                if (fq == 0) rs_out[(size_t)row * 16 + u.pn * 4 + wc] = ss; }
    }
};
template <class Epi, class Sched, bool ALIGN_EPI = false, bool SP2 = false>
__device__ __forceinline__ void gemm_phase(PG8_LAS unsigned char* lds, const Gemm g, const Sched& S, const Epi& E, const int tid) {
    const int wid = __builtin_amdgcn_readfirstlane(tid >> 6), lane = tid & 63, wr = wid >> 2, wc = wid & 3, fr = lane & 15, fq = lane >> 4;
    const int K = g.K, nt = K / BK;
    unsigned voffA[2], voffB[2];
#pragma unroll
    for (int i = 0; i < 2; ++i) { int R, C; stage_rc(tid * 16 + i * 8192, R, C); const int Rb = Epi::PERM ? ((R & ~31) + perm32(R & 31)) : R;
        voffA[i] = (unsigned)(R * K + C) * 2u; voffB[i] = (unsigned)(Rb * K + C) * 2u; }
    const size_t kstep = (size_t)(BK * 2);
    const size_t hstep = (size_t)HALF * K * 2;
    const size_t tstep = 2 * hstep;
    const unsigned ldsw = (unsigned)wid * 1024u;
    const int aoff = lds_byte(wr * 64 + fr, fq * 8), boff = lds_byte(wc * 32 + fr, fq * 8);
#define PG8_SA(b, h) (((b) * 2 + (h)) * HTB)
#define PG8_SB(b, h) ((4 + (b) * 2 + (h)) * HTB)
#define PG8_STAGE(bufoff, gbase, voff) do { _Pragma("unroll") for (int _i = 0; _i < 2; ++_i) \
        __builtin_amdgcn_global_load_lds((const unsigned*)((const char*)(gbase) + (voff)[_i]), (PG8_LAS unsigned*)(lds + (bufoff) + ldsw + _i * 8192), 16, 0, 0); } while (0)
#define PG8_LDA(dst, b, h) do { _Pragma("unroll") for (int m = 0; m < 4; ++m) _Pragma("unroll") for (int k = 0; k < 2; ++k) dst[m][k] = *(const PG8_LAS bf16x8*)(lds + PG8_SA(b, h) + aoff + m * 2048 + k * 1024); } while (0)
#define PG8_LDB(dst, b, h) do { _Pragma("unroll") for (int n = 0; n < 2; ++n) _Pragma("unroll") for (int k = 0; k < 2; ++k) dst[n][k] = *(const PG8_LAS bf16x8*)(lds + PG8_SB(b, h) + boff + n * 2048 + k * 1024); } while (0)
#define PG8_MMA(ai, bj, At, Bt) do { __builtin_amdgcn_s_setprio(1); _Pragma("unroll") for (int m = 0; m < 4; ++m) _Pragma("unroll") for (int n = 0; n < 2; ++n) _Pragma("unroll") for (int k = 0; k < 2; ++k) \
        acc[ai][bj][m][n] = __builtin_amdgcn_mfma_f32_16x16x32_bf16(Bt[n][k], At[m][k], acc[ai][bj][m][n], 0, 0, 0); __builtin_amdgcn_s_setprio(0); } while (0)
#define PG8_WAIT_V(n) asm volatile("s_waitcnt vmcnt(" #n ")" ::: "memory")
#define PG8_WAIT_L(n) asm volatile("s_waitcnt lgkmcnt(" #n ")" ::: "memory")
#define PG8_BAR __builtin_amdgcn_s_barrier()
#define PG8_SCHED __builtin_amdgcn_sched_barrier(0)
    Unit cur, nxt; int ui = 0;
    if (!S.next(0, cur)) return;
    f32x4 acc[2][2][4][2];
#pragma unroll
    for (int a = 0; a < 2; ++a)
#pragma unroll
        for (int b = 0; b < 2; ++b)
#pragma unroll
            for (int m = 0; m < 4; ++m)
#pragma unroll
                for (int n = 0; n < 2; ++n) acc[a][b][m][n] = (f32x4){0.f, 0.f, 0.f, 0.f};
    bf16x8 At[4][2], B0[2][2], B1[2][2];
    const char* cA = (const char*)g.A + (size_t)cur.pm * tstep; const char* cB = (const char*)g.Bt + (size_t)cur.pn * tstep;
    S.a_ready(cur);
    if constexpr (SP2) {
        PG8_STAGE(PG8_SB(0, 0), cB, voffB); PG8_STAGE(PG8_SB(0, 1), cB + hstep, voffB); PG8_STAGE(PG8_SA(0, 0), cA, voffA); PG8_STAGE(PG8_SA(0, 1), cA + hstep, voffA);
        if (wr == 1) PG8_BAR;
        PG8_WAIT_V(2); PG8_BAR;
        PG8_STAGE(PG8_SB(1, 0), cB + kstep, voffB); PG8_STAGE(PG8_SA(1, 0), cA + kstep, voffA); PG8_STAGE(PG8_SB(1, 1), cB + hstep + kstep, voffB);
        PG8_WAIT_V(6); PG8_BAR;
    } else {
        PG8_STAGE(PG8_SB(0, 0), cB, voffB); PG8_STAGE(PG8_SA(0, 0), cA, voffA); PG8_STAGE(PG8_SB(0, 1), cB + hstep, voffB); PG8_STAGE(PG8_SA(0, 1), cA + hstep, voffA);
        if (wr == 1) PG8_BAR;
        PG8_WAIT_V(4); PG8_BAR;
        PG8_STAGE(PG8_SB(1, 0), cB + kstep, voffB); PG8_STAGE(PG8_SA(1, 0), cA + kstep, voffA); PG8_STAGE(PG8_SB(1, 1), cB + hstep + kstep, voffB);
        PG8_WAIT_V(6); PG8_BAR;
    }
    for (;;) {
        const bool has_next = S.next(ui + 1, nxt);
        const char* nA = has_next ? (const char*)g.A + (size_t)nxt.pm * tstep : cA; const char* nB = has_next ? (const char*)g.Bt + (size_t)nxt.pn * tstep : cB;
        for (int t = 0; t < nt; t += 2) {
            const bool last = (t == nt - 2);
            const char* a1 = cA + (size_t)(t + 1) * kstep;
            const char* a2 = last ? nA : cA + (size_t)(t + 2) * kstep; const char* b2 = last ? nB : cB + (size_t)(t + 2) * kstep;
            const char* a3 = a2 + kstep; const char* b3 = b2 + kstep;
            if (last && has_next) S.a_ready(nxt);
            if constexpr (SP2) {
            PG8_LDB(B0, 0, 0); PG8_LDB(B1, 0, 1); PG8_SCHED; PG8_LDA(At, 0, 0); PG8_STAGE(PG8_SA(1, 1), a1 + hstep, voffA);
            PG8_WAIT_V(8); PG8_WAIT_L(0); PG8_BAR; PG8_MMA(0, 0, At, B0); PG8_MMA(0, 1, At, B1); PG8_BAR; PG8_SCHED;
            PG8_LDA(At, 0, 1); PG8_STAGE(PG8_SB(0, 0), b2, voffB); PG8_STAGE(PG8_SB(0, 1), b2 + hstep, voffB); PG8_STAGE(PG8_SA(0, 0), a2, voffA);
            PG8_WAIT_V(8); PG8_WAIT_L(0); PG8_BAR; PG8_MMA(1, 0, At, B0); PG8_MMA(1, 1, At, B1); PG8_BAR; PG8_SCHED;
            PG8_LDB(B0, 1, 0); PG8_LDB(B1, 1, 1); PG8_SCHED; PG8_LDA(At, 1, 0); PG8_STAGE(PG8_SA(0, 1), a2 + hstep, voffA);
            PG8_WAIT_V(8); PG8_WAIT_L(0); PG8_BAR; PG8_MMA(0, 0, At, B0); PG8_MMA(0, 1, At, B1); PG8_BAR; PG8_SCHED;
            PG8_LDA(At, 1, 1); PG8_STAGE(PG8_SB(1, 0), b3, voffB); PG8_STAGE(PG8_SB(1, 1), b3 + hstep, voffB); PG8_STAGE(PG8_SA(1, 0), a3, voffA);
            PG8_WAIT_V(8); PG8_WAIT_L(0); PG8_BAR; PG8_MMA(1, 0, At, B0); PG8_MMA(1, 1, At, B1); PG8_BAR; PG8_SCHED;
            } else {
            PG8_LDB(B0, 0, 0); PG8_SCHED; PG8_LDA(At, 0, 0); PG8_STAGE(PG8_SA(1, 1), a1 + hstep, voffA);
            PG8_WAIT_L(8); PG8_BAR; PG8_WAIT_L(0); PG8_MMA(0, 0, At, B0); PG8_BAR; PG8_SCHED;
            PG8_LDB(B1, 0, 1); PG8_STAGE(PG8_SB(0, 0), b2, voffB);
            PG8_BAR; PG8_WAIT_L(0); PG8_MMA(0, 1, At, B1); PG8_BAR;
            PG8_LDA(At, 0, 1); PG8_STAGE(PG8_SA(0, 0), a2, voffA);
            PG8_BAR; PG8_WAIT_L(0); PG8_MMA(1, 0, At, B0); PG8_BAR; PG8_SCHED;
            PG8_STAGE(PG8_SB(0, 1), b2 + hstep, voffB);
            PG8_WAIT_V(6); PG8_BAR; PG8_MMA(1, 1, At, B1); PG8_BAR;
            PG8_LDB(B0, 1, 0); PG8_SCHED; PG8_LDA(At, 1, 0); PG8_STAGE(PG8_SA(0, 1), a2 + hstep, voffA);
            PG8_WAIT_L(8); PG8_BAR; PG8_WAIT_L(0); PG8_MMA(0, 0, At, B0); PG8_BAR; PG8_SCHED;
            PG8_LDB(B1, 1, 1); PG8_STAGE(PG8_SB(1, 0), b3, voffB);
            PG8_BAR; PG8_WAIT_L(0); PG8_MMA(0, 1, At, B1); PG8_BAR;
            PG8_LDA(At, 1, 1); PG8_STAGE(PG8_SA(1, 0), a3, voffA);
            PG8_BAR; PG8_WAIT_L(0); PG8_MMA(1, 0, At, B0); PG8_BAR; PG8_SCHED;
            PG8_STAGE(PG8_SB(1, 1), b3 + hstep, voffB);
            PG8_WAIT_V(6); PG8_BAR; PG8_MMA(1, 1, At, B1); PG8_BAR;
            }
        }
        if constexpr (ALIGN_EPI) { if (wr == 0) PG8_BAR; }
        if constexpr (!Epi::AFTER_DRAIN) { E(acc, cur, wr, wc, fr, fq); S.done(cur); }
        if (!has_next) break;
#pragma unroll
        for (int a = 0; a < 2; ++a)
#pragma unroll
            for (int b = 0; b < 2; ++b)
#pragma unroll
                for (int m = 0; m < 4; ++m)
#pragma unroll
                    for (int n = 0; n < 2; ++n) acc[a][b][m][n] = (f32x4){0.f, 0.f, 0.f, 0.f};
        cur = nxt; cA = nA; cB = nB; ++ui;
        if constexpr (ALIGN_EPI) { if (wr == 1) PG8_BAR; }
    }
    PG8_WAIT_V(0);
    if constexpr (!ALIGN_EPI) { if (wr == 0) PG8_BAR; }
    PG8_BAR;
    if constexpr (Epi::AFTER_DRAIN) { E.fused(acc, cur, wr, wc, fr, fq, lds, wid, lane); S.done(cur); }
#undef PG8_SA
#undef PG8_SB
#undef PG8_STAGE
#undef PG8_LDA
#undef PG8_LDB
#undef PG8_MMA
#undef PG8_WAIT_V
#undef PG8_WAIT_L
#undef PG8_BAR
#undef PG8_SCHED
}
}
#include <hip/hip_cooperative_groups.h>
namespace cg = cooperative_groups;
#define LAS __attribute__((address_space(3)))
typedef unsigned short bf16;
typedef float f32x4 __attribute__((ext_vector_type(4)));
typedef short bf16x8 __attribute__((ext_vector_type(8)));
typedef unsigned v4u __attribute__((ext_vector_type(4)));
typedef unsigned v2u __attribute__((ext_vector_type(2)));
constexpr int D = 1024, NPR = 16384, NSM = 512, M = NPR + NSM, SEQ = 2048, NB = 8, DB = 128, FF = 2816, PLE = 256, NCH = 32;
constexpr int NWAVES = 8, LDS_BYTES = 147456, NPH = 22;
constexpr size_t WGU_SZ = (size_t)5632 * 1024 * 2, WDN_SZ = (size_t)1024 * 2816 * 2, WSQ_SZ = (size_t)1024 * 1024 * 2, WPP_SZ = (size_t)1024 * 256 * 2;
constexpr size_t OFF_WGU = 0, OFF_WDN = OFF_WGU + 4 * WGU_SZ, OFF_WGIN = OFF_WDN + 4 * WDN_SZ, OFF_WHIN = OFF_WGIN + (size_t)3328 * 1024 * 2,
    OFF_WOUT = OFF_WHIN + (size_t)4096 * 1024 * 2, OFF_WPG = OFF_WOUT + 2 * WSQ_SZ, OFF_WPP = OFF_WPG + 2 * WSQ_SZ, OFF_HB = OFF_WPP + 2 * WPP_SZ;
constexpr size_t HB_SZ = (size_t)M * 1024 * 2;
constexpr size_t OFF_BIG = OFF_HB + 2 * HB_SZ, OFF_PB = OFF_BIG + (size_t)M * 4096 * 2, PB_SZ = (size_t)M * 256 * 2, OFF_AB = OFF_PB + 2 * PB_SZ,
    OFF_DB = OFF_AB + (size_t)2048 * 4096 * 2, OFF_RS = OFF_DB + (size_t)2048 * 128 * 4, RS_SZ = (size_t)M * 16 * 4, OFF_R = OFF_RS + 2 * RS_SZ, OFF_PSB = OFF_R + RS_SZ, WS_END = OFF_PSB + (size_t)67108864, OFF_CTL = WS_END, CTL_BYTES = 16384, WS_TOTAL = OFF_CTL + CTL_BYTES;
constexpr size_t OUT_YS = (size_t)NPR * D, OUT_GP = (size_t)M * D, OUT_GS = OUT_GP + 1048576, OUT_HP = OUT_GS + 16777216, OUT_HS = OUT_HP + 1048576, OUT_END = OUT_HS + 16777216;

__device__ __forceinline__ float bf2f(unsigned short u) { return __uint_as_float((unsigned)u << 16); }
__device__ __forceinline__ float bflo(unsigned u) { return __uint_as_float(u << 16); }
__device__ __forceinline__ float bfhi(unsigned u) { return __uint_as_float(u & 0xffff0000u); }
__device__ __forceinline__ unsigned pk2(float lo, float hi) { return pg8::cvt_pk_bf16(lo, hi); }
__device__ __forceinline__ float sigm(float x) { return __builtin_amdgcn_rcpf(1.0f + __expf(-x)); }
__device__ __forceinline__ float logsig(float x) { return fminf(x, 0.f) - __logf(1.0f + __expf(-fabsf(x))); }
__device__ __forceinline__ float wave_sum(float v) {
#pragma unroll
    for (int o = 1; o < 64; o <<= 1) v += __shfl_xor(v, o);
    return v;
}
#define LDS_WAIT() asm volatile("s_waitcnt lgkmcnt(0)" ::: "memory")

__device__ __forceinline__ void tr_item(const float* W, int Nsrc, int K, bf16* WT, const float* sk, int item, int nblk, int mode, int nvalid, LAS float* scr, int lane) {
    const int kb = item / nblk, nb = item % nblk, k0 = 64 * kb, n0 = 32 * nb;
    int src0 = n0, valid = 32;
    if (mode == 1) { const int pn = n0 >> 8, within = n0 & 255, half = within >> 7, j = within & 127; src0 = half * FF + 128 * pn + j; }
    if (mode == 2) { valid = nvalid - n0; valid = valid < 0 ? 0 : (valid > 32 ? 32 : valid); }
    const int c = lane & 31;
    const float* wp = W + (size_t)(k0 + (lane >> 5)) * Nsrc + src0 + c;
#pragma unroll
    for (int i0 = 0; i0 < 32; i0 += 16) {
        float v[16];
#pragma unroll
        for (int i = 0; i < 16; ++i) v[i] = (c < valid) ? wp[(size_t)(2 * (i0 + i)) * Nsrc] : 0.f;
        __builtin_amdgcn_sched_barrier(0);
#pragma unroll
        for (int i = 0; i < 16; ++i) { const int kk = 2 * (i0 + i) + (lane >> 5); scr[kk * 33 + c] = sk ? v[i] * sk[k0 + kk] : v[i]; }
    }
    LDS_WAIT();
    const int ch = lane & 7;
#pragma unroll
    for (int j = 0; j < 4; ++j) { const int n = (lane >> 3) + 8 * j; const LAS float* s = scr + (8 * ch) * 33 + n;
        v4u o; o.x = pk2(s[0 * 33], s[1 * 33]); o.y = pk2(s[2 * 33], s[3 * 33]); o.z = pk2(s[4 * 33], s[5 * 33]); o.w = pk2(s[6 * 33], s[7 * 33]);
        *(v4u*)(WT + (size_t)(n0 + n) * K + k0 + 8 * ch) = o; }
    LDS_WAIT();
}
struct Args { const float* in[26]; float* out; unsigned char* ws; int ph_lo, ph_hi; };
typedef const Args __attribute__((address_space(4))) CArgs;

__device__ __forceinline__ void prologue(CArgs* a, unsigned char* ws, float* outp, LAS unsigned char* lds, int tid, int bid, int G) {
    const int lane = tid & 63, wave = tid >> 6;
    LAS float* scr = (LAS float*)(lds + wave * 16384);
    const int gw = bid * NWAVES + wave, NGW = G * NWAVES;
    constexpr int I_GU = 16 * 176, I_DN = 44 * 32, I_GIN = 16 * 104, I_HIN = 16 * 128, I_SQ = 16 * 32, I_PP = 4 * 32;
    constexpr int NITEMS = 4 * I_GU + 4 * I_DN + I_GIN + I_HIN + 4 * I_SQ + 2 * I_PP;
    for (int it = gw; it < NITEMS; it += NGW) {
        int r = it;
        if (r < 4 * I_GU) { const int q = r / I_GU, li = q >> 1, f = q & 1; r -= q * I_GU;
            tr_item((f ? a->in[20] : a->in[7]) + (size_t)li * 1024 * 5632, 5632, 1024, (bf16*)(ws + OFF_WGU + q * WGU_SZ), (f ? a->in[19] : a->in[6]) + li * 1024, r, 176, 1, 0, scr, lane); continue; }
        r -= 4 * I_GU;
        if (r < 4 * I_DN) { const int q = r / I_DN, li = q >> 1, f = q & 1; r -= q * I_DN;
            tr_item((f ? a->in[21] : a->in[8]) + (size_t)li * 2816 * 1024, 1024, 2816, (bf16*)(ws + OFF_WDN + q * WDN_SZ), nullptr, r, 32, 0, 0, scr, lane); continue; }
        r -= 4 * I_DN;
        if (r < I_GIN) { tr_item(a->in[10], 3088, 1024, (bf16*)(ws + OFF_WGIN), a->in[9], r, 104, 2, 3088, scr, lane); continue; }
        r -= I_GIN;
        if (r < I_HIN) { tr_item(a->in[15], 4096, 1024, (bf16*)(ws + OFF_WHIN), a->in[9] + 1024, r, 128, 0, 0, scr, lane); continue; }
        r -= I_HIN;
        if (r < I_SQ) { tr_item(a->in[14], 1024, 1024, (bf16*)(ws + OFF_WOUT), nullptr, r, 32, 0, 0, scr, lane); continue; }
        r -= I_SQ;
        if (r < I_SQ) { tr_item(a->in[17], 1024, 1024, (bf16*)(ws + OFF_WOUT + WSQ_SZ), nullptr, r, 32, 0, 0, scr, lane); continue; }
        r -= I_SQ;
        if (r < 2 * I_SQ) { const int li = r / I_SQ; r -= li * I_SQ;
            tr_item(a->in[23] + (size_t)li * 1024 * 1024, 1024, 1024, (bf16*)(ws + OFF_WPG + li * WSQ_SZ), a->in[22] + li * 1024, r, 32, 0, 0, scr, lane); continue; }
        r -= 2 * I_SQ;
        { const int li = r / I_PP; r -= li * I_PP;
            tr_item(a->in[24] + (size_t)li * 256 * 1024, 1024, 256, (bf16*)(ws + OFF_WPP + li * WPP_SZ), nullptr, r, 32, 0, 0, scr, lane); }
    }
    bf16* hb = (bf16*)(ws + OFF_HB); float* rs = (float*)(ws + OFF_RS);
    for (int m = gw; m < M; m += NGW) {
        const float* xr = m < NPR ? a->in[0] + (size_t)m * D : a->in[1] + (size_t)(m - NPR) * D;
        float ss = 0.f;
#pragma unroll
        for (int j = 0; j < 4; ++j) { const f32x4 v = *((const f32x4*)xr + lane + 64 * j); ss += (v[0] * v[0] + v[1] * v[1]) + (v[2] * v[2] + v[3] * v[3]);
            *((f32x4*)(outp + (size_t)m * D) + lane + 64 * j) = v; v2u w; w.x = pk2(v[0], v[1]); w.y = pk2(v[2], v[3]); *((v2u*)(hb + (size_t)m * D) + lane + 64 * j) = w; }
        ss = wave_sum(ss);
        if (lane < 16) rs[(size_t)m * 16 + lane] = lane == 0 ? ss : 0.f;
    }
    const int gt = bid * (NWAVES * 64) + tid, NGT = G * NWAVES * 64;
    for (int e = gt; e < 2 * M * 32; e += NGT) { const int li = e / (M * 32), rem = e % (M * 32), m = rem >> 5, c8 = (rem & 31) * 8;
        const float* src = m < NPR ? a->in[4] + ((size_t)li * NPR + m) * 256 + c8 : a->in[5] + ((size_t)li * NSM + (m - NPR)) * 256 + c8;
        const f32x4 v0 = *(const f32x4*)src, v1 = *(const f32x4*)(src + 4);
        v4u w; w.x = pk2(v0[0], v0[1]); w.y = pk2(v0[2], v0[3]); w.z = pk2(v1[0], v1[1]); w.w = pk2(v1[2], v1[3]);
        *(v4u*)((bf16*)(ws + OFF_PB + li * PB_SZ) + (size_t)m * 256 + c8) = w; }
}
template <bool HG> struct MX {
    static constexpr int H = HG ? 8 : 4, DV = HG ? 128 : 256, LDZ = HG ? 4096 : 3328, KC = HG ? 1024 : 512, VC = HG ? 2048 : 1024, GC = HG ? 3072 : 2048, VR = DV / 64, NVG = DV / 16, NVR = DV / 64;
    static constexpr float scale = HG ? 1.0f : 0.08838834764831845f;
};
template <bool HG> __device__ __forceinline__ void prep_phase(LAS unsigned char* lds, bf16* Z, const float* R, const float* wup, const float* bgk, const float* lowb, bf16* AB, float* DBUF, bf16* PB, int tid, int bid, int G) {
    typedef MX<HG> C; constexpr int H = C::H, DV = C::DV, LDZ = C::LDZ, KC = C::KC, VC = C::VC, VR = C::VR, QP = 136, TP = 72, NG = DV / 128, NGV = DV / 16;
    LAS float* gl = (LAS float*)lds; LAS float* segs = (LAS float*)(lds + 32768);
    LAS bf16* qe_s = (LAS bf16*)(lds + 34816); LAS bf16* kn_s = (LAS bf16*)(lds + 52224); LAS bf16* kdT_s = (LAS bf16*)(lds + 69632); LAS bf16* vT_s = (LAS bf16*)(lds + 88064);
    const int t = tid >> 3, cs = tid & 7, j0 = cs * 16, lane = tid & 63, w = tid >> 6;
    for (int unit = bid; unit < NB * H * NCH; unit += G) {
        const int n = unit % NCH, bh = unit / NCH, h = bh % H, b = bh / H;
        const size_t tok0 = (size_t)b * SEQ + 64 * n, m = tok0 + t;
        __syncthreads();
        float lbc[16];
        {
            float g[16];
            if constexpr (!HG) {
                f32x4 r4[4];
#pragma unroll
                for (int i = 0; i < 4; ++i) r4[i] = *(const f32x4*)(R + m * 16 + 4 * i);
#pragma unroll
                for (int q = 0; q < 4; ++q) { const f32x4 bv = *(const f32x4*)(bgk + h * 128 + j0 + 4 * q); g[4 * q] = bv[0]; g[4 * q + 1] = bv[1]; g[4 * q + 2] = bv[2]; g[4 * q + 3] = bv[3]; }
#pragma unroll
                for (int i = 0; i < 16; ++i) { const float ri = r4[i >> 2][i & 3]; const float* wp = wup + i * 512 + h * 128 + j0;
#pragma unroll
                    for (int q = 0; q < 4; ++q) { const f32x4 wv = *(const f32x4*)(wp + 4 * q); g[4 * q] += ri * wv[0]; g[4 * q + 1] += ri * wv[1]; g[4 * q + 2] += ri * wv[2]; g[4 * q + 3] += ri * wv[3]; } }
#pragma unroll
                for (int jj = 0; jj < 16; ++jj) { g[jj] = logsig(g[jj]) * (1.0f / 16.0f); lbc[jj] = 0.f; }
            } else {
                const v4u f0 = *(const v4u*)(Z + m * LDZ + KC + h * 128 + j0), f1 = *(const v4u*)(Z + m * LDZ + KC + h * 128 + j0 + 8);
                const unsigned fw[8] = {f0.x, f0.y, f0.z, f0.w, f1.x, f1.y, f1.z, f1.w};
#pragma unroll
                for (int jj = 0; jj < 16; ++jj) { const float f = (jj & 1) ? bfhi(fw[jj >> 1]) : bflo(fw[jj >> 1]);
                    const float x0 = lowb[h * 128 + j0 + jj], x1 = lowb[1024 + h * 128 + j0 + jj];
                    const float a = logsig(x1 - x0), b2 = logsig(x0 - x1) + logsig(f), mx = fmaxf(a, b2);
                    g[jj] = mx + __logf(1.0f + __expf(-fabsf(a - b2))); lbc[jj] = sigm(x0 - x1); }
            }
#pragma unroll
            for (int q = 0; q < 4; ++q) *(LAS f32x4*)(gl + t * 128 + j0 + 4 * q) = (f32x4){g[4 * q], g[4 * q + 1], g[4 * q + 2], g[4 * q + 3]};
        }
        __syncthreads();
        {
            const int j = tid & 127, sg = tid >> 7; float acc = 0.f;
#pragma unroll
            for (int i = 0; i < 16; ++i) { acc += gl[(16 * sg + i) * 128 + j]; gl[(16 * sg + i) * 128 + j] = acc; }
            segs[sg * 128 + j] = acc;
            __syncthreads();
            float off = 0.f;
            for (int s2 = 0; s2 < sg; ++s2) off += segs[s2 * 128 + j];
            if (sg) {
#pragma unroll
                for (int i = 0; i < 16; ++i) gl[(16 * sg + i) * 128 + j] += off; }
        }
        __syncthreads();
        {
            bf16* qp = Z + m * LDZ + h * 128 + j0; const bf16* kp = Z + m * LDZ + KC + h * 128 + j0;
            const v4u q0 = *(const v4u*)qp, q1 = *(const v4u*)(qp + 8), k0 = *(const v4u*)kp, k1 = *(const v4u*)(kp + 8);
            const unsigned qw[8] = {q0.x, q0.y, q0.z, q0.w, q1.x, q1.y, q1.z, q1.w}, kw[8] = {k0.x, k0.y, k0.z, k0.w, k1.x, k1.y, k1.z, k1.w};
            float bb[16], bl[16];
#pragma unroll
            for (int q = 0; q < 4; ++q) { const f32x4 x = *(const LAS f32x4*)(gl + t * 128 + j0 + 4 * q), y = *(const LAS f32x4*)(gl + 63 * 128 + j0 + 4 * q);
                bb[4 * q] = x[0]; bb[4 * q + 1] = x[1]; bb[4 * q + 2] = x[2]; bb[4 * q + 3] = x[3]; bl[4 * q] = y[0]; bl[4 * q + 1] = y[1]; bl[4 * q + 2] = y[2]; bl[4 * q + 3] = y[3]; }
            float qe[16], kn[16], kd[16];
#pragma unroll
            for (int jj = 0; jj < 16; ++jj) { float qv = (jj & 1) ? bfhi(qw[jj >> 1]) : bflo(qw[jj >> 1]); float kv = (jj & 1) ? bfhi(kw[jj >> 1]) : bflo(kw[jj >> 1]);
                if constexpr (HG) { qv = qv * sigm(qv); kv = lbc[jj] * sigm(-kv); }
                qe[jj] = qv * __expf(bb[jj]) * C::scale; kn[jj] = kv * __expf(-bb[jj]); kd[jj] = kv * __expf(bl[jj] - bb[jj]); }
            v4u o0, o1;
            o0.x = pk2(qe[0], qe[1]); o0.y = pk2(qe[2], qe[3]); o0.z = pk2(qe[4], qe[5]); o0.w = pk2(qe[6], qe[7]); o1.x = pk2(qe[8], qe[9]); o1.y = pk2(qe[10], qe[11]); o1.z = pk2(qe[12], qe[13]); o1.w = pk2(qe[14], qe[15]);
            *(v4u*)qp = o0; *(v4u*)(qp + 8) = o1; *(LAS v4u*)(qe_s + t * QP + j0) = o0; *(LAS v4u*)(qe_s + t * QP + j0 + 8) = o1;
            o0.x = pk2(kn[0], kn[1]); o0.y = pk2(kn[2], kn[3]); o0.z = pk2(kn[4], kn[5]); o0.w = pk2(kn[6], kn[7]); o1.x = pk2(kn[8], kn[9]); o1.y = pk2(kn[10], kn[11]); o1.z = pk2(kn[12], kn[13]); o1.w = pk2(kn[14], kn[15]);
            *(LAS v4u*)(kn_s + t * QP + j0) = o0; *(LAS v4u*)(kn_s + t * QP + j0 + 8) = o1;
#pragma unroll
            for (int jj = 0; jj < 16; jj += 2) { const unsigned pw = pk2(kd[jj], kd[jj + 1]); kdT_s[(j0 + jj) * TP + t] = (bf16)(pw & 0xffffu); kdT_s[(j0 + jj + 1) * TP + t] = (bf16)(pw >> 16); }
            if (t == 63) {
#pragma unroll
                for (int q = 0; q < 4; ++q) *(f32x4*)(DBUF + (size_t)unit * 128 + j0 + 4 * q) = (f32x4){__expf(bl[4 * q]), __expf(bl[4 * q + 1]), __expf(bl[4 * q + 2]), __expf(bl[4 * q + 3])}; }
            const bf16* vp = Z + m * LDZ + VC + h * DV + cs * (DV / 8);
#pragma unroll
            for (int q = 0; q < DV / 64; ++q) { const v4u x = *(const v4u*)(vp + 8 * q); const unsigned xw[4] = {x.x, x.y, x.z, x.w};
#pragma unroll
                for (int e = 0; e < 4; ++e) { const int v = cs * (DV / 8) + 8 * q + 2 * e; vT_s[v * TP + t] = (bf16)(xw[e] & 0xffffu); vT_s[(v + 1) * TP + t] = (bf16)(xw[e] >> 16); } }
        }
        __syncthreads();
        {
            const int r = lane & 15, quad = lane >> 4, tb = w >> 1;
#pragma unroll
            for (int e = 0; e < 2; ++e) { const int sb = 2 * (w & 1) + e; f32x4 c = {0.f, 0.f, 0.f, 0.f};
                if (sb <= tb) {
#pragma unroll
                    for (int ks = 0; ks < 4; ++ks) { const bf16x8 av = *(const LAS bf16x8*)(kn_s + (16 * sb + r) * QP + 32 * ks + 8 * quad), bv = *(const LAS bf16x8*)(qe_s + (16 * tb + r) * QP + 32 * ks + 8 * quad);
                        c = __builtin_amdgcn_mfma_f32_16x16x32_bf16(av, bv, c, 0, 0, 0); } }
                const int tc = 16 * tb + r, s0 = 16 * sb + 4 * quad;
                v2u o; o.x = pk2(s0 <= tc ? c[0] : 0.f, s0 + 1 <= tc ? c[1] : 0.f); o.y = pk2(s0 + 2 <= tc ? c[2] : 0.f, s0 + 3 <= tc ? c[3] : 0.f);
                *(v2u*)(AB + (size_t)unit * 4096 + tc * 64 + s0) = o; }
        }
        {
            const int r = lane & 15, quad = lane >> 4;
#pragma unroll
            for (int vg = 0; vg < NG; ++vg) { const int gv = w * NG + vg;
                const bf16x8 b0 = *(const LAS bf16x8*)(vT_s + (16 * gv + r) * TP + 8 * quad), b1 = *(const LAS bf16x8*)(vT_s + (16 * gv + r) * TP + 32 + 8 * quad);
#pragma unroll
                for (int kb = 0; kb < 8; ++kb) { const bf16x8 a0 = *(const LAS bf16x8*)(kdT_s + (16 * kb + r) * TP + 8 * quad), a1 = *(const LAS bf16x8*)(kdT_s + (16 * kb + r) * TP + 32 + 8 * quad);
                    f32x4 c = {0.f, 0.f, 0.f, 0.f}; c = __builtin_amdgcn_mfma_f32_16x16x32_bf16(a0, b0, c, 0, 0, 0); c = __builtin_amdgcn_mfma_f32_16x16x32_bf16(a1, b1, c, 0, 0, 0);
                    v2u o; o.x = pk2(c[0], c[1]); o.y = pk2(c[2], c[3]);
                    *(v2u*)(PB + (((size_t)unit * NGV + gv) * 4 + (kb >> 1)) * 512 + lane * 8 + (kb & 1) * 4) = o; } }
        }
        for (int c = tid; c < DV * 4; c += NWAVES * 64) { const int v = c >> 2, sq = c & 3;
            const v4u x0 = *(const LAS v4u*)(vT_s + v * TP + 16 * sq), x1 = *(const LAS v4u*)(vT_s + v * TP + 16 * sq + 8);
            bf16* dst = Z + (tok0 + v / VR) * LDZ + VC + h * DV + (v % VR) * 64 + 16 * sq;
            *(v4u*)dst = x0; *(v4u*)(dst + 8) = x1; }
    }
}
template <bool HG> __device__ __forceinline__ void state_phase(bf16* PSB, const float* DBUF, float* Sout, int gt, int ngt) {
    typedef MX<HG> C; constexpr int H = C::H, DV = C::DV, NGV = DV / 16, TOTAL = NB * H * NGV * 4 * 64;
    for (int idx = gt; idx < TOTAL; idx += ngt) {
        const int lane = idx & 63, ks = (idx >> 6) & 3, gvb = idx >> 8, gv = gvb % NGV, bh = gvb / NGV, quad = lane >> 4, r = lane & 15;
        f32x4 S0 = {0.f, 0.f, 0.f, 0.f}, S1 = {0.f, 0.f, 0.f, 0.f};
        bf16* pp = PSB + (((size_t)bh * NCH * NGV + gv) * 4 + ks) * 512 + lane * 8; const float* dp = DBUF + (size_t)bh * NCH * 128 + 32 * ks + 4 * quad;
        for (int n0 = 0; n0 < NCH; n0 += 8) {
            v4u p[8]; f32x4 d0[8], d1[8];
#pragma unroll
            for (int i = 0; i < 8; ++i) { p[i] = *(const v4u*)(pp + (size_t)(n0 + i) * NGV * 2048); d0[i] = *(const f32x4*)(dp + (n0 + i) * 128); d1[i] = *(const f32x4*)(dp + (n0 + i) * 128 + 16); }
            __builtin_amdgcn_sched_barrier(0);
#pragma unroll
            for (int i = 0; i < 8; ++i) { v4u o; o.x = pk2(S0[0], S0[1]); o.y = pk2(S0[2], S0[3]); o.z = pk2(S1[0], S1[1]); o.w = pk2(S1[2], S1[3]);
                *(v4u*)(pp + (size_t)(n0 + i) * NGV * 2048) = o;
                S0 = S0 * d0[i] + (f32x4){bflo(p[i].x), bfhi(p[i].x), bflo(p[i].y), bfhi(p[i].y)}; S1 = S1 * d1[i] + (f32x4){bflo(p[i].z), bfhi(p[i].z), bflo(p[i].w), bfhi(p[i].w)}; }
        }
        float* so = Sout + ((size_t)bh * 128 + 32 * ks + 4 * quad) * DV + 16 * gv + r;
#pragma unroll
        for (int j = 0; j < 4; ++j) { so[j * DV] = S0[j]; so[(16 + j) * DV] = S1[j]; }
    }
}
template <bool HG> __device__ __forceinline__ void out_phase(LAS unsigned char* lds, const bf16* Z, const bf16* AB, const bf16* PSB, bf16* OG, const float* gn, int tid, int w, int bid, int G) {
    typedef MX<HG> C; constexpr int H = C::H, DV = C::DV, LDZ = C::LDZ, VC = C::VC, GC = C::GC, VR = C::VR, VW = DV / 8, NG = VW / 16, NGV = DV / 16;
    const int lane = tid & 63, r = lane & 15, quad = lane >> 4, vbase = w * VW;
    f32x4 gnv[NG];
#pragma unroll
    for (int vg = 0; vg < NG; ++vg) gnv[vg] = *(const f32x4*)(gn + vbase + 16 * vg + 4 * quad);
    int par = 0;
    for (int unit = bid; unit < NB * H * NCH; unit += G, par ^= 1) {
        const int n = unit % NCH, bh = unit / NCH, h = bh % H, b = bh / H; const size_t tok0 = (size_t)b * SEQ + 64 * n;
        bf16x8 sb[NG][4], vb[NG][2], af[4][2]; v2u qlo[4][4], qhi[4][4], gq[NG][4];
#pragma unroll
        for (int vg = 0; vg < NG; ++vg) { const int gv = w * NG + vg, v = vbase + 16 * vg + r;
#pragma unroll
            for (int ks = 0; ks < 4; ++ks) sb[vg][ks] = *(const bf16x8*)(PSB + (((size_t)unit * NGV + gv) * 4 + ks) * 512 + lane * 8);
            const bf16* vtp = Z + (tok0 + v / VR) * LDZ + VC + h * DV + (v % VR) * 64 + 8 * quad; vb[vg][0] = *(const bf16x8*)vtp; vb[vg][1] = *(const bf16x8*)(vtp + 32); }
#pragma unroll
        for (int tb = 0; tb < 4; ++tb) { const bf16* zr = Z + (tok0 + 16 * tb + r) * LDZ; const bf16* qp = zr + h * 128 + 4 * quad;
#pragma unroll
            for (int ks = 0; ks < 4; ++ks) { qlo[tb][ks] = *(const v2u*)(qp + 32 * ks); qhi[tb][ks] = *(const v2u*)(qp + 32 * ks + 16); }
            const bf16* ap = AB + (size_t)unit * 4096 + (16 * tb + r) * 64 + 8 * quad; af[tb][0] = *(const bf16x8*)ap; af[tb][1] = *(const bf16x8*)(ap + 32);
#pragma unroll
            for (int vg = 0; vg < NG; ++vg) gq[vg][tb] = *(const v2u*)(zr + GC + h * DV + vbase + 16 * vg + 4 * quad); }
        __builtin_amdgcn_sched_barrier(0);
        f32x4 o[NG][4];
#pragma unroll
        for (int vg = 0; vg < NG; ++vg)
#pragma unroll
            for (int tb = 0; tb < 4; ++tb) o[vg][tb] = (f32x4){0.f, 0.f, 0.f, 0.f};
#pragma unroll
        for (int ks = 0; ks < 4; ++ks)
#pragma unroll
            for (int tb = 0; tb < 4; ++tb) { const bf16x8 qf = __builtin_bit_cast(bf16x8, ((v4u){qlo[tb][ks].x, qlo[tb][ks].y, qhi[tb][ks].x, qhi[tb][ks].y}));
#pragma unroll
                for (int vg = 0; vg < NG; ++vg) o[vg][tb] = __builtin_amdgcn_mfma_f32_16x16x32_bf16(sb[vg][ks], qf, o[vg][tb], 0, 0, 0); }
#pragma unroll
        for (int js = 0; js < 2; ++js)
#pragma unroll
            for (int tb = 0; tb < 4; ++tb)
#pragma unroll
                for (int vg = 0; vg < NG; ++vg) o[vg][tb] = __builtin_amdgcn_mfma_f32_16x16x32_bf16(vb[vg][js], af[tb][js], o[vg][tb], 0, 0, 0);
        LAS float* ssb = (LAS float*)(lds + par * 2048);
#pragma unroll
        for (int tb = 0; tb < 4; ++tb) { float p = 0.f;
#pragma unroll
            for (int vg = 0; vg < NG; ++vg) p += (o[vg][tb][0] * o[vg][tb][0] + o[vg][tb][1] * o[vg][tb][1]) + (o[vg][tb][2] * o[vg][tb][2] + o[vg][tb][3] * o[vg][tb][3]);
            p += __shfl_xor(p, 16); p += __shfl_xor(p, 32);
            if (quad == 0) ssb[(16 * tb + r) * 8 + w] = p; }
        __syncthreads();
#pragma unroll
        for (int tb = 0; tb < 4; ++tb) { const f32x4 s0 = *(const LAS f32x4*)(ssb + (16 * tb + r) * 8), s1 = *(const LAS f32x4*)(ssb + (16 * tb + r) * 8 + 4);
            const float tot = ((s0[0] + s0[1]) + (s0[2] + s0[3])) + ((s1[0] + s1[1]) + (s1[2] + s1[3])); const float rinv = rsqrtf(tot * (1.0f / DV) + 1e-6f);
#pragma unroll
            for (int vg = 0; vg < NG; ++vg) { const float g0 = bflo(gq[vg][tb].x), g1 = bfhi(gq[vg][tb].x), g2 = bflo(gq[vg][tb].y), g3 = bfhi(gq[vg][tb].y);
                const f32x4 y = o[vg][tb] * rinv * gnv[vg]; v2u pw; pw.x = pk2(y[0] * g0 * sigm(g0), y[1] * g1 * sigm(g1)); pw.y = pk2(y[2] * g2 * sigm(g2), y[3] * g3 * sigm(g3));
                *(v2u*)(OG + (tok0 + 16 * tb + r) * 1024 + h * DV + vbase + 16 * vg + 4 * quad) = pw; } }
    }
}
template <bool HG> __device__ __forceinline__ void sample_block(LAS unsigned char* lds, const bf16* Z, const float* R, const float* wup, const float* bgk, const float* lowb, const float* gn, const float* S0, float* Sout, bf16* OG, int bh, int tid, int w) {
    typedef MX<HG> C; constexpr int H = C::H, DV = C::DV, LDZ = C::LDZ, KC = C::KC, VC = C::VC, GC = C::GC, E = DV / 64;
    const int lane = tid & 63, kk = lane >> 2, t = lane & 3, k = 16 * w + kk, h = bh % H, b = bh / H, hk = h * 128 + k; const size_t m0 = (size_t)NPR + 4 * b;
    LAS float* tab = (LAS float*)lds + w * 192; LAS float* pas = (LAS float*)(lds + 6144); LAS float* red = (LAS float*)(lds + 8192);
    const float* sp = S0 + ((size_t)bh * 128 + 16 * w) * DV + E * lane; float* dp = Sout + ((size_t)bh * 128 + 16 * w) * DV + E * lane;
    float s0[16][E];
#pragma unroll
    for (int i = 0; i < 16; ++i) {
        if constexpr (E == 4) { const f32x4 x = *(const f32x4*)(sp + (size_t)i * DV); s0[i][0] = x[0]; s0[i][1] = x[1]; s0[i][2] = x[2]; s0[i][3] = x[3]; }
        else { const v2u x = *(const v2u*)(sp + (size_t)i * DV); s0[i][0] = __uint_as_float(x.x); s0[i][1] = __uint_as_float(x.y); } }
    float vv[4][E];
#pragma unroll
    for (int s = 0; s < 4; ++s) { const bf16* zv = Z + (m0 + s) * LDZ + VC + h * DV + E * lane;
        if constexpr (E == 4) { const v2u x = *(const v2u*)zv; vv[s][0] = bflo(x.x); vv[s][1] = bfhi(x.x); vv[s][2] = bflo(x.y); vv[s][3] = bfhi(x.y); }
        else { const unsigned x = *(const unsigned*)zv; vv[s][0] = bflo(x); vv[s][1] = bfhi(x); } }
    const bf16* zr = Z + (m0 + t) * LDZ; float q = bf2f(zr[hk]); const float kz = bf2f(zr[KC + hk]); float g, kv;
    if constexpr (!HG) { float x = bgk[hk];
#pragma unroll
        for (int i = 0; i < 16; ++i) x += R[(m0 + t) * 16 + i] * wup[i * 512 + hk];
        g = logsig(x) * (1.0f / 16.0f); kv = kz;
    } else { const float x0 = lowb[hk], x1 = lowb[1024 + hk]; const float a = logsig(x1 - x0), b2 = logsig(x0 - x1) + logsig(kz), mx = fmaxf(a, b2);
        g = mx + __logf(1.0f + __expf(-fabsf(a - b2))); kv = sigm(x0 - x1) * sigm(-kz); q = q * sigm(q); }
    const int l0 = lane & ~3;
    const float g0 = __shfl(g, l0), g1 = __shfl(g, l0 + 1), g2 = __shfl(g, l0 + 2), g3 = __shfl(g, l0 + 3);
    const float b3 = ((g0 + g1) + g2) + g3, bt = t == 0 ? g0 : (t == 1 ? g0 + g1 : (t == 2 ? (g0 + g1) + g2 : b3));
    const float qe = q * __expf(bt) * C::scale, kn = kv * __expf(-bt), kd = kv * __expf(b3 - bt);
    tab[kk * 12 + t] = qe; tab[kk * 12 + 4 + t] = kd; if (t == 0) tab[kk * 12 + 8] = __expf(b3);
    {
        float p[4];
#pragma unroll
        for (int s = 0; s < 4; ++s) { p[s] = qe * __shfl(kn, l0 + s);
            p[s] += __shfl_xor(p[s], 4); p[s] += __shfl_xor(p[s], 8); p[s] += __shfl_xor(p[s], 16); p[s] += __shfl_xor(p[s], 32); }
        if (lane < 4) *(LAS f32x4*)(pas + w * 16 + 4 * lane) = (f32x4){p[0], p[1], p[2], p[3]};
    }
    LDS_WAIT();
    float o[4][E];
#pragma unroll
    for (int tt = 0; tt < 4; ++tt)
#pragma unroll
        for (int e = 0; e < E; ++e) o[tt][e] = 0.f;
#pragma unroll
    for (int i = 0; i < 16; ++i) { const f32x4 q4 = *(const LAS f32x4*)(tab + i * 12), k4 = *(const LAS f32x4*)(tab + i * 12 + 4); const float d = tab[i * 12 + 8]; float sn[E];
#pragma unroll
        for (int e = 0; e < E; ++e) { o[0][e] += q4[0] * s0[i][e]; o[1][e] += q4[1] * s0[i][e]; o[2][e] += q4[2] * s0[i][e]; o[3][e] += q4[3] * s0[i][e];
            sn[e] = d * s0[i][e] + ((k4[0] * vv[0][e] + k4[1] * vv[1][e]) + (k4[2] * vv[2][e] + k4[3] * vv[3][e])); }
        if constexpr (E == 4) *(f32x4*)(dp + (size_t)i * DV) = (f32x4){sn[0], sn[1], sn[2], sn[3]};
        else { v2u x; x.x = __float_as_uint(sn[0]); x.y = __float_as_uint(sn[1]); *(v2u*)(dp + (size_t)i * DV) = x; } }
#pragma unroll
    for (int tt = 0; tt < 4; ++tt) {
        if constexpr (E == 4) *(LAS f32x4*)(red + (w * 4 + tt) * DV + 4 * lane) = (f32x4){o[tt][0], o[tt][1], o[tt][2], o[tt][3]};
        else { red[(w * 4 + tt) * DV + 2 * lane] = o[tt][0]; red[(w * 4 + tt) * DV + 2 * lane + 1] = o[tt][1]; } }
    __syncthreads();
    if (w < 4) {
        float y[E];
#pragma unroll
        for (int e = 0; e < E; ++e) y[e] = 0.f;
#pragma unroll
        for (int ww = 0; ww < 8; ++ww)
#pragma unroll
            for (int e = 0; e < E; ++e) y[e] += red[(ww * 4 + w) * DV + E * lane + e];
#pragma unroll
        for (int s = 0; s < 4; ++s) if (s <= w) { float a = 0.f;
#pragma unroll
            for (int ww = 0; ww < 8; ++ww) a += pas[ww * 16 + 4 * w + s];
#pragma unroll
            for (int e = 0; e < E; ++e) y[e] += a * vv[s][e]; }
        float ss = 0.f;
#pragma unroll
        for (int e = 0; e < E; ++e) ss += y[e] * y[e];
        ss = wave_sum(ss); const float rinv = rsqrtf(ss * (1.0f / DV) + 1e-6f);
        const bf16* zg = Z + (m0 + w) * LDZ + GC + h * DV + E * lane; bf16* op = OG + (m0 + w) * 1024 + h * DV + E * lane; float gg[E];
        if constexpr (E == 4) { const v2u x = *(const v2u*)zg; gg[0] = bflo(x.x); gg[1] = bfhi(x.x); gg[2] = bflo(x.y); gg[3] = bfhi(x.y); } else { const unsigned x = *(const unsigned*)zg; gg[0] = bflo(x); gg[1] = bfhi(x); }
#pragma unroll
        for (int e = 0; e < E; ++e) y[e] = y[e] * rinv * gn[E * lane + e] * (gg[e] * sigm(gg[e]));
        if constexpr (E == 4) { v2u pw; pw.x = pk2(y[0], y[1]); pw.y = pk2(y[2], y[3]); *(v2u*)op = pw; } else { *(unsigned*)op = pk2(y[0], y[1]); }
    }
    __syncthreads();
}
template <int NKS> __device__ __forceinline__ void mini_acc(f32x4 (&acc)[2][4], const bf16* ap, size_t lda, const bf16* bp, size_t ldb) {
#pragma unroll
    for (int c = 0; c < NKS; c += 4) {
        bf16x8 af[4][2], bfr[4][4];
#pragma unroll
        for (int ks = 0; ks < 4; ++ks) if (c + ks < NKS) {
#pragma unroll
            for (int rb = 0; rb < 2; ++rb) af[ks][rb] = *(const bf16x8*)(ap + (size_t)(16 * rb) * lda + 32 * (c + ks));
#pragma unroll
            for (int cb = 0; cb < 4; ++cb) bfr[ks][cb] = *(const bf16x8*)(bp + (size_t)(16 * cb) * ldb + 32 * (c + ks)); }
        __builtin_amdgcn_sched_barrier(0);
#pragma unroll
        for (int ks = 0; ks < 4; ++ks) if (c + ks < NKS) {
#pragma unroll
            for (int rb = 0; rb < 2; ++rb)
#pragma unroll
                for (int cb = 0; cb < 4; ++cb) acc[rb][cb] = __builtin_amdgcn_mfma_f32_16x16x32_bf16(bfr[ks][cb], af[ks][rb], acc[rb][cb], 0, 0, 0); }
        __builtin_amdgcn_sched_barrier(0);
    }
}
template <int MODE, int K> __device__ __forceinline__ void mini_gemm(LAS unsigned char* lds, const bf16* A, const bf16* Bt, const bf16* A2, const bf16* Bt2, float* h, bf16* hb_out, const float* rs_in, float* rs_out, float alpha, int tid, int bid, int G) {
    const int lane = tid & 63, w = tid >> 6, r = lane & 15, quad = lane >> 4;
    LAS float* P = (LAS float*)lds; LAS float* P2 = (LAS float*)(lds + 65536);
    for (int mt = bid; mt < 256; mt += G) {
        const int rt = mt >> 4, ct = mt & 15, row0 = NPR + 32 * rt, col0 = 64 * ct;
        f32x4 acc[2][4];
#pragma unroll
        for (int rb = 0; rb < 2; ++rb)
#pragma unroll
            for (int cb = 0; cb < 4; ++cb) acc[rb][cb] = (f32x4){0.f, 0.f, 0.f, 0.f};
        constexpr int KW = K / 8;
        mini_acc<KW / 32>(acc, A + (size_t)(row0 + r) * K + w * KW + 8 * quad, K, Bt + (size_t)(col0 + r) * K + w * KW + 8 * quad, K);
#pragma unroll
        for (int rb = 0; rb < 2; ++rb)
#pragma unroll
            for (int cb = 0; cb < 4; ++cb) *(LAS f32x4*)(P + (w * 32 + 16 * rb + r) * 64 + 16 * cb + 4 * quad) = acc[rb][cb];
        if constexpr (MODE == 1) {
#pragma unroll
            for (int rb = 0; rb < 2; ++rb)
#pragma unroll
                for (int cb = 0; cb < 4; ++cb) acc[rb][cb] = (f32x4){0.f, 0.f, 0.f, 0.f};
            mini_acc<1>(acc, A2 + (size_t)(row0 + r) * 256 + w * 32 + 8 * quad, 256, Bt2 + (size_t)(col0 + r) * 256 + w * 32 + 8 * quad, 256);
#pragma unroll
            for (int rb = 0; rb < 2; ++rb)
#pragma unroll
                for (int cb = 0; cb < 4; ++cb) *(LAS f32x4*)(P2 + (w * 32 + 16 * rb + r) * 64 + 16 * cb + 4 * quad) = acc[rb][cb];
        }
        __syncthreads();
        const int row = tid >> 4, c4 = (tid & 15) * 4; f32x4 v = {0.f, 0.f, 0.f, 0.f}, v2 = {0.f, 0.f, 0.f, 0.f};
#pragma unroll
        for (int ww = 0; ww < 8; ++ww) { v += *(const LAS f32x4*)(P + (ww * 32 + row) * 64 + c4); if constexpr (MODE == 1) v2 += *(const LAS f32x4*)(P2 + (ww * 32 + row) * 64 + c4); }
        const int grow = row0 + row; const size_t off = (size_t)grow * 1024 + col0 + c4;
        f32x4 o = *(const f32x4*)(h + off);
        if constexpr (MODE == 0) o += v * alpha;
        else { const float s = pg8::row_scale(rs_in, grow); o[0] += sigm(v[0] * s) * v2[0]; o[1] += sigm(v[1] * s) * v2[1]; o[2] += sigm(v[2] * s) * v2[2]; o[3] += sigm(v[3] * s) * v2[3]; }
        *(f32x4*)(h + off) = o; v2u pw; pw.x = pk2(o[0], o[1]); pw.y = pk2(o[2], o[3]); *(v2u*)(hb_out + off) = pw;
        float ss = (o[0] * o[0] + o[1] * o[1]) + (o[2] * o[2] + o[3] * o[3]);
        ss += __shfl_xor(ss, 1); ss += __shfl_xor(ss, 2); ss += __shfl_xor(ss, 4); ss += __shfl_xor(ss, 8);
        if ((tid & 15) == 0) rs_out[(size_t)grow * 16 + ct] = ss;
        __syncthreads();
    }
}
#define XB_TMO      128
#define XB_XCNT(j)  (256  + 64 * (j))
#define XB_XSUB(j)  (1280 + 64 * (j))
#define XB_XGEN(j)  (2304 + 64 * (j))
#define XB_TOP      3328
#define XB_TOPGEN   3392
#define XCD_BAR_WORDS 3456
#define XB_SPIN_CAP (1u << 18)

__device__ __forceinline__ unsigned xb_ld(unsigned* p)              { return __hip_atomic_load(p, __ATOMIC_RELAXED, __HIP_MEMORY_SCOPE_AGENT); }
__device__ __forceinline__ unsigned xb_add(unsigned* p, unsigned v) { return __hip_atomic_fetch_add(p, v, __ATOMIC_RELAXED, __HIP_MEMORY_SCOPE_AGENT); }
__device__ __forceinline__ unsigned xb_xcc_id() { return (unsigned)__builtin_amdgcn_s_getreg((3 << 11) | 20) & 0xFu; }
#define XB_SPIN(cond, bar) do { unsigned _sp = 0; while (cond) { __builtin_amdgcn_s_sleep(1); \
    if ((++_sp & 255u) == 0u) { if (xb_ld(&(bar)[XB_TMO])) break; if (_sp > XB_SPIN_CAP) { atomicAdd(&(bar)[XB_TMO], 1u); break; } } } } while (0)

struct XcdBarrier {
    unsigned* bar; unsigned x;
    volatile LAS unsigned* st;
};

__device__ __forceinline__ XcdBarrier xcd_barrier_post(unsigned* bar, volatile LAS unsigned* st) {
    XcdBarrier b; b.bar = bar; b.x = xb_xcc_id(); b.st = st;
    if (threadIdx.x == 0) (void)xb_add(&bar[XB_XCNT(b.x)], 1u);
    return b;
}
__device__ __forceinline__ void xcd_barrier_complete(unsigned* bar, unsigned x, unsigned& nloc, unsigned& nx) {
    const unsigned G = gridDim.x * gridDim.y * gridDim.z;
    unsigned sum, cnt, mine, sp = 0u;
    for (;;) {
        sum = 0u; cnt = 0u; mine = 0u;
#pragma unroll
        for (unsigned j = 0; j < 16; ++j) { const unsigned c = xb_ld(&bar[XB_XCNT(j)]); sum += c; cnt += (c > 0u) ? 1u : 0u; mine = (j == x) ? c : mine; }
        if (sum == G) break;
        __builtin_amdgcn_s_sleep(1);
        if ((++sp & 255u) == 0u) { if (xb_ld(&bar[XB_TMO])) break; if (sp > XB_SPIN_CAP) { atomicAdd(&bar[XB_TMO], 1u); break; } }
    }
    nloc = mine > 0u ? mine : 1u; nx = cnt > 0u ? cnt : 1u;
}

__device__ __forceinline__ void xcd_barrier(const XcdBarrier& b) {
    asm volatile("s_waitcnt vmcnt(0)" ::: "memory");
    __syncthreads();
    if (threadIdx.x == 0) {
        unsigned* bar = b.bar;
        __builtin_amdgcn_s_waitcnt(0);
        unsigned nloc = b.st[0], nx = b.st[1];
        if (nloc == 0u) { xcd_barrier_complete(bar, b.x, nloc, nx); b.st[0] = nloc; b.st[1] = nx; }
        const unsigned old = xb_add(&bar[XB_XSUB(b.x)], 1u);
        const unsigned gen = old / nloc;
        if (old + 1u == (gen + 1u) * nloc) {
            __builtin_amdgcn_fence(__ATOMIC_RELEASE, "agent");
            asm volatile("s_waitcnt vmcnt(0)" ::: "memory");
            const unsigned og = xb_add(&bar[XB_TOP], 1u);
            const unsigned tg = og / nx;
            if (og + 1u == (tg + 1u) * nx) xb_add(&bar[XB_TOPGEN], 1u);
            else XB_SPIN(xb_ld(&bar[XB_TOPGEN]) == tg, bar);
            __builtin_amdgcn_fence(__ATOMIC_ACQUIRE, "agent");
            xb_add(&bar[XB_XGEN(b.x)], 1u);
            asm volatile("s_waitcnt vmcnt(0)" ::: "memory");
        } else {
            XB_SPIN(xb_ld(&bar[XB_XGEN(b.x)]) == gen, bar);
            __builtin_amdgcn_fence(__ATOMIC_ACQUIRE, "agent");
            asm volatile("s_waitcnt vmcnt(0)" ::: "memory");
        }
    }
    __syncthreads();
}

#define MK_TID() int wave = wave_s; asm volatile("" : "+s"(wave)); unsigned ones_ = ~0u; asm volatile("" : "+s"(ones_)); \
    const int lane = (int)__builtin_amdgcn_mbcnt_hi(ones_, __builtin_amdgcn_mbcnt_lo(ones_, 0u)); const int tid = wave * 64 + lane; const int gw = bid * NWAVES + wave, NGW = G * NWAVES; (void)gw; (void)NGW; (void)tid; (void)lane
__global__ void __launch_bounds__(NWAVES * 64, 2) fwd_kernel(Args a) {
    extern __shared__ __attribute__((aligned(16))) unsigned char lds_raw[];
    LAS unsigned char* lds = (LAS unsigned char*)lds_raw;
    cg::grid_group grid = cg::this_grid();
    const int wave_s = __builtin_amdgcn_readfirstlane((int)threadIdx.x >> 6);
    volatile LAS unsigned* bst = (volatile LAS unsigned*)(lds + 131072 + 256);
    if (threadIdx.x < 2) bst[threadIdx.x] = 0u;
    __syncthreads();
    const XcdBarrier xbar = xcd_barrier_post((unsigned*)(a.ws + OFF_CTL), bst);
    const int ph_lo = a.ph_lo, ph_hi = a.ph_hi;
    for (int ph_ = ph_lo; ph_ < ph_hi; ++ph_) {
#if PROBE_MODE
      const int kk_ = (ph_ - 1) % 10; const bool mid_ = ph_ > 0 && ph_ < NPH - 1;
      const int nrep = (PROBE_MODE == 1 && ph_ == 0) || (PROBE_MODE == 2 && mid_ && (kk_ == 0 || kk_ == 7)) || (PROBE_MODE == 3 && mid_ && kk_ == 2) || (PROBE_MODE == 4 && mid_ && kk_ == 4) ? 2 : 1;
      for (int rep = 0; rep < nrep; ++rep) {
#else
      {
#endif
        int ph = ph_; asm volatile("" : "+s"(ph));
        CArgs* ap = (CArgs*)__builtin_amdgcn_kernarg_segment_ptr(); asm volatile("" : "+s"(ap));
        int bid = blockIdx.x; asm volatile("" : "+s"(bid));
        int G = gridDim.x; asm volatile("" : "+s"(G));
        unsigned char* ws = ap->ws; float* hbuf = ap->out;
        if (ph == 0) { MK_TID(); prologue(ap, ws, hbuf, lds, tid, bid, G); }
        else if (ph == NPH - 1) {
            MK_TID(); const float* fw = ap->in[25];
            for (int m = gw; m < M; m += NGW) { f32x4* hr = (f32x4*)(hbuf + (size_t)m * D); f32x4 v[4]; float ss = 0.f;
#pragma unroll
                for (int j = 0; j < 4; ++j) { v[j] = hr[lane + 64 * j]; ss += (v[j][0] * v[j][0] + v[j][1] * v[j][1]) + (v[j][2] * v[j][2] + v[j][3] * v[j][3]); }
                ss = wave_sum(ss); const float rinv = rsqrtf(ss * (1.0f / D) + 1e-6f);
#pragma unroll
                for (int j = 0; j < 4; ++j) { const f32x4 wv = *((const f32x4*)fw + lane + 64 * j); hr[lane + 64 * j] = v[j] * rinv * wv; } }
        } else {
            const int li = (ph - 1) / 10, k = (ph - 1) % 10, cur = li;
            bf16* hb = (bf16*)(ws + OFF_HB + cur * HB_SZ); bf16* ob = (bf16*)(ws + OFF_HB + (cur ^ 1) * HB_SZ);
            float* rs0 = (float*)(ws + OFF_RS); float* rs1 = (float*)(ws + OFF_RS + RS_SZ); float* Rb = (float*)(ws + OFF_R);
            bf16* big = (bf16*)(ws + OFF_BIG);
            if (k == 0 || k == 7) { MK_TID();
                const int f = k == 7; pg8::Gemm g{hb, (const bf16*)(ws + OFF_WGU + (li * 2 + f) * WGU_SZ), M, 2 * FF, D};
                pg8::StaticOrder S; S.init(M, 2 * FF, G, bid); pg8::EpiSwiglu E{big, FF, rs0};
                pg8::gemm_phase<pg8::EpiSwiglu, pg8::StaticOrder, true, true>(lds, g, S, E, tid);
            } else if (k == 1 || k == 8 || k == 6) { MK_TID();
                pg8::Gemm g; float alpha; float* rso;
                if (k == 6) { g = pg8::Gemm{ob, (const bf16*)(ws + OFF_WOUT + li * WSQ_SZ), M, D, D}; alpha = 1.0f; rso = rs0; }
                else { const int f = k == 8; g = pg8::Gemm{big, (const bf16*)(ws + OFF_WDN + (li * 2 + f) * WDN_SZ), M, D, FF}; alpha = 0.5f; rso = rs1; }
                g.M = NPR; pg8::StaticOrder S; S.init(NPR, D, G, bid); pg8::EpiResid E{hbuf, hb, rso, alpha};
                pg8::gemm_phase<pg8::EpiResid, pg8::StaticOrder, true, true>(lds, g, S, E, tid);
                unsigned ones2_ = ~0u; asm volatile("" : "+s"(ones2_));
                const int tid2 = wave * 64 + (int)__builtin_amdgcn_mbcnt_hi(ones2_, __builtin_amdgcn_mbcnt_lo(ones2_, 0u));
                if (k == 6) mini_gemm<0, D>(lds, g.A, g.Bt, nullptr, nullptr, hbuf, hb, nullptr, rso, alpha, tid2, bid, G);
                else mini_gemm<0, FF>(lds, g.A, g.Bt, nullptr, nullptr, hbuf, hb, nullptr, rso, alpha, tid2, bid, G);
            } else if (k == 2) { MK_TID();
                const int N = li ? 4096 : 3328; pg8::Gemm g{hb, (const bf16*)(ws + (li ? OFF_WHIN : OFF_WGIN)), M, N, D};
                pg8::StaticOrder S; S.init(M, N, G, bid); pg8::EpiZ E{big, N, rs1, Rb, li ? -1 : 12};
                pg8::gemm_phase<pg8::EpiZ, pg8::StaticOrder, true, true>(lds, g, S, E, tid);
            } else if (k == 3) { MK_TID();
                if (li == 0) prep_phase<false>(lds, big, Rb, ap->in[11], ap->in[12], ap->in[18], (bf16*)(ws + OFF_AB), (float*)(ws + OFF_DB), (bf16*)(ws + OFF_PSB), tid, bid, G);
                else prep_phase<true>(lds, big, Rb, ap->in[11], ap->in[12], ap->in[18], (bf16*)(ws + OFF_AB), (float*)(ws + OFF_DB), (bf16*)(ws + OFF_PSB), tid, bid, G);
                __syncthreads();
                for (int rp_ = 0; rp_ < (PROBE_MODE == 6 ? 2 : 1); ++rp_)
                for (int u = bid; u < DB * (li ? 8 : 4); u += G) {
                    if (li == 0) sample_block<false>(lds, big, Rb, ap->in[11], ap->in[12], ap->in[18], ap->in[13], ap->in[2], hbuf + OUT_GS, ob, u, tid, wave);
                    else sample_block<true>(lds, big, Rb, ap->in[11], ap->in[12], ap->in[18], ap->in[16], ap->in[3], hbuf + OUT_HS, ob, u, tid, wave);
                }
            } else if (k == 4) { MK_TID();
                const int gt = bid * (NWAVES * 64) + tid, ngt = G * NWAVES * 64;
                if (li == 0) state_phase<false>((bf16*)(ws + OFF_PSB), (const float*)(ws + OFF_DB), hbuf + OUT_GP, gt, ngt);
                else state_phase<true>((bf16*)(ws + OFF_PSB), (const float*)(ws + OFF_DB), hbuf + OUT_HP, gt, ngt);
            } else if (k == 5) { MK_TID();
                if (li == 0) out_phase<false>(lds, big, (const bf16*)(ws + OFF_AB), (const bf16*)(ws + OFF_PSB), ob, ap->in[13], tid, wave, bid, G);
                else out_phase<true>(lds, big, (const bf16*)(ws + OFF_AB), (const bf16*)(ws + OFF_PSB), ob, ap->in[16], tid, wave, bid, G);
            } else { MK_TID();
                float* pp = (float*)(ws + OFF_BIG);
                { pg8::Gemm g{(const bf16*)(ws + OFF_PB + li * PB_SZ), (const bf16*)(ws + OFF_WPP + li * WPP_SZ), NPR, D, PLE};
                  pg8::StaticOrder S; S.init(NPR, D, G, bid); pg8::EpiStoreF32 E{pp};
                  pg8::gemm_phase<pg8::EpiStoreF32, pg8::StaticOrder, true, true>(lds, g, S, E, tid); }
                { unsigned ones2_ = ~0u; asm volatile("" : "+s"(ones2_)); const int tid2 = wave * 64 + (int)__builtin_amdgcn_mbcnt_hi(ones2_, __builtin_amdgcn_mbcnt_lo(ones2_, 0u));
                  pg8::Gemm g{hb, (const bf16*)(ws + OFF_WPG + li * WSQ_SZ), NPR, D, D};
                  pg8::StaticOrder S; S.init(NPR, D, G, bid); pg8::EpiPle E{hbuf, ob, rs1, rs0, pp};
                  pg8::gemm_phase<pg8::EpiPle, pg8::StaticOrder, true, true>(lds, g, S, E, tid2); }
                { unsigned ones3_ = ~0u; asm volatile("" : "+s"(ones3_)); const int tid3 = wave * 64 + (int)__builtin_amdgcn_mbcnt_hi(ones3_, __builtin_amdgcn_mbcnt_lo(ones3_, 0u));
                  mini_gemm<1, D>(lds, hb, (const bf16*)(ws + OFF_WPG + li * WSQ_SZ), (const bf16*)(ws + OFF_PB + li * PB_SZ), (const bf16*)(ws + OFF_WPP + li * WPP_SZ), hbuf, ob, rs1, rs0, 0.f, tid3, bid, G); }
            }
        }
#if PROBE_MODE
        if (ph_ + 1 < ph_hi || rep + 1 < nrep) grid.sync();
#else
        if (ph_ + 1 < ph_hi) {
            if (ph_ == 0) grid.sync(); else xcd_barrier(xbar);
#if EXTRA_SYNCS
            for (int es = 0; es < EXTRA_SYNCS; ++es) xcd_barrier(xbar);
#endif
        }
#endif
      }
    }
}

extern "C" void kernel_launch(void* const* d_in, const int* in_sizes, int n_in, void* d_out, int out_size, void* d_ws, size_t ws_size, hipStream_t stream) {
    static int grid = 0;
    if (grid == 0) {
        if (n_in != 26 || (size_t)out_size != OUT_END || ws_size < WS_TOTAL) { fprintf(stderr, "kernel_launch: unexpected shapes (n_in %d out %d ws %zu need %zu); nothing launched\n", n_in, out_size, ws_size, (size_t)WS_TOTAL); grid = -1; return; }
        int dev = 0, cus = 0, per_cu = 0;
        if (hipGetDevice(&dev) != hipSuccess || hipDeviceGetAttribute(&cus, hipDeviceAttributeMultiprocessorCount, dev) != hipSuccess) { grid = -1; return; }
        if (hipFuncSetAttribute((const void*)fwd_kernel, hipFuncAttributeMaxDynamicSharedMemorySize, LDS_BYTES) != hipSuccess) { fprintf(stderr, "kernel_launch: hipFuncSetAttribute failed\n"); grid = -1; return; }
        if (hipOccupancyMaxActiveBlocksPerMultiprocessor(&per_cu, (const void*)fwd_kernel, NWAVES * 64, LDS_BYTES) != hipSuccess || per_cu < 1) per_cu = 1;
        (void)hipGetLastError();
        grid = cus * per_cu;
    }
    if (grid < 0) return;
    if (hipMemsetAsync((char*)d_ws + OFF_CTL, 0, CTL_BYTES, stream) != hipSuccess) { fprintf(stderr, "kernel_launch: memset of the barrier words failed\n"); return; }
    Args a{};
    for (int i = 0; i < 26; ++i) a.in[i] = (const float*)d_in[i];
    a.out = (float*)d_out; a.ws = (unsigned char*)d_ws;
#if MK_N_LAUNCHES == 1
    a.ph_lo = 0; a.ph_hi = NPH;
    void* args[] = {&a};
    hipError_t e = hipLaunchCooperativeKernel((const void*)fwd_kernel, dim3(grid), dim3(NWAVES * 64), args, LDS_BYTES, stream);
    if (e != hipSuccess) fprintf(stderr, "kernel_launch: cooperative launch failed: %s (grid %d)\n", hipGetErrorString(e), grid);
#else
    for (int ph = 0; ph < NPH; ++ph) { a.ph_lo = ph; a.ph_hi = ph + 1; hipLaunchKernelGGL(fwd_kernel, dim3(grid), dim3(NWAVES * 64), LDS_BYTES, stream, a); }
#endif
}
```

```cpp
#include <hip/hip_runtime.h>
#include <cstdio>
#include <cstdint>
#ifndef MK_N_LAUNCHES
#define MK_N_LAUNCHES 1
#endif
#ifndef PROBE_MODE
#define PROBE_MODE 0
#endif
#ifndef EXTRA_SYNCS
#define EXTRA_SYNCS 0
#endif
#ifndef PT_ON
#define PT_ON 0
#define PT_LO 12
#define PT_HI 12
#define PT_MUL 4
#endif
namespace pg8 {
#define PG8_LAS __attribute__((address_space(3)))
typedef unsigned short bf16_t;
typedef short bf16x8 __attribute__((ext_vector_type(8)));
typedef float f32x4 __attribute__((ext_vector_type(4)));
typedef unsigned u32x4 __attribute__((ext_vector_type(4)));
constexpr int BM = 256, BK = 64, HALF = 128, HTB = HALF * BK * 2  , STAGE_BYTES = 8 * HTB, NXCD = 8, WGM = 8;

__host__ __device__ __forceinline__ int lds_byte(int r, int c) { const int st = (r >> 4) * 2 + (c >> 5), rr = r & 15, cc = c & 31, ob = rr * 64 + cc * 2; return st * 1024 + (ob ^ (((ob >> 9) & 1) << 5)); }
__host__ __device__ __forceinline__ void stage_rc(int b, int& R, int& C) { const int st = b / 1024, sb = b % 1024, swz = sb ^ (((sb >> 9) & 1) << 5); R = (st >> 1) * 16 + swz / 64; C = (st & 1) * 32 + (swz % 64) / 2; }
__host__ __device__ __forceinline__ int perm32(int rho) { const int n = rho >> 4, i = rho & 15; return 8 * (i >> 2) + 4 * n + (i & 3); }

struct Unit { int pm, pn; };
struct Gemm { const bf16_t* A; const bf16_t* Bt; int M, N, K; };

struct StaticOrder {
    int nM, nN, nwg, G, c;
    __host__ __device__ void init(int M, int N, int G_, int c_) { nM = M / BM; nN = N / BM; nwg = nM * nN; G = G_; c = c_; }
    __host__ __device__ bool next(int i, Unit& u) const {
        const long L = (long)i * G + c; if (L >= nwg) return false;
        int wgid = (int)L; { const int q = nwg / NXCD, r = nwg % NXCD, xcd = wgid % NXCD, off = wgid / NXCD; wgid = (xcd < r ? xcd * (q + 1) : r * (q + 1) + (xcd - r) * q) + off; }
        const int nig = WGM * nN, gid = wgid / nig, fm = gid * WGM, gsz = (nM - fm) < WGM ? (nM - fm) : WGM;
        u.pm = fm + ((wgid % nig) % gsz); u.pn = (wgid % nig) / gsz; return true;
    }
    __device__ __forceinline__ void a_ready(const Unit&) const {}
    __device__ __forceinline__ void done(const Unit&) const {}
};

typedef float f32x2_ __attribute__((ext_vector_type(2))); typedef __bf16 bf16x2_ __attribute__((ext_vector_type(2)));
__device__ __forceinline__ unsigned cvt_pk_bf16(float lo, float hi) { const f32x2_ v = {lo, hi}; return __builtin_bit_cast(unsigned, __builtin_convertvector(v, bf16x2_)); }
typedef float f32x2 __attribute__((ext_vector_type(2)));
typedef unsigned u32x2 __attribute__((ext_vector_type(2)));
__device__ __forceinline__ float row_scale(const float* rs, int row) {
    const f32x4* p = (const f32x4*)(rs + (size_t)row * 16);
    const f32x4 a = p[0], b = p[1], c = p[2], d = p[3];
    const float s = ((a[0] + a[1]) + (a[2] + a[3])) + ((b[0] + b[1]) + (b[2] + b[3])) + ((c[0] + c[1]) + (c[2] + c[3])) + ((d[0] + d[1]) + (d[2] + d[3]));
    return rsqrtf(s * (1.0f / 1024.0f) + 1e-6f);
}
__device__ __forceinline__ void row_scales8(const float* rs, int row0, float (&sc)[2][4]) {
#pragma unroll
    for (int ai = 0; ai < 2; ++ai)
#pragma unroll
        for (int mh = 0; mh < 2; ++mh) { f32x4 p[2][4];
#pragma unroll
            for (int ml = 0; ml < 2; ++ml)
#pragma unroll
                for (int q = 0; q < 4; ++q) p[ml][q] = *(const f32x4*)(rs + (size_t)(row0 + ai * HALF + (2 * mh + ml) * 16) * 16 + 4 * q);
            __builtin_amdgcn_sched_barrier(0);
#pragma unroll
            for (int ml = 0; ml < 2; ++ml) { const f32x4 t = (p[ml][0] + p[ml][1]) + (p[ml][2] + p[ml][3]); sc[ai][2 * mh + ml] = rsqrtf(((t[0] + t[1]) + (t[2] + t[3])) * (1.0f / 1024.0f) + 1e-6f); }
            __builtin_amdgcn_sched_barrier(0); }
}
__device__ __forceinline__ float sigm(float x) { return __builtin_amdgcn_rcpf(1.0f + __expf(-x)); }
struct EpiSwiglu {
    static constexpr bool PERM = true, AFTER_DRAIN = false;
    bf16_t* O; int ldc; const float* rs;
    __device__ __forceinline__ void operator()(const f32x4 (&acc)[2][2][4][2], const Unit& u, int wr, int wc, int fr_, int fq_) const {
        unsigned on_ = ~0u; asm volatile("" : "+s"(on_)); const int ln_ = (int)__builtin_amdgcn_mbcnt_hi(on_, __builtin_amdgcn_mbcnt_lo(on_, 0u)), fr = ln_ & 15, fq = ln_ >> 4; (void)fr_; (void)fq_;
        const int row0 = u.pm * BM + wr * 64 + fr, col0 = u.pn * HALF + wc * 32 + 8 * fq;
        float sc[2][4]; row_scales8(rs, row0, sc);
#pragma unroll
        for (int ai = 0; ai < 2; ++ai)
#pragma unroll
            for (int m = 0; m < 4; ++m) { const int row = row0 + ai * HALF + m * 16; const float s = sc[ai][m];
                float o[8];
#pragma unroll
                for (int n = 0; n < 2; ++n)
#pragma unroll
                    for (int i = 0; i < 4; ++i) { const float g = acc[ai][0][m][n][i] * s, up = acc[ai][1][m][n][i] * s; o[n * 4 + i] = g * sigm(g) * up; }
                u32x4 w; w.x = cvt_pk_bf16(o[0], o[1]); w.y = cvt_pk_bf16(o[2], o[3]); w.z = cvt_pk_bf16(o[4], o[5]); w.w = cvt_pk_bf16(o[6], o[7]);
                *(u32x4*)(O + (size_t)row * ldc + col0) = w; }
    }
};
struct EpiZ {
    static constexpr bool PERM = true, AFTER_DRAIN = false;
    bf16_t* Z; int ldz; const float* rs; float* R; int r_tile;
    __device__ __forceinline__ void operator()(const f32x4 (&acc)[2][2][4][2], const Unit& u, int wr, int wc, int fr_, int fq_) const {
        unsigned on_ = ~0u; asm volatile("" : "+s"(on_)); const int ln_ = (int)__builtin_amdgcn_mbcnt_hi(on_, __builtin_amdgcn_mbcnt_lo(on_, 0u)), fr = ln_ & 15, fq = ln_ >> 4; (void)fr_; (void)fq_;
        const int row0 = u.pm * BM + wr * 64 + fr, col0 = u.pn * BM + wc * 32 + 8 * fq;
        if (u.pn == r_tile) {
            if (wc == 0 && fq < 2) {
#pragma unroll
                for (int ai = 0; ai < 2; ++ai)
#pragma unroll
                    for (int m = 0; m < 4; ++m) { const int row = row0 + ai * HALF + m * 16; const float s = row_scale(rs, row);
#pragma unroll
                        for (int n = 0; n < 2; ++n) *(f32x4*)(R + (size_t)row * 16 + 8 * fq + 4 * n) = acc[ai][0][m][n] * s; }
            }
            return;
        }
        float sc[2][4]; row_scales8(rs, row0, sc);
#pragma unroll
        for (int ai = 0; ai < 2; ++ai)
#pragma unroll
            for (int m = 0; m < 4; ++m) { const int row = row0 + ai * HALF + m * 16; const float s = sc[ai][m];
#pragma unroll
                for (int bj = 0; bj < 2; ++bj) { const f32x4 v0 = acc[ai][bj][m][0] * s, v1 = acc[ai][bj][m][1] * s;
                    u32x4 w; w.x = cvt_pk_bf16(v0[0], v0[1]); w.y = cvt_pk_bf16(v0[2], v0[3]); w.z = cvt_pk_bf16(v1[0], v1[1]); w.w = cvt_pk_bf16(v1[2], v1[3]);
                    *(u32x4*)(Z + (size_t)row * ldz + col0 + bj * HALF) = w; } }
    }
};
struct EpiResid {
    static constexpr bool PERM = false, AFTER_DRAIN = false;
    const float* xin; bf16_t* hb; float* rs_out; float alpha;
    __device__ __forceinline__ void operator()(const f32x4 (&acc)[2][2][4][2], const Unit& u, int wr, int wc, int fr_, int fq_) const {
        unsigned on_ = ~0u; asm volatile("" : "+s"(on_)); const int ln_ = (int)__builtin_amdgcn_mbcnt_hi(on_, __builtin_amdgcn_mbcnt_lo(on_, 0u)), fr = ln_ & 15, fq = ln_ >> 4; (void)fr_; (void)fq_;
        const int row0 = u.pm * BM + wr * 64 + fr, col0 = u.pn * BM + wc * 32 + 4 * fq;
#pragma unroll
        for (int ai = 0; ai < 2; ++ai)
#pragma unroll
            for (int mh = 0; mh < 2; ++mh) { f32x4 hv[2][2][2];
                if (xin) {
#pragma unroll
                    for (int ml = 0; ml < 2; ++ml)
#pragma unroll
                        for (int bj = 0; bj < 2; ++bj)
#pragma unroll
                            for (int n = 0; n < 2; ++n) hv[ml][bj][n] = *(const f32x4*)(xin + (size_t)(row0 + ai * HALF + (2 * mh + ml) * 16) * 1024 + col0 + bj * HALF + n * 16);
                } else { u32x2 hw[2][2][2];
#pragma unroll
                    for (int ml = 0; ml < 2; ++ml)
#pragma unroll
                        for (int bj = 0; bj < 2; ++bj)
#pragma unroll
                            for (int n = 0; n < 2; ++n) hw[ml][bj][n] = *(const u32x2*)(hb + (size_t)(row0 + ai * HALF + (2 * mh + ml) * 16) * 1024 + col0 + bj * HALF + n * 16);
#pragma unroll
                    for (int ml = 0; ml < 2; ++ml)
#pragma unroll
                        for (int bj = 0; bj < 2; ++bj)
#pragma unroll
                            for (int n = 0; n < 2; ++n) { const u32x2 x = hw[ml][bj][n]; hv[ml][bj][n] = (f32x4){__uint_as_float(x.x << 16), __uint_as_float(x.x & 0xffff0000u), __uint_as_float(x.y << 16), __uint_as_float(x.y & 0xffff0000u)}; } }
                __builtin_amdgcn_sched_barrier(0);
#pragma unroll
                for (int ml = 0; ml < 2; ++ml) { const int m = 2 * mh + ml, row = row0 + ai * HALF + m * 16; float ss = 0.f;
#pragma unroll
                    for (int bj = 0; bj < 2; ++bj)
#pragma unroll
                        for (int n = 0; n < 2; ++n) { const size_t off = (size_t)row * 1024 + col0 + bj * HALF + n * 16;
                            const f32x4 o = hv[ml][bj][n] + acc[ai][bj][m][n] * alpha;
                            ss += (o[0] * o[0] + o[1] * o[1]) + (o[2] * o[2] + o[3] * o[3]);
                            u32x2 w; w.x = cvt_pk_bf16(o[0], o[1]); w.y = cvt_pk_bf16(o[2], o[3]); *(u32x2*)(hb + off) = w; }
                    ss += __builtin_bit_cast(float, __builtin_amdgcn_ds_bpermute((ln_ ^ 16) << 2, __builtin_bit_cast(int, ss))); ss += __builtin_bit_cast(float, __builtin_amdgcn_ds_bpermute((ln_ ^ 32) << 2, __builtin_bit_cast(int, ss)));
                    if (fq == 0) rs_out[(size_t)row * 16 + u.pn * 4 + wc] = ss; }
                __builtin_amdgcn_sched_barrier(0); }
    }
};
struct EpiStorePP {
    static constexpr bool PERM = false, AFTER_DRAIN = false;
    bf16_t* O;
    __device__ __forceinline__ void operator()(const f32x4 (&acc)[2][2][4][2], const Unit& u, int wr, int wc, int fr_, int fq_) const {
        unsigned on_ = ~0u; asm volatile("" : "+s"(on_)); const int ln_ = (int)__builtin_amdgcn_mbcnt_hi(on_, __builtin_amdgcn_mbcnt_lo(on_, 0u)), fr = ln_ & 15, fq = ln_ >> 4; (void)fr_; (void)fq_;
        const int row0 = u.pm * BM + wr * 64 + fr, col0 = u.pn * BM + wc * 32 + 4 * fq;
#pragma unroll
        for (int ai = 0; ai < 2; ++ai)
#pragma unroll
            for (int m = 0; m < 4; ++m)
#pragma unroll
                for (int bj = 0; bj < 2; ++bj)
#pragma unroll
                    for (int n = 0; n < 2; ++n) { const f32x4 v = acc[ai][bj][m][n]; u32x2 w; w.x = cvt_pk_bf16(v[0], v[1]); w.y = cvt_pk_bf16(v[2], v[3]);
                        *(u32x2*)(O + (size_t)(row0 + ai * HALF + m * 16) * 1024 + col0 + bj * HALF + n * 16) = w; }
    }
};
struct EpiPle {
    static constexpr bool PERM = false, AFTER_DRAIN = false;
    const bf16_t* hbin; bf16_t* hb; const float* rs_in; float* rs_out; const bf16_t* pp;
    __device__ __forceinline__ void operator()(const f32x4 (&acc)[2][2][4][2], const Unit& u, int wr, int wc, int fr_, int fq_) const {
        unsigned on_ = ~0u; asm volatile("" : "+s"(on_)); const int ln_ = (int)__builtin_amdgcn_mbcnt_hi(on_, __builtin_amdgcn_mbcnt_lo(on_, 0u)), fr = ln_ & 15, fq = ln_ >> 4; (void)fr_; (void)fq_;
        const int row0 = u.pm * BM + wr * 64 + fr, col0 = u.pn * BM + wc * 32 + 4 * fq;
#pragma unroll
        for (int ai = 0; ai < 2; ++ai)
#pragma unroll
            for (int m = 0; m < 4; ++m) { const int row = row0 + ai * HALF + m * 16; const float s = row_scale(rs_in, row); float ss = 0.f;
#pragma unroll
                for (int bj = 0; bj < 2; ++bj)
#pragma unroll
                    for (int n = 0; n < 2; ++n) { const size_t off = (size_t)row * 1024 + col0 + bj * HALF + n * 16;
                        const u32x2 pw = *(const u32x2*)(pp + off); const f32x4 a = acc[ai][bj][m][n] * s, p = {__uint_as_float(pw.x << 16), __uint_as_float(pw.x & 0xffff0000u), __uint_as_float(pw.y << 16), __uint_as_float(pw.y & 0xffff0000u)}; const u32x2 hx = *(const u32x2*)(hbin + off); f32x4 o = {__uint_as_float(hx.x << 16), __uint_as_float(hx.x & 0xffff0000u), __uint_as_float(hx.y << 16), __uint_as_float(hx.y & 0xffff0000u)};
                        o[0] += sigm(a[0]) * p[0]; o[1] += sigm(a[1]) * p[1]; o[2] += sigm(a[2]) * p[2]; o[3] += sigm(a[3]) * p[3];
                        ss += (o[0] * o[0] + o[1] * o[1]) + (o[2] * o[2] + o[3] * o[3]);
                        u32x2 w; w.x = cvt_pk_bf16(o[0], o[1]); w.y = cvt_pk_bf16(o[2], o[3]); *(u32x2*)(hb + off) = w; }
                ss += __builtin_bit_cast(float, __builtin_amdgcn_ds_bpermute((ln_ ^ 16) << 2, __builtin_bit_cast(int, ss))); ss += __builtin_bit_cast(float, __builtin_amdgcn_ds_bpermute((ln_ ^ 32) << 2, __builtin_bit_cast(int, ss)));
                if (fq == 0) rs_out[(size_t)row * 16 + u.pn * 4 + wc] = ss; }
    }
};
template <class Epi, class Sched, bool ALIGN_EPI = false, bool SP2 = false>
__device__ __forceinline__ void gemm_phase(PG8_LAS unsigned char* lds, const Gemm g, const Sched& S, const Epi& E, const int tid) {
    const int wid = __builtin_amdgcn_readfirstlane(tid >> 6), lane = tid & 63, wr = wid >> 2, wc = wid & 3, fr = lane & 15, fq = lane >> 4;
    const int K = g.K, nt = K / BK;
    unsigned voffA[2], voffB[2];
#pragma unroll
    for (int i = 0; i < 2; ++i) { int R, C; stage_rc(tid * 16 + i * 8192, R, C); const int Rb = Epi::PERM ? ((R & ~31) + perm32(R & 31)) : R;
        voffA[i] = (unsigned)(R * K + C) * 2u; voffB[i] = (unsigned)(Rb * K + C) * 2u; }
    const size_t kstep = (size_t)(BK * 2);
    const size_t hstep = (size_t)HALF * K * 2;
    const size_t tstep = 2 * hstep;
    const unsigned ldsw = (unsigned)wid * 1024u;
    const int aoff = lds_byte(wr * 64 + fr, fq * 8), boff = lds_byte(wc * 32 + fr, fq * 8);
#define PG8_SA(b, h) (((b) * 2 + (h)) * HTB)
#define PG8_SB(b, h) ((4 + (b) * 2 + (h)) * HTB)
#define PG8_STAGE(bufoff, gbase, voff) do { _Pragma("unroll") for (int _i = 0; _i < 2; ++_i) \
        __builtin_amdgcn_global_load_lds((const unsigned*)((const char*)(gbase) + (voff)[_i]), (PG8_LAS unsigned*)(lds + (bufoff) + ldsw + _i * 8192), 16, 0, 0); } while (0)
#define PG8_LDA(dst, b, h) do { _Pragma("unroll") for (int m = 0; m < 4; ++m) _Pragma("unroll") for (int k = 0; k < 2; ++k) dst[m][k] = *(const PG8_LAS bf16x8*)(lds + PG8_SA(b, h) + aoff + m * 2048 + k * 1024); } while (0)
#define PG8_LDB(dst, b, h) do { _Pragma("unroll") for (int n = 0; n < 2; ++n) _Pragma("unroll") for (int k = 0; k < 2; ++k) dst[n][k] = *(const PG8_LAS bf16x8*)(lds + PG8_SB(b, h) + boff + n * 2048 + k * 1024); } while (0)
#define PG8_MMA(ai, bj, At, Bt) do { __builtin_amdgcn_s_setprio(1); _Pragma("unroll") for (int m = 0; m < 4; ++m) _Pragma("unroll") for (int n = 0; n < 2; ++n) _Pragma("unroll") for (int k = 0; k < 2; ++k) \
        acc[ai][bj][m][n] = __builtin_amdgcn_mfma_f32_16x16x32_bf16(Bt[n][k], At[m][k], acc[ai][bj][m][n], 0, 0, 0); __builtin_amdgcn_s_setprio(0); } while (0)
#define PG8_WAIT_V(n) asm volatile("s_waitcnt vmcnt(" #n ")" ::: "memory")
#define PG8_WAIT_L(n) asm volatile("s_waitcnt lgkmcnt(" #n ")" ::: "memory")
#define PG8_BAR __builtin_amdgcn_s_barrier()
#define PG8_SCHED __builtin_amdgcn_sched_barrier(0)
    Unit cur, nxt; int ui = 0;
    if (!S.next(0, cur)) return;
    f32x4 acc[2][2][4][2];
#pragma unroll
    for (int a = 0; a < 2; ++a)
#pragma unroll
        for (int b = 0; b < 2; ++b)
#pragma unroll
            for (int m = 0; m < 4; ++m)
#pragma unroll
                for (int n = 0; n < 2; ++n) acc[a][b][m][n] = (f32x4){0.f, 0.f, 0.f, 0.f};
    bf16x8 At[4][2], B0[2][2], B1[2][2];
    const char* cA = (const char*)g.A + (size_t)cur.pm * tstep; const char* cB = (const char*)g.Bt + (size_t)cur.pn * tstep;
    S.a_ready(cur);
    if constexpr (SP2) {
        PG8_STAGE(PG8_SB(0, 0), cB, voffB); PG8_STAGE(PG8_SB(0, 1), cB + hstep, voffB); PG8_STAGE(PG8_SA(0, 0), cA, voffA); PG8_STAGE(PG8_SA(0, 1), cA + hstep, voffA);
        if (wr == 1) PG8_BAR;
        PG8_WAIT_V(2); PG8_BAR;
        PG8_STAGE(PG8_SB(1, 0), cB + kstep, voffB); PG8_STAGE(PG8_SA(1, 0), cA + kstep, voffA); PG8_STAGE(PG8_SB(1, 1), cB + hstep + kstep, voffB);
        PG8_WAIT_V(6); PG8_BAR;
    } else {
        PG8_STAGE(PG8_SB(0, 0), cB, voffB); PG8_STAGE(PG8_SA(0, 0), cA, voffA); PG8_STAGE(PG8_SB(0, 1), cB + hstep, voffB); PG8_STAGE(PG8_SA(0, 1), cA + hstep, voffA);
        if (wr == 1) PG8_BAR;
        PG8_WAIT_V(4); PG8_BAR;
        PG8_STAGE(PG8_SB(1, 0), cB + kstep, voffB); PG8_STAGE(PG8_SA(1, 0), cA + kstep, voffA); PG8_STAGE(PG8_SB(1, 1), cB + hstep + kstep, voffB);
        PG8_WAIT_V(6); PG8_BAR;
    }
    for (;;) {
        const bool has_next = S.next(ui + 1, nxt);
        const char* nA = has_next ? (const char*)g.A + (size_t)nxt.pm * tstep : cA; const char* nB = has_next ? (const char*)g.Bt + (size_t)nxt.pn * tstep : cB;
        for (int t = 0; t < nt; t += 2) {
            const bool last = (t == nt - 2);
            const char* a1 = cA + (size_t)(t + 1) * kstep;
            const char* a2 = last ? nA : cA + (size_t)(t + 2) * kstep; const char* b2 = last ? nB : cB + (size_t)(t + 2) * kstep;
            const char* a3 = a2 + kstep; const char* b3 = b2 + kstep;
            if (last && has_next) S.a_ready(nxt);
            if constexpr (SP2) {
            PG8_LDB(B0, 0, 0); PG8_LDB(B1, 0, 1); PG8_SCHED; PG8_LDA(At, 0, 0); PG8_STAGE(PG8_SA(1, 1), a1 + hstep, voffA);
            PG8_WAIT_V(8); PG8_WAIT_L(0); PG8_BAR; PG8_MMA(0, 0, At, B0); PG8_MMA(0, 1, At, B1); PG8_BAR; PG8_SCHED;
            PG8_LDA(At, 0, 1); PG8_STAGE(PG8_SB(0, 0), b2, voffB); PG8_STAGE(PG8_SB(0, 1), b2 + hstep, voffB); PG8_STAGE(PG8_SA(0, 0), a2, voffA);
            PG8_WAIT_V(8); PG8_WAIT_L(0); PG8_BAR; PG8_MMA(1, 0, At, B0); PG8_MMA(1, 1, At, B1); PG8_BAR; PG8_SCHED;
            PG8_LDB(B0, 1, 0); PG8_LDB(B1, 1, 1); PG8_SCHED; PG8_LDA(At, 1, 0); PG8_STAGE(PG8_SA(0, 1), a2 + hstep, voffA);
            PG8_WAIT_V(8); PG8_WAIT_L(0); PG8_BAR; PG8_MMA(0, 0, At, B0); PG8_MMA(0, 1, At, B1); PG8_BAR; PG8_SCHED;
            PG8_LDA(At, 1, 1); PG8_STAGE(PG8_SB(1, 0), b3, voffB); PG8_STAGE(PG8_SB(1, 1), b3 + hstep, voffB); PG8_STAGE(PG8_SA(1, 0), a3, voffA);
            PG8_WAIT_V(8); PG8_WAIT_L(0); PG8_BAR; PG8_MMA(1, 0, At, B0); PG8_MMA(1, 1, At, B1); PG8_BAR; PG8_SCHED;
            } else {
            PG8_LDB(B0, 0, 0); PG8_SCHED; PG8_LDA(At, 0, 0); PG8_STAGE(PG8_SA(1, 1), a1 + hstep, voffA);
            PG8_WAIT_L(8); PG8_BAR; PG8_WAIT_L(0); PG8_MMA(0, 0, At, B0); PG8_BAR; PG8_SCHED;
            PG8_LDB(B1, 0, 1); PG8_STAGE(PG8_SB(0, 0), b2, voffB);
            PG8_BAR; PG8_WAIT_L(0); PG8_MMA(0, 1, At, B1); PG8_BAR;
            PG8_LDA(At, 0, 1); PG8_STAGE(PG8_SA(0, 0), a2, voffA);
            PG8_BAR; PG8_WAIT_L(0); PG8_MMA(1, 0, At, B0); PG8_BAR; PG8_SCHED;
            PG8_STAGE(PG8_SB(0, 1), b2 + hstep, voffB);
            PG8_WAIT_V(6); PG8_BAR; PG8_MMA(1, 1, At, B1); PG8_BAR;
            PG8_LDB(B0, 1, 0); PG8_SCHED; PG8_LDA(At, 1, 0); PG8_STAGE(PG8_SA(0, 1), a2 + hstep, voffA);
            PG8_WAIT_L(8); PG8_BAR; PG8_WAIT_L(0); PG8_MMA(0, 0, At, B0); PG8_BAR; PG8_SCHED;
            PG8_LDB(B1, 1, 1); PG8_STAGE(PG8_SB(1, 0), b3, voffB);
            PG8_BAR; PG8_WAIT_L(0); PG8_MMA(0, 1, At, B1); PG8_BAR;
            PG8_LDA(At, 1, 1); PG8_STAGE(PG8_SA(1, 0), a3, voffA);
            PG8_BAR; PG8_WAIT_L(0); PG8_MMA(1, 0, At, B0); PG8_BAR; PG8_SCHED;
            PG8_STAGE(PG8_SB(1, 1), b3 + hstep, voffB);
            PG8_WAIT_V(6); PG8_BAR; PG8_MMA(1, 1, At, B1); PG8_BAR;
            }
        }
        if constexpr (ALIGN_EPI) { if (wr == 0) PG8_BAR; }
        if constexpr (!Epi::AFTER_DRAIN) { E(acc, cur, wr, wc, fr, fq); S.done(cur); }
        if (!has_next) break;
#pragma unroll
        for (int a = 0; a < 2; ++a)
#pragma unroll
            for (int b = 0; b < 2; ++b)
#pragma unroll
                for (int m = 0; m < 4; ++m)
#pragma unroll
                    for (int n = 0; n < 2; ++n) acc[a][b][m][n] = (f32x4){0.f, 0.f, 0.f, 0.f};
        cur = nxt; cA = nA; cB = nB; ++ui;
        if constexpr (ALIGN_EPI) { if (wr == 1) PG8_BAR; }
    }
    PG8_WAIT_V(0);
    if constexpr (!ALIGN_EPI) { if (wr == 0) PG8_BAR; }
    PG8_BAR;
    if constexpr (Epi::AFTER_DRAIN) { E.fused(acc, cur, wr, wc, fr, fq, lds, wid, lane); S.done(cur); }
#undef PG8_SA
#undef PG8_SB
#undef PG8_STAGE
#undef PG8_LDA
#undef PG8_LDB
#undef PG8_MMA
#undef PG8_WAIT_V
#undef PG8_WAIT_L
#undef PG8_BAR
#undef PG8_SCHED
}
}
#include <hip/hip_cooperative_groups.h>
namespace cg = cooperative_groups;
#define LAS __attribute__((address_space(3)))
typedef unsigned short bf16;
typedef float f32x4 __attribute__((ext_vector_type(4)));
typedef short bf16x8 __attribute__((ext_vector_type(8)));
typedef unsigned v4u __attribute__((ext_vector_type(4)));
typedef unsigned v2u __attribute__((ext_vector_type(2)));
constexpr int D = 1024, NPR = 16384, NSM = 512, M = NPR + NSM, SEQ = 2048, NB = 8, DB = 128, FF = 2816, PLE = 256, NCH = 32;
constexpr int NWAVES = 8, LDS_BYTES = 147456, NPH = 22;
constexpr size_t WGU_SZ = (size_t)5632 * 1024 * 2, WDN_SZ = (size_t)1024 * 2816 * 2, WSQ_SZ = (size_t)1024 * 1024 * 2, WPP_SZ = (size_t)1024 * 256 * 2;
constexpr size_t OFF_WGU = 0, OFF_WDN = OFF_WGU + 4 * WGU_SZ, OFF_WGIN = OFF_WDN + 4 * WDN_SZ, OFF_WHIN = OFF_WGIN + (size_t)3328 * 1024 * 2,
    OFF_WOUT = OFF_WHIN + (size_t)4096 * 1024 * 2, OFF_WPG = OFF_WOUT + 2 * WSQ_SZ, OFF_WPP = OFF_WPG + 2 * WSQ_SZ, OFF_HB = OFF_WPP + 2 * WPP_SZ;
constexpr size_t HB_SZ = (size_t)M * 1024 * 2;
constexpr size_t OFF_BIG = OFF_HB + 2 * HB_SZ, OFF_PB = OFF_BIG + (size_t)M * 4096 * 2, PB_SZ = (size_t)M * 256 * 2, OFF_AB = OFF_PB + 2 * PB_SZ,
    OFF_DB = OFF_AB + (size_t)2048 * 4096 * 2, OFF_RS = OFF_DB + (size_t)2048 * 128 * 4, RS_SZ = (size_t)M * 16 * 4, OFF_R = OFF_RS + 2 * RS_SZ, OFF_PSB = OFF_R + RS_SZ, OFF_PP = OFF_PSB  , WS_END = OFF_PSB + (size_t)67108864, OFF_LBT = WS_END, OFF_CTL = OFF_LBT + 16384, CTL_BYTES = 16384, WS_TOTAL = OFF_CTL + CTL_BYTES;
constexpr size_t OUT_YS = (size_t)NPR * D, OUT_GP = (size_t)M * D, OUT_GS = OUT_GP + 1048576, OUT_HP = OUT_GS + 16777216, OUT_HS = OUT_HP + 1048576, OUT_END = OUT_HS + 16777216;

__device__ __forceinline__ float bf2f(unsigned short u) { return __uint_as_float((unsigned)u << 16); }
__device__ __forceinline__ float bflo(unsigned u) { return __uint_as_float(u << 16); }
__device__ __forceinline__ float bfhi(unsigned u) { return __uint_as_float(u & 0xffff0000u); }
__device__ __forceinline__ unsigned pk2(float lo, float hi) { return pg8::cvt_pk_bf16(lo, hi); }
__device__ __forceinline__ float sigm(float x) { return __builtin_amdgcn_rcpf(1.0f + __expf(-x)); }
__device__ __forceinline__ float logsig(float x) { return fminf(x, 0.f) - __logf(1.0f + __expf(-fabsf(x))); }
__device__ __forceinline__ float wave_sum(float v) {
#pragma unroll
    for (int o = 1; o < 64; o <<= 1) v += __shfl_xor(v, o);
    return v;
}
#define LDS_WAIT() asm volatile("s_waitcnt lgkmcnt(0)" ::: "memory")
#define BAR_LDS() do { asm volatile("s_waitcnt lgkmcnt(0)" ::: "memory"); __builtin_amdgcn_s_barrier(); asm volatile("" ::: "memory"); } while (0)

__device__ __forceinline__ void tr_item(const float* W, int Nsrc, int K, bf16* WT, const float* sk, int item, int nblk, int mode, int nvalid, LAS float* scr, int lane) {
    const int kb = item / nblk, nb = item % nblk, k0 = 64 * kb, n0 = 64 * nb;
    int src0 = n0, valid = 64;
    if (mode == 1) { const int pn = n0 >> 8, within = n0 & 255, half = within >> 7, j = within & 127; src0 = half * FF + 128 * pn + j; }
    if (mode == 2) { valid = nvalid - n0; valid = valid < 0 ? 0 : (valid > 64 ? 64 : valid); }
    const int c4 = (lane & 15) * 4, kr = lane >> 4;
    const float* wp = W + (size_t)(k0 + kr) * Nsrc + src0 + c4;
    f32x4 v[16];
#pragma unroll
    for (int i = 0; i < 16; ++i) v[i] = (c4 < valid) ? __builtin_nontemporal_load((const f32x4*)(wp + (size_t)(4 * i) * Nsrc)) : (f32x4){0.f, 0.f, 0.f, 0.f};
    __builtin_amdgcn_sched_barrier(0);
#pragma unroll
    for (int i = 0; i < 16; ++i) { const int kk = 4 * i + kr; const float s = sk ? sk[k0 + kk] : 1.0f; LAS float* d = scr + kk * 65 + c4; d[0] = v[i][0] * s; d[1] = v[i][1] * s; d[2] = v[i][2] * s; d[3] = v[i][3] * s; }
    LDS_WAIT();
    const int ch = lane & 7;
#pragma unroll
    for (int j = 0; j < 8; ++j) { const int n = (lane >> 3) + 8 * j; const LAS float* s = scr + (8 * ch) * 65 + n;
        v4u o; o.x = pk2(s[0 * 65], s[1 * 65]); o.y = pk2(s[2 * 65], s[3 * 65]); o.z = pk2(s[4 * 65], s[5 * 65]); o.w = pk2(s[6 * 65], s[7 * 65]);
        *(v4u*)(WT + (size_t)(n0 + n) * K + k0 + 8 * ch) = o; }
    LDS_WAIT();
}
struct Args { const float* in[26]; float* out; unsigned char* ws; int ph_lo, ph_hi; };
typedef const Args __attribute__((address_space(4))) CArgs;

__device__ __forceinline__ void prologue(CArgs* a, unsigned char* ws, float* outp, LAS unsigned char* lds, int tid, int bid, int G) {
    const int lane = tid & 63, wave = tid >> 6;
    LAS float* scr = (LAS float*)(lds + wave * 16640);
    const int gw = bid * NWAVES + wave, NGW = G * NWAVES;
    constexpr int I_GU = 16 * 88, I_DN = 44 * 16, I_GIN = 16 * 52, I_HIN = 16 * 64, I_SQ = 16 * 16, I_PP = 4 * 16;
    constexpr int NITEMS = 4 * I_GU + 4 * I_DN + I_GIN + I_HIN + 4 * I_SQ + 2 * I_PP;
    for (int it = gw; it < NITEMS; it += NGW) {
        int r = it;
        if (r < 4 * I_GU) { const int q = r / I_GU, li = q >> 1, f = q & 1; r -= q * I_GU;
            tr_item((f ? a->in[20] : a->in[7]) + (size_t)li * 1024 * 5632, 5632, 1024, (bf16*)(ws + OFF_WGU + q * WGU_SZ), (f ? a->in[19] : a->in[6]) + li * 1024, r, 88, 1, 0, scr, lane); continue; }
        r -= 4 * I_GU;
        if (r < 4 * I_DN) { const int q = r / I_DN, li = q >> 1, f = q & 1; r -= q * I_DN;
            tr_item((f ? a->in[21] : a->in[8]) + (size_t)li * 2816 * 1024, 1024, 2816, (bf16*)(ws + OFF_WDN + q * WDN_SZ), nullptr, r, 16, 0, 0, scr, lane); continue; }
        r -= 4 * I_DN;
        if (r < I_GIN) { tr_item(a->in[10], 3088, 1024, (bf16*)(ws + OFF_WGIN), a->in[9], r, 52, 2, 3088, scr, lane); continue; }
        r -= I_GIN;
        if (r < I_HIN) { tr_item(a->in[15], 4096, 1024, (bf16*)(ws + OFF_WHIN), a->in[9] + 1024, r, 64, 0, 0, scr, lane); continue; }
        r -= I_HIN;
        if (r < I_SQ) { tr_item(a->in[14], 1024, 1024, (bf16*)(ws + OFF_WOUT), nullptr, r, 16, 0, 0, scr, lane); continue; }
        r -= I_SQ;
        if (r < I_SQ) { tr_item(a->in[17], 1024, 1024, (bf16*)(ws + OFF_WOUT + WSQ_SZ), nullptr, r, 16, 0, 0, scr, lane); continue; }
        r -= I_SQ;
        if (r < 2 * I_SQ) { const int li = r / I_SQ; r -= li * I_SQ;
            tr_item(a->in[23] + (size_t)li * 1024 * 1024, 1024, 1024, (bf16*)(ws + OFF_WPG + li * WSQ_SZ), a->in[22] + li * 1024, r, 16, 0, 0, scr, lane); continue; }
        r -= 2 * I_SQ;
        { const int li = r / I_PP; r -= li * I_PP;
            tr_item(a->in[24] + (size_t)li * 256 * 1024, 1024, 256, (bf16*)(ws + OFF_WPP + li * WPP_SZ), nullptr, r, 16, 0, 0, scr, lane); }
    }
    bf16* hb = (bf16*)(ws + OFF_HB); float* rs = (float*)(ws + OFF_RS);
    for (int m0 = gw; m0 < M; m0 += 2 * NGW) {
        const int m1 = m0 + NGW; const bool has1 = m1 < M;
        const float* xr0 = m0 < NPR ? a->in[0] + (size_t)m0 * D : a->in[1] + (size_t)(m0 - NPR) * D;
        const float* xr1 = !has1 ? xr0 : (m1 < NPR ? a->in[0] + (size_t)m1 * D : a->in[1] + (size_t)(m1 - NPR) * D);
        f32x4 v0[4], v1[4];
#pragma unroll
        for (int j = 0; j < 4; ++j) { v0[j] = __builtin_nontemporal_load((const f32x4*)xr0 + lane + 64 * j); v1[j] = __builtin_nontemporal_load((const f32x4*)xr1 + lane + 64 * j); }
        float s0 = 0.f, s1 = 0.f;
#pragma unroll
        for (int j = 0; j < 4; ++j) { s0 += (v0[j][0] * v0[j][0] + v0[j][1] * v0[j][1]) + (v0[j][2] * v0[j][2] + v0[j][3] * v0[j][3]); s1 += (v1[j][0] * v1[j][0] + v1[j][1] * v1[j][1]) + (v1[j][2] * v1[j][2] + v1[j][3] * v1[j][3]);
            v2u w; w.x = pk2(v0[j][0], v0[j][1]); w.y = pk2(v0[j][2], v0[j][3]); *((v2u*)(hb + (size_t)m0 * D) + lane + 64 * j) = w;
            if (has1) { v2u w1; w1.x = pk2(v1[j][0], v1[j][1]); w1.y = pk2(v1[j][2], v1[j][3]); *((v2u*)(hb + (size_t)m1 * D) + lane + 64 * j) = w1; } }
        s0 = wave_sum(s0); s1 = wave_sum(s1);
        if (lane < 16) { rs[(size_t)m0 * 16 + lane] = lane == 0 ? s0 : 0.f; if (has1) rs[(size_t)m1 * 16 + lane] = lane == 0 ? s1 : 0.f; }
    }
    { const int gt0 = bid * (NWAVES * 64) + tid; if (gt0 < 1024) { const float x0 = a->in[18][gt0], x1 = a->in[18][1024 + gt0];
        *(f32x4*)((float*)(ws + OFF_LBT) + 4 * gt0) = (f32x4){logsig(x1 - x0), logsig(x0 - x1), sigm(x0 - x1), 0.f}; } }
    const int gt = bid * (NWAVES * 64) + tid, NGT = G * NWAVES * 64;
    for (int e = gt; e < 2 * M * 32; e += NGT) { const int li = e / (M * 32), rem = e % (M * 32), m = rem >> 5, c8 = (rem & 31) * 8;
        const float* src = m < NPR ? a->in[4] + ((size_t)li * NPR + m) * 256 + c8 : a->in[5] + ((size_t)li * NSM + (m - NPR)) * 256 + c8;
        const f32x4 v0 = __builtin_nontemporal_load((const f32x4*)src), v1 = __builtin_nontemporal_load((const f32x4*)(src + 4));
        v4u w; w.x = pk2(v0[0], v0[1]); w.y = pk2(v0[2], v0[3]); w.z = pk2(v1[0], v1[1]); w.w = pk2(v1[2], v1[3]);
        *(v4u*)((bf16*)(ws + OFF_PB + li * PB_SZ) + (size_t)m * 256 + c8) = w; }
}
template <bool HG> struct MX {
    static constexpr int H = HG ? 8 : 4, DV = HG ? 128 : 256, LDZ = HG ? 4096 : 3328, KC = HG ? 1024 : 512, VC = HG ? 2048 : 1024, GC = HG ? 3072 : 2048, VR = DV / 64, NVG = DV / 16, NVR = DV / 64;
    static constexpr float scale = HG ? 1.0f : 0.08838834764831845f;
};
template <bool HG> __device__ __forceinline__ void prep_phase(LAS unsigned char* lds, bf16* Z, const float* R, const float* wup, const float* bgk, const float* lbt, bf16* AB, float* DBUF, bf16* PB, int tid, int bid, int G) {
    typedef MX<HG> C; constexpr int H = C::H, DV = C::DV, LDZ = C::LDZ, KC = C::KC, VC = C::VC, VR = C::VR, QP = 136, TP = 72, NG = DV / 128, NGV = DV / 16;
    LAS float* gl = (LAS float*)lds; LAS float* segs = (LAS float*)(lds + 32768);
    LAS bf16* qe_s = (LAS bf16*)(lds + 34816); LAS bf16* kn_s = (LAS bf16*)(lds + 52224); LAS bf16* kdT_s = (LAS bf16*)(lds + 69632); LAS bf16* vT_s = (LAS bf16*)(lds + 88064);
    const int t = tid >> 3, cs = tid & 7, j0 = cs * 16, lane = tid & 63, w = tid >> 6;
    const int tsw = (((t >> 3) ^ cs) << 3) + (t & 7);
    v4u pq0, pq1, pk0, pk1, pv[DV / 64];
#define PREP_LOAD(u_) do { const int n_ = (u_) % NCH, bh_ = (u_) / NCH, h_ = bh_ % H, b_ = bh_ / H; const bf16* zr_ = Z + ((size_t)b_ * SEQ + 64 * n_ + t) * LDZ; \
        pq0 = *(const v4u*)(zr_ + h_ * 128 + j0); pq1 = *(const v4u*)(zr_ + h_ * 128 + j0 + 8); pk0 = *(const v4u*)(zr_ + KC + h_ * 128 + j0); pk1 = *(const v4u*)(zr_ + KC + h_ * 128 + j0 + 8); \
        _Pragma("unroll") for (int q_ = 0; q_ < DV / 64; ++q_) pv[q_] = *(const v4u*)(zr_ + VC + h_ * DV + cs * (DV / 8) + 8 * q_); } while (0)
    if (bid < NB * H * NCH) PREP_LOAD(bid);
    for (int unit = bid; unit < NB * H * NCH; unit += G) {
        const int n = unit % NCH, bh = unit / NCH, h = bh % H, b = bh / H;
        const size_t tok0 = (size_t)b * SEQ + 64 * n, m = tok0 + t;
        BAR_LDS();
        float lbc[16];
        if constexpr (!HG) {
            const int r = lane & 15, quad = lane >> 4, tb = w >> 1, cbase = 4 * (w & 1);
            float ar[4], br[4][4];
#pragma unroll
            for (int ks = 0; ks < 4; ++ks) { ar[ks] = R[(tok0 + 16 * tb + r) * 16 + 4 * ks + quad];
#pragma unroll
                for (int cb = 0; cb < 4; ++cb) br[cb][ks] = wup[(4 * ks + quad) * 512 + h * 128 + 16 * (cbase + cb) + r]; }
            float bias[4];
#pragma unroll
            for (int cb = 0; cb < 4; ++cb) bias[cb] = bgk[h * 128 + 16 * (cbase + cb) + r];
#pragma unroll
            for (int cb = 0; cb < 4; ++cb) { f32x4 c = {0.f, 0.f, 0.f, 0.f};
#pragma unroll
                for (int ks = 0; ks < 4; ++ks) c = __builtin_amdgcn_mfma_f32_16x16x4f32(ar[ks], br[cb][ks], c, 0, 0, 0);
#pragma unroll
                for (int j = 0; j < 4; ++j) gl[(16 * tb + 4 * quad + j) * 128 + 16 * (cbase + cb) + r] = logsig(c[j] + bias[cb]) * (1.0f / 16.0f); }
#pragma unroll
            for (int jj = 0; jj < 16; ++jj) lbc[jj] = 0.f;
        } else {
            float g[16];
            const unsigned fw[8] = {pk0.x, pk0.y, pk0.z, pk0.w, pk1.x, pk1.y, pk1.z, pk1.w};
#pragma unroll
            for (int jj = 0; jj < 16; ++jj) { const float f = (jj & 1) ? bfhi(fw[jj >> 1]) : bflo(fw[jj >> 1]);
                const f32x4 tc = *(const f32x4*)(lbt + (size_t)(h * 128 + j0 + jj) * 4);
                const float a = tc[0], b2 = tc[1] + logsig(f), mx = fmaxf(a, b2);
                g[jj] = mx + __logf(1.0f + __expf(-fabsf(a - b2))); lbc[jj] = tc[2]; }
#pragma unroll
            for (int q = 0; q < 4; ++q) *(LAS f32x4*)(gl + t * 128 + j0 + 4 * q) = (f32x4){g[4 * q], g[4 * q + 1], g[4 * q + 2], g[4 * q + 3]};
        }
        BAR_LDS();
        {
            const int j = tid & 127, sg = tid >> 7; float acc = 0.f;
#pragma unroll
            for (int i = 0; i < 16; ++i) { acc += gl[(16 * sg + i) * 128 + j]; gl[(16 * sg + i) * 128 + j] = acc; }
            segs[sg * 128 + j] = acc;
            BAR_LDS();
            float off = 0.f;
            for (int s2 = 0; s2 < sg; ++s2) off += segs[s2 * 128 + j];
            if (sg) {
#pragma unroll
                for (int i = 0; i < 16; ++i) gl[(16 * sg + i) * 128 + j] += off; }
        }
        BAR_LDS();
        {
            bf16* qp = Z + m * LDZ + h * 128 + j0;
            const v4u q0 = pq0, q1 = pq1, k0 = pk0, k1 = pk1;
            const unsigned qw[8] = {q0.x, q0.y, q0.z, q0.w, q1.x, q1.y, q1.z, q1.w}, kw[8] = {k0.x, k0.y, k0.z, k0.w, k1.x, k1.y, k1.z, k1.w};
            float bb[16], bl[16];
#pragma unroll
            for (int q = 0; q < 4; ++q) { const f32x4 x = *(const LAS f32x4*)(gl + t * 128 + j0 + 4 * q), y = *(const LAS f32x4*)(gl + 63 * 128 + j0 + 4 * q);
                bb[4 * q] = x[0]; bb[4 * q + 1] = x[1]; bb[4 * q + 2] = x[2]; bb[4 * q + 3] = x[3]; bl[4 * q] = y[0]; bl[4 * q + 1] = y[1]; bl[4 * q + 2] = y[2]; bl[4 * q + 3] = y[3]; }
            float qe[16], kn[16], kd[16];
#pragma unroll
            for (int jj = 0; jj < 16; ++jj) { float qv = (jj & 1) ? bfhi(qw[jj >> 1]) : bflo(qw[jj >> 1]); float kv = (jj & 1) ? bfhi(kw[jj >> 1]) : bflo(kw[jj >> 1]);
                if constexpr (HG) { qv = qv * sigm(qv); kv = lbc[jj] * sigm(-kv); }
                qe[jj] = qv * __expf(bb[jj]) * C::scale; kn[jj] = kv * __expf(-bb[jj]); kd[jj] = kv * __expf(bl[jj] - bb[jj]); }
            v4u o0, o1;
            o0.x = pk2(qe[0], qe[1]); o0.y = pk2(qe[2], qe[3]); o0.z = pk2(qe[4], qe[5]); o0.w = pk2(qe[6], qe[7]); o1.x = pk2(qe[8], qe[9]); o1.y = pk2(qe[10], qe[11]); o1.z = pk2(qe[12], qe[13]); o1.w = pk2(qe[14], qe[15]);
            *(v4u*)qp = o0; *(v4u*)(qp + 8) = o1; *(LAS v4u*)(qe_s + t * QP + j0) = o0; *(LAS v4u*)(qe_s + t * QP + j0 + 8) = o1;
            o0.x = pk2(kn[0], kn[1]); o0.y = pk2(kn[2], kn[3]); o0.z = pk2(kn[4], kn[5]); o0.w = pk2(kn[6], kn[7]); o1.x = pk2(kn[8], kn[9]); o1.y = pk2(kn[10], kn[11]); o1.z = pk2(kn[12], kn[13]); o1.w = pk2(kn[14], kn[15]);
            *(LAS v4u*)(kn_s + t * QP + j0) = o0; *(LAS v4u*)(kn_s + t * QP + j0 + 8) = o1;
#pragma unroll
            for (int jj = 0; jj < 16; jj += 2) { const unsigned pw = pk2(kd[jj], kd[jj + 1]); kdT_s[(j0 + jj) * TP + tsw] = (bf16)(pw & 0xffffu); kdT_s[(j0 + jj + 1) * TP + tsw] = (bf16)(pw >> 16); }
            if (t == 63) {
#pragma unroll
                for (int q = 0; q < 4; ++q) *(f32x4*)(DBUF + (size_t)unit * 128 + j0 + 4 * q) = (f32x4){__expf(bl[4 * q]), __expf(bl[4 * q + 1]), __expf(bl[4 * q + 2]), __expf(bl[4 * q + 3])}; }
#pragma unroll
            for (int q = 0; q < DV / 64; ++q) { const v4u x = pv[q]; const unsigned xw[4] = {x.x, x.y, x.z, x.w};
#pragma unroll
                for (int e = 0; e < 4; ++e) { const int v = cs * (DV / 8) + 8 * q + 2 * e; vT_s[v * TP + tsw] = (bf16)(xw[e] & 0xffffu); vT_s[(v + 1) * TP + tsw] = (bf16)(xw[e] >> 16); } }
        }
        BAR_LDS();
        if (unit + G < NB * H * NCH) PREP_LOAD(unit + G);
        {
            const int r = lane & 15, quad = lane >> 4, tb = w >> 1;
#pragma unroll
            for (int e = 0; e < 2; ++e) { const int sb = 2 * (w & 1) + e; f32x4 c = {0.f, 0.f, 0.f, 0.f};
                if (sb <= tb) {
#pragma unroll
                    for (int ks = 0; ks < 4; ++ks) { const bf16x8 av = *(const LAS bf16x8*)(kn_s + (16 * sb + r) * QP + 32 * ks + 8 * quad), bv = *(const LAS bf16x8*)(qe_s + (16 * tb + r) * QP + 32 * ks + 8 * quad);
                        c = __builtin_amdgcn_mfma_f32_16x16x32_bf16(av, bv, c, 0, 0, 0); } }
                const int tc = 16 * tb + r, s0 = 16 * sb + 4 * quad;
                v2u o; o.x = pk2(s0 <= tc ? c[0] : 0.f, s0 + 1 <= tc ? c[1] : 0.f); o.y = pk2(s0 + 2 <= tc ? c[2] : 0.f, s0 + 3 <= tc ? c[3] : 0.f);
                *(v2u*)(AB + (size_t)unit * 4096 + tc * 64 + s0) = o; }
        }
        {
            const int r = lane & 15, quad = lane >> 4;
#pragma unroll
            for (int vg = 0; vg < NG; ++vg) { const int gv = w * NG + vg;
                const int csv = HG ? gv : (gv >> 1);
                const bf16x8 b0 = *(const LAS bf16x8*)(vT_s + (16 * gv + r) * TP + 8 * (quad ^ csv)), b1 = *(const LAS bf16x8*)(vT_s + (16 * gv + r) * TP + 8 * ((4 + quad) ^ csv));
#pragma unroll
                for (int kb = 0; kb < 8; ++kb) { const bf16x8 a0 = *(const LAS bf16x8*)(kdT_s + (16 * kb + r) * TP + 8 * (quad ^ kb)), a1 = *(const LAS bf16x8*)(kdT_s + (16 * kb + r) * TP + 8 * ((4 + quad) ^ kb));
                    f32x4 c = {0.f, 0.f, 0.f, 0.f}; c = __builtin_amdgcn_mfma_f32_16x16x32_bf16(a0, b0, c, 0, 0, 0); c = __builtin_amdgcn_mfma_f32_16x16x32_bf16(a1, b1, c, 0, 0, 0);
                    v2u o; o.x = pk2(c[0], c[1]); o.y = pk2(c[2], c[3]);
                    *(v2u*)(PB + (((size_t)unit * NGV + gv) * 4 + (kb >> 1)) * 512 + lane * 8 + (kb & 1) * 4) = o; } }
        }
        for (int c = tid; c < DV * 4; c += NWAVES * 64) { const int v = c >> 2, sq = c & 3;
            const int csv = v / (DV / 8);
            const v4u x0 = *(const LAS v4u*)(vT_s + v * TP + 8 * ((2 * sq) ^ csv)), x1 = *(const LAS v4u*)(vT_s + v * TP + 8 * ((2 * sq + 1) ^ csv));
            bf16* dst = Z + (tok0 + v / VR) * LDZ + VC + h * DV + (v % VR) * 64 + 16 * sq;
            *(v4u*)dst = x0; *(v4u*)(dst + 8) = x1; }
    }
#undef PREP_LOAD
}
template <bool HG> __device__ __forceinline__ void state_phase(bf16* PSB, const float* DBUF, float* Sout, int gt, int ngt) {
    typedef MX<HG> C; constexpr int H = C::H, DV = C::DV, NGV = DV / 16, TOTAL = NB * H * NGV * 4 * 64;
    for (int idx = gt; idx < TOTAL; idx += ngt) {
        const int lane = idx & 63, ks = (idx >> 6) & 3, gvb = idx >> 8, gv = gvb % NGV, bh = gvb / NGV, quad = lane >> 4, r = lane & 15;
        f32x4 S0 = {0.f, 0.f, 0.f, 0.f}, S1 = {0.f, 0.f, 0.f, 0.f};
        bf16* pp = PSB + (((size_t)bh * NCH * NGV + gv) * 4 + ks) * 512 + lane * 8; const float* dp = DBUF + (size_t)bh * NCH * 128 + 32 * ks + 4 * quad;
        for (int n0 = 0; n0 < NCH; n0 += 8) {
            v4u p[8]; f32x4 d0[8], d1[8];
#pragma unroll
            for (int i = 0; i < 8; ++i) { p[i] = *(const v4u*)(pp + (size_t)(n0 + i) * NGV * 2048); d0[i] = *(const f32x4*)(dp + (n0 + i) * 128); d1[i] = *(const f32x4*)(dp + (n0 + i) * 128 + 16); }
            __builtin_amdgcn_sched_barrier(0);
#pragma unroll
            for (int i = 0; i < 8; ++i) { v4u o; o.x = pk2(S0[0], S0[1]); o.y = pk2(S0[2], S0[3]); o.z = pk2(S1[0], S1[1]); o.w = pk2(S1[2], S1[3]);
                *(v4u*)(pp + (size_t)(n0 + i) * NGV * 2048) = o;
                S0 = S0 * d0[i] + (f32x4){bflo(p[i].x), bfhi(p[i].x), bflo(p[i].y), bfhi(p[i].y)}; S1 = S1 * d1[i] + (f32x4){bflo(p[i].z), bfhi(p[i].z), bflo(p[i].w), bfhi(p[i].w)}; }
        }
        float* so = Sout + ((size_t)bh * 128 + 32 * ks + 4 * quad) * DV + 16 * gv + r;
#pragma unroll
        for (int j = 0; j < 4; ++j) { so[j * DV] = S0[j]; so[(16 + j) * DV] = S1[j]; }
    }
}
template <bool HG> __device__ __forceinline__ void out_phase(LAS unsigned char* lds, const bf16* Z, const bf16* AB, const bf16* PSB, bf16* OG, const float* gn, int tid, int w, int bid, int G) {
    typedef MX<HG> C; constexpr int H = C::H, DV = C::DV, LDZ = C::LDZ, VC = C::VC, GC = C::GC, VR = C::VR, VW = DV / 8, NG = VW / 16, NGV = DV / 16, NU = NB * H * NCH;
    constexpr int QP = 136, AP = 72, OFF_QE = 0, OFF_AA = 64 * QP * 2, BUFSZ = OFF_AA + 64 * AP * 2, OFF_SS = 2 * BUFSZ;
    const int lane = tid & 63, r = lane & 15, quad = lane >> 4, vbase = w * VW;
    f32x4 gnv[NG];
#pragma unroll
    for (int vg = 0; vg < NG; ++vg) gnv[vg] = *(const f32x4*)(gn + vbase + 16 * vg + 4 * quad);
    unsigned oq[2], ov[NG], sq[2];
#pragma unroll
    for (int i = 0; i < 2; ++i) { const int p = tid + 512 * i, row = p >> 4, c16 = p & 15; oq[i] = (unsigned)(row * LDZ + 8 * c16) * 2u; sq[i] = (unsigned)(row * QP + 8 * c16) * 2u; }
#pragma unroll
    for (int vg = 0; vg < NG; ++vg) { const int v = vbase + 16 * vg + r; ov[vg] = (unsigned)((v / VR) * LDZ + (v % VR) * 64 + 8 * quad) * 2u; }
    unsigned oa = (unsigned)tid * 16u, og = (unsigned)(r * LDZ + 4 * quad) * 2u, oo = (unsigned)(r * 1024 + 4 * quad) * 2u, osb = (unsigned)lane * 16u;
    unsigned lq = (unsigned)(r * QP + 4 * quad) * 2u, la = (unsigned)(r * AP + 8 * quad) * 2u, sa = (unsigned)((tid >> 3) * AP + 8 * (tid & 7)) * 2u;
    v4u pq[2], pa; bf16x8 sb[NG][4], vb[NG][2], sbn[NG][4], vbn[NG][2];
#define OP_BASES(u_) const int n_ = (u_) % NCH, bh_ = (u_) / NCH, h_ = bh_ % H, b_ = bh_ / H; const size_t tk_ = (size_t)b_ * SEQ + 64 * n_; \
        const char* zq_ = (const char*)(Z + tk_ * LDZ + h_ * 128); const char* zv_ = (const char*)(Z + tk_ * LDZ + VC + h_ * DV); const char* ab_ = (const char*)(AB + (size_t)(u_) * 4096); \
        const char* sb_ = (const char*)(PSB + ((size_t)(u_) * NGV + w * NG) * 2048)
#define OP_ISSUE(u_) do { OP_BASES(u_); pq[0] = *(const v4u*)(zq_ + oq[0]); pq[1] = *(const v4u*)(zq_ + oq[1]); pa = *(const v4u*)(ab_ + oa); \
        _Pragma("unroll") for (int vg = 0; vg < NG; ++vg) { _Pragma("unroll") for (int ks = 0; ks < 4; ++ks) sbn[vg][ks] = *(const bf16x8*)(sb_ + (vg * 4 + ks) * 1024 + osb); \
            vbn[vg][0] = *(const bf16x8*)(zv_ + ov[vg]); vbn[vg][1] = *(const bf16x8*)(zv_ + ov[vg] + 64); } } while (0)
#define OP_STAGE(buf_) do { LAS unsigned char* bs_ = lds + (buf_) * BUFSZ; *(LAS v4u*)(bs_ + OFF_QE + sq[0]) = pq[0]; *(LAS v4u*)(bs_ + OFF_QE + sq[1]) = pq[1]; *(LAS v4u*)(bs_ + OFF_AA + sa) = pa; } while (0)
#define OP_TAKE() do { _Pragma("unroll") for (int vg = 0; vg < NG; ++vg) { _Pragma("unroll") for (int ks = 0; ks < 4; ++ks) sb[vg][ks] = sbn[vg][ks]; vb[vg][0] = vbn[vg][0]; vb[vg][1] = vbn[vg][1]; } } while (0)
    OP_ISSUE(bid); OP_STAGE(0); OP_TAKE();
    BAR_LDS();
    int par = 0;
    for (int unit = bid; unit < NU; unit += G, par ^= 1) {
        asm volatile("" : "+v"(oq[0]), "+v"(oq[1]), "+v"(oa), "+v"(og), "+v"(oo), "+v"(osb), "+v"(lq), "+v"(la), "+v"(sa), "+v"(sq[0]), "+v"(sq[1]));
#pragma unroll
        for (int vg = 0; vg < NG; ++vg) asm volatile("" : "+v"(ov[vg]));
        const int n = unit % NCH, bh = unit / NCH, h = bh % H, b = bh / H; const size_t tok0 = (size_t)b * SEQ + 64 * n;
        const char* zg = (const char*)(Z + tok0 * LDZ + GC + h * DV + vbase);
        v2u gq[NG][4];
#pragma unroll
        for (int tb = 0; tb < 4; ++tb)
#pragma unroll
            for (int vg = 0; vg < NG; ++vg) gq[vg][tb] = *(const v2u*)(zg + (size_t)tb * 16 * LDZ * 2 + og + 32 * vg);
        const bool more = unit + G < NU;
        if (more) OP_ISSUE(unit + G);
        const LAS unsigned char* bs = lds + par * BUFSZ;
        f32x4 o[NG][4];
#pragma unroll
        for (int vg = 0; vg < NG; ++vg)
#pragma unroll
            for (int tb = 0; tb < 4; ++tb) o[vg][tb] = (f32x4){0.f, 0.f, 0.f, 0.f};
#pragma unroll
        for (int kh = 0; kh < 2; ++kh) { bf16x8 qf[2][4];
#pragma unroll
            for (int kl = 0; kl < 2; ++kl)
#pragma unroll
                for (int tb = 0; tb < 4; ++tb) { const LAS unsigned char* qa = bs + OFF_QE + lq + (16 * tb * QP + 32 * (2 * kh + kl)) * 2;
                    const v2u lo = *(const LAS v2u*)qa, hi = *(const LAS v2u*)(qa + 32); qf[kl][tb] = __builtin_bit_cast(bf16x8, ((v4u){lo.x, lo.y, hi.x, hi.y})); }
            __builtin_amdgcn_sched_barrier(0);
#pragma unroll
            for (int kl = 0; kl < 2; ++kl)
#pragma unroll
                for (int tb = 0; tb < 4; ++tb)
#pragma unroll
                    for (int vg = 0; vg < NG; ++vg) o[vg][tb] = __builtin_amdgcn_mfma_f32_16x16x32_bf16(sb[vg][2 * kh + kl], qf[kl][tb], o[vg][tb], 0, 0, 0);
            __builtin_amdgcn_sched_barrier(0); }
        { bf16x8 af[4][2];
#pragma unroll
            for (int tb = 0; tb < 4; ++tb) { const LAS unsigned char* aa = bs + OFF_AA + la + 16 * tb * AP * 2; af[tb][0] = *(const LAS bf16x8*)aa; af[tb][1] = *(const LAS bf16x8*)(aa + 64); }
            __builtin_amdgcn_sched_barrier(0);
#pragma unroll
            for (int js = 0; js < 2; ++js)
#pragma unroll
                for (int tb = 0; tb < 4; ++tb)
#pragma unroll
                    for (int vg = 0; vg < NG; ++vg) o[vg][tb] = __builtin_amdgcn_mfma_f32_16x16x32_bf16(vb[vg][js], af[tb][js], o[vg][tb], 0, 0, 0);
            __builtin_amdgcn_sched_barrier(0); }
        LAS float* ssb = (LAS float*)(lds + OFF_SS + par * 2048);
#pragma unroll
        for (int tb = 0; tb < 4; ++tb) { float p = 0.f;
#pragma unroll
            for (int vg = 0; vg < NG; ++vg) p += (o[vg][tb][0] * o[vg][tb][0] + o[vg][tb][1] * o[vg][tb][1]) + (o[vg][tb][2] * o[vg][tb][2] + o[vg][tb][3] * o[vg][tb][3]);
            p += __shfl_xor(p, 16); p += __shfl_xor(p, 32);
            if (quad == 0) ssb[(16 * tb + r) * 8 + w] = p; }
        if (more) { OP_STAGE(par ^ 1); OP_TAKE(); }
        BAR_LDS();
        char* ogn = (char*)(OG + tok0 * 1024 + h * DV + vbase);
#pragma unroll
        for (int tb = 0; tb < 4; ++tb) { const f32x4 s0 = *(const LAS f32x4*)(ssb + (16 * tb + r) * 8), s1 = *(const LAS f32x4*)(ssb + (16 * tb + r) * 8 + 4);
            const float tot = ((s0[0] + s0[1]) + (s0[2] + s0[3])) + ((s1[0] + s1[1]) + (s1[2] + s1[3])); const float rinv = rsqrtf(tot * (1.0f / DV) + 1e-6f);
#pragma unroll
            for (int vg = 0; vg < NG; ++vg) { const float g0 = bflo(gq[vg][tb].x), g1 = bfhi(gq[vg][tb].x), g2 = bflo(gq[vg][tb].y), g3 = bfhi(gq[vg][tb].y);
                const f32x4 y = o[vg][tb] * rinv * gnv[vg]; v2u pw; pw.x = pk2(y[0] * g0 * sigm(g0), y[1] * g1 * sigm(g1)); pw.y = pk2(y[2] * g2 * sigm(g2), y[3] * g3 * sigm(g3));
                *(v2u*)(ogn + (size_t)tb * 16 * 1024 * 2 + oo + 32 * vg) = pw; } }
    }
#undef OP_BASES
#undef OP_ISSUE
#undef OP_STAGE
#undef OP_TAKE
}
template <bool HG> __device__ __forceinline__ void sample_block(LAS unsigned char* lds, const bf16* Z, const float* R, const float* wup, const float* bgk, const float* lowb, const float* gn, const float* S0, float* Sout, bf16* OG, int bh, int tid, int w) {
    typedef MX<HG> C; constexpr int H = C::H, DV = C::DV, LDZ = C::LDZ, KC = C::KC, VC = C::VC, GC = C::GC, E = DV / 64;
    const int lane = tid & 63, kk = lane >> 2, t = lane & 3, k = 16 * w + kk, h = bh % H, b = bh / H, hk = h * 128 + k; const size_t m0 = (size_t)NPR + 4 * b;
    LAS float* tab = (LAS float*)lds + w * 192; LAS float* pas = (LAS float*)(lds + 6144); LAS float* red = (LAS float*)(lds + 8192);
    const float* sp = S0 + ((size_t)bh * 128 + 16 * w) * DV + E * lane; float* dp = Sout + ((size_t)bh * 128 + 16 * w) * DV + E * lane;
    float s0[16][E];
#pragma unroll
    for (int i = 0; i < 16; ++i) {
        if constexpr (E == 4) { const f32x4 x = __builtin_nontemporal_load((const f32x4*)(sp + (size_t)i * DV)); s0[i][0] = x[0]; s0[i][1] = x[1]; s0[i][2] = x[2]; s0[i][3] = x[3]; }
        else { const v2u x = __builtin_nontemporal_load((const v2u*)(sp + (size_t)i * DV)); s0[i][0] = __uint_as_float(x.x); s0[i][1] = __uint_as_float(x.y); } }
    float vv[4][E];
#pragma unroll
    for (int s = 0; s < 4; ++s) { const bf16* zv = Z + (m0 + s) * LDZ + VC + h * DV + E * lane;
        if constexpr (E == 4) { const v2u x = *(const v2u*)zv; vv[s][0] = bflo(x.x); vv[s][1] = bfhi(x.x); vv[s][2] = bflo(x.y); vv[s][3] = bfhi(x.y); }
        else { const unsigned x = *(const unsigned*)zv; vv[s][0] = bflo(x); vv[s][1] = bfhi(x); } }
    const bf16* zr = Z + (m0 + t) * LDZ; float q = bf2f(zr[hk]); const float kz = bf2f(zr[KC + hk]); float g, kv;
    if constexpr (!HG) { float x = bgk[hk];
#pragma unroll
        for (int i = 0; i < 16; ++i) x += R[(m0 + t) * 16 + i] * wup[i * 512 + hk];
        g = logsig(x) * (1.0f / 16.0f); kv = kz;
    } else { const float x0 = lowb[hk], x1 = lowb[1024 + hk]; const float a = logsig(x1 - x0), b2 = logsig(x0 - x1) + logsig(kz), mx = fmaxf(a, b2);
        g = mx + __logf(1.0f + __expf(-fabsf(a - b2))); kv = sigm(x0 - x1) * sigm(-kz); q = q * sigm(q); }
    const int l0 = lane & ~3;
    const float g0 = __shfl(g, l0), g1 = __shfl(g, l0 + 1), g2 = __shfl(g, l0 + 2), g3 = __shfl(g, l0 + 3);
    const float b3 = ((g0 + g1) + g2) + g3, bt = t == 0 ? g0 : (t == 1 ? g0 + g1 : (t == 2 ? (g0 + g1) + g2 : b3));
    const float qe = q * __expf(bt) * C::scale, kn = kv * __expf(-bt), kd = kv * __expf(b3 - bt);
    tab[kk * 12 + t] = qe; tab[kk * 12 + 4 + t] = kd; if (t == 0) tab[kk * 12 + 8] = __expf(b3);
    {
        float p[4];
#pragma unroll
        for (int s = 0; s < 4; ++s) { p[s] = qe * __shfl(kn, l0 + s);
            p[s] += __shfl_xor(p[s], 4); p[s] += __shfl_xor(p[s], 8); p[s] += __shfl_xor(p[s], 16); p[s] += __shfl_xor(p[s], 32); }
        if (lane < 4) *(LAS f32x4*)(pas + w * 16 + 4 * lane) = (f32x4){p[0], p[1], p[2], p[3]};
    }
    LDS_WAIT();
    float o[4][E];
#pragma unroll
    for (int tt = 0; tt < 4; ++tt)
#pragma unroll
        for (int e = 0; e < E; ++e) o[tt][e] = 0.f;
#pragma unroll
    for (int i = 0; i < 16; ++i) { const f32x4 q4 = *(const LAS f32x4*)(tab + i * 12), k4 = *(const LAS f32x4*)(tab + i * 12 + 4); const float d = tab[i * 12 + 8]; float sn[E];
#pragma unroll
        for (int e = 0; e < E; ++e) { o[0][e] += q4[0] * s0[i][e]; o[1][e] += q4[1] * s0[i][e]; o[2][e] += q4[2] * s0[i][e]; o[3][e] += q4[3] * s0[i][e];
            sn[e] = d * s0[i][e] + ((k4[0] * vv[0][e] + k4[1] * vv[1][e]) + (k4[2] * vv[2][e] + k4[3] * vv[3][e])); }
        if constexpr (E == 4) __builtin_nontemporal_store(((f32x4){sn[0], sn[1], sn[2], sn[3]}), (f32x4*)(dp + (size_t)i * DV));
        else { v2u x; x.x = __float_as_uint(sn[0]); x.y = __float_as_uint(sn[1]); __builtin_nontemporal_store(x, (v2u*)(dp + (size_t)i * DV)); } }
#pragma unroll
    for (int tt = 0; tt < 4; ++tt) {
        if constexpr (E == 4) *(LAS f32x4*)(red + (w * 4 + tt) * DV + 4 * lane) = (f32x4){o[tt][0], o[tt][1], o[tt][2], o[tt][3]};
        else { red[(w * 4 + tt) * DV + 2 * lane] = o[tt][0]; red[(w * 4 + tt) * DV + 2 * lane + 1] = o[tt][1]; } }
    BAR_LDS();
    if (w < 4) {
        float y[E];
#pragma unroll
        for (int e = 0; e < E; ++e) y[e] = 0.f;
#pragma unroll
        for (int ww = 0; ww < 8; ++ww)
#pragma unroll
            for (int e = 0; e < E; ++e) y[e] += red[(ww * 4 + w) * DV + E * lane + e];
#pragma unroll
        for (int s = 0; s < 4; ++s) if (s <= w) { float a = 0.f;
#pragma unroll
            for (int ww = 0; ww < 8; ++ww) a += pas[ww * 16 + 4 * w + s];
#pragma unroll
            for (int e = 0; e < E; ++e) y[e] += a * vv[s][e]; }
        float ss = 0.f;
#pragma unroll
        for (int e = 0; e < E; ++e) ss += y[e] * y[e];
        ss = wave_sum(ss); const float rinv = rsqrtf(ss * (1.0f / DV) + 1e-6f);
        const bf16* zg = Z + (m0 + w) * LDZ + GC + h * DV + E * lane; bf16* op = OG + (m0 + w) * 1024 + h * DV + E * lane; float gg[E];
        if constexpr (E == 4) { const v2u x = *(const v2u*)zg; gg[0] = bflo(x.x); gg[1] = bfhi(x.x); gg[2] = bflo(x.y); gg[3] = bfhi(x.y); } else { const unsigned x = *(const unsigned*)zg; gg[0] = bflo(x); gg[1] = bfhi(x); }
#pragma unroll
        for (int e = 0; e < E; ++e) y[e] = y[e] * rinv * gn[E * lane + e] * (gg[e] * sigm(gg[e]));
        if constexpr (E == 4) { v2u pw; pw.x = pk2(y[0], y[1]); pw.y = pk2(y[2], y[3]); *(v2u*)op = pw; } else { *(unsigned*)op = pk2(y[0], y[1]); }
    }
    BAR_LDS();
}
template <int NKS> __device__ __forceinline__ void mini_acc(f32x4 (&acc)[2][4], const bf16* ap, size_t lda, const bf16* bp, size_t ldb) {
#pragma unroll
    for (int c = 0; c < NKS; c += 4) {
        bf16x8 af[4][2], bfr[4][4];
#pragma unroll
        for (int ks = 0; ks < 4; ++ks) if (c + ks < NKS) {
#pragma unroll
            for (int rb = 0; rb < 2; ++rb) af[ks][rb] = *(const bf16x8*)(ap + (size_t)(16 * rb) * lda + 32 * (c + ks));
#pragma unroll
            for (int cb = 0; cb < 4; ++cb) bfr[ks][cb] = *(const bf16x8*)(bp + (size_t)(16 * cb) * ldb + 32 * (c + ks)); }
        __builtin_amdgcn_sched_barrier(0);
#pragma unroll
        for (int ks = 0; ks < 4; ++ks) if (c + ks < NKS) {
#pragma unroll
            for (int rb = 0; rb < 2; ++rb)
#pragma unroll
                for (int cb = 0; cb < 4; ++cb) acc[rb][cb] = __builtin_amdgcn_mfma_f32_16x16x32_bf16(bfr[ks][cb], af[ks][rb], acc[rb][cb], 0, 0, 0); }
        __builtin_amdgcn_sched_barrier(0);
    }
}
template <int MODE, int K> __device__ __forceinline__ void mini_gemm(LAS unsigned char* lds, const bf16* A, const bf16* Bt, const bf16* A2, const bf16* Bt2, const float* xin, const bf16* hb_in, bf16* hb_out, const float* rs_in, float* rs_out, float alpha, int tid, int bid, int G) {
    const int lane = tid & 63, w = tid >> 6, r = lane & 15, quad = lane >> 4;
    LAS float* P = (LAS float*)lds; LAS float* P2 = (LAS float*)(lds + 65536);
    for (int mt = bid; mt < 256; mt += G) {
        const int rt = mt >> 4, ct = mt & 15, row0 = NPR + 32 * rt, col0 = 64 * ct;
        f32x4 acc[2][4];
#pragma unroll
        for (int rb = 0; rb < 2; ++rb)
#pragma unroll
            for (int cb = 0; cb < 4; ++cb) acc[rb][cb] = (f32x4){0.f, 0.f, 0.f, 0.f};
        constexpr int KW = K / 8;
        mini_acc<KW / 32>(acc, A + (size_t)(row0 + r) * K + w * KW + 8 * quad, K, Bt + (size_t)(col0 + r) * K + w * KW + 8 * quad, K);
#pragma unroll
        for (int rb = 0; rb < 2; ++rb)
#pragma unroll
            for (int cb = 0; cb < 4; ++cb) *(LAS f32x4*)(P + (w * 32 + 16 * rb + r) * 64 + 16 * cb + 4 * quad) = acc[rb][cb];
        if constexpr (MODE == 1) {
#pragma unroll
            for (int rb = 0; rb < 2; ++rb)
#pragma unroll
                for (int cb = 0; cb < 4; ++cb) acc[rb][cb] = (f32x4){0.f, 0.f, 0.f, 0.f};
            mini_acc<1>(acc, A2 + (size_t)(row0 + r) * 256 + w * 32 + 8 * quad, 256, Bt2 + (size_t)(col0 + r) * 256 + w * 32 + 8 * quad, 256);
#pragma unroll
            for (int rb = 0; rb < 2; ++rb)
#pragma unroll
                for (int cb = 0; cb < 4; ++cb) *(LAS f32x4*)(P2 + (w * 32 + 16 * rb + r) * 64 + 16 * cb + 4 * quad) = acc[rb][cb];
        }
        BAR_LDS();
        const int row = tid >> 4, c4 = (tid & 15) * 4; f32x4 v = {0.f, 0.f, 0.f, 0.f}, v2 = {0.f, 0.f, 0.f, 0.f};
#pragma unroll
        for (int ww = 0; ww < 8; ++ww) { v += *(const LAS f32x4*)(P + (ww * 32 + row) * 64 + c4); if constexpr (MODE == 1) v2 += *(const LAS f32x4*)(P2 + (ww * 32 + row) * 64 + c4); }
        const int grow = row0 + row; const size_t off = (size_t)grow * 1024 + col0 + c4;
        f32x4 o;
        if (xin) o = *(const f32x4*)(xin + off); else { const v2u hx = *(const v2u*)(hb_in + off); o = (f32x4){bflo(hx.x), bfhi(hx.x), bflo(hx.y), bfhi(hx.y)}; }
        if constexpr (MODE == 0) o += v * alpha;
        else { const float s = pg8::row_scale(rs_in, grow); o[0] += sigm(v[0] * s) * v2[0]; o[1] += sigm(v[1] * s) * v2[1]; o[2] += sigm(v[2] * s) * v2[2]; o[3] += sigm(v[3] * s) * v2[3]; }
        v2u pw; pw.x = pk2(o[0], o[1]); pw.y = pk2(o[2], o[3]); *(v2u*)(hb_out + off) = pw;
        float ss = (o[0] * o[0] + o[1] * o[1]) + (o[2] * o[2] + o[3] * o[3]);
        ss += __shfl_xor(ss, 1); ss += __shfl_xor(ss, 2); ss += __shfl_xor(ss, 4); ss += __shfl_xor(ss, 8);
        if ((tid & 15) == 0) rs_out[(size_t)grow * 16 + ct] = ss;
        BAR_LDS();
    }
}
#define XB_TMO      128
#define XB_XCNT(j)  (256  + 64 * (j))
#define XB_XSUB(j)  (1280 + 64 * (j))
#define XB_XGEN(j)  (2304 + 64 * (j))
#define XB_TOP      3328
#define XB_TOPGEN   3392
#define XCD_BAR_WORDS 3456
#define XB_SPIN_CAP (1u << 18)

__device__ __forceinline__ unsigned xb_ld(unsigned* p)              { return __hip_atomic_load(p, __ATOMIC_RELAXED, __HIP_MEMORY_SCOPE_AGENT); }
__device__ __forceinline__ unsigned xb_add(unsigned* p, unsigned v) { return __hip_atomic_fetch_add(p, v, __ATOMIC_RELAXED, __HIP_MEMORY_SCOPE_AGENT); }
__device__ __forceinline__ unsigned xb_xcc_id() { return (unsigned)__builtin_amdgcn_s_getreg((3 << 11) | 20) & 0xFu; }
#define XB_SPIN(cond, bar) do { unsigned _sp = 0; while (cond) { __builtin_amdgcn_s_sleep(1); \
    if ((++_sp & 255u) == 0u) { if (xb_ld(&(bar)[XB_TMO])) break; if (_sp > XB_SPIN_CAP) { atomicAdd(&(bar)[XB_TMO], 1u); break; } } } } while (0)

struct XcdBarrier {
    unsigned* bar; unsigned x;
    volatile LAS unsigned* st;
};

__device__ __forceinline__ XcdBarrier xcd_barrier_post(unsigned* bar, volatile LAS unsigned* st) {
    XcdBarrier b; b.bar = bar; b.x = xb_xcc_id(); b.st = st;
    if (threadIdx.x == 0) (void)xb_add(&bar[XB_XCNT(b.x)], 1u);
    return b;
}
__device__ __forceinline__ void xcd_barrier_complete(unsigned* bar, unsigned x, unsigned& nloc, unsigned& nx) {
    const unsigned G = gridDim.x * gridDim.y * gridDim.z;
    unsigned sum, cnt, mine, sp = 0u;
    for (;;) {
        sum = 0u; cnt = 0u; mine = 0u;
#pragma unroll
        for (unsigned j = 0; j < 16; ++j) { const unsigned c = xb_ld(&bar[XB_XCNT(j)]); sum += c; cnt += (c > 0u) ? 1u : 0u; mine = (j == x) ? c : mine; }
        if (sum == G) break;
        __builtin_amdgcn_s_sleep(1);
        if ((++sp & 255u) == 0u) { if (xb_ld(&bar[XB_TMO])) break; if (sp > XB_SPIN_CAP) { atomicAdd(&bar[XB_TMO], 1u); break; } }
    }
    nloc = mine > 0u ? mine : 1u; nx = cnt > 0u ? cnt : 1u;
}

__device__ __forceinline__ void xcd_barrier(const XcdBarrier& b) {
    asm volatile("s_waitcnt vmcnt(0)" ::: "memory");
    __syncthreads();
    if (threadIdx.x == 0) {
        unsigned* bar = b.bar;
        __builtin_amdgcn_s_waitcnt(0);
        unsigned nloc = b.st[0], nx = b.st[1];
        if (nloc == 0u) { xcd_barrier_complete(bar, b.x, nloc, nx); b.st[0] = nloc; b.st[1] = nx; }
        const unsigned old = xb_add(&bar[XB_XSUB(b.x)], 1u);
        const unsigned gen = old / nloc;
        if (old + 1u == (gen + 1u) * nloc) {
            __builtin_amdgcn_fence(__ATOMIC_RELEASE, "agent");
            asm volatile("s_waitcnt vmcnt(0)" ::: "memory");
            const unsigned og = xb_add(&bar[XB_TOP], 1u);
            const unsigned tg = og / nx;
            if (og + 1u == (tg + 1u) * nx) xb_add(&bar[XB_TOPGEN], 1u);
            else XB_SPIN(xb_ld(&bar[XB_TOPGEN]) == tg, bar);
            __builtin_amdgcn_fence(__ATOMIC_ACQUIRE, "agent");
            xb_add(&bar[XB_XGEN(b.x)], 1u);
            asm volatile("s_waitcnt vmcnt(0)" ::: "memory");
        } else {
            XB_SPIN(xb_ld(&bar[XB_XGEN(b.x)]) == gen, bar);
            __builtin_amdgcn_fence(__ATOMIC_ACQUIRE, "agent");
            asm volatile("s_waitcnt vmcnt(0)" ::: "memory");
        }
    }
    __syncthreads();
}

#define MK_TID() int wave = wave_s; asm volatile("" : "+s"(wave)); unsigned ones_ = ~0u; asm volatile("" : "+s"(ones_)); \
    const int lane = (int)__builtin_amdgcn_mbcnt_hi(ones_, __builtin_amdgcn_mbcnt_lo(ones_, 0u)); const int tid = wave * 64 + lane; const int gw = bid * NWAVES + wave, NGW = G * NWAVES; (void)gw; (void)NGW; (void)tid; (void)lane
__global__ void __launch_bounds__(NWAVES * 64, 2) fwd_kernel(Args a) {
    extern __shared__ __attribute__((aligned(16))) unsigned char lds_raw[];
    LAS unsigned char* lds = (LAS unsigned char*)lds_raw;
    cg::grid_group grid = cg::this_grid();
    const int wave_s = __builtin_amdgcn_readfirstlane((int)threadIdx.x >> 6);
    volatile LAS unsigned* bst = (volatile LAS unsigned*)(lds + LDS_BYTES - 64);
    if (threadIdx.x < 2) bst[threadIdx.x] = 0u;
    __syncthreads();
    const XcdBarrier xbar = xcd_barrier_post((unsigned*)(a.ws + OFF_CTL), bst);
#if PT_ON
#define PT_T0 (blockIdx.x == 0 && wave_s == 0 && __builtin_amdgcn_mbcnt_hi(~0u, __builtin_amdgcn_mbcnt_lo(~0u, 0u)) == 0u)
#define tsl ((volatile LAS unsigned*)(lds + LDS_BYTES - 32))
#endif
    const int ph_lo = a.ph_lo, ph_hi = a.ph_hi;
    for (int ph_ = ph_lo; ph_ < ph_hi; ++ph_) {
#if PROBE_MODE
      const int kk_ = (ph_ - 1) % 10; const bool mid_ = ph_ > 0 && ph_ < NPH - 1;
      const int nrep = (PROBE_MODE == 1 && ph_ == 0) || (PROBE_MODE == 2 && mid_ && (kk_ == 0 || kk_ == 7)) || (PROBE_MODE == 3 && mid_ && kk_ == 2) || (PROBE_MODE == 4 && mid_ && kk_ == 5) ? 2 : 1;
      for (int rep = 0; rep < nrep; ++rep) {
#else
      {
#endif
        int ph = ph_; asm volatile("" : "+s"(ph));
#if PT_ON
        if (ph == PT_LO && PT_T0) { const unsigned long long t_ = __builtin_amdgcn_s_memrealtime(); tsl[0] = (unsigned)t_; tsl[1] = (unsigned)(t_ >> 32); }
        if (ph == PT_HI + 1 && PT_T0) { const unsigned long long t_ = __builtin_amdgcn_s_memrealtime(); tsl[2] = (unsigned)t_; tsl[3] = (unsigned)(t_ >> 32); }
#endif
        CArgs* ap = (CArgs*)__builtin_amdgcn_kernarg_segment_ptr(); asm volatile("" : "+s"(ap));
        int bid = blockIdx.x; asm volatile("" : "+s"(bid));
        int G = gridDim.x; asm volatile("" : "+s"(G));
        unsigned char* ws = ap->ws; float* hbuf = ap->out;
        if (ph == 0) { MK_TID(); prologue(ap, ws, hbuf, lds, tid, bid, G); }
        else if (ph == NPH - 1) {
            MK_TID(); const float* fw = ap->in[25]; const bf16* hfin = (const bf16*)(ws + OFF_HB);
            for (int m = gw; m < M; m += NGW) { const v2u* hr = (const v2u*)(hfin + (size_t)m * D); f32x4 v[4]; float ss = 0.f;
#pragma unroll
                for (int j = 0; j < 4; ++j) { const v2u x = hr[lane + 64 * j]; v[j] = (f32x4){bflo(x.x), bfhi(x.x), bflo(x.y), bfhi(x.y)}; ss += (v[j][0] * v[j][0] + v[j][1] * v[j][1]) + (v[j][2] * v[j][2] + v[j][3] * v[j][3]); }
                ss = wave_sum(ss); const float rinv = rsqrtf(ss * (1.0f / D) + 1e-6f);
#pragma unroll
                for (int j = 0; j < 4; ++j) { const f32x4 wv = *((const f32x4*)fw + lane + 64 * j); __builtin_nontemporal_store(v[j] * rinv * wv, (f32x4*)(hbuf + (size_t)m * D) + lane + 64 * j); } }
        } else {
            const int li = (ph - 1) / 10, k = (ph - 1) % 10, cur = li;
            bf16* hb = (bf16*)(ws + OFF_HB + cur * HB_SZ); bf16* ob = (bf16*)(ws + OFF_HB + (cur ^ 1) * HB_SZ);
            float* rs0 = (float*)(ws + OFF_RS); float* rs1 = (float*)(ws + OFF_RS + RS_SZ); float* Rb = (float*)(ws + OFF_R);
            bf16* big = (bf16*)(ws + OFF_BIG);
            if (k == 0 || k == 7) { MK_TID();
                const int f = k == 7; pg8::Gemm g{hb, (const bf16*)(ws + OFF_WGU + (li * 2 + f) * WGU_SZ), M, 2 * FF, D};
                pg8::StaticOrder S; S.init(M, 2 * FF, G, bid); pg8::EpiSwiglu E{big, FF, rs0};
                pg8::gemm_phase<pg8::EpiSwiglu, pg8::StaticOrder, true, true>(lds, g, S, E, tid);
            } else if (k == 1 || k == 8 || k == 6) { MK_TID();
                pg8::Gemm g; float alpha; float* rso;
                if (k == 6) { g = pg8::Gemm{ob, (const bf16*)(ws + OFF_WOUT + li * WSQ_SZ), M, D, D}; alpha = 1.0f; rso = rs0; }
                else { const int f = k == 8; g = pg8::Gemm{big, (const bf16*)(ws + OFF_WDN + (li * 2 + f) * WDN_SZ), M, D, FF}; alpha = 0.5f; rso = rs1; }
                g.M = NPR; pg8::StaticOrder S; S.init(NPR, D, G, bid); const bool first = (li == 0 && k == 1);
                pg8::EpiResid E{first ? ap->in[0] : (const float*)nullptr, hb, rso, alpha};
                pg8::gemm_phase<pg8::EpiResid, pg8::StaticOrder, true, true>(lds, g, S, E, tid);
                unsigned ones2_ = ~0u; asm volatile("" : "+s"(ones2_));
                const int tid2 = wave * 64 + (int)__builtin_amdgcn_mbcnt_hi(ones2_, __builtin_amdgcn_mbcnt_lo(ones2_, 0u));
                const float* xin_s = first ? ap->in[1] - (size_t)NPR * 1024 : (const float*)nullptr;
                if (k == 6) mini_gemm<0, D>(lds, g.A, g.Bt, nullptr, nullptr, xin_s, hb, hb, nullptr, rso, alpha, tid2, bid, G);
                else mini_gemm<0, FF>(lds, g.A, g.Bt, nullptr, nullptr, xin_s, hb, hb, nullptr, rso, alpha, tid2, bid, G);
            } else if (k == 2) { MK_TID();
                const int N = li ? 4096 : 3328; pg8::Gemm g{hb, (const bf16*)(ws + (li ? OFF_WHIN : OFF_WGIN)), M, N, D};
                pg8::StaticOrder S; S.init(M, N, G, bid); pg8::EpiZ E{big, N, rs1, Rb, li ? -1 : 12};
                pg8::gemm_phase<pg8::EpiZ, pg8::StaticOrder, true, true>(lds, g, S, E, tid);
            } else if (k == 3) { MK_TID();
                if (li == 0) prep_phase<false>(lds, big, Rb, ap->in[11], ap->in[12], (const float*)(ws + OFF_LBT), (bf16*)(ws + OFF_AB), (float*)(ws + OFF_DB), (bf16*)(ws + OFF_PSB), tid, bid, G);
                else prep_phase<true>(lds, big, Rb, ap->in[11], ap->in[12], (const float*)(ws + OFF_LBT), (bf16*)(ws + OFF_AB), (float*)(ws + OFF_DB), (bf16*)(ws + OFF_PSB), tid, bid, G);
                __syncthreads();
                for (int rp_ = 0; rp_ < (PROBE_MODE == 6 ? 2 : 1); ++rp_)
                for (int u = bid; u < DB * (li ? 8 : 4); u += G) {
                    if (li == 0) sample_block<false>(lds, big, Rb, ap->in[11], ap->in[12], ap->in[18], ap->in[13], ap->in[2], hbuf + OUT_GS, ob, u, tid, wave);
                    else sample_block<true>(lds, big, Rb, ap->in[11], ap->in[12], ap->in[18], ap->in[16], ap->in[3], hbuf + OUT_HS, ob, u, tid, wave);
                }
            } else if (k == 4) { MK_TID();
                const int gt = bid * (NWAVES * 64) + tid, ngt = G * NWAVES * 64;
                if (li == 0) state_phase<false>((bf16*)(ws + OFF_PSB), (const float*)(ws + OFF_DB), hbuf + OUT_GP, gt, ngt);
                else state_phase<true>((bf16*)(ws + OFF_PSB), (const float*)(ws + OFF_DB), hbuf + OUT_HP, gt, ngt);
            } else if (k == 5) { MK_TID();
                if (li == 0) out_phase<false>(lds, big, (const bf16*)(ws + OFF_AB), (const bf16*)(ws + OFF_PSB), ob, ap->in[13], tid, wave, bid, G);
                else out_phase<true>(lds, big, (const bf16*)(ws + OFF_AB), (const bf16*)(ws + OFF_PSB), ob, ap->in[16], tid, wave, bid, G);
            } else { MK_TID();
                bf16* pp = (bf16*)(ws + OFF_BIG);
                { pg8::Gemm g{(const bf16*)(ws + OFF_PB + li * PB_SZ), (const bf16*)(ws + OFF_WPP + li * WPP_SZ), NPR, D, PLE};
                  pg8::StaticOrder S; S.init(NPR, D, G, bid); pg8::EpiStorePP E{pp};
                  pg8::gemm_phase<pg8::EpiStorePP, pg8::StaticOrder, true, true>(lds, g, S, E, tid); }
                { unsigned ones2_ = ~0u; asm volatile("" : "+s"(ones2_)); const int tid2 = wave * 64 + (int)__builtin_amdgcn_mbcnt_hi(ones2_, __builtin_amdgcn_mbcnt_lo(ones2_, 0u));
                  pg8::Gemm g{hb, (const bf16*)(ws + OFF_WPG + li * WSQ_SZ), NPR, D, D};
                  pg8::StaticOrder S; S.init(NPR, D, G, bid); pg8::EpiPle E{hb, ob, rs1, rs0, pp};
                  pg8::gemm_phase<pg8::EpiPle, pg8::StaticOrder, true, true>(lds, g, S, E, tid2); }
                { unsigned ones3_ = ~0u; asm volatile("" : "+s"(ones3_)); const int tid3 = wave * 64 + (int)__builtin_amdgcn_mbcnt_hi(ones3_, __builtin_amdgcn_mbcnt_lo(ones3_, 0u));
                  mini_gemm<1, D>(lds, hb, (const bf16*)(ws + OFF_WPG + li * WSQ_SZ), (const bf16*)(ws + OFF_PB + li * PB_SZ), (const bf16*)(ws + OFF_WPP + li * WPP_SZ), nullptr, hb, ob, rs1, rs0, 0.f, tid3, bid, G); }
            }
        }
#if PROBE_MODE
        if (ph_ + 1 < ph_hi || rep + 1 < nrep) grid.sync();
#else
        if (ph_ + 1 < ph_hi) {
            if (ph_ == 0) grid.sync(); else xcd_barrier(xbar);
#if EXTRA_SYNCS
            for (int es = 0; es < EXTRA_SYNCS; ++es) xcd_barrier(xbar);
#endif
        }
#endif
      }
    }
#if PT_ON
    if (PT_T0) { const unsigned long long t0_ = ((unsigned long long)tsl[1] << 32) | tsl[0], t1_ = ((unsigned long long)tsl[3] << 32) | tsl[2], span_ = (t1_ - t0_) * PT_MUL;
        const unsigned long long s_ = __builtin_amdgcn_s_memrealtime(); while (__builtin_amdgcn_s_memrealtime() - s_ < span_) __builtin_amdgcn_s_sleep(8); }
#endif
}

extern "C" void kernel_launch(void* const* d_in, const int* in_sizes, int n_in, void* d_out, int out_size, void* d_ws, size_t ws_size, hipStream_t stream) {
    static int grid = 0;
    if (grid == 0) {
        if (n_in != 26 || (size_t)out_size != OUT_END || ws_size < WS_TOTAL) { fprintf(stderr, "kernel_launch: unexpected shapes (n_in %d out %d ws %zu need %zu); nothing launched\n", n_in, out_size, ws_size, (size_t)WS_TOTAL); grid = -1; return; }
        int dev = 0, cus = 0, per_cu = 0;
        if (hipGetDevice(&dev) != hipSuccess || hipDeviceGetAttribute(&cus, hipDeviceAttributeMultiprocessorCount, dev) != hipSuccess) { grid = -1; return; }
        if (hipFuncSetAttribute((const void*)fwd_kernel, hipFuncAttributeMaxDynamicSharedMemorySize, LDS_BYTES) != hipSuccess) { fprintf(stderr, "kernel_launch: hipFuncSetAttribute failed\n"); grid = -1; return; }
        if (hipOccupancyMaxActiveBlocksPerMultiprocessor(&per_cu, (const void*)fwd_kernel, NWAVES * 64, LDS_BYTES) != hipSuccess || per_cu < 1) per_cu = 1;
        (void)hipGetLastError();
        grid = cus * per_cu;
    }
    if (grid < 0) return;
    if (hipMemsetAsync((char*)d_ws + OFF_CTL, 0, CTL_BYTES, stream) != hipSuccess) { fprintf(stderr, "kernel_launch: memset of the barrier words failed\n"); return; }
    Args a{};
    for (int i = 0; i < 26; ++i) a.in[i] = (const float*)d_in[i];
    a.out = (float*)d_out; a.ws = (unsigned char*)d_ws;
#if MK_N_LAUNCHES == 1
    a.ph_lo = 0; a.ph_hi = NPH;
    void* args[] = {&a};
    hipError_t e = hipLaunchCooperativeKernel((const void*)fwd_kernel, dim3(grid), dim3(NWAVES * 64), args, LDS_BYTES, stream);
    if (e != hipSuccess) fprintf(stderr, "kernel_launch: cooperative launch failed: %s (grid %d)\n", hipGetErrorString(e), grid);
#else
    for (int ph = 0; ph < NPH; ++ph) { a.ph_lo = ph; a.ph_hi = ph + 1; hipLaunchKernelGGL(fwd_kernel, dim3(grid), dim3(NWAVES * 64), LDS_BYTES, stream, a); }
#endif
}
```

```cpp
#include <hip/hip_runtime.h>
#include <cstdio>
#include <cstdint>
#ifndef MK_N_LAUNCHES
#define MK_N_LAUNCHES 1
#endif
#ifndef PROBE_MODE
#define PROBE_MODE 0
#endif
#ifndef EXTRA_SYNCS
#define EXTRA_SYNCS 0
#endif
#ifndef PT_ON
#define PT_ON 0
#define PT_LO 12
#define PT_HI 12
#define PT_MUL 4
#endif
namespace pg8 {
#define PG8_LAS __attribute__((address_space(3)))
typedef unsigned short bf16_t;
typedef short bf16x8 __attribute__((ext_vector_type(8)));
typedef float f32x4 __attribute__((ext_vector_type(4)));
typedef unsigned u32x4 __attribute__((ext_vector_type(4)));
constexpr int BM = 256, BK = 64, HALF = 128, HTB = HALF * BK * 2  , STAGE_BYTES = 8 * HTB, NXCD = 8, WGM = 8;

__host__ __device__ __forceinline__ int lds_byte(int r, int c) { const int st = (r >> 4) * 2 + (c >> 5), rr = r & 15, cc = c & 31, ob = rr * 64 + cc * 2; return st * 1024 + (ob ^ (((ob >> 9) & 1) << 5)); }
__host__ __device__ __forceinline__ void stage_rc(int b, int& R, int& C) { const int st = b / 1024, sb = b % 1024, swz = sb ^ (((sb >> 9) & 1) << 5); R = (st >> 1) * 16 + swz / 64; C = (st & 1) * 32 + (swz % 64) / 2; }
__host__ __device__ __forceinline__ int perm32(int rho) { const int n = rho >> 4, i = rho & 15; return 8 * (i >> 2) + 4 * n + (i & 3); }

struct Unit { int pm, pn; };
struct Gemm { const bf16_t* A; const bf16_t* Bt; int M, N, K; };

struct StaticOrder {
    int nM, nN, nwg, G, c;
    __host__ __device__ void init(int M, int N, int G_, int c_) { nM = M / BM; nN = N / BM; nwg = nM * nN; G = G_; c = c_; }
    __host__ __device__ bool next(int i, Unit& u) const {
        const long L = (long)i * G + c; if (L >= nwg) return false;
        int wgid = (int)L; { const int q = nwg / NXCD, r = nwg % NXCD, xcd = wgid % NXCD, off = wgid / NXCD; wgid = (xcd < r ? xcd * (q + 1) : r * (q + 1) + (xcd - r) * q) + off; }
        const int nig = WGM * nN, gid = wgid / nig, fm = gid * WGM, gsz = (nM - fm) < WGM ? (nM - fm) : WGM;
        u.pm = fm + ((wgid % nig) % gsz); u.pn = (wgid % nig) / gsz; return true;
    }
    __device__ __forceinline__ void a_ready(const Unit&) const {}
    __device__ __forceinline__ void done(const Unit&) const {}
};

typedef float f32x2_ __attribute__((ext_vector_type(2))); typedef __bf16 bf16x2_ __attribute__((ext_vector_type(2)));
__device__ __forceinline__ unsigned cvt_pk_bf16(float lo, float hi) { const f32x2_ v = {lo, hi}; return __builtin_bit_cast(unsigned, __builtin_convertvector(v, bf16x2_)); }
typedef float f32x2 __attribute__((ext_vector_type(2)));
typedef unsigned u32x2 __attribute__((ext_vector_type(2)));
__device__ __forceinline__ float row_scale(const float* rs, int row) {
    const f32x4* p = (const f32x4*)(rs + (size_t)row * 16);
    const f32x4 a = p[0], b = p[1], c = p[2], d = p[3];
    const float s = ((a[0] + a[1]) + (a[2] + a[3])) + ((b[0] + b[1]) + (b[2] + b[3])) + ((c[0] + c[1]) + (c[2] + c[3])) + ((d[0] + d[1]) + (d[2] + d[3]));
    return rsqrtf(s * (1.0f / 1024.0f) + 1e-6f);
}
__device__ __forceinline__ void row_scales8(const float* rs, int row0, float (&sc)[2][4]) {
#pragma unroll
    for (int ai = 0; ai < 2; ++ai)
#pragma unroll
        for (int mh = 0; mh < 2; ++mh) { f32x4 p[2][4];
#pragma unroll
            for (int ml = 0; ml < 2; ++ml)
#pragma unroll
                for (int q = 0; q < 4; ++q) p[ml][q] = *(const f32x4*)(rs + (size_t)(row0 + ai * HALF + (2 * mh + ml) * 16) * 16 + 4 * q);
            __builtin_amdgcn_sched_barrier(0);
#pragma unroll
            for (int ml = 0; ml < 2; ++ml) { const f32x4 t = (p[ml][0] + p[ml][1]) + (p[ml][2] + p[ml][3]); sc[ai][2 * mh + ml] = rsqrtf(((t[0] + t[1]) + (t[2] + t[3])) * (1.0f / 1024.0f) + 1e-6f); }
            __builtin_amdgcn_sched_barrier(0); }
}
__device__ __forceinline__ float sigm(float x) { return __builtin_amdgcn_rcpf(1.0f + __expf(-x)); }
struct EpiSwiglu {
    static constexpr bool PERM = true, AFTER_DRAIN = false;
    bf16_t* O; int ldc; const float* rs;
    __device__ __forceinline__ void operator()(const f32x4 (&acc)[2][2][4][2], const Unit& u, int wr, int wc, int fr_, int fq_) const {
        unsigned on_ = ~0u; asm volatile("" : "+s"(on_)); const int ln_ = (int)__builtin_amdgcn_mbcnt_hi(on_, __builtin_amdgcn_mbcnt_lo(on_, 0u)), fr = ln_ & 15, fq = ln_ >> 4; (void)fr_; (void)fq_;
        const int row0 = u.pm * BM + wr * 64 + fr, col0 = u.pn * HALF + wc * 32 + 8 * fq;
        float sc[2][4]; row_scales8(rs, row0, sc);
#pragma unroll
        for (int ai = 0; ai < 2; ++ai)
#pragma unroll
            for (int m = 0; m < 4; ++m) { const int row = row0 + ai * HALF + m * 16; const float s = sc[ai][m];
                float o[8];
#pragma unroll
                for (int n = 0; n < 2; ++n)
#pragma unroll
                    for (int i = 0; i < 4; ++i) { const float g = acc[ai][0][m][n][i] * s, up = acc[ai][1][m][n][i] * s; o[n * 4 + i] = g * sigm(g) * up; }
                u32x4 w; w.x = cvt_pk_bf16(o[0], o[1]); w.y = cvt_pk_bf16(o[2], o[3]); w.z = cvt_pk_bf16(o[4], o[5]); w.w = cvt_pk_bf16(o[6], o[7]);
                *(u32x4*)(O + (size_t)row * ldc + col0) = w; }
    }
};
struct EpiZ {
    static constexpr bool PERM = true, AFTER_DRAIN = false;
    bf16_t* Z; int ldz; const float* rs; float* R; int r_tile;
    __device__ __forceinline__ void operator()(const f32x4 (&acc)[2][2][4][2], const Unit& u, int wr, int wc, int fr_, int fq_) const {
        unsigned on_ = ~0u; asm volatile("" : "+s"(on_)); const int ln_ = (int)__builtin_amdgcn_mbcnt_hi(on_, __builtin_amdgcn_mbcnt_lo(on_, 0u)), fr = ln_ & 15, fq = ln_ >> 4; (void)fr_; (void)fq_;
        const int row0 = u.pm * BM + wr * 64 + fr, col0 = u.pn * BM + wc * 32 + 8 * fq;
        if (u.pn == r_tile) {
            if (wc == 0 && fq < 2) {
#pragma unroll
                for (int ai = 0; ai < 2; ++ai)
#pragma unroll
                    for (int m = 0; m < 4; ++m) { const int row = row0 + ai * HALF + m * 16; const float s = row_scale(rs, row);
#pragma unroll
                        for (int n = 0; n < 2; ++n) *(f32x4*)(R + (size_t)row * 16 + 8 * fq + 4 * n) = acc[ai][0][m][n] * s; }
            }
            return;
        }
        float sc[2][4]; row_scales8(rs, row0, sc);
#pragma unroll
        for (int ai = 0; ai < 2; ++ai)
#pragma unroll
            for (int m = 0; m < 4; ++m) { const int row = row0 + ai * HALF + m * 16; const float s = sc[ai][m];
#pragma unroll
                for (int bj = 0; bj < 2; ++bj) { const f32x4 v0 = acc[ai][bj][m][0] * s, v1 = acc[ai][bj][m][1] * s;
                    u32x4 w; w.x = cvt_pk_bf16(v0[0], v0[1]); w.y = cvt_pk_bf16(v0[2], v0[3]); w.z = cvt_pk_bf16(v1[0], v1[1]); w.w = cvt_pk_bf16(v1[2], v1[3]);
                    *(u32x4*)(Z + (size_t)row * ldz + col0 + bj * HALF) = w; } }
    }
};
struct EpiResid {
    static constexpr bool PERM = false, AFTER_DRAIN = false;
    const float* xin; bf16_t* hb; float* rs_out; float alpha;
    __device__ __forceinline__ void operator()(const f32x4 (&acc)[2][2][4][2], const Unit& u, int wr, int wc, int fr_, int fq_) const {
        unsigned on_ = ~0u; asm volatile("" : "+s"(on_)); const int ln_ = (int)__builtin_amdgcn_mbcnt_hi(on_, __builtin_amdgcn_mbcnt_lo(on_, 0u)), fr = ln_ & 15, fq = ln_ >> 4; (void)fr_; (void)fq_;
        const int row0 = u.pm * BM + wr * 64 + fr, col0 = u.pn * BM + wc * 32 + 4 * fq;
#pragma unroll
        for (int ai = 0; ai < 2; ++ai)
#pragma unroll
            for (int mh = 0; mh < 2; ++mh) { f32x4 hv[2][2][2];
                if (xin) {
#pragma unroll
                    for (int ml = 0; ml < 2; ++ml)
#pragma unroll
                        for (int bj = 0; bj < 2; ++bj)
#pragma unroll
                            for (int n = 0; n < 2; ++n) hv[ml][bj][n] = *(const f32x4*)(xin + (size_t)(row0 + ai * HALF + (2 * mh + ml) * 16) * 1024 + col0 + bj * HALF + n * 16);
                } else { u32x2 hw[2][2][2];
#pragma unroll
                    for (int ml = 0; ml < 2; ++ml)
#pragma unroll
                        for (int bj = 0; bj < 2; ++bj)
#pragma unroll
                            for (int n = 0; n < 2; ++n) hw[ml][bj][n] = *(const u32x2*)(hb + (size_t)(row0 + ai * HALF + (2 * mh + ml) * 16) * 1024 + col0 + bj * HALF + n * 16);
#pragma unroll
                    for (int ml = 0; ml < 2; ++ml)
#pragma unroll
                        for (int bj = 0; bj < 2; ++bj)
#pragma unroll
                            for (int n = 0; n < 2; ++n) { const u32x2 x = hw[ml][bj][n]; hv[ml][bj][n] = (f32x4){__uint_as_float(x.x << 16), __uint_as_float(x.x & 0xffff0000u), __uint_as_float(x.y << 16), __uint_as_float(x.y & 0xffff0000u)}; } }
                __builtin_amdgcn_sched_barrier(0);
#pragma unroll
                for (int ml = 0; ml < 2; ++ml) { const int m = 2 * mh + ml, row = row0 + ai * HALF + m * 16; float ss = 0.f;
#pragma unroll
                    for (int bj = 0; bj < 2; ++bj)
#pragma unroll
                        for (int n = 0; n < 2; ++n) { const size_t off = (size_t)row * 1024 + col0 + bj * HALF + n * 16;
                            const f32x4 o = hv[ml][bj][n] + acc[ai][bj][m][n] * alpha;
                            ss += (o[0] * o[0] + o[1] * o[1]) + (o[2] * o[2] + o[3] * o[3]);
                            u32x2 w; w.x = cvt_pk_bf16(o[0], o[1]); w.y = cvt_pk_bf16(o[2], o[3]); *(u32x2*)(hb + off) = w; }
                    ss += __builtin_bit_cast(float, __builtin_amdgcn_ds_bpermute((ln_ ^ 16) << 2, __builtin_bit_cast(int, ss))); ss += __builtin_bit_cast(float, __builtin_amdgcn_ds_bpermute((ln_ ^ 32) << 2, __builtin_bit_cast(int, ss)));
                    if (fq == 0) rs_out[(size_t)row * 16 + u.pn * 4 + wc] = ss; }
                __builtin_amdgcn_sched_barrier(0); }
    }
};
struct EpiStorePP {
    static constexpr bool PERM = false, AFTER_DRAIN = false;
    bf16_t* O;
    __device__ __forceinline__ void operator()(const f32x4 (&acc)[2][2][4][2], const Unit& u, int wr, int wc, int fr_, int fq_) const {
        unsigned on_ = ~0u; asm volatile("" : "+s"(on_)); const int ln_ = (int)__builtin_amdgcn_mbcnt_hi(on_, __builtin_amdgcn_mbcnt_lo(on_, 0u)), fr = ln_ & 15, fq = ln_ >> 4; (void)fr_; (void)fq_;
        const int row0 = u.pm * BM + wr * 64 + fr, col0 = u.pn * BM + wc * 32 + 4 * fq;
#pragma unroll
        for (int ai = 0; ai < 2; ++ai)
#pragma unroll
            for (int m = 0; m < 4; ++m)
#pragma unroll
                for (int bj = 0; bj < 2; ++bj)
#pragma unroll
                    for (int n = 0; n < 2; ++n) { const f32x4 v = acc[ai][bj][m][n]; u32x2 w; w.x = cvt_pk_bf16(v[0], v[1]); w.y = cvt_pk_bf16(v[2], v[3]);
                        *(u32x2*)(O + (size_t)(row0 + ai * HALF + m * 16) * 1024 + col0 + bj * HALF + n * 16) = w; }
    }
};
struct EpiPle {
    static constexpr bool PERM = false, AFTER_DRAIN = false;
    const bf16_t* hbin; bf16_t* hb; const float* rs_in; float* rs_out; const bf16_t* pp;
    __device__ __forceinline__ void operator()(const f32x4 (&acc)[2][2][4][2], const Unit& u, int wr, int wc, int fr_, int fq_) const {
        unsigned on_ = ~0u; asm volatile("" : "+s"(on_)); const int ln_ = (int)__builtin_amdgcn_mbcnt_hi(on_, __builtin_amdgcn_mbcnt_lo(on_, 0u)), fr = ln_ & 15, fq = ln_ >> 4; (void)fr_; (void)fq_;
        const int row0 = u.pm * BM + wr * 64 + fr, col0 = u.pn * BM + wc * 32 + 4 * fq;
#pragma unroll
        for (int ai = 0; ai < 2; ++ai)
#pragma unroll
            for (int m = 0; m < 4; ++m) { const int row = row0 + ai * HALF + m * 16; const float s = row_scale(rs_in, row); float ss = 0.f;
#pragma unroll
                for (int bj = 0; bj < 2; ++bj)
#pragma unroll
                    for (int n = 0; n < 2; ++n) { const size_t off = (size_t)row * 1024 + col0 + bj * HALF + n * 16;
                        const u32x2 pw = *(const u32x2*)(pp + off); const f32x4 a = acc[ai][bj][m][n] * s, p = {__uint_as_float(pw.x << 16), __uint_as_float(pw.x & 0xffff0000u), __uint_as_float(pw.y << 16), __uint_as_float(pw.y & 0xffff0000u)}; const u32x2 hx = *(const u32x2*)(hbin + off); f32x4 o = {__uint_as_float(hx.x << 16), __uint_as_float(hx.x & 0xffff0000u), __uint_as_float(hx.y << 16), __uint_as_float(hx.y & 0xffff0000u)};
                        o[0] += sigm(a[0]) * p[0]; o[1] += sigm(a[1]) * p[1]; o[2] += sigm(a[2]) * p[2]; o[3] += sigm(a[3]) * p[3];
                        ss += (o[0] * o[0] + o[1] * o[1]) + (o[2] * o[2] + o[3] * o[3]);
                        u32x2 w; w.x = cvt_pk_bf16(o[0], o[1]); w.y = cvt_pk_bf16(o[2], o[3]); *(u32x2*)(hb + off) = w; }
                ss += __builtin_bit_cast(float, __builtin_amdgcn_ds_bpermute((ln_ ^ 16) << 2, __builtin_bit_cast(int, ss))); ss += __builtin_bit_cast(float, __builtin_amdgcn_ds_bpermute((ln_ ^ 32) << 2, __builtin_bit_cast(int, ss)));
                if (fq == 0) rs_out[(size_t)row * 16 + u.pn * 4 + wc] = ss; }
    }
};
template <class Epi, class Sched, bool ALIGN_EPI = false, bool SP2 = false>
__device__ __forceinline__ void gemm_phase(PG8_LAS unsigned char* lds, const Gemm g, const Sched& S, const Epi& E, const int tid) {
    const int wid = __builtin_amdgcn_readfirstlane(tid >> 6), lane = tid & 63, wr = wid >> 2, wc = wid & 3, fr = lane & 15, fq = lane >> 4;
    const int K = g.K, nt = K / BK;
    unsigned voffA[2], voffB[2];
#pragma unroll
    for (int i = 0; i < 2; ++i) { int R, C; stage_rc(tid * 16 + i * 8192, R, C); const int Rb = Epi::PERM ? ((R & ~31) + perm32(R & 31)) : R;
        voffA[i] = (unsigned)(R * K + C) * 2u; voffB[i] = (unsigned)(Rb * K + C) * 2u; }
    const size_t kstep = (size_t)(BK * 2);
    const size_t hstep = (size_t)HALF * K * 2;
    const size_t tstep = 2 * hstep;
    const unsigned ldsw = (unsigned)wid * 1024u;
    const int aoff = lds_byte(wr * 64 + fr, fq * 8), boff = lds_byte(wc * 32 + fr, fq * 8);
#define PG8_SA(b, h) (((b) * 2 + (h)) * HTB)
#define PG8_SB(b, h) ((4 + (b) * 2 + (h)) * HTB)
#define PG8_STAGE(bufoff, gbase, voff) do { _Pragma("unroll") for (int _i = 0; _i < 2; ++_i) \
        __builtin_amdgcn_global_load_lds((const unsigned*)((const char*)(gbase) + (voff)[_i]), (PG8_LAS unsigned*)(lds + (bufoff) + ldsw + _i * 8192), 16, 0, 0); } while (0)
#define PG8_LDA(dst, b, h) do { _Pragma("unroll") for (int m = 0; m < 4; ++m) _Pragma("unroll") for (int k = 0; k < 2; ++k) dst[m][k] = *(const PG8_LAS bf16x8*)(lds + PG8_SA(b, h) + aoff + m * 2048 + k * 1024); } while (0)
#define PG8_LDB(dst, b, h) do { _Pragma("unroll") for (int n = 0; n < 2; ++n) _Pragma("unroll") for (int k = 0; k < 2; ++k) dst[n][k] = *(const PG8_LAS bf16x8*)(lds + PG8_SB(b, h) + boff + n * 2048 + k * 1024); } while (0)
#define PG8_MMA(ai, bj, At, Bt) do { __builtin_amdgcn_s_setprio(1); _Pragma("unroll") for (int m = 0; m < 4; ++m) _Pragma("unroll") for (int n = 0; n < 2; ++n) _Pragma("unroll") for (int k = 0; k < 2; ++k) \
        acc[ai][bj][m][n] = __builtin_amdgcn_mfma_f32_16x16x32_bf16(Bt[n][k], At[m][k], acc[ai][bj][m][n], 0, 0, 0); __builtin_amdgcn_s_setprio(0); } while (0)
#define PG8_WAIT_V(n) asm volatile("s_waitcnt vmcnt(" #n ")" ::: "memory")
#define PG8_WAIT_L(n) asm volatile("s_waitcnt lgkmcnt(" #n ")" ::: "memory")
#define PG8_BAR __builtin_amdgcn_s_barrier()
#define PG8_SCHED __builtin_amdgcn_sched_barrier(0)
    Unit cur, nxt; int ui = 0;
    if (!S.next(0, cur)) return;
    f32x4 acc[2][2][4][2];
#pragma unroll
    for (int a = 0; a < 2; ++a)
#pragma unroll
        for (int b = 0; b < 2; ++b)
#pragma unroll
            for (int m = 0; m < 4; ++m)
#pragma unroll
                for (int n = 0; n < 2; ++n) acc[a][b][m][n] = (f32x4){0.f, 0.f, 0.f, 0.f};
    bf16x8 At[4][2], B0[2][2], B1[2][2];
    const char* cA = (const char*)g.A + (size_t)cur.pm * tstep; const char* cB = (const char*)g.Bt + (size_t)cur.pn * tstep;
    S.a_ready(cur);
    if constexpr (SP2) {
        PG8_STAGE(PG8_SB(0, 0), cB, voffB); PG8_STAGE(PG8_SB(0, 1), cB + hstep, voffB); PG8_STAGE(PG8_SA(0, 0), cA, voffA); PG8_STAGE(PG8_SA(0, 1), cA + hstep, voffA);
        if (wr == 1) PG8_BAR;
        PG8_WAIT_V(2); PG8_BAR;
        PG8_STAGE(PG8_SB(1, 0), cB + kstep, voffB); PG8_STAGE(PG8_SA(1, 0), cA + kstep, voffA); PG8_STAGE(PG8_SB(1, 1), cB + hstep + kstep, voffB);
        PG8_WAIT_V(6); PG8_BAR;
    } else {
        PG8_STAGE(PG8_SB(0, 0), cB, voffB); PG8_STAGE(PG8_SA(0, 0), cA, voffA); PG8_STAGE(PG8_SB(0, 1), cB + hstep, voffB); PG8_STAGE(PG8_SA(0, 1), cA + hstep, voffA);
        if (wr == 1) PG8_BAR;
        PG8_WAIT_V(4); PG8_BAR;
        PG8_STAGE(PG8_SB(1, 0), cB + kstep, voffB); PG8_STAGE(PG8_SA(1, 0), cA + kstep, voffA); PG8_STAGE(PG8_SB(1, 1), cB + hstep + kstep, voffB);
        PG8_WAIT_V(6); PG8_BAR;
    }
    for (;;) {
        const bool has_next = S.next(ui + 1, nxt);
        const char* nA = has_next ? (const char*)g.A + (size_t)nxt.pm * tstep : cA; const char* nB = has_next ? (const char*)g.Bt + (size_t)nxt.pn * tstep : cB;
        for (int t = 0; t < nt; t += 2) {
            const bool last = (t == nt - 2);
            const char* a1 = cA + (size_t)(t + 1) * kstep;
            const char* a2 = last ? nA : cA + (size_t)(t + 2) * kstep; const char* b2 = last ? nB : cB + (size_t)(t + 2) * kstep;
            const char* a3 = a2 + kstep; const char* b3 = b2 + kstep;
            if (last && has_next) S.a_ready(nxt);
            if constexpr (SP2) {
            PG8_LDB(B0, 0, 0); PG8_LDB(B1, 0, 1); PG8_SCHED; PG8_LDA(At, 0, 0); PG8_STAGE(PG8_SA(1, 1), a1 + hstep, voffA);
            PG8_WAIT_V(8); PG8_WAIT_L(0); PG8_BAR; PG8_MMA(0, 0, At, B0); PG8_MMA(0, 1, At, B1); PG8_BAR; PG8_SCHED;
            PG8_LDA(At, 0, 1); PG8_STAGE(PG8_SB(0, 0), b2, voffB); PG8_STAGE(PG8_SB(0, 1), b2 + hstep, voffB); PG8_STAGE(PG8_SA(0, 0), a2, voffA);
            PG8_WAIT_V(8); PG8_WAIT_L(0); PG8_BAR; PG8_MMA(1, 0, At, B0); PG8_MMA(1, 1, At, B1); PG8_BAR; PG8_SCHED;
            PG8_LDB(B0, 1, 0); PG8_LDB(B1, 1, 1); PG8_SCHED; PG8_LDA(At, 1, 0); PG8_STAGE(PG8_SA(0, 1), a2 + hstep, voffA);
            PG8_WAIT_V(8); PG8_WAIT_L(0); PG8_BAR; PG8_MMA(0, 0, At, B0); PG8_MMA(0, 1, At, B1); PG8_BAR; PG8_SCHED;
            PG8_LDA(At, 1, 1); PG8_STAGE(PG8_SB(1, 0), b3, voffB); PG8_STAGE(PG8_SB(1, 1), b3 + hstep, voffB); PG8_STAGE(PG8_SA(1, 0), a3, voffA);
            PG8_WAIT_V(8); PG8_WAIT_L(0); PG8_BAR; PG8_MMA(1, 0, At, B0); PG8_MMA(1, 1, At, B1); PG8_BAR; PG8_SCHED;
            } else {
            PG8_LDB(B0, 0, 0); PG8_SCHED; PG8_LDA(At, 0, 0); PG8_STAGE(PG8_SA(1, 1), a1 + hstep, voffA);
            PG8_WAIT_L(8); PG8_BAR; PG8_WAIT_L(0); PG8_MMA(0, 0, At, B0); PG8_BAR; PG8_SCHED;
            PG8_LDB(B1, 0, 1); PG8_STAGE(PG8_SB(0, 0), b2, voffB);
            PG8_BAR; PG8_WAIT_L(0); PG8_MMA(0, 1, At, B1); PG8_BAR;
            PG8_LDA(At, 0, 1); PG8_STAGE(PG8_SA(0, 0), a2, voffA);
            PG8_BAR; PG8_WAIT_L(0); PG8_MMA(1, 0, At, B0); PG8_BAR; PG8_SCHED;
            PG8_STAGE(PG8_SB(0, 1), b2 + hstep, voffB);
            PG8_WAIT_V(6); PG8_BAR; PG8_MMA(1, 1, At, B1); PG8_BAR;
            PG8_LDB(B0, 1, 0); PG8_SCHED; PG8_LDA(At, 1, 0); PG8_STAGE(PG8_SA(0, 1), a2 + hstep, voffA);
            PG8_WAIT_L(8); PG8_BAR; PG8_WAIT_L(0); PG8_MMA(0, 0, At, B0); PG8_BAR; PG8_SCHED;
            PG8_LDB(B1, 1, 1); PG8_STAGE(PG8_SB(1, 0), b3, voffB);
            PG8_BAR; PG8_WAIT_L(0); PG8_MMA(0, 1, At, B1); PG8_BAR;
            PG8_LDA(At, 1, 1); PG8_STAGE(PG8_SA(1, 0), a3, voffA);
            PG8_BAR; PG8_WAIT_L(0); PG8_MMA(1, 0, At, B0); PG8_BAR; PG8_SCHED;
            PG8_STAGE(PG8_SB(1, 1), b3 + hstep, voffB);
            PG8_WAIT_V(6); PG8_BAR; PG8_MMA(1, 1, At, B1); PG8_BAR;
            }
        }
        if constexpr (ALIGN_EPI) { if (wr == 0) PG8_BAR; }
        if constexpr (!Epi::AFTER_DRAIN) { E(acc, cur, wr, wc, fr, fq); S.done(cur); }
        if (!has_next) break;
#pragma unroll
        for (int a = 0; a < 2; ++a)
#pragma unroll
            for (int b = 0; b < 2; ++b)
#pragma unroll
                for (int m = 0; m < 4; ++m)
#pragma unroll
                    for (int n = 0; n < 2; ++n) acc[a][b][m][n] = (f32x4){0.f, 0.f, 0.f, 0.f};
        cur = nxt; cA = nA; cB = nB; ++ui;
        if constexpr (ALIGN_EPI) { if (wr == 1) PG8_BAR; }
    }
    PG8_WAIT_V(0);
    if constexpr (!ALIGN_EPI) { if (wr == 0) PG8_BAR; }
    PG8_BAR;
    if constexpr (Epi::AFTER_DRAIN) { E.fused(acc, cur, wr, wc, fr, fq, lds, wid, lane); S.done(cur); }
#undef PG8_SA
#undef PG8_SB
#undef PG8_STAGE
#undef PG8_LDA
#undef PG8_LDB
#undef PG8_MMA
#undef PG8_WAIT_V
#undef PG8_WAIT_L
#undef PG8_BAR
#undef PG8_SCHED
}
}
#include <hip/hip_cooperative_groups.h>
namespace cg = cooperative_groups;
#define LAS __attribute__((address_space(3)))
typedef unsigned short bf16;
typedef float f32x4 __attribute__((ext_vector_type(4)));
typedef short bf16x8 __attribute__((ext_vector_type(8)));
typedef unsigned v4u __attribute__((ext_vector_type(4)));
typedef unsigned v2u __attribute__((ext_vector_type(2)));
constexpr int D = 1024, NPR = 16384, NSM = 512, M = NPR + NSM, SEQ = 2048, NB = 8, DB = 128, FF = 2816, PLE = 256, NCH = 32;
constexpr int NWAVES = 8, LDS_BYTES = 147456, NPH = 22;
constexpr size_t WGU_SZ = (size_t)5632 * 1024 * 2, WDN_SZ = (size_t)1024 * 2816 * 2, WSQ_SZ = (size_t)1024 * 1024 * 2, WPP_SZ = (size_t)1024 * 256 * 2;
constexpr size_t OFF_WGU = 0, OFF_WDN = OFF_WGU + 4 * WGU_SZ, OFF_WGIN = OFF_WDN + 4 * WDN_SZ, OFF_WHIN = OFF_WGIN + (size_t)3328 * 1024 * 2,
    OFF_WOUT = OFF_WHIN + (size_t)4096 * 1024 * 2, OFF_WPG = OFF_WOUT + 2 * WSQ_SZ, OFF_WPP = OFF_WPG + 2 * WSQ_SZ, OFF_HB = OFF_WPP + 2 * WPP_SZ;
constexpr size_t HB_SZ = (size_t)M * 1024 * 2;
constexpr size_t OFF_BIG = OFF_HB + 2 * HB_SZ, OFF_PB = OFF_BIG + (size_t)M * 4096 * 2, PB_SZ = (size_t)M * 256 * 2, OFF_AB = OFF_PB + 2 * PB_SZ,
    OFF_DB = OFF_AB + (size_t)2048 * 4096 * 2, OFF_RS = OFF_DB + (size_t)2048 * 128 * 4, RS_SZ = (size_t)M * 16 * 4, OFF_R = OFF_RS + 2 * RS_SZ, OFF_PSB = OFF_R + RS_SZ, OFF_PP = OFF_PSB  , WS_END = OFF_PSB + (size_t)67108864, OFF_LBT = WS_END, OFF_CTL = OFF_LBT + 16384, CTL_BYTES = 16384, WS_TOTAL = OFF_CTL + CTL_BYTES;
constexpr size_t OUT_YS = (size_t)NPR * D, OUT_GP = (size_t)M * D, OUT_GS = OUT_GP + 1048576, OUT_HP = OUT_GS + 16777216, OUT_HS = OUT_HP + 1048576, OUT_END = OUT_HS + 16777216;

__device__ __forceinline__ float bf2f(unsigned short u) { return __uint_as_float((unsigned)u << 16); }
__device__ __forceinline__ float bflo(unsigned u) { return __uint_as_float(u << 16); }
__device__ __forceinline__ float bfhi(unsigned u) { return __uint_as_float(u & 0xffff0000u); }
__device__ __forceinline__ unsigned pk2(float lo, float hi) { return pg8::cvt_pk_bf16(lo, hi); }
__device__ __forceinline__ float sigm(float x) { return __builtin_amdgcn_rcpf(1.0f + __expf(-x)); }
__device__ __forceinline__ float logsig(float x) { return fminf(x, 0.f) - __logf(1.0f + __expf(-fabsf(x))); }
__device__ __forceinline__ float wave_sum(float v) {
#pragma unroll
    for (int o = 1; o < 64; o <<= 1) v += __shfl_xor(v, o);
    return v;
}
#define LDS_WAIT() asm volatile("s_waitcnt lgkmcnt(0)" ::: "memory")
#define BAR_LDS() do { asm volatile("s_waitcnt lgkmcnt(0)" ::: "memory"); __builtin_amdgcn_s_barrier(); asm volatile("" ::: "memory"); } while (0)

__device__ __forceinline__ void tr_item(const float* W, int Nsrc, int K, bf16* WT, const float* sk, int item, int nblk, int mode, int nvalid, LAS float* scr, int lane) {
    const int kb = item / nblk, nb = item % nblk, k0 = 64 * kb, n0 = 64 * nb;
    int src0 = n0, valid = 64;
    if (mode == 1) { const int pn = n0 >> 8, within = n0 & 255, half = within >> 7, j = within & 127; src0 = half * FF + 128 * pn + j; }
    if (mode == 2) { valid = nvalid - n0; valid = valid < 0 ? 0 : (valid > 64 ? 64 : valid); }
    const int c4 = (lane & 15) * 4, kr = lane >> 4;
    const float* wp = W + (size_t)(k0 + kr) * Nsrc + src0 + c4;
    f32x4 v[16];
#pragma unroll
    for (int i = 0; i < 16; ++i) v[i] = (c4 < valid) ? __builtin_nontemporal_load((const f32x4*)(wp + (size_t)(4 * i) * Nsrc)) : (f32x4){0.f, 0.f, 0.f, 0.f};
    __builtin_amdgcn_sched_barrier(0);
#pragma unroll
    for (int i = 0; i < 16; ++i) { const int kk = 4 * i + kr; const float s = sk ? sk[k0 + kk] : 1.0f; LAS float* d = scr + kk * 65 + c4; d[0] = v[i][0] * s; d[1] = v[i][1] * s; d[2] = v[i][2] * s; d[3] = v[i][3] * s; }
    LDS_WAIT();
    const int ch = lane & 7;
#pragma unroll
    for (int j = 0; j < 8; ++j) { const int n = (lane >> 3) + 8 * j; const LAS float* s = scr + (8 * ch) * 65 + n;
        v4u o; o.x = pk2(s[0 * 65], s[1 * 65]); o.y = pk2(s[2 * 65], s[3 * 65]); o.z = pk2(s[4 * 65], s[5 * 65]); o.w = pk2(s[6 * 65], s[7 * 65]);
        *(v4u*)(WT + (size_t)(n0 + n) * K + k0 + 8 * ch) = o; }
    LDS_WAIT();
}
struct Args { const float* in[26]; float* out; unsigned char* ws; int ph_lo, ph_hi; };
typedef const Args __attribute__((address_space(4))) CArgs;

__device__ __forceinline__ void prologue(CArgs* a, unsigned char* ws, float* outp, LAS unsigned char* lds, int tid, int bid, int G) {
    const int lane = tid & 63, wave = tid >> 6;
    LAS float* scr = (LAS float*)(lds + wave * 16640);
    const int gw = bid * NWAVES + wave, NGW = G * NWAVES;
    constexpr int I_GU = 16 * 88, I_DN = 44 * 16, I_GIN = 16 * 52, I_HIN = 16 * 64, I_SQ = 16 * 16, I_PP = 4 * 16;
    constexpr int NITEMS = 4 * I_GU + 4 * I_DN + I_GIN + I_HIN + 4 * I_SQ + 2 * I_PP;
    for (int it = gw; it < NITEMS; it += NGW) {
        int r = it;
        if (r < 4 * I_GU) { const int q = r / I_GU, li = q >> 1, f = q & 1; r -= q * I_GU;
            tr_item((f ? a->in[20] : a->in[7]) + (size_t)li * 1024 * 5632, 5632, 1024, (bf16*)(ws + OFF_WGU + q * WGU_SZ), (f ? a->in[19] : a->in[6]) + li * 1024, r, 88, 1, 0, scr, lane); continue; }
        r -= 4 * I_GU;
        if (r < 4 * I_DN) { const int q = r / I_DN, li = q >> 1, f = q & 1; r -= q * I_DN;
            tr_item((f ? a->in[21] : a->in[8]) + (size_t)li * 2816 * 1024, 1024, 2816, (bf16*)(ws + OFF_WDN + q * WDN_SZ), nullptr, r, 16, 0, 0, scr, lane); continue; }
        r -= 4 * I_DN;
        if (r < I_GIN) { tr_item(a->in[10], 3088, 1024, (bf16*)(ws + OFF_WGIN), a->in[9], r, 52, 2, 3088, scr, lane); continue; }
        r -= I_GIN;
        if (r < I_HIN) { tr_item(a->in[15], 4096, 1024, (bf16*)(ws + OFF_WHIN), a->in[9] + 1024, r, 64, 0, 0, scr, lane); continue; }
        r -= I_HIN;
        if (r < I_SQ) { tr_item(a->in[14], 1024, 1024, (bf16*)(ws + OFF_WOUT), nullptr, r, 16, 0, 0, scr, lane); continue; }
        r -= I_SQ;
        if (r < I_SQ) { tr_item(a->in[17], 1024, 1024, (bf16*)(ws + OFF_WOUT + WSQ_SZ), nullptr, r, 16, 0, 0, scr, lane); continue; }
        r -= I_SQ;
        if (r < 2 * I_SQ) { const int li = r / I_SQ; r -= li * I_SQ;
            tr_item(a->in[23] + (size_t)li * 1024 * 1024, 1024, 1024, (bf16*)(ws + OFF_WPG + li * WSQ_SZ), a->in[22] + li * 1024, r, 16, 0, 0, scr, lane); continue; }
        r -= 2 * I_SQ;
        { const int li = r / I_PP; r -= li * I_PP;
            tr_item(a->in[24] + (size_t)li * 256 * 1024, 1024, 256, (bf16*)(ws + OFF_WPP + li * WPP_SZ), nullptr, r, 16, 0, 0, scr, lane); }
    }
    bf16* hb = (bf16*)(ws + OFF_HB); float* rs = (float*)(ws + OFF_RS);
    for (int m0 = gw; m0 < M; m0 += 2 * NGW) {
        const int m1 = m0 + NGW; const bool has1 = m1 < M;
        const float* xr0 = m0 < NPR ? a->in[0] + (size_t)m0 * D : a->in[1] + (size_t)(m0 - NPR) * D;
        const float* xr1 = !has1 ? xr0 : (m1 < NPR ? a->in[0] + (size_t)m1 * D : a->in[1] + (size_t)(m1 - NPR) * D);
        f32x4 v0[4], v1[4];
#pragma unroll
        for (int j = 0; j < 4; ++j) { v0[j] = __builtin_nontemporal_load((const f32x4*)xr0 + lane + 64 * j); v1[j] = __builtin_nontemporal_load((const f32x4*)xr1 + lane + 64 * j); }
        float s0 = 0.f, s1 = 0.f;
#pragma unroll
        for (int j = 0; j < 4; ++j) { s0 += (v0[j][0] * v0[j][0] + v0[j][1] * v0[j][1]) + (v0[j][2] * v0[j][2] + v0[j][3] * v0[j][3]); s1 += (v1[j][0] * v1[j][0] + v1[j][1] * v1[j][1]) + (v1[j][2] * v1[j][2] + v1[j][3] * v1[j][3]);
            v2u w; w.x = pk2(v0[j][0], v0[j][1]); w.y = pk2(v0[j][2], v0[j][3]); *((v2u*)(hb + (size_t)m0 * D) + lane + 64 * j) = w;
            if (has1) { v2u w1; w1.x = pk2(v1[j][0], v1[j][1]); w1.y = pk2(v1[j][2], v1[j][3]); *((v2u*)(hb + (size_t)m1 * D) + lane + 64 * j) = w1; } }
        s0 = wave_sum(s0); s1 = wave_sum(s1);
        if (lane < 16) { rs[(size_t)m0 * 16 + lane] = lane == 0 ? s0 : 0.f; if (has1) rs[(size_t)m1 * 16 + lane] = lane == 0 ? s1 : 0.f; }
    }
    { const int gt0 = bid * (NWAVES * 64) + tid; if (gt0 < 1024) { const float x0 = a->in[18][gt0], x1 = a->in[18][1024 + gt0];
        *(f32x4*)((float*)(ws + OFF_LBT) + 4 * gt0) = (f32x4){logsig(x1 - x0), logsig(x0 - x1), sigm(x0 - x1), 0.f}; } }
    const int gt = bid * (NWAVES * 64) + tid, NGT = G * NWAVES * 64;
    for (int e = gt; e < 2 * M * 32; e += NGT) { const int li = e / (M * 32), rem = e % (M * 32), m = rem >> 5, c8 = (rem & 31) * 8;
        const float* src = m < NPR ? a->in[4] + ((size_t)li * NPR + m) * 256 + c8 : a->in[5] + ((size_t)li * NSM + (m - NPR)) * 256 + c8;
        const f32x4 v0 = __builtin_nontemporal_load((const f32x4*)src), v1 = __builtin_nontemporal_load((const f32x4*)(src + 4));
        v4u w; w.x = pk2(v0[0], v0[1]); w.y = pk2(v0[2], v0[3]); w.z = pk2(v1[0], v1[1]); w.w = pk2(v1[2], v1[3]);
        *(v4u*)((bf16*)(ws + OFF_PB + li * PB_SZ) + (size_t)m * 256 + c8) = w; }
}
template <bool HG> struct MX {
    static constexpr int H = HG ? 8 : 4, DV = HG ? 128 : 256, LDZ = HG ? 4096 : 3328, KC = HG ? 1024 : 512, VC = HG ? 2048 : 1024, GC = HG ? 3072 : 2048, VR = DV / 64, NVG = DV / 16, NVR = DV / 64;
    static constexpr float scale = HG ? 1.0f : 0.08838834764831845f;
};
template <bool HG> __device__ __forceinline__ void prep_phase(LAS unsigned char* lds, bf16* Z, const float* R, const float* wup, const float* bgk, const float* lbt, bf16* AB, float* DBUF, bf16* PB, int tid, int bid, int G) {
    typedef MX<HG> C; constexpr int H = C::H, DV = C::DV, LDZ = C::LDZ, KC = C::KC, VC = C::VC, VR = C::VR, QP = 136, TP = 72, NG = DV / 128, NGV = DV / 16;
    LAS float* gl = (LAS float*)lds; LAS float* segs = (LAS float*)(lds + 32768);
    LAS bf16* qe_s = (LAS bf16*)(lds + 34816); LAS bf16* kn_s = (LAS bf16*)(lds + 52224); LAS bf16* kdT_s = (LAS bf16*)(lds + 69632); LAS bf16* vT_s = (LAS bf16*)(lds + 88064);
    const int t = tid >> 3, cs = tid & 7, j0 = cs * 16, lane = tid & 63, w = tid >> 6;
    const int tsw = (((t >> 3) ^ cs) << 3) + (t & 7);
    v4u pq0, pq1, pk0, pk1, pv[DV / 64];
#define PREP_LOAD(u_) do { const int n_ = (u_) % NCH, bh_ = (u_) / NCH, h_ = bh_ % H, b_ = bh_ / H; const bf16* zr_ = Z + ((size_t)b_ * SEQ + 64 * n_ + t) * LDZ; \
        pq0 = *(const v4u*)(zr_ + h_ * 128 + j0); pq1 = *(const v4u*)(zr_ + h_ * 128 + j0 + 8); pk0 = *(const v4u*)(zr_ + KC + h_ * 128 + j0); pk1 = *(const v4u*)(zr_ + KC + h_ * 128 + j0 + 8); \
        _Pragma("unroll") for (int q_ = 0; q_ < DV / 64; ++q_) pv[q_] = *(const v4u*)(zr_ + VC + h_ * DV + cs * (DV / 8) + 8 * q_); } while (0)
    if (bid < NB * H * NCH) PREP_LOAD(bid);
    for (int unit = bid; unit < NB * H * NCH; unit += G) {
        const int n = unit % NCH, bh = unit / NCH, h = bh % H, b = bh / H;
        const size_t tok0 = (size_t)b * SEQ + 64 * n, m = tok0 + t;
        BAR_LDS();
        float lbc[16];
        if constexpr (!HG) {
            const int r = lane & 15, quad = lane >> 4, tb = w >> 1, cbase = 4 * (w & 1);
            float ar[4], br[4][4];
#pragma unroll
            for (int ks = 0; ks < 4; ++ks) { ar[ks] = R[(tok0 + 16 * tb + r) * 16 + 4 * ks + quad];
#pragma unroll
                for (int cb = 0; cb < 4; ++cb) br[cb][ks] = wup[(4 * ks + quad) * 512 + h * 128 + 16 * (cbase + cb) + r]; }
            float bias[4];
#pragma unroll
            for (int cb = 0; cb < 4; ++cb) bias[cb] = bgk[h * 128 + 16 * (cbase + cb) + r];
#pragma unroll
            for (int cb = 0; cb < 4; ++cb) { f32x4 c = {0.f, 0.f, 0.f, 0.f};
#pragma unroll
                for (int ks = 0; ks < 4; ++ks) c = __builtin_amdgcn_mfma_f32_16x16x4f32(ar[ks], br[cb][ks], c, 0, 0, 0);
#pragma unroll
                for (int j = 0; j < 4; ++j) gl[(16 * tb + 4 * quad + j) * 128 + 16 * (cbase + cb) + r] = logsig(c[j] + bias[cb]) * (1.0f / 16.0f); }
#pragma unroll
            for (int jj = 0; jj < 16; ++jj) lbc[jj] = 0.f;
        } else {
            float g[16];
            const unsigned fw[8] = {pk0.x, pk0.y, pk0.z, pk0.w, pk1.x, pk1.y, pk1.z, pk1.w};
#pragma unroll
            for (int jj = 0; jj < 16; ++jj) { const float f = (jj & 1) ? bfhi(fw[jj >> 1]) : bflo(fw[jj >> 1]);
                const f32x4 tc = *(const f32x4*)(lbt + (size_t)(h * 128 + j0 + jj) * 4);
                const float a = tc[0], b2 = tc[1] + logsig(f), mx = fmaxf(a, b2);
                g[jj] = mx + __logf(1.0f + __expf(-fabsf(a - b2))); lbc[jj] = tc[2]; }
#pragma unroll
            for (int q = 0; q < 4; ++q) *(LAS f32x4*)(gl + t * 128 + j0 + 4 * q) = (f32x4){g[4 * q], g[4 * q + 1], g[4 * q + 2], g[4 * q + 3]};
        }
        BAR_LDS();
        {
            const int j = tid & 127, sg = tid >> 7; float acc = 0.f;
#pragma unroll
            for (int i = 0; i < 16; ++i) { acc += gl[(16 * sg + i) * 128 + j]; gl[(16 * sg + i) * 128 + j] = acc; }
            segs[sg * 128 + j] = acc;
            BAR_LDS();
            float off = 0.f;
            for (int s2 = 0; s2 < sg; ++s2) off += segs[s2 * 128 + j];
            if (sg) {
#pragma unroll
                for (int i = 0; i < 16; ++i) gl[(16 * sg + i) * 128 + j] += off; }
        }
        BAR_LDS();
        {
            bf16* qp = Z + m * LDZ + h * 128 + j0;
            const v4u q0 = pq0, q1 = pq1, k0 = pk0, k1 = pk1;
            const unsigned qw[8] = {q0.x, q0.y, q0.z, q0.w, q1.x, q1.y, q1.z, q1.w}, kw[8] = {k0.x, k0.y, k0.z, k0.w, k1.x, k1.y, k1.z, k1.w};
            float bb[16], bl[16];
#pragma unroll
            for (int q = 0; q < 4; ++q) { const f32x4 x = *(const LAS f32x4*)(gl + t * 128 + j0 + 4 * q), y = *(const LAS f32x4*)(gl + 63 * 128 + j0 + 4 * q);
                bb[4 * q] = x[0]; bb[4 * q + 1] = x[1]; bb[4 * q + 2] = x[2]; bb[4 * q + 3] = x[3]; bl[4 * q] = y[0]; bl[4 * q + 1] = y[1]; bl[4 * q + 2] = y[2]; bl[4 * q + 3] = y[3]; }
            float qe[16], kn[16], kd[16];
#pragma unroll
            for (int jj = 0; jj < 16; ++jj) { float qv = (jj & 1) ? bfhi(qw[jj >> 1]) : bflo(qw[jj >> 1]); float kv = (jj & 1) ? bfhi(kw[jj >> 1]) : bflo(kw[jj >> 1]);
                if constexpr (HG) { qv = qv * sigm(qv); kv = lbc[jj] * sigm(-kv); }
                qe[jj] = qv * __expf(bb[jj]) * C::scale; kn[jj] = kv * __expf(-bb[jj]); kd[jj] = kv * __expf(bl[jj] - bb[jj]); }
            v4u o0, o1;
            o0.x = pk2(qe[0], qe[1]); o0.y = pk2(qe[2], qe[3]); o0.z = pk2(qe[4], qe[5]); o0.w = pk2(qe[6], qe[7]); o1.x = pk2(qe[8], qe[9]); o1.y = pk2(qe[10], qe[11]); o1.z = pk2(qe[12], qe[13]); o1.w = pk2(qe[14], qe[15]);
            *(v4u*)qp = o0; *(v4u*)(qp + 8) = o1; *(LAS v4u*)(qe_s + t * QP + j0) = o0; *(LAS v4u*)(qe_s + t * QP + j0 + 8) = o1;
            o0.x = pk2(kn[0], kn[1]); o0.y = pk2(kn[2], kn[3]); o0.z = pk2(kn[4], kn[5]); o0.w = pk2(kn[6], kn[7]); o1.x = pk2(kn[8], kn[9]); o1.y = pk2(kn[10], kn[11]); o1.z = pk2(kn[12], kn[13]); o1.w = pk2(kn[14], kn[15]);
            *(LAS v4u*)(kn_s + t * QP + j0) = o0; *(LAS v4u*)(kn_s + t * QP + j0 + 8) = o1;
#pragma unroll
            for (int jj = 0; jj < 16; jj += 2) { const unsigned pw = pk2(kd[jj], kd[jj + 1]); kdT_s[(j0 + jj) * TP + tsw] = (bf16)(pw & 0xffffu); kdT_s[(j0 + jj + 1) * TP + tsw] = (bf16)(pw >> 16); }
            if (t == 63) {
#pragma unroll
                for (int q = 0; q < 4; ++q) *(f32x4*)(DBUF + (size_t)unit * 128 + j0 + 4 * q) = (f32x4){__expf(bl[4 * q]), __expf(bl[4 * q + 1]), __expf(bl[4 * q + 2]), __expf(bl[4 * q + 3])}; }
#pragma unroll
            for (int q = 0; q < DV / 64; ++q) { const v4u x = pv[q]; const unsigned xw[4] = {x.x, x.y, x.z, x.w};
#pragma unroll
                for (int e = 0; e < 4; ++e) { const int v = cs * (DV / 8) + 8 * q + 2 * e; vT_s[v * TP + tsw] = (bf16)(xw[e] & 0xffffu); vT_s[(v + 1) * TP + tsw] = (bf16)(xw[e] >> 16); } }
        }
        BAR_LDS();
        if (unit + G < NB * H * NCH) PREP_LOAD(unit + G);
        {
            const int r = lane & 15, quad = lane >> 4, tb = w >> 1;
#pragma unroll
            for (int e = 0; e < 2; ++e) { const int sb = 2 * (w & 1) + e; f32x4 c = {0.f, 0.f, 0.f, 0.f};
                if (sb <= tb) {
#pragma unroll
                    for (int ks = 0; ks < 4; ++ks) { const bf16x8 av = *(const LAS bf16x8*)(kn_s + (16 * sb + r) * QP + 32 * ks + 8 * quad), bv = *(const LAS bf16x8*)(qe_s + (16 * tb + r) * QP + 32 * ks + 8 * quad);
                        c = __builtin_amdgcn_mfma_f32_16x16x32_bf16(av, bv, c, 0, 0, 0); } }
                const int tc = 16 * tb + r, s0 = 16 * sb + 4 * quad;
                v2u o; o.x = pk2(s0 <= tc ? c[0] : 0.f, s0 + 1 <= tc ? c[1] : 0.f); o.y = pk2(s0 + 2 <= tc ? c[2] : 0.f, s0 + 3 <= tc ? c[3] : 0.f);
                *(v2u*)(AB + (size_t)unit * 4096 + tc * 64 + s0) = o; }
        }
        {
            const int r = lane & 15, quad = lane >> 4;
#pragma unroll
            for (int vg = 0; vg < NG; ++vg) { const int gv = w * NG + vg;
                const int csv = HG ? gv : (gv >> 1);
                const bf16x8 b0 = *(const LAS bf16x8*)(vT_s + (16 * gv + r) * TP + 8 * (quad ^ csv)), b1 = *(const LAS bf16x8*)(vT_s + (16 * gv + r) * TP + 8 * ((4 + quad) ^ csv));
#pragma unroll
                for (int kb = 0; kb < 8; ++kb) { const bf16x8 a0 = *(const LAS bf16x8*)(kdT_s + (16 * kb + r) * TP + 8 * (quad ^ kb)), a1 = *(const LAS bf16x8*)(kdT_s + (16 * kb + r) * TP + 8 * ((4 + quad) ^ kb));
                    f32x4 c = {0.f, 0.f, 0.f, 0.f}; c = __builtin_amdgcn_mfma_f32_16x16x32_bf16(a0, b0, c, 0, 0, 0); c = __builtin_amdgcn_mfma_f32_16x16x32_bf16(a1, b1, c, 0, 0, 0);
                    v2u o; o.x = pk2(c[0], c[1]); o.y = pk2(c[2], c[3]);
                    *(v2u*)(PB + (((size_t)unit * NGV + gv) * 4 + (kb >> 1)) * 512 + lane * 8 + (kb & 1) * 4) = o; } }
        }
        for (int c = tid; c < DV * 4; c += NWAVES * 64) { const int v = c >> 2, sq = c & 3;
            const int csv = v / (DV / 8);
            const v4u x0 = *(const LAS v4u*)(vT_s + v * TP + 8 * ((2 * sq) ^ csv)), x1 = *(const LAS v4u*)(vT_s + v * TP + 8 * ((2 * sq + 1) ^ csv));
            bf16* dst = Z + (tok0 + v / VR) * LDZ + VC + h * DV + (v % VR) * 64 + 16 * sq;
            *(v4u*)dst = x0; *(v4u*)(dst + 8) = x1; }
    }
#undef PREP_LOAD
}
template <bool HG> __device__ __forceinline__ void state_phase(bf16* PSB, const float* DBUF, float* Sout, int gt, int ngt) {
    typedef MX<HG> C; constexpr int H = C::H, DV = C::DV, NGV = DV / 16, TOTAL = NB * H * NGV * 4 * 64;
    for (int idx = gt; idx < TOTAL; idx += ngt) {
        const int lane = idx & 63, ks = (idx >> 6) & 3, gvb = idx >> 8, gv = gvb % NGV, bh = gvb / NGV, quad = lane >> 4, r = lane & 15;
        f32x4 S0 = {0.f, 0.f, 0.f, 0.f}, S1 = {0.f, 0.f, 0.f, 0.f};
        bf16* pp = PSB + (((size_t)bh * NCH * NGV + gv) * 4 + ks) * 512 + lane * 8; const float* dp = DBUF + (size_t)bh * NCH * 128 + 32 * ks + 4 * quad;
        for (int n0 = 0; n0 < NCH; n0 += 8) {
            v4u p[8]; f32x4 d0[8], d1[8];
#pragma unroll
            for (int i = 0; i < 8; ++i) { p[i] = *(const v4u*)(pp + (size_t)(n0 + i) * NGV * 2048); d0[i] = *(const f32x4*)(dp + (n0 + i) * 128); d1[i] = *(const f32x4*)(dp + (n0 + i) * 128 + 16); }
            __builtin_amdgcn_sched_barrier(0);
#pragma unroll
            for (int i = 0; i < 8; ++i) { v4u o; o.x = pk2(S0[0], S0[1]); o.y = pk2(S0[2], S0[3]); o.z = pk2(S1[0], S1[1]); o.w = pk2(S1[2], S1[3]);
                *(v4u*)(pp + (size_t)(n0 + i) * NGV * 2048) = o;
                S0 = S0 * d0[i] + (f32x4){bflo(p[i].x), bfhi(p[i].x), bflo(p[i].y), bfhi(p[i].y)}; S1 = S1 * d1[i] + (f32x4){bflo(p[i].z), bfhi(p[i].z), bflo(p[i].w), bfhi(p[i].w)}; }
        }
        float* so = Sout + ((size_t)bh * 128 + 32 * ks + 4 * quad) * DV + 16 * gv + r;
#pragma unroll
        for (int j = 0; j < 4; ++j) { so[j * DV] = S0[j]; so[(16 + j) * DV] = S1[j]; }
    }
}
template <bool HG> __device__ __forceinline__ void out_phase(LAS unsigned char* lds, const bf16* Z, const bf16* AB, const bf16* PSB, bf16* OG, const float* gn, int tid, int w, int bid, int G) {
    typedef MX<HG> C; constexpr int H = C::H, DV = C::DV, LDZ = C::LDZ, VC = C::VC, GC = C::GC, VR = C::VR, VW = DV / 8, NG = VW / 16, NGV = DV / 16, NU = NB * H * NCH;
    constexpr int QP = 136, AP = 72, OFF_QE = 0, OFF_AA = 64 * QP * 2, BUFSZ = OFF_AA + 64 * AP * 2, OFF_SS = 2 * BUFSZ;
    const int lane = tid & 63, r = lane & 15, quad = lane >> 4, vbase = w * VW;
    f32x4 gnv[NG];
#pragma unroll
    for (int vg = 0; vg < NG; ++vg) gnv[vg] = *(const f32x4*)(gn + vbase + 16 * vg + 4 * quad);
    unsigned oq[2], ov[NG], sq[2];
#pragma unroll
    for (int i = 0; i < 2; ++i) { const int p = tid + 512 * i, row = p >> 4, c16 = p & 15; oq[i] = (unsigned)(row * LDZ + 8 * c16) * 2u; sq[i] = (unsigned)(row * QP + 8 * c16) * 2u; }
#pragma unroll
    for (int vg = 0; vg < NG; ++vg) { const int v = vbase + 16 * vg + r; ov[vg] = (unsigned)((v / VR) * LDZ + (v % VR) * 64 + 8 * quad) * 2u; }
    unsigned oa = (unsigned)tid * 16u, og = (unsigned)(r * LDZ + 4 * quad) * 2u, oo = (unsigned)(r * 1024 + 4 * quad) * 2u, osb = (unsigned)lane * 16u;
    unsigned lq = (unsigned)(r * QP + 4 * quad) * 2u, la = (unsigned)(r * AP + 8 * quad) * 2u, sa = (unsigned)((tid >> 3) * AP + 8 * (tid & 7)) * 2u;
    v4u pq[2], pa; bf16x8 sb[NG][4], vb[NG][2], sbn[NG][4], vbn[NG][2];
#define OP_BASES(u_) const int n_ = (u_) % NCH, bh_ = (u_) / NCH, h_ = bh_ % H, b_ = bh_ / H; const size_t tk_ = (size_t)b_ * SEQ + 64 * n_; \
        const char* zq_ = (const char*)(Z + tk_ * LDZ + h_ * 128); const char* zv_ = (const char*)(Z + tk_ * LDZ + VC + h_ * DV); const char* ab_ = (const char*)(AB + (size_t)(u_) * 4096); \
        const char* sb_ = (const char*)(PSB + ((size_t)(u_) * NGV + w * NG) * 2048)
#define OP_ISSUE(u_) do { OP_BASES(u_); pq[0] = *(const v4u*)(zq_ + oq[0]); pq[1] = *(const v4u*)(zq_ + oq[1]); pa = *(const v4u*)(ab_ + oa); \
        _Pragma("unroll") for (int vg = 0; vg < NG; ++vg) { _Pragma("unroll") for (int ks = 0; ks < 4; ++ks) sbn[vg][ks] = *(const bf16x8*)(sb_ + (vg * 4 + ks) * 1024 + osb); \
            vbn[vg][0] = *(const bf16x8*)(zv_ + ov[vg]); vbn[vg][1] = *(const bf16x8*)(zv_ + ov[vg] + 64); } } while (0)
#define OP_STAGE(buf_) do { LAS unsigned char* bs_ = lds + (buf_) * BUFSZ; *(LAS v4u*)(bs_ + OFF_QE + sq[0]) = pq[0]; *(LAS v4u*)(bs_ + OFF_QE + sq[1]) = pq[1]; *(LAS v4u*)(bs_ + OFF_AA + sa) = pa; } while (0)
#define OP_TAKE() do { _Pragma("unroll") for (int vg = 0; vg < NG; ++vg) { _Pragma("unroll") for (int ks = 0; ks < 4; ++ks) sb[vg][ks] = sbn[vg][ks]; vb[vg][0] = vbn[vg][0]; vb[vg][1] = vbn[vg][1]; } } while (0)
    OP_ISSUE(bid); OP_STAGE(0); OP_TAKE();
    BAR_LDS();
    int par = 0;
    for (int unit = bid; unit < NU; unit += G, par ^= 1) {
        asm volatile("" : "+v"(oq[0]), "+v"(oq[1]), "+v"(oa), "+v"(og), "+v"(oo), "+v"(osb), "+v"(lq), "+v"(la), "+v"(sa), "+v"(sq[0]), "+v"(sq[1]));
#pragma unroll
        for (int vg = 0; vg < NG; ++vg) asm volatile("" : "+v"(ov[vg]));
        const int n = unit % NCH, bh = unit / NCH, h = bh % H, b = bh / H; const size_t tok0 = (size_t)b * SEQ + 64 * n;
        const char* zg = (const char*)(Z + tok0 * LDZ + GC + h * DV + vbase);
        v2u gq[NG][4];
#pragma unroll
        for (int tb = 0; tb < 4; ++tb)
#pragma unroll
            for (int vg = 0; vg < NG; ++vg) gq[vg][tb] = *(const v2u*)(zg + (size_t)tb * 16 * LDZ * 2 + og + 32 * vg);
        const bool more = unit + G < NU;
        if (more) OP_ISSUE(unit + G);
        const LAS unsigned char* bs = lds + par * BUFSZ;
        f32x4 o[NG][4];
#pragma unroll
        for (int vg = 0; vg < NG; ++vg)
#pragma unroll
            for (int tb = 0; tb < 4; ++tb) o[vg][tb] = (f32x4){0.f, 0.f, 0.f, 0.f};
#pragma unroll
        for (int kh = 0; kh < 2; ++kh) { bf16x8 qf[2][4];
#pragma unroll
            for (int kl = 0; kl < 2; ++kl)
#pragma unroll
                for (int tb = 0; tb < 4; ++tb) { const LAS unsigned char* qa = bs + OFF_QE + lq + (16 * tb * QP + 32 * (2 * kh + kl)) * 2;
                    const v2u lo = *(const LAS v2u*)qa, hi = *(const LAS v2u*)(qa + 32); qf[kl][tb] = __builtin_bit_cast(bf16x8, ((v4u){lo.x, lo.y, hi.x, hi.y})); }
            __builtin_amdgcn_sched_barrier(0);
#pragma unroll
            for (int kl = 0; kl < 2; ++kl)
#pragma unroll
                for (int tb = 0; tb < 4; ++tb)
#pragma unroll
                    for (int vg = 0; vg < NG; ++vg) o[vg][tb] = __builtin_amdgcn_mfma_f32_16x16x32_bf16(sb[vg][2 * kh + kl], qf[kl][tb], o[vg][tb], 0, 0, 0);
            __builtin_amdgcn_sched_barrier(0); }
        { bf16x8 af[4][2];
#pragma unroll
            for (int tb = 0; tb < 4; ++tb) { const LAS unsigned char* aa = bs + OFF_AA + la + 16 * tb * AP * 2; af[tb][0] = *(const LAS bf16x8*)aa; af[tb][1] = *(const LAS bf16x8*)(aa + 64); }
            __builtin_amdgcn_sched_barrier(0);
#pragma unroll
            for (int js = 0; js < 2; ++js)
#pragma unroll
                for (int tb = 0; tb < 4; ++tb)
#pragma unroll
                    for (int vg = 0; vg < NG; ++vg) o[vg][tb] = __builtin_amdgcn_mfma_f32_16x16x32_bf16(vb[vg][js], af[tb][js], o[vg][tb], 0, 0, 0);
            __builtin_amdgcn_sched_barrier(0); }
        LAS float* ssb = (LAS float*)(lds + OFF_SS + par * 2048);
#pragma unroll
        for (int tb = 0; tb < 4; ++tb) { float p = 0.f;
#pragma unroll
            for (int vg = 0; vg < NG; ++vg) p += (o[vg][tb][0] * o[vg][tb][0] + o[vg][tb][1] * o[vg][tb][1]) + (o[vg][tb][2] * o[vg][tb][2] + o[vg][tb][3] * o[vg][tb][3]);
            p += __shfl_xor(p, 16); p += __shfl_xor(p, 32);
            if (quad == 0) ssb[(16 * tb + r) * 8 + w] = p; }
        if (more) { OP_STAGE(par ^ 1); OP_TAKE(); }
        BAR_LDS();
        char* ogn = (char*)(OG + tok0 * 1024 + h * DV + vbase);
#pragma unroll
        for (int tb = 0; tb < 4; ++tb) { const f32x4 s0 = *(const LAS f32x4*)(ssb + (16 * tb + r) * 8), s1 = *(const LAS f32x4*)(ssb + (16 * tb + r) * 8 + 4);
            const float tot = ((s0[0] + s0[1]) + (s0[2] + s0[3])) + ((s1[0] + s1[1]) + (s1[2] + s1[3])); const float rinv = rsqrtf(tot * (1.0f / DV) + 1e-6f);
#pragma unroll
            for (int vg = 0; vg < NG; ++vg) { const float g0 = bflo(gq[vg][tb].x), g1 = bfhi(gq[vg][tb].x), g2 = bflo(gq[vg][tb].y), g3 = bfhi(gq[vg][tb].y);
                const f32x4 y = o[vg][tb] * rinv * gnv[vg]; v2u pw; pw.x = pk2(y[0] * g0 * sigm(g0), y[1] * g1 * sigm(g1)); pw.y = pk2(y[2] * g2 * sigm(g2), y[3] * g3 * sigm(g3));
                *(v2u*)(ogn + (size_t)tb * 16 * 1024 * 2 + oo + 32 * vg) = pw; } }
    }
#undef OP_BASES
#undef OP_ISSUE
#undef OP_STAGE
#undef OP_TAKE
}
template <bool HG> __device__ __forceinline__ void sample_block(LAS unsigned char* lds, const bf16* Z, const float* R, const float* wup, const float* bgk, const float* lowb, const float* gn, const float* S0, float* Sout, bf16* OG, int bh, int tid, int w) {
    typedef MX<HG> C; constexpr int H = C::H, DV = C::DV, LDZ = C::LDZ, KC = C::KC, VC = C::VC, GC = C::GC, E = DV / 64;
    const int lane = tid & 63, kk = lane >> 2, t = lane & 3, k = 16 * w + kk, h = bh % H, b = bh / H, hk = h * 128 + k; const size_t m0 = (size_t)NPR + 4 * b;
    LAS float* tab = (LAS float*)lds + w * 192; LAS float* pas = (LAS float*)(lds + 6144); LAS float* red = (LAS float*)(lds + 8192);
    const float* sp = S0 + ((size_t)bh * 128 + 16 * w) * DV + E * lane; float* dp = Sout + ((size_t)bh * 128 + 16 * w) * DV + E * lane;
    float s0[16][E];
#pragma unroll
    for (int i = 0; i < 16; ++i) {
        if constexpr (E == 4) { const f32x4 x = __builtin_nontemporal_load((const f32x4*)(sp + (size_t)i * DV)); s0[i][0] = x[0]; s0[i][1] = x[1]; s0[i][2] = x[2]; s0[i][3] = x[3]; }
        else { const v2u x = __builtin_nontemporal_load((const v2u*)(sp + (size_t)i * DV)); s0[i][0] = __uint_as_float(x.x); s0[i][1] = __uint_as_float(x.y); } }
    float vv[4][E];
#pragma unroll
    for (int s = 0; s < 4; ++s) { const bf16* zv = Z + (m0 + s) * LDZ + VC + h * DV + E * lane;
        if constexpr (E == 4) { const v2u x = *(const v2u*)zv; vv[s][0] = bflo(x.x); vv[s][1] = bfhi(x.x); vv[s][2] = bflo(x.y); vv[s][3] = bfhi(x.y); }
        else { const unsigned x = *(const unsigned*)zv; vv[s][0] = bflo(x); vv[s][1] = bfhi(x); } }
    const bf16* zr = Z + (m0 + t) * LDZ; float q = bf2f(zr[hk]); const float kz = bf2f(zr[KC + hk]); float g, kv;
    if constexpr (!HG) { float x = bgk[hk];
#pragma unroll
        for (int i = 0; i < 16; ++i) x += R[(m0 + t) * 16 + i] * wup[i * 512 + hk];
        g = logsig(x) * (1.0f / 16.0f); kv = kz;
    } else { const float x0 = lowb[hk], x1 = lowb[1024 + hk]; const float a = logsig(x1 - x0), b2 = logsig(x0 - x1) + logsig(kz), mx = fmaxf(a, b2);
        g = mx + __logf(1.0f + __expf(-fabsf(a - b2))); kv = sigm(x0 - x1) * sigm(-kz); q = q * sigm(q); }
    const int l0 = lane & ~3;
    const float g0 = __shfl(g, l0), g1 = __shfl(g, l0 + 1), g2 = __shfl(g, l0 + 2), g3 = __shfl(g, l0 + 3);
    const float b3 = ((g0 + g1) + g2) + g3, bt = t == 0 ? g0 : (t == 1 ? g0 + g1 : (t == 2 ? (g0 + g1) + g2 : b3));
    const float qe = q * __expf(bt) * C::scale, kn = kv * __expf(-bt), kd = kv * __expf(b3 - bt);
    tab[kk * 12 + t] = qe; tab[kk * 12 + 4 + t] = kd; if (t == 0) tab[kk * 12 + 8] = __expf(b3);
    {
        float p[4];
#pragma unroll
        for (int s = 0; s < 4; ++s) { p[s] = qe * __shfl(kn, l0 + s);
            p[s] += __shfl_xor(p[s], 4); p[s] += __shfl_xor(p[s], 8); p[s] += __shfl_xor(p[s], 16); p[s] += __shfl_xor(p[s], 32); }
        if (lane < 4) *(LAS f32x4*)(pas + w * 16 + 4 * lane) = (f32x4){p[0], p[1], p[2], p[3]};
    }
    LDS_WAIT();
    float o[4][E];
#pragma unroll
    for (int tt = 0; tt < 4; ++tt)
#pragma unroll
        for (int e = 0; e < E; ++e) o[tt][e] = 0.f;
#pragma unroll
    for (int i = 0; i < 16; ++i) { const f32x4 q4 = *(const LAS f32x4*)(tab + i * 12), k4 = *(const LAS f32x4*)(tab + i * 12 + 4); const float d = tab[i * 12 + 8]; float sn[E];
#pragma unroll
        for (int e = 0; e < E; ++e) { o[0][e] += q4[0] * s0[i][e]; o[1][e] += q4[1] * s0[i][e]; o[2][e] += q4[2] * s0[i][e]; o[3][e] += q4[3] * s0[i][e];
            sn[e] = d * s0[i][e] + ((k4[0] * vv[0][e] + k4[1] * vv[1][e]) + (k4[2] * vv[2][e] + k4[3] * vv[3][e])); }
        if constexpr (E == 4) __builtin_nontemporal_store(((f32x4){sn[0], sn[1], sn[2], sn[3]}), (f32x4*)(dp + (size_t)i * DV));
        else { v2u x; x.x = __float_as_uint(sn[0]); x.y = __float_as_uint(sn[1]); __builtin_nontemporal_store(x, (v2u*)(dp + (size_t)i * DV)); } }
#pragma unroll
    for (int tt = 0; tt < 4; ++tt) {
        if constexpr (E == 4) *(LAS f32x4*)(red + (w * 4 + tt) * DV + 4 * lane) = (f32x4){o[tt][0], o[tt][1], o[tt][2], o[tt][3]};
        else { red[(w * 4 + tt) * DV + 2 * lane] = o[tt][0]; red[(w * 4 + tt) * DV + 2 * lane + 1] = o[tt][1]; } }
    BAR_LDS();
    if (w < 4) {
        float y[E];
#pragma unroll
        for (int e = 0; e < E; ++e) y[e] = 0.f;
#pragma unroll
        for (int ww = 0; ww < 8; ++ww)
#pragma unroll
            for (int e = 0; e < E; ++e) y[e] += red[(ww * 4 + w) * DV + E * lane + e];
#pragma unroll
        for (int s = 0; s < 4; ++s) if (s <= w) { float a = 0.f;
#pragma unroll
            for (int ww = 0; ww < 8; ++ww) a += pas[ww * 16 + 4 * w + s];
#pragma unroll
            for (int e = 0; e < E; ++e) y[e] += a * vv[s][e]; }
        float ss = 0.f;
#pragma unroll
        for (int e = 0; e < E; ++e) ss += y[e] * y[e];
        ss = wave_sum(ss); const float rinv = rsqrtf(ss * (1.0f / DV) + 1e-6f);
        const bf16* zg = Z + (m0 + w) * LDZ + GC + h * DV + E * lane; bf16* op = OG + (m0 + w) * 1024 + h * DV + E * lane; float gg[E];
        if constexpr (E == 4) { const v2u x = *(const v2u*)zg; gg[0] = bflo(x.x); gg[1] = bfhi(x.x); gg[2] = bflo(x.y); gg[3] = bfhi(x.y); } else { const unsigned x = *(const unsigned*)zg; gg[0] = bflo(x); gg[1] = bfhi(x); }
#pragma unroll
        for (int e = 0; e < E; ++e) y[e] = y[e] * rinv * gn[E * lane + e] * (gg[e] * sigm(gg[e]));
        if constexpr (E == 4) { v2u pw; pw.x = pk2(y[0], y[1]); pw.y = pk2(y[2], y[3]); *(v2u*)op = pw; } else { *(unsigned*)op = pk2(y[0], y[1]); }
    }
    BAR_LDS();
}
template <int NKS> __device__ __forceinline__ void mini_acc(f32x4 (&acc)[2][4], const bf16* ap, size_t lda, const bf16* bp, size_t ldb) {
#pragma unroll
    for (int c = 0; c < NKS; c += 4) {
        bf16x8 af[4][2], bfr[4][4];
#pragma unroll
        for (int ks = 0; ks < 4; ++ks) if (c + ks < NKS) {
#pragma unroll
            for (int rb = 0; rb < 2; ++rb) af[ks][rb] = *(const bf16x8*)(ap + (size_t)(16 * rb) * lda + 32 * (c + ks));
#pragma unroll
            for (int cb = 0; cb < 4; ++cb) bfr[ks][cb] = *(const bf16x8*)(bp + (size_t)(16 * cb) * ldb + 32 * (c + ks)); }
        __builtin_amdgcn_sched_barrier(0);
#pragma unroll
        for (int ks = 0; ks < 4; ++ks) if (c + ks < NKS) {
#pragma unroll
            for (int rb = 0; rb < 2; ++rb)
#pragma unroll
                for (int cb = 0; cb < 4; ++cb) acc[rb][cb] = __builtin_amdgcn_mfma_f32_16x16x32_bf16(bfr[ks][cb], af[ks][rb], acc[rb][cb], 0, 0, 0); }
        __builtin_amdgcn_sched_barrier(0);
    }
}
template <int MODE, int K> __device__ __forceinline__ void mini_gemm(LAS unsigned char* lds, const bf16* A, const bf16* Bt, const bf16* A2, const bf16* Bt2, const float* xin, const bf16* hb_in, bf16* hb_out, const float* rs_in, float* rs_out, float alpha, int tid, int bid, int G) {
    const int lane = tid & 63, w = tid >> 6, r = lane & 15, quad = lane >> 4;
    LAS float* P = (LAS float*)lds; LAS float* P2 = (LAS float*)(lds + 65536);
    for (int mt = bid; mt < 256; mt += G) {
        const int rt = mt >> 4, ct = mt & 15, row0 = NPR + 32 * rt, col0 = 64 * ct;
        f32x4 acc[2][4];
#pragma unroll
        for (int rb = 0; rb < 2; ++rb)
#pragma unroll
            for (int cb = 0; cb < 4; ++cb) acc[rb][cb] = (f32x4){0.f, 0.f, 0.f, 0.f};
        constexpr int KW = K / 8;
        mini_acc<KW / 32>(acc, A + (size_t)(row0 + r) * K + w * KW + 8 * quad, K, Bt + (size_t)(col0 + r) * K + w * KW + 8 * quad, K);
#pragma unroll
        for (int rb = 0; rb < 2; ++rb)
#pragma unroll
            for (int cb = 0; cb < 4; ++cb) *(LAS f32x4*)(P + (w * 32 + 16 * rb + r) * 64 + 16 * cb + 4 * quad) = acc[rb][cb];
        if constexpr (MODE == 1) {
#pragma unroll
            for (int rb = 0; rb < 2; ++rb)
#pragma unroll
                for (int cb = 0; cb < 4; ++cb) acc[rb][cb] = (f32x4){0.f, 0.f, 0.f, 0.f};
            mini_acc<1>(acc, A2 + (size_t)(row0 + r) * 256 + w * 32 + 8 * quad, 256, Bt2 + (size_t)(col0 + r) * 256 + w * 32 + 8 * quad, 256);
#pragma unroll
            for (int rb = 0; rb < 2; ++rb)
#pragma unroll
                for (int cb = 0; cb < 4; ++cb) *(LAS f32x4*)(P2 + (w * 32 + 16 * rb + r) * 64 + 16 * cb + 4 * quad) = acc[rb][cb];
        }
        BAR_LDS();
        const int row = tid >> 4, c4 = (tid & 15) * 4; f32x4 v = {0.f, 0.f, 0.f, 0.f}, v2 = {0.f, 0.f, 0.f, 0.f};
#pragma unroll
        for (int ww = 0; ww < 8; ++ww) { v += *(const LAS f32x4*)(P + (ww * 32 + row) * 64 + c4); if constexpr (MODE == 1) v2 += *(const LAS f32x4*)(P2 + (ww * 32 + row) * 64 + c4); }
        const int grow = row0 + row; const size_t off = (size_t)grow * 1024 + col0 + c4;
        f32x4 o;
        if (xin) o = *(const f32x4*)(xin + off); else { const v2u hx = *(const v2u*)(hb_in + off); o = (f32x4){bflo(hx.x), bfhi(hx.x), bflo(hx.y), bfhi(hx.y)}; }
        if constexpr (MODE == 0) o += v * alpha;
        else { const float s = pg8::row_scale(rs_in, grow); o[0] += sigm(v[0] * s) * v2[0]; o[1] += sigm(v[1] * s) * v2[1]; o[2] += sigm(v[2] * s) * v2[2]; o[3] += sigm(v[3] * s) * v2[3]; }
        v2u pw; pw.x = pk2(o[0], o[1]); pw.y = pk2(o[2], o[3]); *(v2u*)(hb_out + off) = pw;
        float ss = (o[0] * o[0] + o[1] * o[1]) + (o[2] * o[2] + o[3] * o[3]);
        ss += __shfl_xor(ss, 1); ss += __shfl_xor(ss, 2); ss += __shfl_xor(ss, 4); ss += __shfl_xor(ss, 8);
        if ((tid & 15) == 0) rs_out[(size_t)grow * 16 + ct] = ss;
        BAR_LDS();
    }
}
#define XB_TMO      128
#define XB_XCNT(j)  (256  + 64 * (j))
#define XB_XSUB(j)  (1280 + 64 * (j))
#define XB_XGEN(j)  (2304 + 64 * (j))
#define XB_TOP      3328
#define XB_TOPGEN   3392
#define XCD_BAR_WORDS 3456
#define XB_SPIN_CAP (1u << 18)

__device__ __forceinline__ unsigned xb_ld(unsigned* p)              { return __hip_atomic_load(p, __ATOMIC_RELAXED, __HIP_MEMORY_SCOPE_AGENT); }
__device__ __forceinline__ unsigned xb_add(unsigned* p, unsigned v) { return __hip_atomic_fetch_add(p, v, __ATOMIC_RELAXED, __HIP_MEMORY_SCOPE_AGENT); }
__device__ __forceinline__ unsigned xb_xcc_id() { return (unsigned)__builtin_amdgcn_s_getreg((3 << 11) | 20) & 0xFu; }
#define XB_SPIN(cond, bar) do { unsigned _sp = 0; while (cond) { __builtin_amdgcn_s_sleep(1); \
    if ((++_sp & 255u) == 0u) { if (xb_ld(&(bar)[XB_TMO])) break; if (_sp > XB_SPIN_CAP) { atomicAdd(&(bar)[XB_TMO], 1u); break; } } } } while (0)

struct XcdBarrier {
    unsigned* bar; unsigned x;
    volatile LAS unsigned* st;
};

__device__ __forceinline__ XcdBarrier xcd_barrier_post(unsigned* bar, volatile LAS unsigned* st) {
    XcdBarrier b; b.bar = bar; b.x = xb_xcc_id(); b.st = st;
    if (threadIdx.x == 0) (void)xb_add(&bar[XB_XCNT(b.x)], 1u);
    return b;
}
__device__ __forceinline__ void xcd_barrier_complete(unsigned* bar, unsigned x, unsigned& nloc, unsigned& nx) {
    const unsigned G = gridDim.x * gridDim.y * gridDim.z;
    unsigned sum, cnt, mine, sp = 0u;
    for (;;) {
        sum = 0u; cnt = 0u; mine = 0u;
#pragma unroll
        for (unsigned j = 0; j < 16; ++j) { const unsigned c = xb_ld(&bar[XB_XCNT(j)]); sum += c; cnt += (c > 0u) ? 1u : 0u; mine = (j == x) ? c : mine; }
        if (sum == G) break;
        __builtin_amdgcn_s_sleep(1);
        if ((++sp & 255u) == 0u) { if (xb_ld(&bar[XB_TMO])) break; if (sp > XB_SPIN_CAP) { atomicAdd(&bar[XB_TMO], 1u); break; } }
    }
    nloc = mine > 0u ? mine : 1u; nx = cnt > 0u ? cnt : 1u;
}

__device__ __forceinline__ void xcd_barrier(const XcdBarrier& b) {
    asm volatile("s_waitcnt vmcnt(0)" ::: "memory");
    __syncthreads();
    if (threadIdx.x == 0) {
        unsigned* bar = b.bar;
        __builtin_amdgcn_s_waitcnt(0);
        unsigned nloc = b.st[0], nx = b.st[1];
        if (nloc == 0u) { xcd_barrier_complete(bar, b.x, nloc, nx); b.st[0] = nloc; b.st[1] = nx; }
        const unsigned old = xb_add(&bar[XB_XSUB(b.x)], 1u);
        const unsigned gen = old / nloc;
        if (old + 1u == (gen + 1u) * nloc) {
            __builtin_amdgcn_fence(__ATOMIC_RELEASE, "agent");
            asm volatile("s_waitcnt vmcnt(0)" ::: "memory");
            const unsigned og = xb_add(&bar[XB_TOP], 1u);
            const unsigned tg = og / nx;
            if (og + 1u == (tg + 1u) * nx) xb_add(&bar[XB_TOPGEN], 1u);
            else XB_SPIN(xb_ld(&bar[XB_TOPGEN]) == tg, bar);
            __builtin_amdgcn_fence(__ATOMIC_ACQUIRE, "agent");
            xb_add(&bar[XB_XGEN(b.x)], 1u);
            asm volatile("s_waitcnt vmcnt(0)" ::: "memory");
        } else {
            XB_SPIN(xb_ld(&bar[XB_XGEN(b.x)]) == gen, bar);
            __builtin_amdgcn_fence(__ATOMIC_ACQUIRE, "agent");
            asm volatile("s_waitcnt vmcnt(0)" ::: "memory");
        }
    }
    __syncthreads();
}

#define MK_TID() int wave = wave_s; asm volatile("" : "+s"(wave)); unsigned ones_ = ~0u; asm volatile("" : "+s"(ones_)); \
    const int lane = (int)__builtin_amdgcn_mbcnt_hi(ones_, __builtin_amdgcn_mbcnt_lo(ones_, 0u)); const int tid = wave * 64 + lane; const int gw = bid * NWAVES + wave, NGW = G * NWAVES; (void)gw; (void)NGW; (void)tid; (void)lane
__global__ void __launch_bounds__(NWAVES * 64, 2) fwd_kernel(Args a) {
    extern __shared__ __attribute__((aligned(16))) unsigned char lds_raw[];
    LAS unsigned char* lds = (LAS unsigned char*)lds_raw;
    cg::grid_group grid = cg::this_grid();
    const int wave_s = __builtin_amdgcn_readfirstlane((int)threadIdx.x >> 6);
    volatile LAS unsigned* bst = (volatile LAS unsigned*)(lds + LDS_BYTES - 64);
    if (threadIdx.x < 2) bst[threadIdx.x] = 0u;
    __syncthreads();
    const XcdBarrier xbar = xcd_barrier_post((unsigned*)(a.ws + OFF_CTL), bst);
#if PT_ON
#define PT_T0 (blockIdx.x == 0 && wave_s == 0 && __builtin_amdgcn_mbcnt_hi(~0u, __builtin_amdgcn_mbcnt_lo(~0u, 0u)) == 0u)
#define tsl ((volatile LAS unsigned*)(lds + LDS_BYTES - 32))
#endif
    const int ph_lo = a.ph_lo, ph_hi = a.ph_hi;
    for (int ph_ = ph_lo; ph_ < ph_hi; ++ph_) {
#if PROBE_MODE
      const int kk_ = (ph_ - 1) % 10; const bool mid_ = ph_ > 0 && ph_ < NPH - 1;
      const int nrep = (PROBE_MODE == 1 && ph_ == 0) || (PROBE_MODE == 2 && mid_ && (kk_ == 0 || kk_ == 7)) || (PROBE_MODE == 3 && mid_ && kk_ == 2) || (PROBE_MODE == 4 && mid_ && kk_ == 5) ? 2 : 1;
      for (int rep = 0; rep < nrep; ++rep) {
#else
      {
#endif
        int ph = ph_; asm volatile("" : "+s"(ph));
#if PT_ON
        if (ph == PT_LO && PT_T0) { const unsigned long long t_ = __builtin_amdgcn_s_memrealtime(); tsl[0] = (unsigned)t_; tsl[1] = (unsigned)(t_ >> 32); }
        if (ph == PT_HI + 1 && PT_T0) { const unsigned long long t_ = __builtin_amdgcn_s_memrealtime(); tsl[2] = (unsigned)t_; tsl[3] = (unsigned)(t_ >> 32); }
#endif
        CArgs* ap = (CArgs*)__builtin_amdgcn_kernarg_segment_ptr(); asm volatile("" : "+s"(ap));
        int bid = blockIdx.x; asm volatile("" : "+s"(bid));
        int G = gridDim.x; asm volatile("" : "+s"(G));
        unsigned char* ws = ap->ws; float* hbuf = ap->out;
        if (ph == 0) { MK_TID(); prologue(ap, ws, hbuf, lds, tid, bid, G); }
        else if (ph == NPH - 1) {
            MK_TID(); const float* fw = ap->in[25]; const bf16* hfin = (const bf16*)(ws + OFF_HB);
            for (int m = gw; m < M; m += NGW) { const v2u* hr = (const v2u*)(hfin + (size_t)m * D); f32x4 v[4]; float ss = 0.f;
#pragma unroll
                for (int j = 0; j < 4; ++j) { const v2u x = hr[lane + 64 * j]; v[j] = (f32x4){bflo(x.x), bfhi(x.x), bflo(x.y), bfhi(x.y)}; ss += (v[j][0] * v[j][0] + v[j][1] * v[j][1]) + (v[j][2] * v[j][2] + v[j][3] * v[j][3]); }
                ss = wave_sum(ss); const float rinv = rsqrtf(ss * (1.0f / D) + 1e-6f);
#pragma unroll
                for (int j = 0; j < 4; ++j) { const f32x4 wv = *((const f32x4*)fw + lane + 64 * j); __builtin_nontemporal_store(v[j] * rinv * wv, (f32x4*)(hbuf + (size_t)m * D) + lane + 64 * j); } }
        } else {
            const int li = (ph - 1) / 10, k = (ph - 1) % 10, cur = li;
            bf16* hb = (bf16*)(ws + OFF_HB + cur * HB_SZ); bf16* ob = (bf16*)(ws + OFF_HB + (cur ^ 1) * HB_SZ);
            float* rs0 = (float*)(ws + OFF_RS); float* rs1 = (float*)(ws + OFF_RS + RS_SZ); float* Rb = (float*)(ws + OFF_R);
            bf16* big = (bf16*)(ws + OFF_BIG);
            if (k == 0 || k == 7) { MK_TID();
                const int f = k == 7; pg8::Gemm g{hb, (const bf16*)(ws + OFF_WGU + (li * 2 + f) * WGU_SZ), M, 2 * FF, D};
                pg8::StaticOrder S; S.init(M, 2 * FF, G, bid); pg8::EpiSwiglu E{big, FF, rs0};
                pg8::gemm_phase<pg8::EpiSwiglu, pg8::StaticOrder, true, true>(lds, g, S, E, tid);
            } else if (k == 1 || k == 8 || k == 6) { MK_TID();
                pg8::Gemm g; float alpha; float* rso;
                if (k == 6) { g = pg8::Gemm{ob, (const bf16*)(ws + OFF_WOUT + li * WSQ_SZ), M, D, D}; alpha = 1.0f; rso = rs0; }
                else { const int f = k == 8; g = pg8::Gemm{big, (const bf16*)(ws + OFF_WDN + (li * 2 + f) * WDN_SZ), M, D, FF}; alpha = 0.5f; rso = rs1; }
                g.M = NPR; pg8::StaticOrder S; S.init(NPR, D, G, bid); const bool first = (li == 0 && k == 1);
                pg8::EpiResid E{first ? ap->in[0] : (const float*)nullptr, hb, rso, alpha};
                pg8::gemm_phase<pg8::EpiResid, pg8::StaticOrder, true, true>(lds, g, S, E, tid);
                unsigned ones2_ = ~0u; asm volatile("" : "+s"(ones2_));
                const int tid2 = wave * 64 + (int)__builtin_amdgcn_mbcnt_hi(ones2_, __builtin_amdgcn_mbcnt_lo(ones2_, 0u));
                const float* xin_s = first ? ap->in[1] - (size_t)NPR * 1024 : (const float*)nullptr;
                if (k == 6) mini_gemm<0, D>(lds, g.A, g.Bt, nullptr, nullptr, xin_s, hb, hb, nullptr, rso, alpha, tid2, bid, G);
                else mini_gemm<0, FF>(lds, g.A, g.Bt, nullptr, nullptr, xin_s, hb, hb, nullptr, rso, alpha, tid2, bid, G);
            } else if (k == 2) { MK_TID();
                const int N = li ? 4096 : 3328; pg8::Gemm g{hb, (const bf16*)(ws + (li ? OFF_WHIN : OFF_WGIN)), M, N, D};
                pg8::StaticOrder S; S.init(M, N, G, bid); pg8::EpiZ E{big, N, rs1, Rb, li ? -1 : 12};
                pg8::gemm_phase<pg8::EpiZ, pg8::StaticOrder, true, true>(lds, g, S, E, tid);
            } else if (k == 3) { MK_TID();
                if (li == 0) prep_phase<false>(lds, big, Rb, ap->in[11], ap->in[12], (const float*)(ws + OFF_LBT), (bf16*)(ws + OFF_AB), (float*)(ws + OFF_DB), (bf16*)(ws + OFF_PSB), tid, bid, G);
                else prep_phase<true>(lds, big, Rb, ap->in[11], ap->in[12], (const float*)(ws + OFF_LBT), (bf16*)(ws + OFF_AB), (float*)(ws + OFF_DB), (bf16*)(ws + OFF_PSB), tid, bid, G);
                __syncthreads();
                for (int rp_ = 0; rp_ < (PROBE_MODE == 6 ? 2 : 1); ++rp_)
                for (int u = bid; u < DB * (li ? 8 : 4); u += G) {
                    if (li == 0) sample_block<false>(lds, big, Rb, ap->in[11], ap->in[12], ap->in[18], ap->in[13], ap->in[2], hbuf + OUT_GS, ob, u, tid, wave);
                    else sample_block<true>(lds, big, Rb, ap->in[11], ap->in[12], ap->in[18], ap->in[16], ap->in[3], hbuf + OUT_HS, ob, u, tid, wave);
                }
            } else if (k == 4) { MK_TID();
                const int gt = bid * (NWAVES * 64) + tid, ngt = G * NWAVES * 64;
                if (li == 0) state_phase<false>((bf16*)(ws + OFF_PSB), (const float*)(ws + OFF_DB), hbuf + OUT_GP, gt, ngt);
                else state_phase<true>((bf16*)(ws + OFF_PSB), (const float*)(ws + OFF_DB), hbuf + OUT_HP, gt, ngt);
            } else if (k == 5) { MK_TID();
                if (li == 0) out_phase<false>(lds, big, (const bf16*)(ws + OFF_AB), (const bf16*)(ws + OFF_PSB), ob, ap->in[13], tid, wave, bid, G);
                else out_phase<true>(lds, big, (const bf16*)(ws + OFF_AB), (const bf16*)(ws + OFF_PSB), ob, ap->in[16], tid, wave, bid, G);
            } else { MK_TID();
                bf16* pp = (bf16*)(ws + OFF_BIG);
                { pg8::Gemm g{(const bf16*)(ws + OFF_PB + li * PB_SZ), (const bf16*)(ws + OFF_WPP + li * WPP_SZ), NPR, D, PLE};
                  pg8::StaticOrder S; S.init(NPR, D, G, bid); pg8::EpiStorePP E{pp};
                  pg8::gemm_phase<pg8::EpiStorePP, pg8::StaticOrder, true, true>(lds, g, S, E, tid); }
                { unsigned ones2_ = ~0u; asm volatile("" : "+s"(ones2_)); const int tid2 = wave * 64 + (int)__builtin_amdgcn_mbcnt_hi(ones2_, __builtin_amdgcn_mbcnt_lo(ones2_, 0u));
                  pg8::Gemm g{hb, (const bf16*)(ws + OFF_WPG + li * WSQ_SZ), NPR, D, D};
                  pg8::StaticOrder S; S.init(NPR, D, G, bid); pg8::EpiPle E{hb, ob, rs1, rs0, pp};
                  pg8::gemm_phase<pg8::EpiPle, pg8::StaticOrder, true, true>(lds, g, S, E, tid2); }
                { unsigned ones3_ = ~0u; asm volatile("" : "+s"(ones3_)); const int tid3 = wave * 64 + (int)__builtin_amdgcn_mbcnt_hi(ones3_, __builtin_amdgcn_mbcnt_lo(ones3_, 0u));
                  mini_gemm<1, D>(lds, hb, (const bf16*)(ws + OFF_WPG + li * WSQ_SZ), (const bf16*)(ws + OFF_PB + li * PB_SZ), (const bf16*)(ws + OFF_WPP + li * WPP_SZ), nullptr, hb, ob, rs1, rs0, 0.f, tid3, bid, G); }
            }
        }
#if PROBE_MODE
        if (ph_ + 1 < ph_hi || rep + 1 < nrep) grid.sync();
#else
        if (ph_ + 1 < ph_hi) {
            if (ph_lo < 0) grid.sync(); else xcd_barrier(xbar);
#if EXTRA_SYNCS
            for (int es = 0; es < EXTRA_SYNCS; ++es) xcd_barrier(xbar);
#endif
        }
#endif
      }
    }
#if PT_ON
    if (PT_T0) { const unsigned long long t0_ = ((unsigned long long)tsl[1] << 32) | tsl[0], t1_ = ((unsigned long long)tsl[3] << 32) | tsl[2], span_ = (t1_ - t0_) * PT_MUL;
        const unsigned long long s_ = __builtin_amdgcn_s_memrealtime(); while (__builtin_amdgcn_s_memrealtime() - s_ < span_) __builtin_amdgcn_s_sleep(8); }
#endif
}

extern "C" void kernel_launch(void* const* d_in, const int* in_sizes, int n_in, void* d_out, int out_size, void* d_ws, size_t ws_size, hipStream_t stream) {
    static int grid = 0;
    if (grid == 0) {
        if (n_in != 26 || (size_t)out_size != OUT_END || ws_size < WS_TOTAL) { fprintf(stderr, "kernel_launch: unexpected shapes (n_in %d out %d ws %zu need %zu); nothing launched\n", n_in, out_size, ws_size, (size_t)WS_TOTAL); grid = -1; return; }
        int dev = 0, cus = 0, per_cu = 0;
        if (hipGetDevice(&dev) != hipSuccess || hipDeviceGetAttribute(&cus, hipDeviceAttributeMultiprocessorCount, dev) != hipSuccess) { grid = -1; return; }
        if (hipFuncSetAttribute((const void*)fwd_kernel, hipFuncAttributeMaxDynamicSharedMemorySize, LDS_BYTES) != hipSuccess) { fprintf(stderr, "kernel_launch: hipFuncSetAttribute failed\n"); grid = -1; return; }
        if (hipOccupancyMaxActiveBlocksPerMultiprocessor(&per_cu, (const void*)fwd_kernel, NWAVES * 64, LDS_BYTES) != hipSuccess || per_cu < 1) per_cu = 1;
        (void)hipGetLastError();
        grid = cus * per_cu;
    }
    if (grid < 0) return;
    if (hipMemsetAsync((char*)d_ws + OFF_CTL, 0, CTL_BYTES, stream) != hipSuccess) { fprintf(stderr, "kernel_launch: memset of the barrier words failed\n"); return; }
    Args a{};
    for (int i = 0; i < 26; ++i) a.in[i] = (const float*)d_in[i];
    a.out = (float*)d_out; a.ws = (unsigned char*)d_ws;
#if MK_N_LAUNCHES == 1
    a.ph_lo = 0; a.ph_hi = NPH;
    void* args[] = {&a};
    hipError_t e = hipLaunchCooperativeKernel((const void*)fwd_kernel, dim3(grid), dim3(NWAVES * 64), args, LDS_BYTES, stream);
    if (e != hipSuccess) fprintf(stderr, "kernel_launch: cooperative launch failed: %s (grid %d)\n", hipGetErrorString(e), grid);
#else
    for (int ph = 0; ph < NPH; ++ph) { a.ph_lo = ph; a.ph_hi = ph + 1; hipLaunchKernelGGL(fwd_kernel, dim3(grid), dim3(NWAVES * 64), LDS_BYTES, stream, a); }
#endif
}
```

```cpp
#include <hip/hip_runtime.h>
#include <cstdio>
#include <cstdint>
#ifndef MK_N_LAUNCHES
#define MK_N_LAUNCHES 1
#endif
#ifndef PROBE_MODE
#define PROBE_MODE 0
#endif
#ifndef EXTRA_SYNCS
#define EXTRA_SYNCS 0
#endif
#ifndef PT_ON
#define PT_ON 0
#define PT_LO 12
#define PT_HI 12
#define PT_MUL 4
#endif
namespace pg8 {
#define PG8_LAS __attribute__((address_space(3)))
typedef unsigned short bf16_t;
typedef short bf16x8 __attribute__((ext_vector_type(8)));
typedef float f32x4 __attribute__((ext_vector_type(4)));
typedef unsigned u32x4 __attribute__((ext_vector_type(4)));
constexpr int BM = 256, BK = 64, HALF = 128, HTB = HALF * BK * 2  , STAGE_BYTES = 8 * HTB, NXCD = 8, WGM = 8;

__host__ __device__ __forceinline__ int lds_byte(int r, int c) { const int st = (r >> 4) * 2 + (c >> 5), rr = r & 15, cc = c & 31, ob = rr * 64 + cc * 2; return st * 1024 + (ob ^ (((ob >> 9) & 1) << 5)); }
__host__ __device__ __forceinline__ void stage_rc(int b, int& R, int& C) { const int st = b / 1024, sb = b % 1024, swz = sb ^ (((sb >> 9) & 1) << 5); R = (st >> 1) * 16 + swz / 64; C = (st & 1) * 32 + (swz % 64) / 2; }
__host__ __device__ __forceinline__ int perm32(int rho) { const int n = rho >> 4, i = rho & 15; return 8 * (i >> 2) + 4 * n + (i & 3); }

struct Unit { int pm, pn; };
struct Gemm { const bf16_t* A; const bf16_t* Bt; int M, N, K; };

struct StaticOrder {
    int nM, nN, nwg, G, c;
    __host__ __device__ void init(int M, int N, int G_, int c_) { nM = M / BM; nN = N / BM; nwg = nM * nN; G = G_; c = c_; }
    __host__ __device__ bool next(int i, Unit& u) const {
        const long L = (long)i * G + c; if (L >= nwg) return false;
        int wgid = (int)L; { const int q = nwg / NXCD, r = nwg % NXCD, xcd = wgid % NXCD, off = wgid / NXCD; wgid = (xcd < r ? xcd * (q + 1) : r * (q + 1) + (xcd - r) * q) + off; }
        const int nig = WGM * nN, gid = wgid / nig, fm = gid * WGM, gsz = (nM - fm) < WGM ? (nM - fm) : WGM;
        u.pm = fm + ((wgid % nig) % gsz); u.pn = (wgid % nig) / gsz; return true;
    }
    __device__ __forceinline__ void a_ready(const Unit&) const {}
    __device__ __forceinline__ void done(const Unit&) const {}
};

typedef float f32x2_ __attribute__((ext_vector_type(2))); typedef __bf16 bf16x2_ __attribute__((ext_vector_type(2)));
__device__ __forceinline__ unsigned cvt_pk_bf16(float lo, float hi) { const f32x2_ v = {lo, hi}; return __builtin_bit_cast(unsigned, __builtin_convertvector(v, bf16x2_)); }
typedef float f32x2 __attribute__((ext_vector_type(2)));
typedef unsigned u32x2 __attribute__((ext_vector_type(2)));
__device__ __forceinline__ float row_scale(const float* rs, int row) {
    const f32x4* p = (const f32x4*)(rs + (size_t)row * 16);
    const f32x4 a = p[0], b = p[1], c = p[2], d = p[3];
    const float s = ((a[0] + a[1]) + (a[2] + a[3])) + ((b[0] + b[1]) + (b[2] + b[3])) + ((c[0] + c[1]) + (c[2] + c[3])) + ((d[0] + d[1]) + (d[2] + d[3]));
    return rsqrtf(s * (1.0f / 1024.0f) + 1e-6f);
}
__device__ __forceinline__ void row_scales8(const float* rs, int row0, float (&sc)[2][4]) {
#pragma unroll
    for (int ai = 0; ai < 2; ++ai)
#pragma unroll
        for (int mh = 0; mh < 2; ++mh) { f32x4 p[2][4];
#pragma unroll
            for (int ml = 0; ml < 2; ++ml)
#pragma unroll
                for (int q = 0; q < 4; ++q) p[ml][q] = *(const f32x4*)(rs + (size_t)(row0 + ai * HALF + (2 * mh + ml) * 16) * 16 + 4 * q);
            __builtin_amdgcn_sched_barrier(0);
#pragma unroll
            for (int ml = 0; ml < 2; ++ml) { const f32x4 t = (p[ml][0] + p[ml][1]) + (p[ml][2] + p[ml][3]); sc[ai][2 * mh + ml] = rsqrtf(((t[0] + t[1]) + (t[2] + t[3])) * (1.0f / 1024.0f) + 1e-6f); }
            __builtin_amdgcn_sched_barrier(0); }
}
__device__ __forceinline__ float sigm(float x) { return __builtin_amdgcn_rcpf(1.0f + __expf(-x)); }
struct EpiSwiglu {
    static constexpr bool PERM = true, AFTER_DRAIN = false;
    bf16_t* O; int ldc; const float* rs;
    __device__ __forceinline__ void operator()(const f32x4 (&acc)[2][2][4][2], const Unit& u, int wr, int wc, int fr_, int fq_) const {
        unsigned on_ = ~0u; asm volatile("" : "+s"(on_)); const int ln_ = (int)__builtin_amdgcn_mbcnt_hi(on_, __builtin_amdgcn_mbcnt_lo(on_, 0u)), fr = ln_ & 15, fq = ln_ >> 4; (void)fr_; (void)fq_;
        const int row0 = u.pm * BM + wr * 64 + fr, col0 = u.pn * HALF + wc * 32 + 8 * fq;
        float sc[2][4]; row_scales8(rs, row0, sc);
#pragma unroll
        for (int ai = 0; ai < 2; ++ai)
#pragma unroll
            for (int m = 0; m < 4; ++m) { const int row = row0 + ai * HALF + m * 16; const float s = sc[ai][m];
                float o[8];
#pragma unroll
                for (int n = 0; n < 2; ++n)
#pragma unroll
                    for (int i = 0; i < 4; ++i) { const float g = acc[ai][0][m][n][i] * s, up = acc[ai][1][m][n][i] * s; o[n * 4 + i] = g * sigm(g) * up; }
                u32x4 w; w.x = cvt_pk_bf16(o[0], o[1]); w.y = cvt_pk_bf16(o[2], o[3]); w.z = cvt_pk_bf16(o[4], o[5]); w.w = cvt_pk_bf16(o[6], o[7]);
                *(u32x4*)(O + (size_t)row * ldc + col0) = w; }
    }
};
struct EpiZ {
    static constexpr bool PERM = true, AFTER_DRAIN = false;
    bf16_t* Z; int ldz; const float* rs; float* R; int r_tile;
    __device__ __forceinline__ void operator()(const f32x4 (&acc)[2][2][4][2], const Unit& u, int wr, int wc, int fr_, int fq_) const {
        unsigned on_ = ~0u; asm volatile("" : "+s"(on_)); const int ln_ = (int)__builtin_amdgcn_mbcnt_hi(on_, __builtin_amdgcn_mbcnt_lo(on_, 0u)), fr = ln_ & 15, fq = ln_ >> 4; (void)fr_; (void)fq_;
        const int row0 = u.pm * BM + wr * 64 + fr, col0 = u.pn * BM + wc * 32 + 8 * fq;
        if (u.pn == r_tile) {
            if (wc == 0 && fq < 2) {
#pragma unroll
                for (int ai = 0; ai < 2; ++ai)
#pragma unroll
                    for (int m = 0; m < 4; ++m) { const int row = row0 + ai * HALF + m * 16; const float s = row_scale(rs, row);
#pragma unroll
                        for (int n = 0; n < 2; ++n) *(f32x4*)(R + (size_t)row * 16 + 8 * fq + 4 * n) = acc[ai][0][m][n] * s; }
            }
            return;
        }
        float sc[2][4]; row_scales8(rs, row0, sc);
#pragma unroll
        for (int ai = 0; ai < 2; ++ai)
#pragma unroll
            for (int m = 0; m < 4; ++m) { const int row = row0 + ai * HALF + m * 16; const float s = sc[ai][m];
#pragma unroll
                for (int bj = 0; bj < 2; ++bj) { const f32x4 v0 = acc[ai][bj][m][0] * s, v1 = acc[ai][bj][m][1] * s;
                    u32x4 w; w.x = cvt_pk_bf16(v0[0], v0[1]); w.y = cvt_pk_bf16(v0[2], v0[3]); w.z = cvt_pk_bf16(v1[0], v1[1]); w.w = cvt_pk_bf16(v1[2], v1[3]);
                    *(u32x4*)(Z + (size_t)row * ldz + col0 + bj * HALF) = w; } }
    }
};
struct EpiResid {
    static constexpr bool PERM = true, AFTER_DRAIN = false;
    const float* xin; bf16_t* hb; float* rs_out; float alpha;
    __device__ __forceinline__ void operator()(const f32x4 (&acc)[2][2][4][2], const Unit& u, int wr, int wc, int fr_, int fq_) const {
        unsigned on_ = ~0u; asm volatile("" : "+s"(on_)); const int ln_ = (int)__builtin_amdgcn_mbcnt_hi(on_, __builtin_amdgcn_mbcnt_lo(on_, 0u)), fr = ln_ & 15, fq = ln_ >> 4; (void)fr_; (void)fq_;
        const int row0 = u.pm * BM + wr * 64 + fr, col0 = u.pn * BM + wc * 32 + 8 * fq;
#pragma unroll
        for (int ai = 0; ai < 2; ++ai)
#pragma unroll
            for (int mh = 0; mh < 2; ++mh) { f32x4 hv[2][2][2];
                if (xin) {
#pragma unroll
                    for (int ml = 0; ml < 2; ++ml)
#pragma unroll
                        for (int bj = 0; bj < 2; ++bj)
#pragma unroll
                            for (int n = 0; n < 2; ++n) hv[ml][bj][n] = *(const f32x4*)(xin + (size_t)(row0 + ai * HALF + (2 * mh + ml) * 16) * 1024 + col0 + bj * HALF + 4 * n);
                } else { u32x4 hw[2][2];
#pragma unroll
                    for (int ml = 0; ml < 2; ++ml)
#pragma unroll
                        for (int bj = 0; bj < 2; ++bj) hw[ml][bj] = *(const u32x4*)(hb + (size_t)(row0 + ai * HALF + (2 * mh + ml) * 16) * 1024 + col0 + bj * HALF);
#pragma unroll
                    for (int ml = 0; ml < 2; ++ml)
#pragma unroll
                        for (int bj = 0; bj < 2; ++bj) { const u32x4 x = hw[ml][bj];
                            hv[ml][bj][0] = (f32x4){__uint_as_float(x.x << 16), __uint_as_float(x.x & 0xffff0000u), __uint_as_float(x.y << 16), __uint_as_float(x.y & 0xffff0000u)};
                            hv[ml][bj][1] = (f32x4){__uint_as_float(x.z << 16), __uint_as_float(x.z & 0xffff0000u), __uint_as_float(x.w << 16), __uint_as_float(x.w & 0xffff0000u)}; } }
                __builtin_amdgcn_sched_barrier(0);
#pragma unroll
                for (int ml = 0; ml < 2; ++ml) { const int m = 2 * mh + ml, row = row0 + ai * HALF + m * 16; float ss = 0.f;
#pragma unroll
                    for (int bj = 0; bj < 2; ++bj) { const f32x4 o0 = hv[ml][bj][0] + acc[ai][bj][m][0] * alpha, o1 = hv[ml][bj][1] + acc[ai][bj][m][1] * alpha;
                        ss += ((o0[0] * o0[0] + o0[1] * o0[1]) + (o0[2] * o0[2] + o0[3] * o0[3])) + ((o1[0] * o1[0] + o1[1] * o1[1]) + (o1[2] * o1[2] + o1[3] * o1[3]));
                        u32x4 w; w.x = cvt_pk_bf16(o0[0], o0[1]); w.y = cvt_pk_bf16(o0[2], o0[3]); w.z = cvt_pk_bf16(o1[0], o1[1]); w.w = cvt_pk_bf16(o1[2], o1[3]);
                        *(u32x4*)(hb + (size_t)row * 1024 + col0 + bj * HALF) = w; }
                    ss += __builtin_bit_cast(float, __builtin_amdgcn_ds_bpermute((ln_ ^ 16) << 2, __builtin_bit_cast(int, ss))); ss += __builtin_bit_cast(float, __builtin_amdgcn_ds_bpermute((ln_ ^ 32) << 2, __builtin_bit_cast(int, ss)));
                    if (fq == 0) rs_out[(size_t)row * 16 + u.pn * 4 + wc] = ss; }
                __builtin_amdgcn_sched_barrier(0); }
    }
};
struct EpiStorePP {
    static constexpr bool PERM = false, AFTER_DRAIN = false;
    bf16_t* O;
    __device__ __forceinline__ void operator()(const f32x4 (&acc)[2][2][4][2], const Unit& u, int wr, int wc, int fr_, int fq_) const {
        unsigned on_ = ~0u; asm volatile("" : "+s"(on_)); const int ln_ = (int)__builtin_amdgcn_mbcnt_hi(on_, __builtin_amdgcn_mbcnt_lo(on_, 0u)), fr = ln_ & 15, fq = ln_ >> 4; (void)fr_; (void)fq_;
        const int row0 = u.pm * BM + wr * 64 + fr, col0 = u.pn * BM + wc * 32 + 4 * fq;
#pragma unroll
        for (int ai = 0; ai < 2; ++ai)
#pragma unroll
            for (int m = 0; m < 4; ++m)
#pragma unroll
                for (int bj = 0; bj < 2; ++bj)
#pragma unroll
                    for (int n = 0; n < 2; ++n) { const f32x4 v = acc[ai][bj][m][n]; u32x2 w; w.x = cvt_pk_bf16(v[0], v[1]); w.y = cvt_pk_bf16(v[2], v[3]);
                        *(u32x2*)(O + (size_t)(row0 + ai * HALF + m * 16) * 1024 + col0 + bj * HALF + n * 16) = w; }
    }
};
struct EpiPle {
    static constexpr bool PERM = false, AFTER_DRAIN = false;
    const bf16_t* hbin; bf16_t* hb; const float* rs_in; float* rs_out; const bf16_t* pp;
    __device__ __forceinline__ void operator()(const f32x4 (&acc)[2][2][4][2], const Unit& u, int wr, int wc, int fr_, int fq_) const {
        unsigned on_ = ~0u; asm volatile("" : "+s"(on_)); const int ln_ = (int)__builtin_amdgcn_mbcnt_hi(on_, __builtin_amdgcn_mbcnt_lo(on_, 0u)), fr = ln_ & 15, fq = ln_ >> 4; (void)fr_; (void)fq_;
        const int row0 = u.pm * BM + wr * 64 + fr, col0 = u.pn * BM + wc * 32 + 4 * fq;
#pragma unroll
        for (int ai = 0; ai < 2; ++ai)
#pragma unroll
            for (int m = 0; m < 4; ++m) { const int row = row0 + ai * HALF + m * 16; const float s = row_scale(rs_in, row); float ss = 0.f;
#pragma unroll
                for (int bj = 0; bj < 2; ++bj)
#pragma unroll
                    for (int n = 0; n < 2; ++n) { const size_t off = (size_t)row * 1024 + col0 + bj * HALF + n * 16;
                        const u32x2 pw = *(const u32x2*)(pp + off); const f32x4 a = acc[ai][bj][m][n] * s, p = {__uint_as_float(pw.x << 16), __uint_as_float(pw.x & 0xffff0000u), __uint_as_float(pw.y << 16), __uint_as_float(pw.y & 0xffff0000u)}; const u32x2 hx = *(const u32x2*)(hbin + off); f32x4 o = {__uint_as_float(hx.x << 16), __uint_as_float(hx.x & 0xffff0000u), __uint_as_float(hx.y << 16), __uint_as_float(hx.y & 0xffff0000u)};
                        o[0] += sigm(a[0]) * p[0]; o[1] += sigm(a[1]) * p[1]; o[2] += sigm(a[2]) * p[2]; o[3] += sigm(a[3]) * p[3];
                        ss += (o[0] * o[0] + o[1] * o[1]) + (o[2] * o[2] + o[3] * o[3]);
                        u32x2 w; w.x = cvt_pk_bf16(o[0], o[1]); w.y = cvt_pk_bf16(o[2], o[3]); *(u32x2*)(hb + off) = w; }
                ss += __builtin_bit_cast(float, __builtin_amdgcn_ds_bpermute((ln_ ^ 16) << 2, __builtin_bit_cast(int, ss))); ss += __builtin_bit_cast(float, __builtin_amdgcn_ds_bpermute((ln_ ^ 32) << 2, __builtin_bit_cast(int, ss)));
                if (fq == 0) rs_out[(size_t)row * 16 + u.pn * 4 + wc] = ss; }
    }
};
template <class Epi, class Sched, bool ALIGN_EPI = false, bool SP2 = false>
__device__ __forceinline__ void gemm_phase(PG8_LAS unsigned char* lds, const Gemm g, const Sched& S, const Epi& E, const int tid) {
    const int wid = __builtin_amdgcn_readfirstlane(tid >> 6), lane = tid & 63, wr = wid >> 2, wc = wid & 3, fr = lane & 15, fq = lane >> 4;
    const int K = g.K, nt = K / BK;
    unsigned voffA[2], voffB[2];
#pragma unroll
    for (int i = 0; i < 2; ++i) { int R, C; stage_rc(tid * 16 + i * 8192, R, C); const int Rb = Epi::PERM ? ((R & ~31) + perm32(R & 31)) : R;
        voffA[i] = (unsigned)(R * K + C) * 2u; voffB[i] = (unsigned)(Rb * K + C) * 2u; }
    const size_t kstep = (size_t)(BK * 2);
    const size_t hstep = (size_t)HALF * K * 2;
    const size_t tstep = 2 * hstep;
    const unsigned ldsw = (unsigned)wid * 1024u;
    const int aoff = lds_byte(wr * 64 + fr, fq * 8), boff = lds_byte(wc * 32 + fr, fq * 8);
#define PG8_SA(b, h) (((b) * 2 + (h)) * HTB)
#define PG8_SB(b, h) ((4 + (b) * 2 + (h)) * HTB)
#define PG8_STAGE(bufoff, gbase, voff) do { _Pragma("unroll") for (int _i = 0; _i < 2; ++_i) \
        __builtin_amdgcn_global_load_lds((const unsigned*)((const char*)(gbase) + (voff)[_i]), (PG8_LAS unsigned*)(lds + (bufoff) + ldsw + _i * 8192), 16, 0, 0); } while (0)
#define PG8_LDA(dst, b, h) do { _Pragma("unroll") for (int m = 0; m < 4; ++m) _Pragma("unroll") for (int k = 0; k < 2; ++k) dst[m][k] = *(const PG8_LAS bf16x8*)(lds + PG8_SA(b, h) + aoff + m * 2048 + k * 1024); } while (0)
#define PG8_LDB(dst, b, h) do { _Pragma("unroll") for (int n = 0; n < 2; ++n) _Pragma("unroll") for (int k = 0; k < 2; ++k) dst[n][k] = *(const PG8_LAS bf16x8*)(lds + PG8_SB(b, h) + boff + n * 2048 + k * 1024); } while (0)
#define PG8_MMA(ai, bj, At, Bt) do { __builtin_amdgcn_s_setprio(1); _Pragma("unroll") for (int m = 0; m < 4; ++m) _Pragma("unroll") for (int n = 0; n < 2; ++n) _Pragma("unroll") for (int k = 0; k < 2; ++k) \
        acc[ai][bj][m][n] = __builtin_amdgcn_mfma_f32_16x16x32_bf16(Bt[n][k], At[m][k], acc[ai][bj][m][n], 0, 0, 0); __builtin_amdgcn_s_setprio(0); } while (0)
#define PG8_WAIT_V(n) asm volatile("s_waitcnt vmcnt(" #n ")" ::: "memory")
#define PG8_WAIT_L(n) asm volatile("s_waitcnt lgkmcnt(" #n ")" ::: "memory")
#define PG8_BAR __builtin_amdgcn_s_barrier()
#define PG8_SCHED __builtin_amdgcn_sched_barrier(0)
    Unit cur, nxt; int ui = 0;
    if (!S.next(0, cur)) return;
    f32x4 acc[2][2][4][2];
#pragma unroll
    for (int a = 0; a < 2; ++a)
#pragma unroll
        for (int b = 0; b < 2; ++b)
#pragma unroll
            for (int m = 0; m < 4; ++m)
#pragma unroll
                for (int n = 0; n < 2; ++n) acc[a][b][m][n] = (f32x4){0.f, 0.f, 0.f, 0.f};
    bf16x8 At[4][2], B0[2][2], B1[2][2];
    const char* cA = (const char*)g.A + (size_t)cur.pm * tstep; const char* cB = (const char*)g.Bt + (size_t)cur.pn * tstep;
    S.a_ready(cur);
    if constexpr (SP2) {
        PG8_STAGE(PG8_SB(0, 0), cB, voffB); PG8_STAGE(PG8_SB(0, 1), cB + hstep, voffB); PG8_STAGE(PG8_SA(0, 0), cA, voffA); PG8_STAGE(PG8_SA(0, 1), cA + hstep, voffA);
        if (wr == 1) PG8_BAR;
        PG8_WAIT_V(2); PG8_BAR;
        PG8_STAGE(PG8_SB(1, 0), cB + kstep, voffB); PG8_STAGE(PG8_SA(1, 0), cA + kstep, voffA); PG8_STAGE(PG8_SB(1, 1), cB + hstep + kstep, voffB);
        PG8_WAIT_V(6); PG8_BAR;
    } else {
        PG8_STAGE(PG8_SB(0, 0), cB, voffB); PG8_STAGE(PG8_SA(0, 0), cA, voffA); PG8_STAGE(PG8_SB(0, 1), cB + hstep, voffB); PG8_STAGE(PG8_SA(0, 1), cA + hstep, voffA);
        if (wr == 1) PG8_BAR;
        PG8_WAIT_V(4); PG8_BAR;
        PG8_STAGE(PG8_SB(1, 0), cB + kstep, voffB); PG8_STAGE(PG8_SA(1, 0), cA + kstep, voffA); PG8_STAGE(PG8_SB(1, 1), cB + hstep + kstep, voffB);
        PG8_WAIT_V(6); PG8_BAR;
    }
    for (;;) {
        const bool has_next = S.next(ui + 1, nxt);
        const char* nA = has_next ? (const char*)g.A + (size_t)nxt.pm * tstep : cA; const char* nB = has_next ? (const char*)g.Bt + (size_t)nxt.pn * tstep : cB;
        for (int t = 0; t < nt; t += 2) {
            const bool last = (t == nt - 2);
            const char* a1 = cA + (size_t)(t + 1) * kstep;
            const char* a2 = last ? nA : cA + (size_t)(t + 2) * kstep; const char* b2 = last ? nB : cB + (size_t)(t + 2) * kstep;
            const char* a3 = a2 + kstep; const char* b3 = b2 + kstep;
            if (last && has_next) S.a_ready(nxt);
            if constexpr (SP2) {
            PG8_LDB(B0, 0, 0); PG8_LDB(B1, 0, 1); PG8_SCHED; PG8_LDA(At, 0, 0); PG8_STAGE(PG8_SA(1, 1), a1 + hstep, voffA);
            PG8_WAIT_V(8); PG8_WAIT_L(0); PG8_BAR; PG8_MMA(0, 0, At, B0); PG8_MMA(0, 1, At, B1); PG8_BAR; PG8_SCHED;
            PG8_LDA(At, 0, 1); PG8_STAGE(PG8_SB(0, 0), b2, voffB); PG8_STAGE(PG8_SB(0, 1), b2 + hstep, voffB); PG8_STAGE(PG8_SA(0, 0), a2, voffA);
            PG8_WAIT_V(8); PG8_WAIT_L(0); PG8_BAR; PG8_MMA(1, 0, At, B0); PG8_MMA(1, 1, At, B1); PG8_BAR; PG8_SCHED;
            PG8_LDB(B0, 1, 0); PG8_LDB(B1, 1, 1); PG8_SCHED; PG8_LDA(At, 1, 0); PG8_STAGE(PG8_SA(0, 1), a2 + hstep, voffA);
            PG8_WAIT_V(8); PG8_WAIT_L(0); PG8_BAR; PG8_MMA(0, 0, At, B0); PG8_MMA(0, 1, At, B1); PG8_BAR; PG8_SCHED;
            PG8_LDA(At, 1, 1); PG8_STAGE(PG8_SB(1, 0), b3, voffB); PG8_STAGE(PG8_SB(1, 1), b3 + hstep, voffB); PG8_STAGE(PG8_SA(1, 0), a3, voffA);
            PG8_WAIT_V(8); PG8_WAIT_L(0); PG8_BAR; PG8_MMA(1, 0, At, B0); PG8_MMA(1, 1, At, B1); PG8_BAR; PG8_SCHED;
            } else {
            PG8_LDB(B0, 0, 0); PG8_SCHED; PG8_LDA(At, 0, 0); PG8_STAGE(PG8_SA(1, 1), a1 + hstep, voffA);
            PG8_WAIT_L(8); PG8_BAR; PG8_WAIT_L(0); PG8_MMA(0, 0, At, B0); PG8_BAR; PG8_SCHED;
            PG8_LDB(B1, 0, 1); PG8_STAGE(PG8_SB(0, 0), b2, voffB);
            PG8_BAR; PG8_WAIT_L(0); PG8_MMA(0, 1, At, B1); PG8_BAR;
            PG8_LDA(At, 0, 1); PG8_STAGE(PG8_SA(0, 0), a2, voffA);
            PG8_BAR; PG8_WAIT_L(0); PG8_MMA(1, 0, At, B0); PG8_BAR; PG8_SCHED;
            PG8_STAGE(PG8_SB(0, 1), b2 + hstep, voffB);
            PG8_WAIT_V(6); PG8_BAR; PG8_MMA(1, 1, At, B1); PG8_BAR;
            PG8_LDB(B0, 1, 0); PG8_SCHED; PG8_LDA(At, 1, 0); PG8_STAGE(PG8_SA(0, 1), a2 + hstep, voffA);
            PG8_WAIT_L(8); PG8_BAR; PG8_WAIT_L(0); PG8_MMA(0, 0, At, B0); PG8_BAR; PG8_SCHED;
            PG8_LDB(B1, 1, 1); PG8_STAGE(PG8_SB(1, 0), b3, voffB);
            PG8_BAR; PG8_WAIT_L(0); PG8_MMA(0, 1, At, B1); PG8_BAR;
            PG8_LDA(At, 1, 1); PG8_STAGE(PG8_SA(1, 0), a3, voffA);
            PG8_BAR; PG8_WAIT_L(0); PG8_MMA(1, 0, At, B0); PG8_BAR; PG8_SCHED;
            PG8_STAGE(PG8_SB(1, 1), b3 + hstep, voffB);
            PG8_WAIT_V(6); PG8_BAR; PG8_MMA(1, 1, At, B1); PG8_BAR;
            }
        }
        if constexpr (ALIGN_EPI) { if (wr == 0) PG8_BAR; }
        if constexpr (!Epi::AFTER_DRAIN) { E(acc, cur, wr, wc, fr, fq); S.done(cur); }
        if (!has_next) break;
#pragma unroll
        for (int a = 0; a < 2; ++a)
#pragma unroll
            for (int b = 0; b < 2; ++b)
#pragma unroll
                for (int m = 0; m < 4; ++m)
#pragma unroll
                    for (int n = 0; n < 2; ++n) acc[a][b][m][n] = (f32x4){0.f, 0.f, 0.f, 0.f};
        cur = nxt; cA = nA; cB = nB; ++ui;
        if constexpr (ALIGN_EPI) { if (wr == 1) PG8_BAR; }
    }
    PG8_WAIT_V(0);
    if constexpr (!ALIGN_EPI) { if (wr == 0) PG8_BAR; }
    PG8_BAR;
    if constexpr (Epi::AFTER_DRAIN) { E.fused(acc, cur, wr, wc, fr, fq, lds, wid, lane); S.done(cur); }
#undef PG8_SA
#undef PG8_SB
#undef PG8_STAGE
#undef PG8_LDA
#undef PG8_LDB
#undef PG8_MMA
#undef PG8_WAIT_V
#undef PG8_WAIT_L
#undef PG8_BAR
#undef PG8_SCHED
}
}
#include <hip/hip_cooperative_groups.h>
namespace cg = cooperative_groups;
#define LAS __attribute__((address_space(3)))
typedef unsigned short bf16;
typedef float f32x4 __attribute__((ext_vector_type(4)));
typedef short bf16x8 __attribute__((ext_vector_type(8)));
typedef unsigned v4u __attribute__((ext_vector_type(4)));
typedef unsigned v2u __attribute__((ext_vector_type(2)));
constexpr int D = 1024, NPR = 16384, NSM = 512, M = NPR + NSM, SEQ = 2048, NB = 8, DB = 128, FF = 2816, PLE = 256, NCH = 32;
constexpr int NWAVES = 8, LDS_BYTES = 147456, NPH = 22;
constexpr size_t WGU_SZ = (size_t)5632 * 1024 * 2, WDN_SZ = (size_t)1024 * 2816 * 2, WSQ_SZ = (size_t)1024 * 1024 * 2, WPP_SZ = (size_t)1024 * 256 * 2;
constexpr size_t OFF_WGU = 0, OFF_WDN = OFF_WGU + 4 * WGU_SZ, OFF_WGIN = OFF_WDN + 4 * WDN_SZ, OFF_WHIN = OFF_WGIN + (size_t)3328 * 1024 * 2,
    OFF_WOUT = OFF_WHIN + (size_t)4096 * 1024 * 2, OFF_WPG = OFF_WOUT + 2 * WSQ_SZ, OFF_WPP = OFF_WPG + 2 * WSQ_SZ, OFF_HB = OFF_WPP + 2 * WPP_SZ;
constexpr size_t HB_SZ = (size_t)M * 1024 * 2;
constexpr size_t OFF_BIG = OFF_HB + 2 * HB_SZ, OFF_PB = OFF_BIG + (size_t)M * 4096 * 2, PB_SZ = (size_t)M * 256 * 2, OFF_AB = OFF_PB + 2 * PB_SZ,
    OFF_DB = OFF_AB + (size_t)2048 * 4096 * 2, OFF_RS = OFF_DB + (size_t)2048 * 128 * 4, RS_SZ = (size_t)M * 16 * 4, OFF_R = OFF_RS + 2 * RS_SZ, OFF_PSB = OFF_R + RS_SZ, OFF_PP = OFF_PSB  , WS_END = OFF_PSB + (size_t)67108864, OFF_LBT = WS_END, OFF_CTL = OFF_LBT + 16384, CTL_BYTES = 16384, WS_TOTAL = OFF_CTL + CTL_BYTES;
constexpr size_t OUT_YS = (size_t)NPR * D, OUT_GP = (size_t)M * D, OUT_GS = OUT_GP + 1048576, OUT_HP = OUT_GS + 16777216, OUT_HS = OUT_HP + 1048576, OUT_END = OUT_HS + 16777216;

__device__ __forceinline__ float bf2f(unsigned short u) { return __uint_as_float((unsigned)u << 16); }
__device__ __forceinline__ float bflo(unsigned u) { return __uint_as_float(u << 16); }
__device__ __forceinline__ float bfhi(unsigned u) { return __uint_as_float(u & 0xffff0000u); }
__device__ __forceinline__ unsigned pk2(float lo, float hi) { return pg8::cvt_pk_bf16(lo, hi); }
__device__ __forceinline__ float sigm(float x) { return __builtin_amdgcn_rcpf(1.0f + __expf(-x)); }
__device__ __forceinline__ float logsig(float x) { return fminf(x, 0.f) - __logf(1.0f + __expf(-fabsf(x))); }
__device__ __forceinline__ float wave_sum(float v) {
#pragma unroll
    for (int o = 1; o < 64; o <<= 1) v += __shfl_xor(v, o);
    return v;
}
#define LDS_WAIT() asm volatile("s_waitcnt lgkmcnt(0)" ::: "memory")
#define BAR_LDS() do { asm volatile("s_waitcnt lgkmcnt(0)" ::: "memory"); __builtin_amdgcn_s_barrier(); asm volatile("" ::: "memory"); } while (0)

__device__ __forceinline__ void tr_item(const float* W, int Nsrc, int K, bf16* WT, const float* sk, int item, int nblk, int mode, int nvalid, LAS float* scr, int lane) {
    const int kb = item / nblk, nb = item % nblk, k0 = 64 * kb, n0 = 64 * nb;
    int src0 = n0, valid = 64;
    if (mode == 1) { const int pn = n0 >> 8, within = n0 & 255, half = within >> 7, j = within & 127; src0 = half * FF + 128 * pn + j; }
    if (mode == 2) { valid = nvalid - n0; valid = valid < 0 ? 0 : (valid > 64 ? 64 : valid); }
    const int c4 = (lane & 15) * 4, kr = lane >> 4;
    const float* wp = W + (size_t)(k0 + kr) * Nsrc + src0 + c4;
    f32x4 v[16];
#pragma unroll
    for (int i = 0; i < 16; ++i) v[i] = (c4 < valid) ? __builtin_nontemporal_load((const f32x4*)(wp + (size_t)(4 * i) * Nsrc)) : (f32x4){0.f, 0.f, 0.f, 0.f};
    __builtin_amdgcn_sched_barrier(0);
#pragma unroll
    for (int i = 0; i < 16; ++i) { const int kk = 4 * i + kr; const float s = sk ? sk[k0 + kk] : 1.0f; LAS float* d = scr + kk * 65 + c4; d[0] = v[i][0] * s; d[1] = v[i][1] * s; d[2] = v[i][2] * s; d[3] = v[i][3] * s; }
    LDS_WAIT();
    const int ch = lane & 7;
#pragma unroll
    for (int j = 0; j < 8; ++j) { const int n = (lane >> 3) + 8 * j; const LAS float* s = scr + (8 * ch) * 65 + n;
        v4u o; o.x = pk2(s[0 * 65], s[1 * 65]); o.y = pk2(s[2 * 65], s[3 * 65]); o.z = pk2(s[4 * 65], s[5 * 65]); o.w = pk2(s[6 * 65], s[7 * 65]);
        *(v4u*)(WT + (size_t)(n0 + n) * K + k0 + 8 * ch) = o; }
    LDS_WAIT();
}
struct Args { const float* in[26]; float* out; unsigned char* ws; int ph_lo, ph_hi; };
typedef const Args __attribute__((address_space(4))) CArgs;

__device__ __forceinline__ void prologue(CArgs* a, unsigned char* ws, float* outp, LAS unsigned char* lds, int tid, int bid, int G) {
    const int lane = tid & 63, wave = tid >> 6;
    LAS float* scr = (LAS float*)(lds + wave * 16640);
    const int gw = bid * NWAVES + wave, NGW = G * NWAVES;
    constexpr int I_GU = 16 * 88, I_DN = 44 * 16, I_GIN = 16 * 52, I_HIN = 16 * 64, I_SQ = 16 * 16, I_PP = 4 * 16;
    constexpr int NITEMS = 4 * I_GU + 4 * I_DN + I_GIN + I_HIN + 4 * I_SQ + 2 * I_PP;
    for (int it = gw; it < NITEMS; it += NGW) {
        int r = it;
        if (r < 4 * I_GU) { const int q = r / I_GU, li = q >> 1, f = q & 1; r -= q * I_GU;
            tr_item((f ? a->in[20] : a->in[7]) + (size_t)li * 1024 * 5632, 5632, 1024, (bf16*)(ws + OFF_WGU + q * WGU_SZ), (f ? a->in[19] : a->in[6]) + li * 1024, r, 88, 1, 0, scr, lane); continue; }
        r -= 4 * I_GU;
        if (r < 4 * I_DN) { const int q = r / I_DN, li = q >> 1, f = q & 1; r -= q * I_DN;
            tr_item((f ? a->in[21] : a->in[8]) + (size_t)li * 2816 * 1024, 1024, 2816, (bf16*)(ws + OFF_WDN + q * WDN_SZ), nullptr, r, 16, 0, 0, scr, lane); continue; }
        r -= 4 * I_DN;
        if (r < I_GIN) { tr_item(a->in[10], 3088, 1024, (bf16*)(ws + OFF_WGIN), a->in[9], r, 52, 2, 3088, scr, lane); continue; }
        r -= I_GIN;
        if (r < I_HIN) { tr_item(a->in[15], 4096, 1024, (bf16*)(ws + OFF_WHIN), a->in[9] + 1024, r, 64, 0, 0, scr, lane); continue; }
        r -= I_HIN;
        if (r < I_SQ) { tr_item(a->in[14], 1024, 1024, (bf16*)(ws + OFF_WOUT), nullptr, r, 16, 0, 0, scr, lane); continue; }
        r -= I_SQ;
        if (r < I_SQ) { tr_item(a->in[17], 1024, 1024, (bf16*)(ws + OFF_WOUT + WSQ_SZ), nullptr, r, 16, 0, 0, scr, lane); continue; }
        r -= I_SQ;
        if (r < 2 * I_SQ) { const int li = r / I_SQ; r -= li * I_SQ;
            tr_item(a->in[23] + (size_t)li * 1024 * 1024, 1024, 1024, (bf16*)(ws + OFF_WPG + li * WSQ_SZ), a->in[22] + li * 1024, r, 16, 0, 0, scr, lane); continue; }
        r -= 2 * I_SQ;
        { const int li = r / I_PP; r -= li * I_PP;
            tr_item(a->in[24] + (size_t)li * 256 * 1024, 1024, 256, (bf16*)(ws + OFF_WPP + li * WPP_SZ), nullptr, r, 16, 0, 0, scr, lane); }
    }
    bf16* hb = (bf16*)(ws + OFF_HB); float* rs = (float*)(ws + OFF_RS);
    for (int m0 = gw; m0 < M; m0 += 2 * NGW) {
        const int m1 = m0 + NGW; const bool has1 = m1 < M;
        const float* xr0 = m0 < NPR ? a->in[0] + (size_t)m0 * D : a->in[1] + (size_t)(m0 - NPR) * D;
        const float* xr1 = !has1 ? xr0 : (m1 < NPR ? a->in[0] + (size_t)m1 * D : a->in[1] + (size_t)(m1 - NPR) * D);
        f32x4 v0[4], v1[4];
#pragma unroll
        for (int j = 0; j < 4; ++j) { v0[j] = __builtin_nontemporal_load((const f32x4*)xr0 + lane + 64 * j); v1[j] = __builtin_nontemporal_load((const f32x4*)xr1 + lane + 64 * j); }
        float s0 = 0.f, s1 = 0.f;
#pragma unroll
        for (int j = 0; j < 4; ++j) { s0 += (v0[j][0] * v0[j][0] + v0[j][1] * v0[j][1]) + (v0[j][2] * v0[j][2] + v0[j][3] * v0[j][3]); s1 += (v1[j][0] * v1[j][0] + v1[j][1] * v1[j][1]) + (v1[j][2] * v1[j][2] + v1[j][3] * v1[j][3]);
            v2u w; w.x = pk2(v0[j][0], v0[j][1]); w.y = pk2(v0[j][2], v0[j][3]); *((v2u*)(hb + (size_t)m0 * D) + lane + 64 * j) = w;
            if (has1) { v2u w1; w1.x = pk2(v1[j][0], v1[j][1]); w1.y = pk2(v1[j][2], v1[j][3]); *((v2u*)(hb + (size_t)m1 * D) + lane + 64 * j) = w1; } }
        s0 = wave_sum(s0); s1 = wave_sum(s1);
        if (lane < 16) { rs[(size_t)m0 * 16 + lane] = lane == 0 ? s0 : 0.f; if (has1) rs[(size_t)m1 * 16 + lane] = lane == 0 ? s1 : 0.f; }
    }
    { const int gt0 = bid * (NWAVES * 64) + tid; if (gt0 < 1024) { const float x0 = a->in[18][gt0], x1 = a->in[18][1024 + gt0];
        *(f32x4*)((float*)(ws + OFF_LBT) + 4 * gt0) = (f32x4){logsig(x1 - x0), logsig(x0 - x1), sigm(x0 - x1), 0.f}; } }
    const int gt = bid * (NWAVES * 64) + tid, NGT = G * NWAVES * 64;
    for (int e = gt; e < 2 * M * 32; e += NGT) { const int li = e / (M * 32), rem = e % (M * 32), m = rem >> 5, c8 = (rem & 31) * 8;
        const float* src = m < NPR ? a->in[4] + ((size_t)li * NPR + m) * 256 + c8 : a->in[5] + ((size_t)li * NSM + (m - NPR)) * 256 + c8;
        const f32x4 v0 = __builtin_nontemporal_load((const f32x4*)src), v1 = __builtin_nontemporal_load((const f32x4*)(src + 4));
        v4u w; w.x = pk2(v0[0], v0[1]); w.y = pk2(v0[2], v0[3]); w.z = pk2(v1[0], v1[1]); w.w = pk2(v1[2], v1[3]);
        *(v4u*)((bf16*)(ws + OFF_PB + li * PB_SZ) + (size_t)m * 256 + c8) = w; }
}
template <bool HG> struct MX {
    static constexpr int H = HG ? 8 : 4, DV = HG ? 128 : 256, LDZ = HG ? 4096 : 3328, KC = HG ? 1024 : 512, VC = HG ? 2048 : 1024, GC = HG ? 3072 : 2048, VR = DV / 64, NVG = DV / 16, NVR = DV / 64;
    static constexpr float scale = HG ? 1.0f : 0.08838834764831845f;
};
template <bool HG> __device__ __forceinline__ void prep_phase(LAS unsigned char* lds, bf16* Z, const float* R, const float* wup, const float* bgk, const float* lbt, bf16* AB, float* DBUF, bf16* PB, int tid, int bid, int G) {
    typedef MX<HG> C; constexpr int H = C::H, DV = C::DV, LDZ = C::LDZ, KC = C::KC, VC = C::VC, VR = C::VR, QP = 136, TP = 72, NG = DV / 128, NGV = DV / 16;
    LAS float* gl = (LAS float*)lds; LAS float* segs = (LAS float*)(lds + 32768);
    LAS bf16* qe_s = (LAS bf16*)(lds + 34816); LAS bf16* kn_s = (LAS bf16*)(lds + 52224); LAS bf16* kdT_s = (LAS bf16*)(lds + 69632); LAS bf16* vT_s = (LAS bf16*)(lds + 88064);
    const int t = tid >> 3, cs = tid & 7, j0 = cs * 16, lane = tid & 63, w = tid >> 6;
    const int tsw = (((t >> 3) ^ cs) << 3) + (t & 7);
    v4u pq0, pq1, pk0, pk1, pv[DV / 64];
#define PREP_LOAD(u_) do { const int n_ = (u_) % NCH, bh_ = (u_) / NCH, h_ = bh_ % H, b_ = bh_ / H; const bf16* zr_ = Z + ((size_t)b_ * SEQ + 64 * n_ + t) * LDZ; \
        pq0 = *(const v4u*)(zr_ + h_ * 128 + j0); pq1 = *(const v4u*)(zr_ + h_ * 128 + j0 + 8); pk0 = *(const v4u*)(zr_ + KC + h_ * 128 + j0); pk1 = *(const v4u*)(zr_ + KC + h_ * 128 + j0 + 8); \
        _Pragma("unroll") for (int q_ = 0; q_ < DV / 64; ++q_) pv[q_] = *(const v4u*)(zr_ + VC + h_ * DV + cs * (DV / 8) + 8 * q_); } while (0)
    if (bid < NB * H * NCH) PREP_LOAD(bid);
    for (int unit = bid; unit < NB * H * NCH; unit += G) {
        const int n = unit % NCH, bh = unit / NCH, h = bh % H, b = bh / H;
        const size_t tok0 = (size_t)b * SEQ + 64 * n, m = tok0 + t;
        BAR_LDS();
        float lbc[16];
        if constexpr (!HG) {
            const int r = lane & 15, quad = lane >> 4, tb = w >> 1, cbase = 4 * (w & 1);
            float ar[4], br[4][4];
#pragma unroll
            for (int ks = 0; ks < 4; ++ks) { ar[ks] = R[(tok0 + 16 * tb + r) * 16 + 4 * ks + quad];
#pragma unroll
                for (int cb = 0; cb < 4; ++cb) br[cb][ks] = wup[(4 * ks + quad) * 512 + h * 128 + 16 * (cbase + cb) + r]; }
            float bias[4];
#pragma unroll
            for (int cb = 0; cb < 4; ++cb) bias[cb] = bgk[h * 128 + 16 * (cbase + cb) + r];
#pragma unroll
            for (int cb = 0; cb < 4; ++cb) { f32x4 c = {0.f, 0.f, 0.f, 0.f};
#pragma unroll
                for (int ks = 0; ks < 4; ++ks) c = __builtin_amdgcn_mfma_f32_16x16x4f32(ar[ks], br[cb][ks], c, 0, 0, 0);
#pragma unroll
                for (int j = 0; j < 4; ++j) gl[(16 * tb + 4 * quad + j) * 128 + 16 * (cbase + cb) + r] = logsig(c[j] + bias[cb]) * (1.0f / 16.0f); }
#pragma unroll
            for (int jj = 0; jj < 16; ++jj) lbc[jj] = 0.f;
        } else {
            float g[16];
            const unsigned fw[8] = {pk0.x, pk0.y, pk0.z, pk0.w, pk1.x, pk1.y, pk1.z, pk1.w};
#pragma unroll
            for (int jj = 0; jj < 16; ++jj) { const float f = (jj & 1) ? bfhi(fw[jj >> 1]) : bflo(fw[jj >> 1]);
                const f32x4 tc = *(const f32x4*)(lbt + (size_t)(h * 128 + j0 + jj) * 4);
                const float a = tc[0], b2 = tc[1] + logsig(f), mx = fmaxf(a, b2);
                g[jj] = mx + __logf(1.0f + __expf(-fabsf(a - b2))); lbc[jj] = tc[2]; }
#pragma unroll
            for (int q = 0; q < 4; ++q) *(LAS f32x4*)(gl + t * 128 + j0 + 4 * q) = (f32x4){g[4 * q], g[4 * q + 1], g[4 * q + 2], g[4 * q + 3]};
        }
        BAR_LDS();
        {
            const int j = tid & 127, sg = tid >> 7; float acc = 0.f;
#pragma unroll
            for (int i = 0; i < 16; ++i) { acc += gl[(16 * sg + i) * 128 + j]; gl[(16 * sg + i) * 128 + j] = acc; }
            segs[sg * 128 + j] = acc;
            BAR_LDS();
            float off = 0.f;
            for (int s2 = 0; s2 < sg; ++s2) off += segs[s2 * 128 + j];
            if (sg) {
#pragma unroll
                for (int i = 0; i < 16; ++i) gl[(16 * sg + i) * 128 + j] += off; }
        }
        BAR_LDS();
        {
            bf16* qp = Z + m * LDZ + h * 128 + j0;
            const v4u q0 = pq0, q1 = pq1, k0 = pk0, k1 = pk1;
            const unsigned qw[8] = {q0.x, q0.y, q0.z, q0.w, q1.x, q1.y, q1.z, q1.w}, kw[8] = {k0.x, k0.y, k0.z, k0.w, k1.x, k1.y, k1.z, k1.w};
            float bb[16], bl[16];
#pragma unroll
            for (int q = 0; q < 4; ++q) { const f32x4 x = *(const LAS f32x4*)(gl + t * 128 + j0 + 4 * q), y = *(const LAS f32x4*)(gl + 63 * 128 + j0 + 4 * q);
                bb[4 * q] = x[0]; bb[4 * q + 1] = x[1]; bb[4 * q + 2] = x[2]; bb[4 * q + 3] = x[3]; bl[4 * q] = y[0]; bl[4 * q + 1] = y[1]; bl[4 * q + 2] = y[2]; bl[4 * q + 3] = y[3]; }
            float qe[16], kn[16], kd[16];
#pragma unroll
            for (int jj = 0; jj < 16; ++jj) { float qv = (jj & 1) ? bfhi(qw[jj >> 1]) : bflo(qw[jj >> 1]); float kv = (jj & 1) ? bfhi(kw[jj >> 1]) : bflo(kw[jj >> 1]);
                if constexpr (HG) { qv = qv * sigm(qv); kv = lbc[jj] * sigm(-kv); }
                qe[jj] = qv * __expf(bb[jj]) * C::scale; kn[jj] = kv * __expf(-bb[jj]); kd[jj] = kv * __expf(bl[jj] - bb[jj]); }
            v4u o0, o1;
            o0.x = pk2(qe[0], qe[1]); o0.y = pk2(qe[2], qe[3]); o0.z = pk2(qe[4], qe[5]); o0.w = pk2(qe[6], qe[7]); o1.x = pk2(qe[8], qe[9]); o1.y = pk2(qe[10], qe[11]); o1.z = pk2(qe[12], qe[13]); o1.w = pk2(qe[14], qe[15]);
            *(v4u*)qp = o0; *(v4u*)(qp + 8) = o1; *(LAS v4u*)(qe_s + t * QP + j0) = o0; *(LAS v4u*)(qe_s + t * QP + j0 + 8) = o1;
            o0.x = pk2(kn[0], kn[1]); o0.y = pk2(kn[2], kn[3]); o0.z = pk2(kn[4], kn[5]); o0.w = pk2(kn[6], kn[7]); o1.x = pk2(kn[8], kn[9]); o1.y = pk2(kn[10], kn[11]); o1.z = pk2(kn[12], kn[13]); o1.w = pk2(kn[14], kn[15]);
            *(LAS v4u*)(kn_s + t * QP + j0) = o0; *(LAS v4u*)(kn_s + t * QP + j0 + 8) = o1;
#pragma unroll
            for (int jj = 0; jj < 16; jj += 2) { const unsigned pw = pk2(kd[jj], kd[jj + 1]); kdT_s[(j0 + jj) * TP + tsw] = (bf16)(pw & 0xffffu); kdT_s[(j0 + jj + 1) * TP + tsw] = (bf16)(pw >> 16); }
            if (t == 63) {
#pragma unroll
                for (int q = 0; q < 4; ++q) *(f32x4*)(DBUF + (size_t)unit * 128 + j0 + 4 * q) = (f32x4){__expf(bl[4 * q]), __expf(bl[4 * q + 1]), __expf(bl[4 * q + 2]), __expf(bl[4 * q + 3])}; }
#pragma unroll
            for (int q = 0; q < DV / 64; ++q) { const v4u x = pv[q]; const unsigned xw[4] = {x.x, x.y, x.z, x.w};
#pragma unroll
                for (int e = 0; e < 4; ++e) { const int v = cs * (DV / 8) + 8 * q + 2 * e; vT_s[v * TP + tsw] = (bf16)(xw[e] & 0xffffu); vT_s[(v + 1) * TP + tsw] = (bf16)(xw[e] >> 16); } }
        }
        BAR_LDS();
        if (unit + G < NB * H * NCH) PREP_LOAD(unit + G);
        {
            const int r = lane & 15, quad = lane >> 4, tb = w >> 1;
#pragma unroll
            for (int e = 0; e < 2; ++e) { const int sb = 2 * (w & 1) + e; f32x4 c = {0.f, 0.f, 0.f, 0.f};
                if (sb <= tb) {
#pragma unroll
                    for (int ks = 0; ks < 4; ++ks) { const bf16x8 av = *(const LAS bf16x8*)(kn_s + (16 * sb + r) * QP + 32 * ks + 8 * quad), bv = *(const LAS bf16x8*)(qe_s + (16 * tb + r) * QP + 32 * ks + 8 * quad);
                        c = __builtin_amdgcn_mfma_f32_16x16x32_bf16(av, bv, c, 0, 0, 0); } }
                const int tc = 16 * tb + r, s0 = 16 * sb + 4 * quad;
                v2u o; o.x = pk2(s0 <= tc ? c[0] : 0.f, s0 + 1 <= tc ? c[1] : 0.f); o.y = pk2(s0 + 2 <= tc ? c[2] : 0.f, s0 + 3 <= tc ? c[3] : 0.f);
                *(v2u*)(AB + (size_t)unit * 4096 + tc * 64 + s0) = o; }
        }
        {
            const int r = lane & 15, quad = lane >> 4;
#pragma unroll
            for (int vg = 0; vg < NG; ++vg) { const int gv = w * NG + vg;
                const int csv = HG ? gv : (gv >> 1);
                const bf16x8 b0 = *(const LAS bf16x8*)(vT_s + (16 * gv + r) * TP + 8 * (quad ^ csv)), b1 = *(const LAS bf16x8*)(vT_s + (16 * gv + r) * TP + 8 * ((4 + quad) ^ csv));
#pragma unroll
                for (int kb = 0; kb < 8; ++kb) { const bf16x8 a0 = *(const LAS bf16x8*)(kdT_s + (16 * kb + r) * TP + 8 * (quad ^ kb)), a1 = *(const LAS bf16x8*)(kdT_s + (16 * kb + r) * TP + 8 * ((4 + quad) ^ kb));
                    f32x4 c = {0.f, 0.f, 0.f, 0.f}; c = __builtin_amdgcn_mfma_f32_16x16x32_bf16(a0, b0, c, 0, 0, 0); c = __builtin_amdgcn_mfma_f32_16x16x32_bf16(a1, b1, c, 0, 0, 0);
                    v2u o; o.x = pk2(c[0], c[1]); o.y = pk2(c[2], c[3]);
                    *(v2u*)(PB + (((size_t)unit * NGV + gv) * 4 + (kb >> 1)) * 512 + lane * 8 + (kb & 1) * 4) = o; } }
        }
        for (int c = tid; c < DV * 4; c += NWAVES * 64) { const int v = c >> 2, sq = c & 3;
            const int csv = v / (DV / 8);
            const v4u x0 = *(const LAS v4u*)(vT_s + v * TP + 8 * ((2 * sq) ^ csv)), x1 = *(const LAS v4u*)(vT_s + v * TP + 8 * ((2 * sq + 1) ^ csv));
            bf16* dst = Z + (tok0 + v / VR) * LDZ + VC + h * DV + (v % VR) * 64 + 16 * sq;
            *(v4u*)dst = x0; *(v4u*)(dst + 8) = x1; }
    }
#undef PREP_LOAD
}
template <bool HG> __device__ __forceinline__ void state_phase(bf16* PSB, const float* DBUF, float* Sout, int gt, int ngt) {
    typedef MX<HG> C; constexpr int H = C::H, DV = C::DV, NGV = DV / 16, TOTAL = NB * H * NGV * 4 * 64;
    for (int idx = gt; idx < TOTAL; idx += ngt) {
        const int lane = idx & 63, ks = (idx >> 6) & 3, gvb = idx >> 8, gv = gvb % NGV, bh = gvb / NGV, quad = lane >> 4, r = lane & 15;
        f32x4 S0 = {0.f, 0.f, 0.f, 0.f}, S1 = {0.f, 0.f, 0.f, 0.f};
        bf16* pp = PSB + (((size_t)bh * NCH * NGV + gv) * 4 + ks) * 512 + lane * 8; const float* dp = DBUF + (size_t)bh * NCH * 128 + 32 * ks + 4 * quad;
        for (int n0 = 0; n0 < NCH; n0 += 8) {
            v4u p[8]; f32x4 d0[8], d1[8];
#pragma unroll
            for (int i = 0; i < 8; ++i) { p[i] = *(const v4u*)(pp + (size_t)(n0 + i) * NGV * 2048); d0[i] = *(const f32x4*)(dp + (n0 + i) * 128); d1[i] = *(const f32x4*)(dp + (n0 + i) * 128 + 16); }
            __builtin_amdgcn_sched_barrier(0);
#pragma unroll
            for (int i = 0; i < 8; ++i) { v4u o; o.x = pk2(S0[0], S0[1]); o.y = pk2(S0[2], S0[3]); o.z = pk2(S1[0], S1[1]); o.w = pk2(S1[2], S1[3]);
                *(v4u*)(pp + (size_t)(n0 + i) * NGV * 2048) = o;
                S0 = S0 * d0[i] + (f32x4){bflo(p[i].x), bfhi(p[i].x), bflo(p[i].y), bfhi(p[i].y)}; S1 = S1 * d1[i] + (f32x4){bflo(p[i].z), bfhi(p[i].z), bflo(p[i].w), bfhi(p[i].w)}; }
        }
        float* so = Sout + ((size_t)bh * 128 + 32 * ks + 4 * quad) * DV + 16 * gv + r;
#pragma unroll
        for (int j = 0; j < 4; ++j) { so[j * DV] = S0[j]; so[(16 + j) * DV] = S1[j]; }
    }
}
template <bool HG> __device__ __forceinline__ void out_phase(LAS unsigned char* lds, const bf16* Z, const bf16* AB, const bf16* PSB, bf16* OG, const float* gn, int tid, int w, int bid, int G) {
    typedef MX<HG> C; constexpr int H = C::H, DV = C::DV, LDZ = C::LDZ, VC = C::VC, GC = C::GC, VR = C::VR, VW = DV / 8, NG = VW / 16, NGV = DV / 16, NU = NB * H * NCH;
    constexpr int QP = 136, AP = 72, OFF_QE = 0, OFF_AA = 64 * QP * 2, BUFSZ = OFF_AA + 64 * AP * 2, OFF_SS = 2 * BUFSZ;
    const int lane = tid & 63, r = lane & 15, quad = lane >> 4, vbase = w * VW;
    f32x4 gnv[NG];
#pragma unroll
    for (int vg = 0; vg < NG; ++vg) gnv[vg] = *(const f32x4*)(gn + vbase + 16 * vg + 4 * quad);
    unsigned oq[2], ov[NG], sq[2];
#pragma unroll
    for (int i = 0; i < 2; ++i) { const int p = tid + 512 * i, row = p >> 4, c16 = p & 15; oq[i] = (unsigned)(row * LDZ + 8 * c16) * 2u; sq[i] = (unsigned)(row * QP + 8 * c16) * 2u; }
#pragma unroll
    for (int vg = 0; vg < NG; ++vg) { const int v = vbase + 16 * vg + r; ov[vg] = (unsigned)((v / VR) * LDZ + (v % VR) * 64 + 8 * quad) * 2u; }
    unsigned oa = (unsigned)tid * 16u, og = (unsigned)(r * LDZ + 4 * quad) * 2u, oo = (unsigned)(r * 1024 + 4 * quad) * 2u, osb = (unsigned)lane * 16u;
    unsigned lq = (unsigned)(r * QP + 4 * quad) * 2u, la = (unsigned)(r * AP + 8 * quad) * 2u, sa = (unsigned)((tid >> 3) * AP + 8 * (tid & 7)) * 2u;
    v4u pq[2], pa; bf16x8 sb[NG][4], vb[NG][2], sbn[NG][4], vbn[NG][2];
#define OP_BASES(u_) const int n_ = (u_) % NCH, bh_ = (u_) / NCH, h_ = bh_ % H, b_ = bh_ / H; const size_t tk_ = (size_t)b_ * SEQ + 64 * n_; \
        const char* zq_ = (const char*)(Z + tk_ * LDZ + h_ * 128); const char* zv_ = (const char*)(Z + tk_ * LDZ + VC + h_ * DV); const char* ab_ = (const char*)(AB + (size_t)(u_) * 4096); \
        const char* sb_ = (const char*)(PSB + ((size_t)(u_) * NGV + w * NG) * 2048)
#define OP_ISSUE(u_) do { OP_BASES(u_); pq[0] = *(const v4u*)(zq_ + oq[0]); pq[1] = *(const v4u*)(zq_ + oq[1]); pa = *(const v4u*)(ab_ + oa); \
        _Pragma("unroll") for (int vg = 0; vg < NG; ++vg) { _Pragma("unroll") for (int ks = 0; ks < 4; ++ks) sbn[vg][ks] = *(const bf16x8*)(sb_ + (vg * 4 + ks) * 1024 + osb); \
            vbn[vg][0] = *(const bf16x8*)(zv_ + ov[vg]); vbn[vg][1] = *(const bf16x8*)(zv_ + ov[vg] + 64); } } while (0)
#define OP_STAGE(buf_) do { LAS unsigned char* bs_ = lds + (buf_) * BUFSZ; *(LAS v4u*)(bs_ + OFF_QE + sq[0]) = pq[0]; *(LAS v4u*)(bs_ + OFF_QE + sq[1]) = pq[1]; *(LAS v4u*)(bs_ + OFF_AA + sa) = pa; } while (0)
#define OP_TAKE() do { _Pragma("unroll") for (int vg = 0; vg < NG; ++vg) { _Pragma("unroll") for (int ks = 0; ks < 4; ++ks) sb[vg][ks] = sbn[vg][ks]; vb[vg][0] = vbn[vg][0]; vb[vg][1] = vbn[vg][1]; } } while (0)
    OP_ISSUE(bid); OP_STAGE(0); OP_TAKE();
    BAR_LDS();
    int par = 0;
    for (int unit = bid; unit < NU; unit += G, par ^= 1) {
        asm volatile("" : "+v"(oq[0]), "+v"(oq[1]), "+v"(oa), "+v"(og), "+v"(oo), "+v"(osb), "+v"(lq), "+v"(la), "+v"(sa), "+v"(sq[0]), "+v"(sq[1]));
#pragma unroll
        for (int vg = 0; vg < NG; ++vg) asm volatile("" : "+v"(ov[vg]));
        const int n = unit % NCH, bh = unit / NCH, h = bh % H, b = bh / H; const size_t tok0 = (size_t)b * SEQ + 64 * n;
        const char* zg = (const char*)(Z + tok0 * LDZ + GC + h * DV + vbase);
        v2u gq[NG][4];
#pragma unroll
        for (int tb = 0; tb < 4; ++tb)
#pragma unroll
            for (int vg = 0; vg < NG; ++vg) gq[vg][tb] = *(const v2u*)(zg + (size_t)tb * 16 * LDZ * 2 + og + 32 * vg);
        const bool more = unit + G < NU;
        if (more) OP_ISSUE(unit + G);
        const LAS unsigned char* bs = lds + par * BUFSZ;
        f32x4 o[NG][4];
#pragma unroll
        for (int vg = 0; vg < NG; ++vg)
#pragma unroll
            for (int tb = 0; tb < 4; ++tb) o[vg][tb] = (f32x4){0.f, 0.f, 0.f, 0.f};
#pragma unroll
        for (int kh = 0; kh < 2; ++kh) { bf16x8 qf[2][4];
#pragma unroll
            for (int kl = 0; kl < 2; ++kl)
#pragma unroll
                for (int tb = 0; tb < 4; ++tb) { const LAS unsigned char* qa = bs + OFF_QE + lq + (16 * tb * QP + 32 * (2 * kh + kl)) * 2;
                    const v2u lo = *(const LAS v2u*)qa, hi = *(const LAS v2u*)(qa + 32); qf[kl][tb] = __builtin_bit_cast(bf16x8, ((v4u){lo.x, lo.y, hi.x, hi.y})); }
            __builtin_amdgcn_sched_barrier(0);
#pragma unroll
            for (int kl = 0; kl < 2; ++kl)
#pragma unroll
                for (int tb = 0; tb < 4; ++tb)
#pragma unroll
                    for (int vg = 0; vg < NG; ++vg) o[vg][tb] = __builtin_amdgcn_mfma_f32_16x16x32_bf16(sb[vg][2 * kh + kl], qf[kl][tb], o[vg][tb], 0, 0, 0);
            __builtin_amdgcn_sched_barrier(0); }
        { bf16x8 af[4][2];
#pragma unroll
            for (int tb = 0; tb < 4; ++tb) { const LAS unsigned char* aa = bs + OFF_AA + la + 16 * tb * AP * 2; af[tb][0] = *(const LAS bf16x8*)aa; af[tb][1] = *(const LAS bf16x8*)(aa + 64); }
            __builtin_amdgcn_sched_barrier(0);
#pragma unroll
            for (int js = 0; js < 2; ++js)
#pragma unroll
                for (int tb = 0; tb < 4; ++tb)
#pragma unroll
                    for (int vg = 0; vg < NG; ++vg) o[vg][tb] = __builtin_amdgcn_mfma_f32_16x16x32_bf16(vb[vg][js], af[tb][js], o[vg][tb], 0, 0, 0);
            __builtin_amdgcn_sched_barrier(0); }
        LAS float* ssb = (LAS float*)(lds + OFF_SS + par * 2048);
#pragma unroll
        for (int tb = 0; tb < 4; ++tb) { float p = 0.f;
#pragma unroll
            for (int vg = 0; vg < NG; ++vg) p += (o[vg][tb][0] * o[vg][tb][0] + o[vg][tb][1] * o[vg][tb][1]) + (o[vg][tb][2] * o[vg][tb][2] + o[vg][tb][3] * o[vg][tb][3]);
            p += __shfl_xor(p, 16); p += __shfl_xor(p, 32);
            if (quad == 0) ssb[(16 * tb + r) * 8 + w] = p; }
        if (more) { OP_STAGE(par ^ 1); OP_TAKE(); }
        BAR_LDS();
        char* ogn = (char*)(OG + tok0 * 1024 + h * DV + vbase);
#pragma unroll
        for (int tb = 0; tb < 4; ++tb) { const f32x4 s0 = *(const LAS f32x4*)(ssb + (16 * tb + r) * 8), s1 = *(const LAS f32x4*)(ssb + (16 * tb + r) * 8 + 4);
            const float tot = ((s0[0] + s0[1]) + (s0[2] + s0[3])) + ((s1[0] + s1[1]) + (s1[2] + s1[3])); const float rinv = rsqrtf(tot * (1.0f / DV) + 1e-6f);
#pragma unroll
            for (int vg = 0; vg < NG; ++vg) { const float g0 = bflo(gq[vg][tb].x), g1 = bfhi(gq[vg][tb].x), g2 = bflo(gq[vg][tb].y), g3 = bfhi(gq[vg][tb].y);
                const f32x4 y = o[vg][tb] * rinv * gnv[vg]; v2u pw; pw.x = pk2(y[0] * g0 * sigm(g0), y[1] * g1 * sigm(g1)); pw.y = pk2(y[2] * g2 * sigm(g2), y[3] * g3 * sigm(g3));
                *(v2u*)(ogn + (size_t)tb * 16 * 1024 * 2 + oo + 32 * vg) = pw; } }
    }
#undef OP_BASES
#undef OP_ISSUE
#undef OP_STAGE
#undef OP_TAKE
}
template <bool HG> __device__ __forceinline__ void sample_block(LAS unsigned char* lds, const bf16* Z, const float* R, const float* wup, const float* bgk, const float* lowb, const float* gn, const float* S0, float* Sout, bf16* OG, int bh, int tid, int w) {
    typedef MX<HG> C; constexpr int H = C::H, DV = C::DV, LDZ = C::LDZ, KC = C::KC, VC = C::VC, GC = C::GC, E = DV / 64;
    const int lane = tid & 63, kk = lane >> 2, t = lane & 3, k = 16 * w + kk, h = bh % H, b = bh / H, hk = h * 128 + k; const size_t m0 = (size_t)NPR + 4 * b;
    LAS float* tab = (LAS float*)lds + w * 192; LAS float* pas = (LAS float*)(lds + 6144); LAS float* red = (LAS float*)(lds + 8192);
    const float* sp = S0 + ((size_t)bh * 128 + 16 * w) * DV + E * lane; float* dp = Sout + ((size_t)bh * 128 + 16 * w) * DV + E * lane;
    float s0[16][E];
#pragma unroll
    for (int i = 0; i < 16; ++i) {
        if constexpr (E == 4) { const f32x4 x = __builtin_nontemporal_load((const f32x4*)(sp + (size_t)i * DV)); s0[i][0] = x[0]; s0[i][1] = x[1]; s0[i][2] = x[2]; s0[i][3] = x[3]; }
        else { const v2u x = __builtin_nontemporal_load((const v2u*)(sp + (size_t)i * DV)); s0[i][0] = __uint_as_float(x.x); s0[i][1] = __uint_as_float(x.y); } }
    float vv[4][E];
#pragma unroll
    for (int s = 0; s < 4; ++s) { const bf16* zv = Z + (m0 + s) * LDZ + VC + h * DV + E * lane;
        if constexpr (E == 4) { const v2u x = *(const v2u*)zv; vv[s][0] = bflo(x.x); vv[s][1] = bfhi(x.x); vv[s][2] = bflo(x.y); vv[s][3] = bfhi(x.y); }
        else { const unsigned x = *(const unsigned*)zv; vv[s][0] = bflo(x); vv[s][1] = bfhi(x); } }
    const bf16* zr = Z + (m0 + t) * LDZ; float q = bf2f(zr[hk]); const float kz = bf2f(zr[KC + hk]); float g, kv;
    if constexpr (!HG) { float x = bgk[hk];
#pragma unroll
        for (int i = 0; i < 16; ++i) x += R[(m0 + t) * 16 + i] * wup[i * 512 + hk];
        g = logsig(x) * (1.0f / 16.0f); kv = kz;
    } else { const float x0 = lowb[hk], x1 = lowb[1024 + hk]; const float a = logsig(x1 - x0), b2 = logsig(x0 - x1) + logsig(kz), mx = fmaxf(a, b2);
        g = mx + __logf(1.0f + __expf(-fabsf(a - b2))); kv = sigm(x0 - x1) * sigm(-kz); q = q * sigm(q); }
    const int l0 = lane & ~3;
    const float g0 = __shfl(g, l0), g1 = __shfl(g, l0 + 1), g2 = __shfl(g, l0 + 2), g3 = __shfl(g, l0 + 3);
    const float b3 = ((g0 + g1) + g2) + g3, bt = t == 0 ? g0 : (t == 1 ? g0 + g1 : (t == 2 ? (g0 + g1) + g2 : b3));
    const float qe = q * __expf(bt) * C::scale, kn = kv * __expf(-bt), kd = kv * __expf(b3 - bt);
    tab[kk * 12 + t] = qe; tab[kk * 12 + 4 + t] = kd; if (t == 0) tab[kk * 12 + 8] = __expf(b3);
    {
        float p[4];
#pragma unroll
        for (int s = 0; s < 4; ++s) { p[s] = qe * __shfl(kn, l0 + s);
            p[s] += __shfl_xor(p[s], 4); p[s] += __shfl_xor(p[s], 8); p[s] += __shfl_xor(p[s], 16); p[s] += __shfl_xor(p[s], 32); }
        if (lane < 4) *(LAS f32x4*)(pas + w * 16 + 4 * lane) = (f32x4){p[0], p[1], p[2], p[3]};
    }
    LDS_WAIT();
    float o[4][E];
#pragma unroll
    for (int tt = 0; tt < 4; ++tt)
#pragma unroll
        for (int e = 0; e < E; ++e) o[tt][e] = 0.f;
#pragma unroll
    for (int i = 0; i < 16; ++i) { const f32x4 q4 = *(const LAS f32x4*)(tab + i * 12), k4 = *(const LAS f32x4*)(tab + i * 12 + 4); const float d = tab[i * 12 + 8]; float sn[E];
#pragma unroll
        for (int e = 0; e < E; ++e) { o[0][e] += q4[0] * s0[i][e]; o[1][e] += q4[1] * s0[i][e]; o[2][e] += q4[2] * s0[i][e]; o[3][e] += q4[3] * s0[i][e];
            sn[e] = d * s0[i][e] + ((k4[0] * vv[0][e] + k4[1] * vv[1][e]) + (k4[2] * vv[2][e] + k4[3] * vv[3][e])); }
        if constexpr (E == 4) __builtin_nontemporal_store(((f32x4){sn[0], sn[1], sn[2], sn[3]}), (f32x4*)(dp + (size_t)i * DV));
        else { v2u x; x.x = __float_as_uint(sn[0]); x.y = __float_as_uint(sn[1]); __builtin_nontemporal_store(x, (v2u*)(dp + (size_t)i * DV)); } }
#pragma unroll
    for (int tt = 0; tt < 4; ++tt) {
        if constexpr (E == 4) *(LAS f32x4*)(red + (w * 4 + tt) * DV + 4 * lane) = (f32x4){o[tt][0], o[tt][1], o[tt][2], o[tt][3]};
        else { red[(w * 4 + tt) * DV + 2 * lane] = o[tt][0]; red[(w * 4 + tt) * DV + 2 * lane + 1] = o[tt][1]; } }
    BAR_LDS();
    if (w < 4) {
        float y[E];
#pragma unroll
        for (int e = 0; e < E; ++e) y[e] = 0.f;
#pragma unroll
        for (int ww = 0; ww < 8; ++ww)
#pragma unroll
            for (int e = 0; e < E; ++e) y[e] += red[(ww * 4 + w) * DV + E * lane + e];
#pragma unroll
        for (int s = 0; s < 4; ++s) if (s <= w) { float a = 0.f;
#pragma unroll
            for (int ww = 0; ww < 8; ++ww) a += pas[ww * 16 + 4 * w + s];
#pragma unroll
            for (int e = 0; e < E; ++e) y[e] += a * vv[s][e]; }
        float ss = 0.f;
#pragma unroll
        for (int e = 0; e < E; ++e) ss += y[e] * y[e];
        ss = wave_sum(ss); const float rinv = rsqrtf(ss * (1.0f / DV) + 1e-6f);
        const bf16* zg = Z + (m0 + w) * LDZ + GC + h * DV + E * lane; bf16* op = OG + (m0 + w) * 1024 + h * DV + E * lane; float gg[E];
        if constexpr (E == 4) { const v2u x = *(const v2u*)zg; gg[0] = bflo(x.x); gg[1] = bfhi(x.x); gg[2] = bflo(x.y); gg[3] = bfhi(x.y); } else { const unsigned x = *(const unsigned*)zg; gg[0] = bflo(x); gg[1] = bfhi(x); }
#pragma unroll
        for (int e = 0; e < E; ++e) y[e] = y[e] * rinv * gn[E * lane + e] * (gg[e] * sigm(gg[e]));
        if constexpr (E == 4) { v2u pw; pw.x = pk2(y[0], y[1]); pw.y = pk2(y[2], y[3]); *(v2u*)op = pw; } else { *(unsigned*)op = pk2(y[0], y[1]); }
    }
    BAR_LDS();
}
template <int NKS> __device__ __forceinline__ void mini_acc(f32x4 (&acc)[2][4], const bf16* ap, size_t lda, const bf16* bp, size_t ldb) {
#pragma unroll
    for (int c = 0; c < NKS; c += 4) {
        bf16x8 af[4][2], bfr[4][4];
#pragma unroll
        for (int ks = 0; ks < 4; ++ks) if (c + ks < NKS) {
#pragma unroll
            for (int rb = 0; rb < 2; ++rb) af[ks][rb] = *(const bf16x8*)(ap + (size_t)(16 * rb) * lda + 32 * (c + ks));
#pragma unroll
            for (int cb = 0; cb < 4; ++cb) bfr[ks][cb] = *(const bf16x8*)(bp + (size_t)(16 * cb) * ldb + 32 * (c + ks)); }
        __builtin_amdgcn_sched_barrier(0);
#pragma unroll
        for (int ks = 0; ks < 4; ++ks) if (c + ks < NKS) {
#pragma unroll
            for (int rb = 0; rb < 2; ++rb)
#pragma unroll
                for (int cb = 0; cb < 4; ++cb) acc[rb][cb] = __builtin_amdgcn_mfma_f32_16x16x32_bf16(bfr[ks][cb], af[ks][rb], acc[rb][cb], 0, 0, 0); }
        __builtin_amdgcn_sched_barrier(0);
    }
}
template <int MODE, int K> __device__ __forceinline__ void mini_gemm(LAS unsigned char* lds, const bf16* A, const bf16* Bt, const bf16* A2, const bf16* Bt2, const float* xin, const bf16* hb_in, bf16* hb_out, const float* rs_in, float* rs_out, float alpha, int tid, int bid, int G) {
    const int lane = tid & 63, w = tid >> 6, r = lane & 15, quad = lane >> 4;
    LAS float* P = (LAS float*)lds; LAS float* P2 = (LAS float*)(lds + 65536);
    for (int mt = bid; mt < 256; mt += G) {
        const int rt = mt >> 4, ct = mt & 15, row0 = NPR + 32 * rt, col0 = 64 * ct;
        f32x4 acc[2][4];
#pragma unroll
        for (int rb = 0; rb < 2; ++rb)
#pragma unroll
            for (int cb = 0; cb < 4; ++cb) acc[rb][cb] = (f32x4){0.f, 0.f, 0.f, 0.f};
        constexpr int KW = K / 8;
        mini_acc<KW / 32>(acc, A + (size_t)(row0 + r) * K + w * KW + 8 * quad, K, Bt + (size_t)(col0 + r) * K + w * KW + 8 * quad, K);
#pragma unroll
        for (int rb = 0; rb < 2; ++rb)
#pragma unroll
            for (int cb = 0; cb < 4; ++cb) *(LAS f32x4*)(P + (w * 32 + 16 * rb + r) * 64 + 16 * cb + 4 * quad) = acc[rb][cb];
        if constexpr (MODE == 1) {
#pragma unroll
            for (int rb = 0; rb < 2; ++rb)
#pragma unroll
                for (int cb = 0; cb < 4; ++cb) acc[rb][cb] = (f32x4){0.f, 0.f, 0.f, 0.f};
            mini_acc<1>(acc, A2 + (size_t)(row0 + r) * 256 + w * 32 + 8 * quad, 256, Bt2 + (size_t)(col0 + r) * 256 + w * 32 + 8 * quad, 256);
#pragma unroll
            for (int rb = 0; rb < 2; ++rb)
#pragma unroll
                for (int cb = 0; cb < 4; ++cb) *(LAS f32x4*)(P2 + (w * 32 + 16 * rb + r) * 64 + 16 * cb + 4 * quad) = acc[rb][cb];
        }
        BAR_LDS();
        const int row = tid >> 4, c4 = (tid & 15) * 4; f32x4 v = {0.f, 0.f, 0.f, 0.f}, v2 = {0.f, 0.f, 0.f, 0.f};
#pragma unroll
        for (int ww = 0; ww < 8; ++ww) { v += *(const LAS f32x4*)(P + (ww * 32 + row) * 64 + c4); if constexpr (MODE == 1) v2 += *(const LAS f32x4*)(P2 + (ww * 32 + row) * 64 + c4); }
        const int grow = row0 + row; const size_t off = (size_t)grow * 1024 + col0 + c4;
        f32x4 o;
        if (xin) o = *(const f32x4*)(xin + off); else { const v2u hx = *(const v2u*)(hb_in + off); o = (f32x4){bflo(hx.x), bfhi(hx.x), bflo(hx.y), bfhi(hx.y)}; }
        if constexpr (MODE == 0) o += v * alpha;
        else { const float s = pg8::row_scale(rs_in, grow); o[0] += sigm(v[0] * s) * v2[0]; o[1] += sigm(v[1] * s) * v2[1]; o[2] += sigm(v[2] * s) * v2[2]; o[3] += sigm(v[3] * s) * v2[3]; }
        v2u pw; pw.x = pk2(o[0], o[1]); pw.y = pk2(o[2], o[3]); *(v2u*)(hb_out + off) = pw;
        float ss = (o[0] * o[0] + o[1] * o[1]) + (o[2] * o[2] + o[3] * o[3]);
        ss += __shfl_xor(ss, 1); ss += __shfl_xor(ss, 2); ss += __shfl_xor(ss, 4); ss += __shfl_xor(ss, 8);
        if ((tid & 15) == 0) rs_out[(size_t)grow * 16 + ct] = ss;
        BAR_LDS();
    }
}
#define XB_TMO      128
#define XB_XCNT(j)  (256  + 64 * (j))
#define XB_XSUB(j)  (1280 + 64 * (j))
#define XB_XGEN(j)  (2304 + 64 * (j))
#define XB_TOP      3328
#define XB_TOPGEN   3392
#define XCD_BAR_WORDS 3456
#define XB_SPIN_CAP (1u << 18)

__device__ __forceinline__ unsigned xb_ld(unsigned* p)              { return __hip_atomic_load(p, __ATOMIC_RELAXED, __HIP_MEMORY_SCOPE_AGENT); }
__device__ __forceinline__ unsigned xb_add(unsigned* p, unsigned v) { return __hip_atomic_fetch_add(p, v, __ATOMIC_RELAXED, __HIP_MEMORY_SCOPE_AGENT); }
__device__ __forceinline__ unsigned xb_xcc_id() { return (unsigned)__builtin_amdgcn_s_getreg((3 << 11) | 20) & 0xFu; }
#define XB_SPIN(cond, bar) do { unsigned _sp = 0; while (cond) { __builtin_amdgcn_s_sleep(1); \
    if ((++_sp & 255u) == 0u) { if (xb_ld(&(bar)[XB_TMO])) break; if (_sp > XB_SPIN_CAP) { atomicAdd(&(bar)[XB_TMO], 1u); break; } } } } while (0)

struct XcdBarrier {
    unsigned* bar; unsigned x;
    volatile LAS unsigned* st;
};

__device__ __forceinline__ XcdBarrier xcd_barrier_post(unsigned* bar, volatile LAS unsigned* st) {
    XcdBarrier b; b.bar = bar; b.x = xb_xcc_id(); b.st = st;
    if (threadIdx.x == 0) (void)xb_add(&bar[XB_XCNT(b.x)], 1u);
    return b;
}
__device__ __forceinline__ void xcd_barrier_complete(unsigned* bar, unsigned x, unsigned& nloc, unsigned& nx) {
    const unsigned G = gridDim.x * gridDim.y * gridDim.z;
    unsigned sum, cnt, mine, sp = 0u;
    for (;;) {
        sum = 0u; cnt = 0u; mine = 0u;
#pragma unroll
        for (unsigned j = 0; j < 16; ++j) { const unsigned c = xb_ld(&bar[XB_XCNT(j)]); sum += c; cnt += (c > 0u) ? 1u : 0u; mine = (j == x) ? c : mine; }
        if (sum == G) break;
        __builtin_amdgcn_s_sleep(1);
        if ((++sp & 255u) == 0u) { if (xb_ld(&bar[XB_TMO])) break; if (sp > XB_SPIN_CAP) { atomicAdd(&bar[XB_TMO], 1u); break; } }
    }
    nloc = mine > 0u ? mine : 1u; nx = cnt > 0u ? cnt : 1u;
}

__device__ __forceinline__ void xcd_barrier(const XcdBarrier& b) {
    asm volatile("s_waitcnt vmcnt(0)" ::: "memory");
    __syncthreads();
    if (threadIdx.x == 0) {
        unsigned* bar = b.bar;
        __builtin_amdgcn_s_waitcnt(0);
        unsigned nloc = b.st[0], nx = b.st[1];
        if (nloc == 0u) { xcd_barrier_complete(bar, b.x, nloc, nx); b.st[0] = nloc; b.st[1] = nx; }
        const unsigned old = xb_add(&bar[XB_XSUB(b.x)], 1u);
        const unsigned gen = old / nloc;
        if (old + 1u == (gen + 1u) * nloc) {
            __builtin_amdgcn_fence(__ATOMIC_RELEASE, "agent");
            asm volatile("s_waitcnt vmcnt(0)" ::: "memory");
            const unsigned og = xb_add(&bar[XB_TOP], 1u);
            const unsigned tg = og / nx;
            if (og + 1u == (tg + 1u) * nx) xb_add(&bar[XB_TOPGEN], 1u);
            else XB_SPIN(xb_ld(&bar[XB_TOPGEN]) == tg, bar);
            __builtin_amdgcn_fence(__ATOMIC_ACQUIRE, "agent");
            xb_add(&bar[XB_XGEN(b.x)], 1u);
            asm volatile("s_waitcnt vmcnt(0)" ::: "memory");
        } else {
            XB_SPIN(xb_ld(&bar[XB_XGEN(b.x)]) == gen, bar);
            __builtin_amdgcn_fence(__ATOMIC_ACQUIRE, "agent");
            asm volatile("s_waitcnt vmcnt(0)" ::: "memory");
        }
    }
    __syncthreads();
}

#define MK_TID() int wave = wave_s; asm volatile("" : "+s"(wave)); unsigned ones_ = ~0u; asm volatile("" : "+s"(ones_)); \
    const int lane = (int)__builtin_amdgcn_mbcnt_hi(ones_, __builtin_amdgcn_mbcnt_lo(ones_, 0u)); const int tid = wave * 64 + lane; const int gw = bid * NWAVES + wave, NGW = G * NWAVES; (void)gw; (void)NGW; (void)tid; (void)lane
__global__ void __launch_bounds__(NWAVES * 64, 2) fwd_kernel(Args a) {
    extern __shared__ __attribute__((aligned(16))) unsigned char lds_raw[];
    LAS unsigned char* lds = (LAS unsigned char*)lds_raw;
    cg::grid_group grid = cg::this_grid();
    const int wave_s = __builtin_amdgcn_readfirstlane((int)threadIdx.x >> 6);
    volatile LAS unsigned* bst = (volatile LAS unsigned*)(lds + LDS_BYTES - 64);
    if (threadIdx.x < 2) bst[threadIdx.x] = 0u;
    __syncthreads();
    const XcdBarrier xbar = xcd_barrier_post((unsigned*)(a.ws + OFF_CTL), bst);
#if PT_ON
#define PT_T0 (blockIdx.x == 0 && wave_s == 0 && __builtin_amdgcn_mbcnt_hi(~0u, __builtin_amdgcn_mbcnt_lo(~0u, 0u)) == 0u)
#define tsl ((volatile LAS unsigned*)(lds + LDS_BYTES - 32))
#endif
    const int ph_lo = a.ph_lo, ph_hi = a.ph_hi;
    for (int ph_ = ph_lo; ph_ < ph_hi; ++ph_) {
#if PROBE_MODE
      const int kk_ = (ph_ - 1) % 10; const bool mid_ = ph_ > 0 && ph_ < NPH - 1;
      const int nrep = (PROBE_MODE == 1 && ph_ == 0) || (PROBE_MODE == 2 && mid_ && (kk_ == 0 || kk_ == 7)) || (PROBE_MODE == 3 && mid_ && kk_ == 2) || (PROBE_MODE == 4 && mid_ && kk_ == 5) ? 2 : 1;
      for (int rep = 0; rep < nrep; ++rep) {
#else
      {
#endif
        int ph = ph_; asm volatile("" : "+s"(ph));
#if PT_ON
        if (ph == PT_LO && PT_T0) { const unsigned long long t_ = __builtin_amdgcn_s_memrealtime(); tsl[0] = (unsigned)t_; tsl[1] = (unsigned)(t_ >> 32); }
        if (ph == PT_HI + 1 && PT_T0) { const unsigned long long t_ = __builtin_amdgcn_s_memrealtime(); tsl[2] = (unsigned)t_; tsl[3] = (unsigned)(t_ >> 32); }
#endif
        CArgs* ap = (CArgs*)__builtin_amdgcn_kernarg_segment_ptr(); asm volatile("" : "+s"(ap));
        int bid = blockIdx.x; asm volatile("" : "+s"(bid));
        int G = gridDim.x; asm volatile("" : "+s"(G));
        unsigned char* ws = ap->ws; float* hbuf = ap->out;
        if (ph == 0) { MK_TID(); prologue(ap, ws, hbuf, lds, tid, bid, G); }
        else if (ph == NPH - 1) {
            MK_TID(); const float* fw = ap->in[25]; const bf16* hfin = (const bf16*)(ws + OFF_HB);
            for (int m = gw; m < M; m += NGW) { const v2u* hr = (const v2u*)(hfin + (size_t)m * D); f32x4 v[4]; float ss = 0.f;
#pragma unroll
                for (int j = 0; j < 4; ++j) { const v2u x = hr[lane + 64 * j]; v[j] = (f32x4){bflo(x.x), bfhi(x.x), bflo(x.y), bfhi(x.y)}; ss += (v[j][0] * v[j][0] + v[j][1] * v[j][1]) + (v[j][2] * v[j][2] + v[j][3] * v[j][3]); }
                ss = wave_sum(ss); const float rinv = rsqrtf(ss * (1.0f / D) + 1e-6f);
#pragma unroll
                for (int j = 0; j < 4; ++j) { const f32x4 wv = *((const f32x4*)fw + lane + 64 * j); __builtin_nontemporal_store(v[j] * rinv * wv, (f32x4*)(hbuf + (size_t)m * D) + lane + 64 * j); } }
        } else {
            const int li = (ph - 1) / 10, k = (ph - 1) % 10, cur = li;
            bf16* hb = (bf16*)(ws + OFF_HB + cur * HB_SZ); bf16* ob = (bf16*)(ws + OFF_HB + (cur ^ 1) * HB_SZ);
            float* rs0 = (float*)(ws + OFF_RS); float* rs1 = (float*)(ws + OFF_RS + RS_SZ); float* Rb = (float*)(ws + OFF_R);
            bf16* big = (bf16*)(ws + OFF_BIG);
            if (k == 0 || k == 7) { MK_TID();
                const int f = k == 7; pg8::Gemm g{hb, (const bf16*)(ws + OFF_WGU + (li * 2 + f) * WGU_SZ), M, 2 * FF, D};
                pg8::StaticOrder S; S.init(M, 2 * FF, G, bid); pg8::EpiSwiglu E{big, FF, rs0};
                pg8::gemm_phase<pg8::EpiSwiglu, pg8::StaticOrder, true, true>(lds, g, S, E, tid);
            } else if (k == 1 || k == 8 || k == 6) { MK_TID();
                pg8::Gemm g; float alpha; float* rso;
                if (k == 6) { g = pg8::Gemm{ob, (const bf16*)(ws + OFF_WOUT + li * WSQ_SZ), M, D, D}; alpha = 1.0f; rso = rs0; }
                else { const int f = k == 8; g = pg8::Gemm{big, (const bf16*)(ws + OFF_WDN + (li * 2 + f) * WDN_SZ), M, D, FF}; alpha = 0.5f; rso = rs1; }
                g.M = NPR; pg8::StaticOrder S; S.init(NPR, D, G, bid); const bool first = (li == 0 && k == 1);
                pg8::EpiResid E{first ? ap->in[0] : (const float*)nullptr, hb, rso, alpha};
                pg8::gemm_phase<pg8::EpiResid, pg8::StaticOrder, true, true>(lds, g, S, E, tid);
                unsigned ones2_ = ~0u; asm volatile("" : "+s"(ones2_));
                const int tid2 = wave * 64 + (int)__builtin_amdgcn_mbcnt_hi(ones2_, __builtin_amdgcn_mbcnt_lo(ones2_, 0u));
                const float* xin_s = first ? ap->in[1] - (size_t)NPR * 1024 : (const float*)nullptr;
                if (k == 6) mini_gemm<0, D>(lds, g.A, g.Bt, nullptr, nullptr, xin_s, hb, hb, nullptr, rso, alpha, tid2, bid, G);
                else mini_gemm<0, FF>(lds, g.A, g.Bt, nullptr, nullptr, xin_s, hb, hb, nullptr, rso, alpha, tid2, bid, G);
            } else if (k == 2) { MK_TID();
                const int N = li ? 4096 : 3328; pg8::Gemm g{hb, (const bf16*)(ws + (li ? OFF_WHIN : OFF_WGIN)), M, N, D};
                pg8::StaticOrder S; S.init(M, N, G, bid); pg8::EpiZ E{big, N, rs1, Rb, li ? -1 : 12};
                pg8::gemm_phase<pg8::EpiZ, pg8::StaticOrder, true, true>(lds, g, S, E, tid);
            } else if (k == 3) { MK_TID();
                if (li == 0) prep_phase<false>(lds, big, Rb, ap->in[11], ap->in[12], (const float*)(ws + OFF_LBT), (bf16*)(ws + OFF_AB), (float*)(ws + OFF_DB), (bf16*)(ws + OFF_PSB), tid, bid, G);
                else prep_phase<true>(lds, big, Rb, ap->in[11], ap->in[12], (const float*)(ws + OFF_LBT), (bf16*)(ws + OFF_AB), (float*)(ws + OFF_DB), (bf16*)(ws + OFF_PSB), tid, bid, G);
                __syncthreads();
                for (int rp_ = 0; rp_ < (PROBE_MODE == 6 ? 2 : 1); ++rp_)
                for (int u = bid; u < DB * (li ? 8 : 4); u += G) {
                    if (li == 0) sample_block<false>(lds, big, Rb, ap->in[11], ap->in[12], ap->in[18], ap->in[13], ap->in[2], hbuf + OUT_GS, ob, u, tid, wave);
                    else sample_block<true>(lds, big, Rb, ap->in[11], ap->in[12], ap->in[18], ap->in[16], ap->in[3], hbuf + OUT_HS, ob, u, tid, wave);
                }
            } else if (k == 4) { MK_TID();
                const int gt = bid * (NWAVES * 64) + tid, ngt = G * NWAVES * 64;
                if (li == 0) state_phase<false>((bf16*)(ws + OFF_PSB), (const float*)(ws + OFF_DB), hbuf + OUT_GP, gt, ngt);
                else state_phase<true>((bf16*)(ws + OFF_PSB), (const float*)(ws + OFF_DB), hbuf + OUT_HP, gt, ngt);
            } else if (k == 5) { MK_TID();
                if (li == 0) out_phase<false>(lds, big, (const bf16*)(ws + OFF_AB), (const bf16*)(ws + OFF_PSB), ob, ap->in[13], tid, wave, bid, G);
                else out_phase<true>(lds, big, (const bf16*)(ws + OFF_AB), (const bf16*)(ws + OFF_PSB), ob, ap->in[16], tid, wave, bid, G);
            } else { MK_TID();
                bf16* pp = (bf16*)(ws + OFF_BIG);
                { pg8::Gemm g{(const bf16*)(ws + OFF_PB + li * PB_SZ), (const bf16*)(ws + OFF_WPP + li * WPP_SZ), NPR, D, PLE};
                  pg8::StaticOrder S; S.init(NPR, D, G, bid); pg8::EpiStorePP E{pp};
                  pg8::gemm_phase<pg8::EpiStorePP, pg8::StaticOrder, true, true>(lds, g, S, E, tid); }
                { unsigned ones2_ = ~0u; asm volatile("" : "+s"(ones2_)); const int tid2 = wave * 64 + (int)__builtin_amdgcn_mbcnt_hi(ones2_, __builtin_amdgcn_mbcnt_lo(ones2_, 0u));
                  pg8::Gemm g{hb, (const bf16*)(ws + OFF_WPG + li * WSQ_SZ), NPR, D, D};
                  pg8::StaticOrder S; S.init(NPR, D, G, bid); pg8::EpiPle E{hb, ob, rs1, rs0, pp};
                  pg8::gemm_phase<pg8::EpiPle, pg8::StaticOrder, true, true>(lds, g, S, E, tid2); }
                { unsigned ones3_ = ~0u; asm volatile("" : "+s"(ones3_)); const int tid3 = wave * 64 + (int)__builtin_amdgcn_mbcnt_hi(ones3_, __builtin_amdgcn_mbcnt_lo(ones3_, 0u));
                  mini_gemm<1, D>(lds, hb, (const bf16*)(ws + OFF_WPG + li * WSQ_SZ), (const bf16*)(ws + OFF_PB + li * PB_SZ), (const bf16*)(ws + OFF_WPP + li * WPP_SZ), nullptr, hb, ob, rs1, rs0, 0.f, tid3, bid, G); }
            }
        }
#if PROBE_MODE
        if (ph_ + 1 < ph_hi || rep + 1 < nrep) grid.sync();
#else
        if (ph_ + 1 < ph_hi) {
            if (ph_lo < 0) grid.sync(); else xcd_barrier(xbar);
#if EXTRA_SYNCS
            for (int es = 0; es < EXTRA_SYNCS; ++es) xcd_barrier(xbar);
#endif
        }
#endif
      }
    }
#if PT_ON
    if (PT_T0) { const unsigned long long t0_ = ((unsigned long long)tsl[1] << 32) | tsl[0], t1_ = ((unsigned long long)tsl[3] << 32) | tsl[2], span_ = (t1_ - t0_) * PT_MUL;
        const unsigned long long s_ = __builtin_amdgcn_s_memrealtime(); while (__builtin_amdgcn_s_memrealtime() - s_ < span_) __builtin_amdgcn_s_sleep(8); }
#endif
}

extern "C" void kernel_launch(void* const* d_in, const int* in_sizes, int n_in, void* d_out, int out_size, void* d_ws, size_t ws_size, hipStream_t stream) {
    static int grid = 0;
    if (grid == 0) {
        if (n_in != 26 || (size_t)out_size != OUT_END || ws_size < WS_TOTAL) { fprintf(stderr, "kernel_launch: unexpected shapes (n_in %d out %d ws %zu need %zu); nothing launched\n", n_in, out_size, ws_size, (size_t)WS_TOTAL); grid = -1; return; }
        int dev = 0, cus = 0, per_cu = 0;
        if (hipGetDevice(&dev) != hipSuccess || hipDeviceGetAttribute(&cus, hipDeviceAttributeMultiprocessorCount, dev) != hipSuccess) { grid = -1; return; }
        if (hipFuncSetAttribute((const void*)fwd_kernel, hipFuncAttributeMaxDynamicSharedMemorySize, LDS_BYTES) != hipSuccess) { fprintf(stderr, "kernel_launch: hipFuncSetAttribute failed\n"); grid = -1; return; }
        if (hipOccupancyMaxActiveBlocksPerMultiprocessor(&per_cu, (const void*)fwd_kernel, NWAVES * 64, LDS_BYTES) != hipSuccess || per_cu < 1) per_cu = 1;
        (void)hipGetLastError();
        grid = cus * per_cu;
    }
    if (grid < 0) return;
    if (hipMemsetAsync((char*)d_ws + OFF_CTL, 0, CTL_BYTES, stream) != hipSuccess) { fprintf(stderr, "kernel_launch: memset of the barrier words failed\n"); return; }
    Args a{};
    for (int i = 0; i < 26; ++i) a.in[i] = (const float*)d_in[i];
    a.out = (float*)d_out; a.ws = (unsigned char*)d_ws;
#if MK_N_LAUNCHES == 1
    a.ph_lo = 0; a.ph_hi = NPH;
    void* args[] = {&a};
    hipError_t e = hipLaunchCooperativeKernel((const void*)fwd_kernel, dim3(grid), dim3(NWAVES * 64), args, LDS_BYTES, stream);
    if (e != hipSuccess) fprintf(stderr, "kernel_launch: cooperative launch failed: %s (grid %d)\n", hipGetErrorString(e), grid);
#else
    for (int ph = 0; ph < NPH; ++ph) { a.ph_lo = ph; a.ph_hi = ph + 1; hipLaunchKernelGGL(fwd_kernel, dim3(grid), dim3(NWAVES * 64), LDS_BYTES, stream, a); }
#endif
}
```

```cpp
#include <hip/hip_runtime.h>
#include <cstdio>
#include <cstdint>
#ifndef MK_N_LAUNCHES
#define MK_N_LAUNCHES 1
#endif
#ifndef PROBE_MODE
#define PROBE_MODE 0
#endif
#ifndef EXTRA_SYNCS
#define EXTRA_SYNCS 0
#endif
#ifndef PT_ON
#define PT_ON 0
#define PT_LO 14
#define PT_HI 14
#define PT_MUL 4
#endif
namespace pg8 {
#define PG8_LAS __attribute__((address_space(3)))
typedef unsigned short bf16_t;
typedef short bf16x8 __attribute__((ext_vector_type(8)));
typedef float f32x4 __attribute__((ext_vector_type(4)));
typedef unsigned u32x4 __attribute__((ext_vector_type(4)));
constexpr int BM = 256, BK = 64, HALF = 128, HTB = HALF * BK * 2  , STAGE_BYTES = 8 * HTB, NXCD = 8, WGM = 8;

__host__ __device__ __forceinline__ int lds_byte(int r, int c) { const int st = (r >> 4) * 2 + (c >> 5), rr = r & 15, cc = c & 31, ob = rr * 64 + cc * 2; return st * 1024 + (ob ^ (((ob >> 9) & 1) << 5)); }
__host__ __device__ __forceinline__ void stage_rc(int b, int& R, int& C) { const int st = b / 1024, sb = b % 1024, swz = sb ^ (((sb >> 9) & 1) << 5); R = (st >> 1) * 16 + swz / 64; C = (st & 1) * 32 + (swz % 64) / 2; }
__host__ __device__ __forceinline__ int perm32(int rho) { const int n = rho >> 4, i = rho & 15; return 8 * (i >> 2) + 4 * n + (i & 3); }

struct Unit { int pm, pn; };
struct Gemm { const bf16_t* A; const bf16_t* Bt; int M, N, K; };

struct StaticOrder {
    int nM, nN, nwg, G, c;
    __host__ __device__ void init(int M, int N, int G_, int c_) { nM = M / BM; nN = N / BM; nwg = nM * nN; G = G_; c = c_; }
    __host__ __device__ bool next(int i, Unit& u) const {
        const long L = (long)i * G + c; if (L >= nwg) return false;
        int wgid = (int)L; { const int q = nwg / NXCD, r = nwg % NXCD, xcd = wgid % NXCD, off = wgid / NXCD; wgid = (xcd < r ? xcd * (q + 1) : r * (q + 1) + (xcd - r) * q) + off; }
        const int nig = WGM * nN, gid = wgid / nig, fm = gid * WGM, gsz = (nM - fm) < WGM ? (nM - fm) : WGM;
        u.pm = fm + ((wgid % nig) % gsz); u.pn = (wgid % nig) / gsz; return true;
    }
    __device__ __forceinline__ void a_ready(const Unit&) const {}
    __device__ __forceinline__ void done(const Unit&) const {}
};

typedef float f32x2_ __attribute__((ext_vector_type(2))); typedef __bf16 bf16x2_ __attribute__((ext_vector_type(2)));
__device__ __forceinline__ unsigned cvt_pk_bf16(float lo, float hi) { const f32x2_ v = {lo, hi}; return __builtin_bit_cast(unsigned, __builtin_convertvector(v, bf16x2_)); }
typedef float f32x2 __attribute__((ext_vector_type(2)));
typedef unsigned u32x2 __attribute__((ext_vector_type(2)));
__device__ __forceinline__ float row_scale(const float* rs, int row) {
    const f32x4* p = (const f32x4*)(rs + (size_t)row * 16);
    const f32x4 a = p[0], b = p[1], c = p[2], d = p[3];
    const float s = ((a[0] + a[1]) + (a[2] + a[3])) + ((b[0] + b[1]) + (b[2] + b[3])) + ((c[0] + c[1]) + (c[2] + c[3])) + ((d[0] + d[1]) + (d[2] + d[3]));
    return rsqrtf(s * (1.0f / 1024.0f) + 1e-6f);
}
__device__ __forceinline__ void row_scales8(const float* rs, int row0, float (&sc)[2][4]) {
#pragma unroll
    for (int ai = 0; ai < 2; ++ai)
#pragma unroll
        for (int mh = 0; mh < 2; ++mh) { f32x4 p[2][4];
#pragma unroll
            for (int ml = 0; ml < 2; ++ml)
#pragma unroll
                for (int q = 0; q < 4; ++q) p[ml][q] = *(const f32x4*)(rs + (size_t)(row0 + ai * HALF + (2 * mh + ml) * 16) * 16 + 4 * q);
            __builtin_amdgcn_sched_barrier(0);
#pragma unroll
            for (int ml = 0; ml < 2; ++ml) { const f32x4 t = (p[ml][0] + p[ml][1]) + (p[ml][2] + p[ml][3]); sc[ai][2 * mh + ml] = rsqrtf(((t[0] + t[1]) + (t[2] + t[3])) * (1.0f / 1024.0f) + 1e-6f); }
            __builtin_amdgcn_sched_barrier(0); }
}
__device__ __forceinline__ float sigm(float x) { return __builtin_amdgcn_rcpf(1.0f + __expf(-x)); }
struct EpiSwiglu {
    static constexpr bool PERM = true, AFTER_DRAIN = false;
    bf16_t* O; int ldc; const float* rs;
    __device__ __forceinline__ void operator()(const f32x4 (&acc)[2][2][4][2], const Unit& u, int wr, int wc, int fr_, int fq_) const {
        unsigned on_ = ~0u; asm volatile("" : "+s"(on_)); const int ln_ = (int)__builtin_amdgcn_mbcnt_hi(on_, __builtin_amdgcn_mbcnt_lo(on_, 0u)), fr = ln_ & 15, fq = ln_ >> 4; (void)fr_; (void)fq_;
        const int row0 = u.pm * BM + wr * 64 + fr, col0 = u.pn * HALF + wc * 32 + 8 * fq;
        float sc[2][4]; row_scales8(rs, row0, sc);
#pragma unroll
        for (int ai = 0; ai < 2; ++ai)
#pragma unroll
            for (int m = 0; m < 4; ++m) { const int row = row0 + ai * HALF + m * 16; const float s = sc[ai][m];
                float o[8];
#pragma unroll
                for (int n = 0; n < 2; ++n)
#pragma unroll
                    for (int i = 0; i < 4; ++i) { const float g = acc[ai][0][m][n][i] * s, up = acc[ai][1][m][n][i] * s; o[n * 4 + i] = g * sigm(g) * up; }
                u32x4 w; w.x = cvt_pk_bf16(o[0], o[1]); w.y = cvt_pk_bf16(o[2], o[3]); w.z = cvt_pk_bf16(o[4], o[5]); w.w = cvt_pk_bf16(o[6], o[7]);
                *(u32x4*)(O + (size_t)row * ldc + col0) = w; }
    }
};
struct EpiZ {
    static constexpr bool PERM = true, AFTER_DRAIN = false;
    bf16_t* Z; int ldz; const float* rs; float* R; int r_tile;
    __device__ __forceinline__ void operator()(const f32x4 (&acc)[2][2][4][2], const Unit& u, int wr, int wc, int fr_, int fq_) const {
        unsigned on_ = ~0u; asm volatile("" : "+s"(on_)); const int ln_ = (int)__builtin_amdgcn_mbcnt_hi(on_, __builtin_amdgcn_mbcnt_lo(on_, 0u)), fr = ln_ & 15, fq = ln_ >> 4; (void)fr_; (void)fq_;
        const int row0 = u.pm * BM + wr * 64 + fr, col0 = u.pn * BM + wc * 32 + 8 * fq;
        if (u.pn == r_tile) {
            if (wc == 0 && fq < 2) {
#pragma unroll
                for (int ai = 0; ai < 2; ++ai)
#pragma unroll
                    for (int m = 0; m < 4; ++m) { const int row = row0 + ai * HALF + m * 16; const float s = row_scale(rs, row);
#pragma unroll
                        for (int n = 0; n < 2; ++n) *(f32x4*)(R + (size_t)row * 16 + 8 * fq + 4 * n) = acc[ai][0][m][n] * s; }
            }
            return;
        }
        float sc[2][4]; row_scales8(rs, row0, sc);
#pragma unroll
        for (int ai = 0; ai < 2; ++ai)
#pragma unroll
            for (int m = 0; m < 4; ++m) { const int row = row0 + ai * HALF + m * 16; const float s = sc[ai][m];
#pragma unroll
                for (int bj = 0; bj < 2; ++bj) { const f32x4 v0 = acc[ai][bj][m][0] * s, v1 = acc[ai][bj][m][1] * s;
                    u32x4 w; w.x = cvt_pk_bf16(v0[0], v0[1]); w.y = cvt_pk_bf16(v0[2], v0[3]); w.z = cvt_pk_bf16(v1[0], v1[1]); w.w = cvt_pk_bf16(v1[2], v1[3]);
                    *(u32x4*)(Z + (size_t)row * ldz + col0 + bj * HALF) = w; } }
    }
};
struct EpiResid {
    static constexpr bool PERM = true, AFTER_DRAIN = false;
    const float* xin; bf16_t* hb; float* rs_out; float alpha;
    __device__ __forceinline__ void operator()(const f32x4 (&acc)[2][2][4][2], const Unit& u, int wr, int wc, int fr_, int fq_) const {
        unsigned on_ = ~0u; asm volatile("" : "+s"(on_)); const int ln_ = (int)__builtin_amdgcn_mbcnt_hi(on_, __builtin_amdgcn_mbcnt_lo(on_, 0u)), fr = ln_ & 15, fq = ln_ >> 4; (void)fr_; (void)fq_;
        const int row0 = u.pm * BM + wr * 64 + fr, col0 = u.pn * BM + wc * 32 + 8 * fq;
#pragma unroll
        for (int ai = 0; ai < 2; ++ai)
#pragma unroll
            for (int mh = 0; mh < 2; ++mh) { f32x4 hv[2][2][2];
                if (xin) {
#pragma unroll
                    for (int ml = 0; ml < 2; ++ml)
#pragma unroll
                        for (int bj = 0; bj < 2; ++bj)
#pragma unroll
                            for (int n = 0; n < 2; ++n) hv[ml][bj][n] = *(const f32x4*)(xin + (size_t)(row0 + ai * HALF + (2 * mh + ml) * 16) * 1024 + col0 + bj * HALF + 4 * n);
                } else { u32x4 hw[2][2];
#pragma unroll
                    for (int ml = 0; ml < 2; ++ml)
#pragma unroll
                        for (int bj = 0; bj < 2; ++bj) hw[ml][bj] = *(const u32x4*)(hb + (size_t)(row0 + ai * HALF + (2 * mh + ml) * 16) * 1024 + col0 + bj * HALF);
#pragma unroll
                    for (int ml = 0; ml < 2; ++ml)
#pragma unroll
                        for (int bj = 0; bj < 2; ++bj) { const u32x4 x = hw[ml][bj];
                            hv[ml][bj][0] = (f32x4){__uint_as_float(x.x << 16), __uint_as_float(x.x & 0xffff0000u), __uint_as_float(x.y << 16), __uint_as_float(x.y & 0xffff0000u)};
                            hv[ml][bj][1] = (f32x4){__uint_as_float(x.z << 16), __uint_as_float(x.z & 0xffff0000u), __uint_as_float(x.w << 16), __uint_as_float(x.w & 0xffff0000u)}; } }
                __builtin_amdgcn_sched_barrier(0);
#pragma unroll
                for (int ml = 0; ml < 2; ++ml) { const int m = 2 * mh + ml, row = row0 + ai * HALF + m * 16; float ss = 0.f;
#pragma unroll
                    for (int bj = 0; bj < 2; ++bj) { const f32x4 o0 = hv[ml][bj][0] + acc[ai][bj][m][0] * alpha, o1 = hv[ml][bj][1] + acc[ai][bj][m][1] * alpha;
                        ss += ((o0[0] * o0[0] + o0[1] * o0[1]) + (o0[2] * o0[2] + o0[3] * o0[3])) + ((o1[0] * o1[0] + o1[1] * o1[1]) + (o1[2] * o1[2] + o1[3] * o1[3]));
                        u32x4 w; w.x = cvt_pk_bf16(o0[0], o0[1]); w.y = cvt_pk_bf16(o0[2], o0[3]); w.z = cvt_pk_bf16(o1[0], o1[1]); w.w = cvt_pk_bf16(o1[2], o1[3]);
                        *(u32x4*)(hb + (size_t)row * 1024 + col0 + bj * HALF) = w; }
                    ss += __builtin_bit_cast(float, __builtin_amdgcn_ds_bpermute((ln_ ^ 16) << 2, __builtin_bit_cast(int, ss))); ss += __builtin_bit_cast(float, __builtin_amdgcn_ds_bpermute((ln_ ^ 32) << 2, __builtin_bit_cast(int, ss)));
                    if (fq == 0) rs_out[(size_t)row * 16 + u.pn * 4 + wc] = ss; }
                __builtin_amdgcn_sched_barrier(0); }
    }
};
struct EpiStorePP {
    static constexpr bool PERM = false, AFTER_DRAIN = false;
    bf16_t* O;
    __device__ __forceinline__ void operator()(const f32x4 (&acc)[2][2][4][2], const Unit& u, int wr, int wc, int fr_, int fq_) const {
        unsigned on_ = ~0u; asm volatile("" : "+s"(on_)); const int ln_ = (int)__builtin_amdgcn_mbcnt_hi(on_, __builtin_amdgcn_mbcnt_lo(on_, 0u)), fr = ln_ & 15, fq = ln_ >> 4; (void)fr_; (void)fq_;
        const int row0 = u.pm * BM + wr * 64 + fr, col0 = u.pn * BM + wc * 32 + 4 * fq;
#pragma unroll
        for (int ai = 0; ai < 2; ++ai)
#pragma unroll
            for (int m = 0; m < 4; ++m)
#pragma unroll
                for (int bj = 0; bj < 2; ++bj)
#pragma unroll
                    for (int n = 0; n < 2; ++n) { const f32x4 v = acc[ai][bj][m][n]; u32x2 w; w.x = cvt_pk_bf16(v[0], v[1]); w.y = cvt_pk_bf16(v[2], v[3]);
                        *(u32x2*)(O + (size_t)(row0 + ai * HALF + m * 16) * 1024 + col0 + bj * HALF + n * 16) = w; }
    }
};
struct EpiPle {
    static constexpr bool PERM = false, AFTER_DRAIN = false;
    const bf16_t* hbin; bf16_t* hb; const float* rs_in; float* rs_out; const bf16_t* pp;
    __device__ __forceinline__ void operator()(const f32x4 (&acc)[2][2][4][2], const Unit& u, int wr, int wc, int fr_, int fq_) const {
        unsigned on_ = ~0u; asm volatile("" : "+s"(on_)); const int ln_ = (int)__builtin_amdgcn_mbcnt_hi(on_, __builtin_amdgcn_mbcnt_lo(on_, 0u)), fr = ln_ & 15, fq = ln_ >> 4; (void)fr_; (void)fq_;
        const int row0 = u.pm * BM + wr * 64 + fr, col0 = u.pn * BM + wc * 32 + 4 * fq;
#pragma unroll
        for (int ai = 0; ai < 2; ++ai)
#pragma unroll
            for (int m = 0; m < 4; ++m) { const int row = row0 + ai * HALF + m * 16; const float s = row_scale(rs_in, row); float ss = 0.f;
#pragma unroll
                for (int bj = 0; bj < 2; ++bj)
#pragma unroll
                    for (int n = 0; n < 2; ++n) { const size_t off = (size_t)row * 1024 + col0 + bj * HALF + n * 16;
                        const u32x2 pw = *(const u32x2*)(pp + off); const f32x4 a = acc[ai][bj][m][n] * s, p = {__uint_as_float(pw.x << 16), __uint_as_float(pw.x & 0xffff0000u), __uint_as_float(pw.y << 16), __uint_as_float(pw.y & 0xffff0000u)}; const u32x2 hx = *(const u32x2*)(hbin + off); f32x4 o = {__uint_as_float(hx.x << 16), __uint_as_float(hx.x & 0xffff0000u), __uint_as_float(hx.y << 16), __uint_as_float(hx.y & 0xffff0000u)};
                        o[0] += sigm(a[0]) * p[0]; o[1] += sigm(a[1]) * p[1]; o[2] += sigm(a[2]) * p[2]; o[3] += sigm(a[3]) * p[3];
                        ss += (o[0] * o[0] + o[1] * o[1]) + (o[2] * o[2] + o[3] * o[3]);
                        u32x2 w; w.x = cvt_pk_bf16(o[0], o[1]); w.y = cvt_pk_bf16(o[2], o[3]); *(u32x2*)(hb + off) = w; }
                ss += __builtin_bit_cast(float, __builtin_amdgcn_ds_bpermute((ln_ ^ 16) << 2, __builtin_bit_cast(int, ss))); ss += __builtin_bit_cast(float, __builtin_amdgcn_ds_bpermute((ln_ ^ 32) << 2, __builtin_bit_cast(int, ss)));
                if (fq == 0) rs_out[(size_t)row * 16 + u.pn * 4 + wc] = ss; }
    }
};
template <class Epi, class Sched, bool ALIGN_EPI = false, bool SP2 = false>
__device__ __forceinline__ void gemm_phase(PG8_LAS unsigned char* lds, const Gemm g, const Sched& S, const Epi& E, const int tid) {
    const int wid = __builtin_amdgcn_readfirstlane(tid >> 6), lane = tid & 63, wr = wid >> 2, wc = wid & 3, fr = lane & 15, fq = lane >> 4;
    const int K = g.K, nt = K / BK;
    unsigned voffA[2], voffB[2];
#pragma unroll
    for (int i = 0; i < 2; ++i) { int R, C; stage_rc(tid * 16 + i * 8192, R, C); const int Rb = Epi::PERM ? ((R & ~31) + perm32(R & 31)) : R;
        voffA[i] = (unsigned)(R * K + C) * 2u; voffB[i] = (unsigned)(Rb * K + C) * 2u; }
    const size_t kstep = (size_t)(BK * 2);
    const size_t hstep = (size_t)HALF * K * 2;
    const size_t tstep = 2 * hstep;
    const unsigned ldsw = (unsigned)wid * 1024u;
    const int aoff = lds_byte(wr * 64 + fr, fq * 8), boff = lds_byte(wc * 32 + fr, fq * 8);
#define PG8_SA(b, h) (((b) * 2 + (h)) * HTB)
#define PG8_SB(b, h) ((4 + (b) * 2 + (h)) * HTB)
#define PG8_STAGE(bufoff, gbase, voff) do { _Pragma("unroll") for (int _i = 0; _i < 2; ++_i) \
        __builtin_amdgcn_global_load_lds((const unsigned*)((const char*)(gbase) + (voff)[_i]), (PG8_LAS unsigned*)(lds + (bufoff) + ldsw + _i * 8192), 16, 0, 0); } while (0)
#define PG8_LDA(dst, b, h) do { _Pragma("unroll") for (int m = 0; m < 4; ++m) _Pragma("unroll") for (int k = 0; k < 2; ++k) dst[m][k] = *(const PG8_LAS bf16x8*)(lds + PG8_SA(b, h) + aoff + m * 2048 + k * 1024); } while (0)
#define PG8_LDB(dst, b, h) do { _Pragma("unroll") for (int n = 0; n < 2; ++n) _Pragma("unroll") for (int k = 0; k < 2; ++k) dst[n][k] = *(const PG8_LAS bf16x8*)(lds + PG8_SB(b, h) + boff + n * 2048 + k * 1024); } while (0)
#define PG8_MMA(ai, bj, At, Bt) do { __builtin_amdgcn_s_setprio(1); _Pragma("unroll") for (int m = 0; m < 4; ++m) _Pragma("unroll") for (int n = 0; n < 2; ++n) _Pragma("unroll") for (int k = 0; k < 2; ++k) \
        acc[ai][bj][m][n] = __builtin_amdgcn_mfma_f32_16x16x32_bf16(Bt[n][k], At[m][k], acc[ai][bj][m][n], 0, 0, 0); __builtin_amdgcn_s_setprio(0); } while (0)
#define PG8_WAIT_V(n) asm volatile("s_waitcnt vmcnt(" #n ")" ::: "memory")
#define PG8_WAIT_L(n) asm volatile("s_waitcnt lgkmcnt(" #n ")" ::: "memory")
#define PG8_BAR __builtin_amdgcn_s_barrier()
#define PG8_SCHED __builtin_amdgcn_sched_barrier(0)
    Unit cur, nxt; int ui = 0;
    if (!S.next(0, cur)) return;
    f32x4 acc[2][2][4][2];
#pragma unroll
    for (int a = 0; a < 2; ++a)
#pragma unroll
        for (int b = 0; b < 2; ++b)
#pragma unroll
            for (int m = 0; m < 4; ++m)
#pragma unroll
                for (int n = 0; n < 2; ++n) acc[a][b][m][n] = (f32x4){0.f, 0.f, 0.f, 0.f};
    bf16x8 At[4][2], B0[2][2], B1[2][2];
    const char* cA = (const char*)g.A + (size_t)cur.pm * tstep; const char* cB = (const char*)g.Bt + (size_t)cur.pn * tstep;
    S.a_ready(cur);
    if constexpr (SP2) {
        PG8_STAGE(PG8_SB(0, 0), cB, voffB); PG8_STAGE(PG8_SB(0, 1), cB + hstep, voffB); PG8_STAGE(PG8_SA(0, 0), cA, voffA); PG8_STAGE(PG8_SA(0, 1), cA + hstep, voffA);
        if (wr == 1) PG8_BAR;
        PG8_WAIT_V(2); PG8_BAR;
        PG8_STAGE(PG8_SB(1, 0), cB + kstep, voffB); PG8_STAGE(PG8_SA(1, 0), cA + kstep, voffA); PG8_STAGE(PG8_SB(1, 1), cB + hstep + kstep, voffB);
        PG8_WAIT_V(6); PG8_BAR;
    } else {
        PG8_STAGE(PG8_SB(0, 0), cB, voffB); PG8_STAGE(PG8_SA(0, 0), cA, voffA); PG8_STAGE(PG8_SB(0, 1), cB + hstep, voffB); PG8_STAGE(PG8_SA(0, 1), cA + hstep, voffA);
        if (wr == 1) PG8_BAR;
        PG8_WAIT_V(4); PG8_BAR;
        PG8_STAGE(PG8_SB(1, 0), cB + kstep, voffB); PG8_STAGE(PG8_SA(1, 0), cA + kstep, voffA); PG8_STAGE(PG8_SB(1, 1), cB + hstep + kstep, voffB);
        PG8_WAIT_V(6); PG8_BAR;
    }
    for (;;) {
        const bool has_next = S.next(ui + 1, nxt);
        const char* nA = has_next ? (const char*)g.A + (size_t)nxt.pm * tstep : cA; const char* nB = has_next ? (const char*)g.Bt + (size_t)nxt.pn * tstep : cB;
        for (int t = 0; t < nt; t += 2) {
            const bool last = (t == nt - 2);
            const char* a1 = cA + (size_t)(t + 1) * kstep;
            const char* a2 = last ? nA : cA + (size_t)(t + 2) * kstep; const char* b2 = last ? nB : cB + (size_t)(t + 2) * kstep;
            const char* a3 = a2 + kstep; const char* b3 = b2 + kstep;
            if (last && has_next) S.a_ready(nxt);
            if constexpr (SP2) {
            PG8_LDB(B0, 0, 0); PG8_LDB(B1, 0, 1); PG8_SCHED; PG8_LDA(At, 0, 0); PG8_STAGE(PG8_SA(1, 1), a1 + hstep, voffA);
            PG8_WAIT_V(8); PG8_WAIT_L(0); PG8_BAR; PG8_MMA(0, 0, At, B0); PG8_MMA(0, 1, At, B1); PG8_BAR; PG8_SCHED;
            PG8_LDA(At, 0, 1); PG8_STAGE(PG8_SB(0, 0), b2, voffB); PG8_STAGE(PG8_SB(0, 1), b2 + hstep, voffB); PG8_STAGE(PG8_SA(0, 0), a2, voffA);
            PG8_WAIT_V(8); PG8_WAIT_L(0); PG8_BAR; PG8_MMA(1, 0, At, B0); PG8_MMA(1, 1, At, B1); PG8_BAR; PG8_SCHED;
            PG8_LDB(B0, 1, 0); PG8_LDB(B1, 1, 1); PG8_SCHED; PG8_LDA(At, 1, 0); PG8_STAGE(PG8_SA(0, 1), a2 + hstep, voffA);
            PG8_WAIT_V(8); PG8_WAIT_L(0); PG8_BAR; PG8_MMA(0, 0, At, B0); PG8_MMA(0, 1, At, B1); PG8_BAR; PG8_SCHED;
            PG8_LDA(At, 1, 1); PG8_STAGE(PG8_SB(1, 0), b3, voffB); PG8_STAGE(PG8_SB(1, 1), b3 + hstep, voffB); PG8_STAGE(PG8_SA(1, 0), a3, voffA);
            PG8_WAIT_V(8); PG8_WAIT_L(0); PG8_BAR; PG8_MMA(1, 0, At, B0); PG8_MMA(1, 1, At, B1); PG8_BAR; PG8_SCHED;
            } else {
            PG8_LDB(B0, 0, 0); PG8_SCHED; PG8_LDA(At, 0, 0); PG8_STAGE(PG8_SA(1, 1), a1 + hstep, voffA);
            PG8_WAIT_L(8); PG8_BAR; PG8_WAIT_L(0); PG8_MMA(0, 0, At, B0); PG8_BAR; PG8_SCHED;
            PG8_LDB(B1, 0, 1); PG8_STAGE(PG8_SB(0, 0), b2, voffB);
            PG8_BAR; PG8_WAIT_L(0); PG8_MMA(0, 1, At, B1); PG8_BAR;
            PG8_LDA(At, 0, 1); PG8_STAGE(PG8_SA(0, 0), a2, voffA);
            PG8_BAR; PG8_WAIT_L(0); PG8_MMA(1, 0, At, B0); PG8_BAR; PG8_SCHED;
            PG8_STAGE(PG8_SB(0, 1), b2 + hstep, voffB);
            PG8_WAIT_V(6); PG8_BAR; PG8_MMA(1, 1, At, B1); PG8_BAR;
            PG8_LDB(B0, 1, 0); PG8_SCHED; PG8_LDA(At, 1, 0); PG8_STAGE(PG8_SA(0, 1), a2 + hstep, voffA);
            PG8_WAIT_L(8); PG8_BAR; PG8_WAIT_L(0); PG8_MMA(0, 0, At, B0); PG8_BAR; PG8_SCHED;
            PG8_LDB(B1, 1, 1); PG8_STAGE(PG8_SB(1, 0), b3, voffB);
            PG8_BAR; PG8_WAIT_L(0); PG8_MMA(0, 1, At, B1); PG8_BAR;
            PG8_LDA(At, 1, 1); PG8_STAGE(PG8_SA(1, 0), a3, voffA);
            PG8_BAR; PG8_WAIT_L(0); PG8_MMA(1, 0, At, B0); PG8_BAR; PG8_SCHED;
            PG8_STAGE(PG8_SB(1, 1), b3 + hstep, voffB);
            PG8_WAIT_V(6); PG8_BAR; PG8_MMA(1, 1, At, B1); PG8_BAR;
            }
        }
        if constexpr (ALIGN_EPI) { if (wr == 0) PG8_BAR; }
        if constexpr (!Epi::AFTER_DRAIN) { E(acc, cur, wr, wc, fr, fq); S.done(cur); }
        if (!has_next) break;
#pragma unroll
        for (int a = 0; a < 2; ++a)
#pragma unroll
            for (int b = 0; b < 2; ++b)
#pragma unroll
                for (int m = 0; m < 4; ++m)
#pragma unroll
                    for (int n = 0; n < 2; ++n) acc[a][b][m][n] = (f32x4){0.f, 0.f, 0.f, 0.f};
        cur = nxt; cA = nA; cB = nB; ++ui;
        if constexpr (ALIGN_EPI) { if (wr == 1) PG8_BAR; }
    }
    PG8_WAIT_V(0);
    if constexpr (!ALIGN_EPI) { if (wr == 0) PG8_BAR; }
    PG8_BAR;
    if constexpr (Epi::AFTER_DRAIN) { E.fused(acc, cur, wr, wc, fr, fq, lds, wid, lane); S.done(cur); }
#undef PG8_SA
#undef PG8_SB
#undef PG8_STAGE
#undef PG8_LDA
#undef PG8_LDB
#undef PG8_MMA
#undef PG8_WAIT_V
#undef PG8_WAIT_L
#undef PG8_BAR
#undef PG8_SCHED
}
}
#include <hip/hip_cooperative_groups.h>
namespace cg = cooperative_groups;
#define LAS __attribute__((address_space(3)))
typedef unsigned short bf16;
typedef float f32x4 __attribute__((ext_vector_type(4)));
typedef short bf16x8 __attribute__((ext_vector_type(8)));
typedef unsigned v4u __attribute__((ext_vector_type(4)));
typedef unsigned v2u __attribute__((ext_vector_type(2)));
constexpr int D = 1024, NPR = 16384, NSM = 512, M = NPR + NSM, SEQ = 2048, NB = 8, DB = 128, FF = 2816, PLE = 256, NCH = 32;
constexpr int NWAVES = 8, LDS_BYTES = 147456, NPH = 22;
constexpr size_t WGU_SZ = (size_t)5632 * 1024 * 2, WDN_SZ = (size_t)1024 * 2816 * 2, WSQ_SZ = (size_t)1024 * 1024 * 2, WPP_SZ = (size_t)1024 * 256 * 2;
constexpr size_t OFF_WGU = 0, OFF_WDN = OFF_WGU + 4 * WGU_SZ, OFF_WGIN = OFF_WDN + 4 * WDN_SZ, OFF_WHIN = OFF_WGIN + (size_t)3328 * 1024 * 2,
    OFF_WOUT = OFF_WHIN + (size_t)4096 * 1024 * 2, OFF_WPG = OFF_WOUT + 2 * WSQ_SZ, OFF_WPP = OFF_WPG + 2 * WSQ_SZ, OFF_HB = OFF_WPP + 2 * WPP_SZ;
constexpr size_t HB_SZ = (size_t)M * 1024 * 2;
constexpr size_t OFF_BIG = OFF_HB + 2 * HB_SZ, OFF_PB = OFF_BIG + (size_t)M * 4096 * 2, PB_SZ = (size_t)M * 256 * 2, OFF_AB = OFF_PB + 2 * PB_SZ,
    OFF_DB = OFF_AB + (size_t)2048 * 4096 * 2, OFF_RS = OFF_DB + (size_t)2048 * 128 * 4, RS_SZ = (size_t)M * 16 * 4, OFF_R = OFF_RS + 2 * RS_SZ, OFF_PSB = OFF_R + RS_SZ, OFF_PP = OFF_PSB  , WS_END = OFF_PSB + (size_t)67108864, OFF_LBT = WS_END, OFF_CTL = OFF_LBT + 16384, CTL_BYTES = 16384, WS_TOTAL = OFF_CTL + CTL_BYTES;
constexpr size_t OUT_YS = (size_t)NPR * D, OUT_GP = (size_t)M * D, OUT_GS = OUT_GP + 1048576, OUT_HP = OUT_GS + 16777216, OUT_HS = OUT_HP + 1048576, OUT_END = OUT_HS + 16777216;

__device__ __forceinline__ float bf2f(unsigned short u) { return __uint_as_float((unsigned)u << 16); }
__device__ __forceinline__ float bflo(unsigned u) { return __uint_as_float(u << 16); }
__device__ __forceinline__ float bfhi(unsigned u) { return __uint_as_float(u & 0xffff0000u); }
__device__ __forceinline__ unsigned pk2(float lo, float hi) { return pg8::cvt_pk_bf16(lo, hi); }
__device__ __forceinline__ float sigm(float x) { return __builtin_amdgcn_rcpf(1.0f + __expf(-x)); }
__device__ __forceinline__ float logsig(float x) { return fminf(x, 0.f) - __logf(1.0f + __expf(-fabsf(x))); }
__device__ __forceinline__ float wave_sum(float v) {
#pragma unroll
    for (int o = 1; o < 64; o <<= 1) v += __shfl_xor(v, o);
    return v;
}
#define LDS_WAIT() asm volatile("s_waitcnt lgkmcnt(0)" ::: "memory")
#define BAR_LDS() do { asm volatile("s_waitcnt lgkmcnt(0)" ::: "memory"); __builtin_amdgcn_s_barrier(); asm volatile("" ::: "memory"); } while (0)

__device__ __forceinline__ void tr_item(const float* W, int Nsrc, int K, bf16* WT, const float* sk, int item, int nblk, int mode, int nvalid, LAS float* scr, int lane) {
    const int kb = item / nblk, nb = item % nblk, k0 = 64 * kb, n0 = 64 * nb;
    int src0 = n0, valid = 64;
    if (mode == 1) { const int pn = n0 >> 8, within = n0 & 255, half = within >> 7, j = within & 127; src0 = half * FF + 128 * pn + j; }
    if (mode == 2) { valid = nvalid - n0; valid = valid < 0 ? 0 : (valid > 64 ? 64 : valid); }
    const int c4 = (lane & 15) * 4, kr = lane >> 4;
    const float* wp = W + (size_t)(k0 + kr) * Nsrc + src0 + c4;
    f32x4 v[16];
#pragma unroll
    for (int i = 0; i < 16; ++i) v[i] = (c4 < valid) ? __builtin_nontemporal_load((const f32x4*)(wp + (size_t)(4 * i) * Nsrc)) : (f32x4){0.f, 0.f, 0.f, 0.f};
    __builtin_amdgcn_sched_barrier(0);
#pragma unroll
    for (int i = 0; i < 16; ++i) { const int kk = 4 * i + kr; const float s = sk ? sk[k0 + kk] : 1.0f; LAS float* d = scr + kk * 65 + c4; d[0] = v[i][0] * s; d[1] = v[i][1] * s; d[2] = v[i][2] * s; d[3] = v[i][3] * s; }
    LDS_WAIT();
    const int ch = lane & 7;
#pragma unroll
    for (int j = 0; j < 8; ++j) { const int n = (lane >> 3) + 8 * j; const LAS float* s = scr + (8 * ch) * 65 + n;
        v4u o; o.x = pk2(s[0 * 65], s[1 * 65]); o.y = pk2(s[2 * 65], s[3 * 65]); o.z = pk2(s[4 * 65], s[5 * 65]); o.w = pk2(s[6 * 65], s[7 * 65]);
        *(v4u*)(WT + (size_t)(n0 + n) * K + k0 + 8 * ch) = o; }
    LDS_WAIT();
}
struct Args { const float* in[26]; float* out; unsigned char* ws; int ph_lo, ph_hi; };
typedef const Args __attribute__((address_space(4))) CArgs;

__device__ __forceinline__ void prologue(CArgs* a, unsigned char* ws, float* outp, LAS unsigned char* lds, int tid, int bid, int G) {
    const int lane = tid & 63, wave = tid >> 6;
    LAS float* scr = (LAS float*)(lds + wave * 16640);
    const int gw = bid * NWAVES + wave, NGW = G * NWAVES;
    constexpr int I_GU = 16 * 88, I_DN = 44 * 16, I_GIN = 16 * 52, I_HIN = 16 * 64, I_SQ = 16 * 16, I_PP = 4 * 16;
    constexpr int NITEMS = 4 * I_GU + 4 * I_DN + I_GIN + I_HIN + 4 * I_SQ + 2 * I_PP;
    for (int it = gw; it < NITEMS; it += NGW) {
        int r = it;
        if (r < 4 * I_GU) { const int q = r / I_GU, li = q >> 1, f = q & 1; r -= q * I_GU;
            tr_item((f ? a->in[20] : a->in[7]) + (size_t)li * 1024 * 5632, 5632, 1024, (bf16*)(ws + OFF_WGU + q * WGU_SZ), (f ? a->in[19] : a->in[6]) + li * 1024, r, 88, 1, 0, scr, lane); continue; }
        r -= 4 * I_GU;
        if (r < 4 * I_DN) { const int q = r / I_DN, li = q >> 1, f = q & 1; r -= q * I_DN;
            tr_item((f ? a->in[21] : a->in[8]) + (size_t)li * 2816 * 1024, 1024, 2816, (bf16*)(ws + OFF_WDN + q * WDN_SZ), nullptr, r, 16, 0, 0, scr, lane); continue; }
        r -= 4 * I_DN;
        if (r < I_GIN) { tr_item(a->in[10], 3088, 1024, (bf16*)(ws + OFF_WGIN), a->in[9], r, 52, 2, 3088, scr, lane); continue; }
        r -= I_GIN;
        if (r < I_HIN) { tr_item(a->in[15], 4096, 1024, (bf16*)(ws + OFF_WHIN), a->in[9] + 1024, r, 64, 0, 0, scr, lane); continue; }
        r -= I_HIN;
        if (r < I_SQ) { tr_item(a->in[14], 1024, 1024, (bf16*)(ws + OFF_WOUT), nullptr, r, 16, 0, 0, scr, lane); continue; }
        r -= I_SQ;
        if (r < I_SQ) { tr_item(a->in[17], 1024, 1024, (bf16*)(ws + OFF_WOUT + WSQ_SZ), nullptr, r, 16, 0, 0, scr, lane); continue; }
        r -= I_SQ;
        if (r < 2 * I_SQ) { const int li = r / I_SQ; r -= li * I_SQ;
            tr_item(a->in[23] + (size_t)li * 1024 * 1024, 1024, 1024, (bf16*)(ws + OFF_WPG + li * WSQ_SZ), a->in[22] + li * 1024, r, 16, 0, 0, scr, lane); continue; }
        r -= 2 * I_SQ;
        { const int li = r / I_PP; r -= li * I_PP;
            tr_item(a->in[24] + (size_t)li * 256 * 1024, 1024, 256, (bf16*)(ws + OFF_WPP + li * WPP_SZ), nullptr, r, 16, 0, 0, scr, lane); }
    }
    bf16* hb = (bf16*)(ws + OFF_HB); float* rs = (float*)(ws + OFF_RS);
    for (int m0 = gw; m0 < M; m0 += 2 * NGW) {
        const int m1 = m0 + NGW; const bool has1 = m1 < M;
        const float* xr0 = m0 < NPR ? a->in[0] + (size_t)m0 * D : a->in[1] + (size_t)(m0 - NPR) * D;
        const float* xr1 = !has1 ? xr0 : (m1 < NPR ? a->in[0] + (size_t)m1 * D : a->in[1] + (size_t)(m1 - NPR) * D);
        f32x4 v0[4], v1[4];
#pragma unroll
        for (int j = 0; j < 4; ++j) { v0[j] = __builtin_nontemporal_load((const f32x4*)xr0 + lane + 64 * j); v1[j] = __builtin_nontemporal_load((const f32x4*)xr1 + lane + 64 * j); }
        float s0 = 0.f, s1 = 0.f;
#pragma unroll
        for (int j = 0; j < 4; ++j) { s0 += (v0[j][0] * v0[j][0] + v0[j][1] * v0[j][1]) + (v0[j][2] * v0[j][2] + v0[j][3] * v0[j][3]); s1 += (v1[j][0] * v1[j][0] + v1[j][1] * v1[j][1]) + (v1[j][2] * v1[j][2] + v1[j][3] * v1[j][3]);
            v2u w; w.x = pk2(v0[j][0], v0[j][1]); w.y = pk2(v0[j][2], v0[j][3]); *((v2u*)(hb + (size_t)m0 * D) + lane + 64 * j) = w;
            if (has1) { v2u w1; w1.x = pk2(v1[j][0], v1[j][1]); w1.y = pk2(v1[j][2], v1[j][3]); *((v2u*)(hb + (size_t)m1 * D) + lane + 64 * j) = w1; } }
        s0 = wave_sum(s0); s1 = wave_sum(s1);
        if (lane < 16) { rs[(size_t)m0 * 16 + lane] = lane == 0 ? s0 : 0.f; if (has1) rs[(size_t)m1 * 16 + lane] = lane == 0 ? s1 : 0.f; }
    }
    { const int gt0 = bid * (NWAVES * 64) + tid; if (gt0 < 1024) { const float x0 = a->in[18][gt0], x1 = a->in[18][1024 + gt0];
        *(f32x4*)((float*)(ws + OFF_LBT) + 4 * gt0) = (f32x4){logsig(x1 - x0), logsig(x0 - x1), sigm(x0 - x1), 0.f}; } }
    const int gt = bid * (NWAVES * 64) + tid, NGT = G * NWAVES * 64;
    for (int e = gt; e < 2 * M * 32; e += NGT) { const int li = e / (M * 32), rem = e % (M * 32), m = rem >> 5, c8 = (rem & 31) * 8;
        const float* src = m < NPR ? a->in[4] + ((size_t)li * NPR + m) * 256 + c8 : a->in[5] + ((size_t)li * NSM + (m - NPR)) * 256 + c8;
        const f32x4 v0 = __builtin_nontemporal_load((const f32x4*)src), v1 = __builtin_nontemporal_load((const f32x4*)(src + 4));
        v4u w; w.x = pk2(v0[0], v0[1]); w.y = pk2(v0[2], v0[3]); w.z = pk2(v1[0], v1[1]); w.w = pk2(v1[2], v1[3]);
        *(v4u*)((bf16*)(ws + OFF_PB + li * PB_SZ) + (size_t)m * 256 + c8) = w; }
}
template <bool HG> struct MX {
    static constexpr int H = HG ? 8 : 4, DV = HG ? 128 : 256, LDZ = HG ? 4096 : 3328, KC = HG ? 1024 : 512, VC = HG ? 2048 : 1024, GC = HG ? 3072 : 2048, VR = DV / 64, NVG = DV / 16, NVR = DV / 64;
    static constexpr float scale = HG ? 1.0f : 0.08838834764831845f;
};
template <bool HG> __device__ __forceinline__ void prep_phase(LAS unsigned char* lds, bf16* Z, const float* R, const float* wup, const float* bgk, const float* lbt, bf16* AB, float* DBUF, bf16* PB, int tid, int bid, int G) {
    typedef MX<HG> C; constexpr int H = C::H, DV = C::DV, LDZ = C::LDZ, KC = C::KC, VC = C::VC, VR = C::VR, QP = 136, TP = 72, NG = DV / 128, NGV = DV / 16;
    LAS float* gl = (LAS float*)lds; LAS float* segs = (LAS float*)(lds + 32768);
    LAS bf16* qe_s = (LAS bf16*)(lds + 34816); LAS bf16* kn_s = (LAS bf16*)(lds + 52224); LAS bf16* kdT_s = (LAS bf16*)(lds + 69632); LAS bf16* vT_s = (LAS bf16*)(lds + 88064);
    const int t = tid >> 3, cs = tid & 7, j0 = cs * 16, lane = tid & 63, w = tid >> 6;
    const int tsw = (((t >> 3) ^ cs) << 3) + (t & 7);
    v4u pq0, pq1, pk0, pk1, pv[DV / 64];
#define PREP_LOAD(u_) do { const int n_ = (u_) % NCH, bh_ = (u_) / NCH, h_ = bh_ % H, b_ = bh_ / H; const bf16* zr_ = Z + ((size_t)b_ * SEQ + 64 * n_ + t) * LDZ; \
        pq0 = *(const v4u*)(zr_ + h_ * 128 + j0); pq1 = *(const v4u*)(zr_ + h_ * 128 + j0 + 8); pk0 = *(const v4u*)(zr_ + KC + h_ * 128 + j0); pk1 = *(const v4u*)(zr_ + KC + h_ * 128 + j0 + 8); \
        _Pragma("unroll") for (int q_ = 0; q_ < DV / 64; ++q_) pv[q_] = *(const v4u*)(zr_ + VC + h_ * DV + cs * (DV / 8) + 8 * q_); } while (0)
    const bool hfix = (G % (NCH * H)) == 0; const int h0 = (bid / NCH) % H;
    float br[4][4], bias[4], ca[16], cc[16], com[16];
    if constexpr (!HG) { const int r_ = lane & 15, quad_ = lane >> 4, cbase_ = 4 * (w & 1);
#pragma unroll
        for (int ks = 0; ks < 4; ++ks)
#pragma unroll
            for (int cb = 0; cb < 4; ++cb) br[cb][ks] = wup[(4 * ks + quad_) * 512 + h0 * 128 + 16 * (cbase_ + cb) + r_];
#pragma unroll
        for (int cb = 0; cb < 4; ++cb) bias[cb] = bgk[h0 * 128 + 16 * (cbase_ + cb) + r_];
    } else {
#pragma unroll
        for (int jj = 0; jj < 16; ++jj) { const f32x4 tc = *(const f32x4*)(lbt + (size_t)(h0 * 128 + j0 + jj) * 4); ca[jj] = tc[0]; cc[jj] = tc[1]; com[jj] = tc[2]; }
    }
    if (bid < NB * H * NCH) PREP_LOAD(bid);
    for (int unit = bid; unit < NB * H * NCH; unit += G) {
        const int n = unit % NCH, bh = unit / NCH, h = bh % H, b = bh / H;
        const size_t tok0 = (size_t)b * SEQ + 64 * n, m = tok0 + t;
        BAR_LDS();
        float lbc[16];
        if constexpr (!HG) {
            const int r = lane & 15, quad = lane >> 4, tb = w >> 1, cbase = 4 * (w & 1);
            float ar[4];
#pragma unroll
            for (int ks = 0; ks < 4; ++ks) ar[ks] = R[(tok0 + 16 * tb + r) * 16 + 4 * ks + quad];
            if (!hfix) {
#pragma unroll
                for (int ks = 0; ks < 4; ++ks)
#pragma unroll
                    for (int cb = 0; cb < 4; ++cb) br[cb][ks] = wup[(4 * ks + quad) * 512 + h * 128 + 16 * (cbase + cb) + r];
#pragma unroll
                for (int cb = 0; cb < 4; ++cb) bias[cb] = bgk[h * 128 + 16 * (cbase + cb) + r]; }
#pragma unroll
            for (int cb = 0; cb < 4; ++cb) { f32x4 c = {0.f, 0.f, 0.f, 0.f};
#pragma unroll
                for (int ks = 0; ks < 4; ++ks) c = __builtin_amdgcn_mfma_f32_16x16x4f32(ar[ks], br[cb][ks], c, 0, 0, 0);
#pragma unroll
                for (int j = 0; j < 4; ++j) gl[(16 * tb + 4 * quad + j) * 128 + 16 * (cbase + cb) + r] = logsig(c[j] + bias[cb]) * (1.0f / 16.0f); }
#pragma unroll
            for (int jj = 0; jj < 16; ++jj) lbc[jj] = 0.f;
        } else {
            float g[16];
            const unsigned fw[8] = {pk0.x, pk0.y, pk0.z, pk0.w, pk1.x, pk1.y, pk1.z, pk1.w};
#pragma unroll
            for (int jj = 0; jj < 16; ++jj) { const float f = (jj & 1) ? bfhi(fw[jj >> 1]) : bflo(fw[jj >> 1]);
                if (!hfix) { const f32x4 tc = *(const f32x4*)(lbt + (size_t)(h * 128 + j0 + jj) * 4); ca[jj] = tc[0]; cc[jj] = tc[1]; com[jj] = tc[2]; }
                const float a = ca[jj], b2 = cc[jj] + logsig(f), mx = fmaxf(a, b2);
                g[jj] = mx + __logf(1.0f + __expf(-fabsf(a - b2))); lbc[jj] = com[jj]; }
#pragma unroll
            for (int q = 0; q < 4; ++q) *(LAS f32x4*)(gl + t * 128 + j0 + 4 * q) = (f32x4){g[4 * q], g[4 * q + 1], g[4 * q + 2], g[4 * q + 3]};
        }
        BAR_LDS();
        {
            const int j = tid & 127, sg = tid >> 7; float acc = 0.f;
#pragma unroll
            for (int i = 0; i < 16; ++i) { acc += gl[(16 * sg + i) * 128 + j]; gl[(16 * sg + i) * 128 + j] = acc; }
            segs[sg * 128 + j] = acc;
        }
        BAR_LDS();
        {
            bf16* qp = Z + m * LDZ + h * 128 + j0;
            const v4u q0 = pq0, q1 = pq1, k0 = pk0, k1 = pk1;
            const unsigned qw[8] = {q0.x, q0.y, q0.z, q0.w, q1.x, q1.y, q1.z, q1.w}, kw[8] = {k0.x, k0.y, k0.z, k0.w, k1.x, k1.y, k1.z, k1.w};
            float bb[16], bl[16];
#pragma unroll
            for (int q = 0; q < 4; ++q) { f32x4 x = *(const LAS f32x4*)(gl + t * 128 + j0 + 4 * q), y = *(const LAS f32x4*)(gl + 63 * 128 + j0 + 4 * q);
                const f32x4 g0 = *(const LAS f32x4*)(segs + j0 + 4 * q), g1 = *(const LAS f32x4*)(segs + 128 + j0 + 4 * q), g2 = *(const LAS f32x4*)(segs + 256 + j0 + 4 * q);
                const int sgt = t >> 4; const f32x4 z4 = {0.f, 0.f, 0.f, 0.f};
                x += (sgt > 0 ? g0 : z4) + (sgt > 1 ? g1 : z4) + (sgt > 2 ? g2 : z4); y += (g0 + g1) + g2;
                bb[4 * q] = x[0]; bb[4 * q + 1] = x[1]; bb[4 * q + 2] = x[2]; bb[4 * q + 3] = x[3]; bl[4 * q] = y[0]; bl[4 * q + 1] = y[1]; bl[4 * q + 2] = y[2]; bl[4 * q + 3] = y[3]; }
            float qe[16], kn[16], kd[16];
#pragma unroll
            for (int jj = 0; jj < 16; ++jj) { float qv = (jj & 1) ? bfhi(qw[jj >> 1]) : bflo(qw[jj >> 1]); float kv = (jj & 1) ? bfhi(kw[jj >> 1]) : bflo(kw[jj >> 1]);
                if constexpr (HG) { qv = qv * sigm(qv); kv = lbc[jj] * sigm(-kv); }
                qe[jj] = qv * __expf(bb[jj]) * C::scale; kn[jj] = kv * __expf(-bb[jj]); kd[jj] = kv * __expf(bl[jj] - bb[jj]); }
            v4u o0, o1;
            o0.x = pk2(qe[0], qe[1]); o0.y = pk2(qe[2], qe[3]); o0.z = pk2(qe[4], qe[5]); o0.w = pk2(qe[6], qe[7]); o1.x = pk2(qe[8], qe[9]); o1.y = pk2(qe[10], qe[11]); o1.z = pk2(qe[12], qe[13]); o1.w = pk2(qe[14], qe[15]);
            *(v4u*)qp = o0; *(v4u*)(qp + 8) = o1; *(LAS v4u*)(qe_s + t * QP + j0) = o0; *(LAS v4u*)(qe_s + t * QP + j0 + 8) = o1;
            o0.x = pk2(kn[0], kn[1]); o0.y = pk2(kn[2], kn[3]); o0.z = pk2(kn[4], kn[5]); o0.w = pk2(kn[6], kn[7]); o1.x = pk2(kn[8], kn[9]); o1.y = pk2(kn[10], kn[11]); o1.z = pk2(kn[12], kn[13]); o1.w = pk2(kn[14], kn[15]);
            *(LAS v4u*)(kn_s + t * QP + j0) = o0; *(LAS v4u*)(kn_s + t * QP + j0 + 8) = o1;
#pragma unroll
            for (int jj = 0; jj < 16; jj += 2) { const unsigned pw = pk2(kd[jj], kd[jj + 1]); kdT_s[(j0 + jj) * TP + tsw] = (bf16)(pw & 0xffffu); kdT_s[(j0 + jj + 1) * TP + tsw] = (bf16)(pw >> 16); }
            if (t == 63) {
#pragma unroll
                for (int q = 0; q < 4; ++q) *(f32x4*)(DBUF + (size_t)unit * 128 + j0 + 4 * q) = (f32x4){__expf(bl[4 * q]), __expf(bl[4 * q + 1]), __expf(bl[4 * q + 2]), __expf(bl[4 * q + 3])}; }
#pragma unroll
            for (int q = 0; q < DV / 64; ++q) { const v4u x = pv[q]; const unsigned xw[4] = {x.x, x.y, x.z, x.w};
#pragma unroll
                for (int e = 0; e < 4; ++e) { const int v = cs * (DV / 8) + 8 * q + 2 * e; vT_s[v * TP + tsw] = (bf16)(xw[e] & 0xffffu); vT_s[(v + 1) * TP + tsw] = (bf16)(xw[e] >> 16); } }
        }
        BAR_LDS();
        if (unit + G < NB * H * NCH) PREP_LOAD(unit + G);
        {
            const int r = lane & 15, quad = lane >> 4, tb = w >> 1;
#pragma unroll
            for (int e = 0; e < 2; ++e) { const int sb = 2 * (w & 1) + e; f32x4 c = {0.f, 0.f, 0.f, 0.f};
                if (sb <= tb) {
#pragma unroll
                    for (int ks = 0; ks < 4; ++ks) { const bf16x8 av = *(const LAS bf16x8*)(kn_s + (16 * sb + r) * QP + 32 * ks + 8 * quad), bv = *(const LAS bf16x8*)(qe_s + (16 * tb + r) * QP + 32 * ks + 8 * quad);
                        c = __builtin_amdgcn_mfma_f32_16x16x32_bf16(av, bv, c, 0, 0, 0); } }
                const int tc = 16 * tb + r, s0 = 16 * sb + 4 * quad;
                v2u o; o.x = pk2(s0 <= tc ? c[0] : 0.f, s0 + 1 <= tc ? c[1] : 0.f); o.y = pk2(s0 + 2 <= tc ? c[2] : 0.f, s0 + 3 <= tc ? c[3] : 0.f);
                *(v2u*)(AB + (size_t)unit * 4096 + tc * 64 + s0) = o; }
        }
        {
            const int r = lane & 15, quad = lane >> 4;
#pragma unroll
            for (int vg = 0; vg < NG; ++vg) { const int gv = w * NG + vg;
                const int csv = HG ? gv : (gv >> 1);
                const bf16x8 b0 = *(const LAS bf16x8*)(vT_s + (16 * gv + r) * TP + 8 * (quad ^ csv)), b1 = *(const LAS bf16x8*)(vT_s + (16 * gv + r) * TP + 8 * ((4 + quad) ^ csv));
#pragma unroll
                for (int kb = 0; kb < 8; ++kb) { const bf16x8 a0 = *(const LAS bf16x8*)(kdT_s + (16 * kb + r) * TP + 8 * (quad ^ kb)), a1 = *(const LAS bf16x8*)(kdT_s + (16 * kb + r) * TP + 8 * ((4 + quad) ^ kb));
                    f32x4 c = {0.f, 0.f, 0.f, 0.f}; c = __builtin_amdgcn_mfma_f32_16x16x32_bf16(a0, b0, c, 0, 0, 0); c = __builtin_amdgcn_mfma_f32_16x16x32_bf16(a1, b1, c, 0, 0, 0);
                    v2u o; o.x = pk2(c[0], c[1]); o.y = pk2(c[2], c[3]);
                    *(v2u*)(PB + (((size_t)unit * NGV + gv) * 4 + (kb >> 1)) * 512 + lane * 8 + (kb & 1) * 4) = o; } }
        }
        for (int c = tid; c < DV * 4; c += NWAVES * 64) { const int v = c >> 2, sq = c & 3;
            const int csv = v / (DV / 8);
            const v4u x0 = *(const LAS v4u*)(vT_s + v * TP + 8 * ((2 * sq) ^ csv)), x1 = *(const LAS v4u*)(vT_s + v * TP + 8 * ((2 * sq + 1) ^ csv));
            bf16* dst = Z + (tok0 + v / VR) * LDZ + VC + h * DV + (v % VR) * 64 + 16 * sq;
            *(v4u*)dst = x0; *(v4u*)(dst + 8) = x1; }
    }
#undef PREP_LOAD
}
template <bool HG> __device__ __forceinline__ void state_phase(bf16* PSB, const float* DBUF, float* Sout, int gt, int ngt) {
    typedef MX<HG> C; constexpr int H = C::H, DV = C::DV, NGV = DV / 16, TOTAL = NB * H * NGV * 4 * 64;
    for (int idx = gt; idx < TOTAL; idx += ngt) {
        const int lane = idx & 63, ks = (idx >> 6) & 3, gvb = idx >> 8, gv = gvb % NGV, bh = gvb / NGV, quad = lane >> 4, r = lane & 15;
        f32x4 S0 = {0.f, 0.f, 0.f, 0.f}, S1 = {0.f, 0.f, 0.f, 0.f};
        bf16* pp = PSB + (((size_t)bh * NCH * NGV + gv) * 4 + ks) * 512 + lane * 8; const float* dp = DBUF + (size_t)bh * NCH * 128 + 32 * ks + 4 * quad;
        for (int n0 = 0; n0 < NCH; n0 += 8) {
            v4u p[8]; f32x4 d0[8], d1[8];
#pragma unroll
            for (int i = 0; i < 8; ++i) { p[i] = *(const v4u*)(pp + (size_t)(n0 + i) * NGV * 2048); d0[i] = *(const f32x4*)(dp + (n0 + i) * 128); d1[i] = *(const f32x4*)(dp + (n0 + i) * 128 + 16); }
            __builtin_amdgcn_sched_barrier(0);
#pragma unroll
            for (int i = 0; i < 8; ++i) { v4u o; o.x = pk2(S0[0], S0[1]); o.y = pk2(S0[2], S0[3]); o.z = pk2(S1[0], S1[1]); o.w = pk2(S1[2], S1[3]);
                *(v4u*)(pp + (size_t)(n0 + i) * NGV * 2048) = o;
                S0 = S0 * d0[i] + (f32x4){bflo(p[i].x), bfhi(p[i].x), bflo(p[i].y), bfhi(p[i].y)}; S1 = S1 * d1[i] + (f32x4){bflo(p[i].z), bfhi(p[i].z), bflo(p[i].w), bfhi(p[i].w)}; }
        }
        float* so = Sout + ((size_t)bh * 128 + 32 * ks + 4 * quad) * DV + 16 * gv + r;
#pragma unroll
        for (int j = 0; j < 4; ++j) { so[j * DV] = S0[j]; so[(16 + j) * DV] = S1[j]; }
    }
}
template <bool HG> __device__ __forceinline__ void out_phase(LAS unsigned char* lds, const bf16* Z, const bf16* AB, const bf16* PSB, bf16* OG, const float* gn, int tid, int w, int bid, int G) {
    typedef MX<HG> C; constexpr int H = C::H, DV = C::DV, LDZ = C::LDZ, VC = C::VC, GC = C::GC, VR = C::VR, VW = DV / 8, NG = VW / 16, NGV = DV / 16, NU = NB * H * NCH;
    constexpr int QP = 136, AP = 72, OFF_QE = 0, OFF_AA = 64 * QP * 2, BUFSZ = OFF_AA + 64 * AP * 2, OFF_SS = 2 * BUFSZ;
    const int lane = tid & 63, r = lane & 15, quad = lane >> 4, vbase = w * VW;
    f32x4 gnv[NG];
#pragma unroll
    for (int vg = 0; vg < NG; ++vg) gnv[vg] = *(const f32x4*)(gn + vbase + 16 * vg + 4 * quad);
    unsigned oq[2], ov[NG], sq[2];
#pragma unroll
    for (int i = 0; i < 2; ++i) { const int p = tid + 512 * i, row = p >> 4, c16 = p & 15; oq[i] = (unsigned)(row * LDZ + 8 * c16) * 2u; sq[i] = (unsigned)(row * QP + 8 * c16) * 2u; }
#pragma unroll
    for (int vg = 0; vg < NG; ++vg) { const int v = vbase + 16 * vg + r; ov[vg] = (unsigned)((v / VR) * LDZ + (v % VR) * 64 + 8 * quad) * 2u; }
    unsigned oa = (unsigned)tid * 16u, og = (unsigned)(r * LDZ + 4 * quad) * 2u, oo = (unsigned)(r * 1024 + 4 * quad) * 2u, osb = (unsigned)lane * 16u;
    unsigned lq = (unsigned)(r * QP + 4 * quad) * 2u, la = (unsigned)(r * AP + 8 * quad) * 2u, sa = (unsigned)((tid >> 3) * AP + 8 * (tid & 7)) * 2u;
    v4u pq[2], pa; bf16x8 sb[NG][4], vb[NG][2], sbn[NG][4], vbn[NG][2];
#define OP_BASES(u_) const int n_ = (u_) % NCH, bh_ = (u_) / NCH, h_ = bh_ % H, b_ = bh_ / H; const size_t tk_ = (size_t)b_ * SEQ + 64 * n_; \
        const char* zq_ = (const char*)(Z + tk_ * LDZ + h_ * 128); const char* zv_ = (const char*)(Z + tk_ * LDZ + VC + h_ * DV); const char* ab_ = (const char*)(AB + (size_t)(u_) * 4096); \
        const char* sb_ = (const char*)(PSB + ((size_t)(u_) * NGV + w * NG) * 2048)
#define OP_ISSUE(u_) do { OP_BASES(u_); pq[0] = *(const v4u*)(zq_ + oq[0]); pq[1] = *(const v4u*)(zq_ + oq[1]); pa = *(const v4u*)(ab_ + oa); \
        _Pragma("unroll") for (int vg = 0; vg < NG; ++vg) { _Pragma("unroll") for (int ks = 0; ks < 4; ++ks) sbn[vg][ks] = *(const bf16x8*)(sb_ + (vg * 4 + ks) * 1024 + osb); \
            vbn[vg][0] = *(const bf16x8*)(zv_ + ov[vg]); vbn[vg][1] = *(const bf16x8*)(zv_ + ov[vg] + 64); } } while (0)
#define OP_STAGE(buf_) do { LAS unsigned char* bs_ = lds + (buf_) * BUFSZ; *(LAS v4u*)(bs_ + OFF_QE + sq[0]) = pq[0]; *(LAS v4u*)(bs_ + OFF_QE + sq[1]) = pq[1]; *(LAS v4u*)(bs_ + OFF_AA + sa) = pa; } while (0)
#define OP_TAKE() do { _Pragma("unroll") for (int vg = 0; vg < NG; ++vg) { _Pragma("unroll") for (int ks = 0; ks < 4; ++ks) sb[vg][ks] = sbn[vg][ks]; vb[vg][0] = vbn[vg][0]; vb[vg][1] = vbn[vg][1]; } } while (0)
    OP_ISSUE(bid); OP_STAGE(0); OP_TAKE();
    BAR_LDS();
    int par = 0;
    for (int unit = bid; unit < NU; unit += G, par ^= 1) {
        asm volatile("" : "+v"(oq[0]), "+v"(oq[1]), "+v"(oa), "+v"(og), "+v"(oo), "+v"(osb), "+v"(lq), "+v"(la), "+v"(sa), "+v"(sq[0]), "+v"(sq[1]));
#pragma unroll
        for (int vg = 0; vg < NG; ++vg) asm volatile("" : "+v"(ov[vg]));
        const int n = unit % NCH, bh = unit / NCH, h = bh % H, b = bh / H; const size_t tok0 = (size_t)b * SEQ + 64 * n;
        const char* zg = (const char*)(Z + tok0 * LDZ + GC + h * DV + vbase);
        v2u gq[NG][4];
#pragma unroll
        for (int tb = 0; tb < 4; ++tb)
#pragma unroll
            for (int vg = 0; vg < NG; ++vg) gq[vg][tb] = *(const v2u*)(zg + (size_t)tb * 16 * LDZ * 2 + og + 32 * vg);
        const bool more = unit + G < NU;
        if (more) OP_ISSUE(unit + G);
        const LAS unsigned char* bs = lds + par * BUFSZ;
        f32x4 o[NG][4];
#pragma unroll
        for (int vg = 0; vg < NG; ++vg)
#pragma unroll
            for (int tb = 0; tb < 4; ++tb) o[vg][tb] = (f32x4){0.f, 0.f, 0.f, 0.f};
#pragma unroll
        for (int kh = 0; kh < 2; ++kh) { bf16x8 qf[2][4];
#pragma unroll
            for (int kl = 0; kl < 2; ++kl)
#pragma unroll
                for (int tb = 0; tb < 4; ++tb) { const LAS unsigned char* qa = bs + OFF_QE + lq + (16 * tb * QP + 32 * (2 * kh + kl)) * 2;
                    const v2u lo = *(const LAS v2u*)qa, hi = *(const LAS v2u*)(qa + 32); qf[kl][tb] = __builtin_bit_cast(bf16x8, ((v4u){lo.x, lo.y, hi.x, hi.y})); }
            __builtin_amdgcn_sched_barrier(0);
#pragma unroll
            for (int kl = 0; kl < 2; ++kl)
#pragma unroll
                for (int tb = 0; tb < 4; ++tb)
#pragma unroll
                    for (int vg = 0; vg < NG; ++vg) o[vg][tb] = __builtin_amdgcn_mfma_f32_16x16x32_bf16(sb[vg][2 * kh + kl], qf[kl][tb], o[vg][tb], 0, 0, 0);
            __builtin_amdgcn_sched_barrier(0); }
        { bf16x8 af[4][2];
#pragma unroll
            for (int tb = 0; tb < 4; ++tb) { const LAS unsigned char* aa = bs + OFF_AA + la + 16 * tb * AP * 2; af[tb][0] = *(const LAS bf16x8*)aa; af[tb][1] = *(const LAS bf16x8*)(aa + 64); }
            __builtin_amdgcn_sched_barrier(0);
#pragma unroll
            for (int js = 0; js < 2; ++js)
#pragma unroll
                for (int tb = 0; tb < 4; ++tb)
#pragma unroll
                    for (int vg = 0; vg < NG; ++vg) o[vg][tb] = __builtin_amdgcn_mfma_f32_16x16x32_bf16(vb[vg][js], af[tb][js], o[vg][tb], 0, 0, 0);
            __builtin_amdgcn_sched_barrier(0); }
        LAS float* ssb = (LAS float*)(lds + OFF_SS + par * 2048);
#pragma unroll
        for (int tb = 0; tb < 4; ++tb) { float p = 0.f;
#pragma unroll
            for (int vg = 0; vg < NG; ++vg) p += (o[vg][tb][0] * o[vg][tb][0] + o[vg][tb][1] * o[vg][tb][1]) + (o[vg][tb][2] * o[vg][tb][2] + o[vg][tb][3] * o[vg][tb][3]);
            p += __shfl_xor(p, 16); p += __shfl_xor(p, 32);
            if (quad == 0) ssb[(16 * tb + r) * 8 + w] = p; }
        if (more) { OP_STAGE(par ^ 1); OP_TAKE(); }
        BAR_LDS();
        char* ogn = (char*)(OG + tok0 * 1024 + h * DV + vbase);
#pragma unroll
        for (int tb = 0; tb < 4; ++tb) { const f32x4 s0 = *(const LAS f32x4*)(ssb + (16 * tb + r) * 8), s1 = *(const LAS f32x4*)(ssb + (16 * tb + r) * 8 + 4);
            const float tot = ((s0[0] + s0[1]) + (s0[2] + s0[3])) + ((s1[0] + s1[1]) + (s1[2] + s1[3])); const float rinv = rsqrtf(tot * (1.0f / DV) + 1e-6f);
#pragma unroll
            for (int vg = 0; vg < NG; ++vg) { const float g0 = bflo(gq[vg][tb].x), g1 = bfhi(gq[vg][tb].x), g2 = bflo(gq[vg][tb].y), g3 = bfhi(gq[vg][tb].y);
                const f32x4 y = o[vg][tb] * rinv * gnv[vg]; v2u pw; pw.x = pk2(y[0] * g0 * sigm(g0), y[1] * g1 * sigm(g1)); pw.y = pk2(y[2] * g2 * sigm(g2), y[3] * g3 * sigm(g3));
                *(v2u*)(ogn + (size_t)tb * 16 * 1024 * 2 + oo + 32 * vg) = pw; } }
    }
#undef OP_BASES
#undef OP_ISSUE
#undef OP_STAGE
#undef OP_TAKE
}
template <bool HG> __device__ __forceinline__ void sample_block(LAS unsigned char* lds, const bf16* Z, const float* R, const float* wup, const float* bgk, const float* lowb, const float* gn, const float* S0, float* Sout, bf16* OG, int bh, int tid, int w) {
    typedef MX<HG> C; constexpr int H = C::H, DV = C::DV, LDZ = C::LDZ, KC = C::KC, VC = C::VC, GC = C::GC, E = DV / 64;
    const int lane = tid & 63, kk = lane >> 2, t = lane & 3, k = 16 * w + kk, h = bh % H, b = bh / H, hk = h * 128 + k; const size_t m0 = (size_t)NPR + 4 * b;
    LAS float* tab = (LAS float*)lds + w * 192; LAS float* pas = (LAS float*)(lds + 6144); LAS float* red = (LAS float*)(lds + 8192);
    const float* sp = S0 + ((size_t)bh * 128 + 16 * w) * DV + E * lane; float* dp = Sout + ((size_t)bh * 128 + 16 * w) * DV + E * lane;
    float s0[16][E];
#pragma unroll
    for (int i = 0; i < 16; ++i) {
        if constexpr (E == 4) { const f32x4 x = __builtin_nontemporal_load((const f32x4*)(sp + (size_t)i * DV)); s0[i][0] = x[0]; s0[i][1] = x[1]; s0[i][2] = x[2]; s0[i][3] = x[3]; }
        else { const v2u x = __builtin_nontemporal_load((const v2u*)(sp + (size_t)i * DV)); s0[i][0] = __uint_as_float(x.x); s0[i][1] = __uint_as_float(x.y); } }
    float vv[4][E];
#pragma unroll
    for (int s = 0; s < 4; ++s) { const bf16* zv = Z + (m0 + s) * LDZ + VC + h * DV + E * lane;
        if constexpr (E == 4) { const v2u x = *(const v2u*)zv; vv[s][0] = bflo(x.x); vv[s][1] = bfhi(x.x); vv[s][2] = bflo(x.y); vv[s][3] = bfhi(x.y); }
        else { const unsigned x = *(const unsigned*)zv; vv[s][0] = bflo(x); vv[s][1] = bfhi(x); } }
    const bf16* zr = Z + (m0 + t) * LDZ; float q = bf2f(zr[hk]); const float kz = bf2f(zr[KC + hk]); float g, kv;
    if constexpr (!HG) { float x = bgk[hk];
#pragma unroll
        for (int i = 0; i < 16; ++i) x += R[(m0 + t) * 16 + i] * wup[i * 512 + hk];
        g = logsig(x) * (1.0f / 16.0f); kv = kz;
    } else { const float x0 = lowb[hk], x1 = lowb[1024 + hk]; const float a = logsig(x1 - x0), b2 = logsig(x0 - x1) + logsig(kz), mx = fmaxf(a, b2);
        g = mx + __logf(1.0f + __expf(-fabsf(a - b2))); kv = sigm(x0 - x1) * sigm(-kz); q = q * sigm(q); }
    const int l0 = lane & ~3;
    const float g0 = __shfl(g, l0), g1 = __shfl(g, l0 + 1), g2 = __shfl(g, l0 + 2), g3 = __shfl(g, l0 + 3);
    const float b3 = ((g0 + g1) + g2) + g3, bt = t == 0 ? g0 : (t == 1 ? g0 + g1 : (t == 2 ? (g0 + g1) + g2 : b3));
    const float qe = q * __expf(bt) * C::scale, kn = kv * __expf(-bt), kd = kv * __expf(b3 - bt);
    tab[kk * 12 + t] = qe; tab[kk * 12 + 4 + t] = kd; if (t == 0) tab[kk * 12 + 8] = __expf(b3);
    {
        float p[4];
#pragma unroll
        for (int s = 0; s < 4; ++s) { p[s] = qe * __shfl(kn, l0 + s);
            p[s] += __shfl_xor(p[s], 4); p[s] += __shfl_xor(p[s], 8); p[s] += __shfl_xor(p[s], 16); p[s] += __shfl_xor(p[s], 32); }
        if (lane < 4) *(LAS f32x4*)(pas + w * 16 + 4 * lane) = (f32x4){p[0], p[1], p[2], p[3]};
    }
    LDS_WAIT();
    float o[4][E];
#pragma unroll
    for (int tt = 0; tt < 4; ++tt)
#pragma unroll
        for (int e = 0; e < E; ++e) o[tt][e] = 0.f;
#pragma unroll
    for (int i = 0; i < 16; ++i) { const f32x4 q4 = *(const LAS f32x4*)(tab + i * 12), k4 = *(const LAS f32x4*)(tab + i * 12 + 4); const float d = tab[i * 12 + 8]; float sn[E];
#pragma unroll
        for (int e = 0; e < E; ++e) { o[0][e] += q4[0] * s0[i][e]; o[1][e] += q4[1] * s0[i][e]; o[2][e] += q4[2] * s0[i][e]; o[3][e] += q4[3] * s0[i][e];
            sn[e] = d * s0[i][e] + ((k4[0] * vv[0][e] + k4[1] * vv[1][e]) + (k4[2] * vv[2][e] + k4[3] * vv[3][e])); }
        if constexpr (E == 4) __builtin_nontemporal_store(((f32x4){sn[0], sn[1], sn[2], sn[3]}), (f32x4*)(dp + (size_t)i * DV));
        else { v2u x; x.x = __float_as_uint(sn[0]); x.y = __float_as_uint(sn[1]); __builtin_nontemporal_store(x, (v2u*)(dp + (size_t)i * DV)); } }
#pragma unroll
    for (int tt = 0; tt < 4; ++tt) {
        if constexpr (E == 4) *(LAS f32x4*)(red + (w * 4 + tt) * DV + 4 * lane) = (f32x4){o[tt][0], o[tt][1], o[tt][2], o[tt][3]};
        else { red[(w * 4 + tt) * DV + 2 * lane] = o[tt][0]; red[(w * 4 + tt) * DV + 2 * lane + 1] = o[tt][1]; } }
    BAR_LDS();
    if (w < 4) {
        float y[E];
#pragma unroll
        for (int e = 0; e < E; ++e) y[e] = 0.f;
#pragma unroll
        for (int ww = 0; ww < 8; ++ww)
#pragma unroll
            for (int e = 0; e < E; ++e) y[e] += red[(ww * 4 + w) * DV + E * lane + e];
#pragma unroll
        for (int s = 0; s < 4; ++s) if (s <= w) { float a = 0.f;
#pragma unroll
            for (int ww = 0; ww < 8; ++ww) a += pas[ww * 16 + 4 * w + s];
#pragma unroll
            for (int e = 0; e < E; ++e) y[e] += a * vv[s][e]; }
        float ss = 0.f;
#pragma unroll
        for (int e = 0; e < E; ++e) ss += y[e] * y[e];
        ss = wave_sum(ss); const float rinv = rsqrtf(ss * (1.0f / DV) + 1e-6f);
        const bf16* zg = Z + (m0 + w) * LDZ + GC + h * DV + E * lane; bf16* op = OG + (m0 + w) * 1024 + h * DV + E * lane; float gg[E];
        if constexpr (E == 4) { const v2u x = *(const v2u*)zg; gg[0] = bflo(x.x); gg[1] = bfhi(x.x); gg[2] = bflo(x.y); gg[3] = bfhi(x.y); } else { const unsigned x = *(const unsigned*)zg; gg[0] = bflo(x); gg[1] = bfhi(x); }
#pragma unroll
        for (int e = 0; e < E; ++e) y[e] = y[e] * rinv * gn[E * lane + e] * (gg[e] * sigm(gg[e]));
        if constexpr (E == 4) { v2u pw; pw.x = pk2(y[0], y[1]); pw.y = pk2(y[2], y[3]); *(v2u*)op = pw; } else { *(unsigned*)op = pk2(y[0], y[1]); }
    }
    BAR_LDS();
}
template <int NKS> __device__ __forceinline__ void mini_acc(f32x4 (&acc)[2][4], const bf16* ap, size_t lda, const bf16* bp, size_t ldb) {
#pragma unroll
    for (int c = 0; c < NKS; c += 4) {
        bf16x8 af[4][2], bfr[4][4];
#pragma unroll
        for (int ks = 0; ks < 4; ++ks) if (c + ks < NKS) {
#pragma unroll
            for (int rb = 0; rb < 2; ++rb) af[ks][rb] = *(const bf16x8*)(ap + (size_t)(16 * rb) * lda + 32 * (c + ks));
#pragma unroll
            for (int cb = 0; cb < 4; ++cb) bfr[ks][cb] = *(const bf16x8*)(bp + (size_t)(16 * cb) * ldb + 32 * (c + ks)); }
        __builtin_amdgcn_sched_barrier(0);
#pragma unroll
        for (int ks = 0; ks < 4; ++ks) if (c + ks < NKS) {
#pragma unroll
            for (int rb = 0; rb < 2; ++rb)
#pragma unroll
                for (int cb = 0; cb < 4; ++cb) acc[rb][cb] = __builtin_amdgcn_mfma_f32_16x16x32_bf16(bfr[ks][cb], af[ks][rb], acc[rb][cb], 0, 0, 0); }
        __builtin_amdgcn_sched_barrier(0);
    }
}
template <int MODE, int K> __device__ __forceinline__ void mini_gemm(LAS unsigned char* lds, const bf16* A, const bf16* Bt, const bf16* A2, const bf16* Bt2, const float* xin, const bf16* hb_in, bf16* hb_out, const float* rs_in, float* rs_out, float alpha, int tid, int bid, int G) {
    const int lane = tid & 63, w = tid >> 6, r = lane & 15, quad = lane >> 4;
    LAS float* P = (LAS float*)lds; LAS float* P2 = (LAS float*)(lds + 65536);
    for (int mt = bid; mt < 256; mt += G) {
        const int rt = mt >> 4, ct = mt & 15, row0 = NPR + 32 * rt, col0 = 64 * ct;
        f32x4 acc[2][4];
#pragma unroll
        for (int rb = 0; rb < 2; ++rb)
#pragma unroll
            for (int cb = 0; cb < 4; ++cb) acc[rb][cb] = (f32x4){0.f, 0.f, 0.f, 0.f};
        constexpr int KW = K / 8;
        mini_acc<KW / 32>(acc, A + (size_t)(row0 + r) * K + w * KW + 8 * quad, K, Bt + (size_t)(col0 + r) * K + w * KW + 8 * quad, K);
#pragma unroll
        for (int rb = 0; rb < 2; ++rb)
#pragma unroll
            for (int cb = 0; cb < 4; ++cb) *(LAS f32x4*)(P + (w * 32 + 16 * rb + r) * 64 + 16 * cb + 4 * quad) = acc[rb][cb];
        if constexpr (MODE == 1) {
#pragma unroll
            for (int rb = 0; rb < 2; ++rb)
#pragma unroll
                for (int cb = 0; cb < 4; ++cb) acc[rb][cb] = (f32x4){0.f, 0.f, 0.f, 0.f};
            mini_acc<1>(acc, A2 + (size_t)(row0 + r) * 256 + w * 32 + 8 * quad, 256, Bt2 + (size_t)(col0 + r) * 256 + w * 32 + 8 * quad, 256);
#pragma unroll
            for (int rb = 0; rb < 2; ++rb)
#pragma unroll
                for (int cb = 0; cb < 4; ++cb) *(LAS f32x4*)(P2 + (w * 32 + 16 * rb + r) * 64 + 16 * cb + 4 * quad) = acc[rb][cb];
        }
        BAR_LDS();
        const int row = tid >> 4, c4 = (tid & 15) * 4; f32x4 v = {0.f, 0.f, 0.f, 0.f}, v2 = {0.f, 0.f, 0.f, 0.f};
#pragma unroll
        for (int ww = 0; ww < 8; ++ww) { v += *(const LAS f32x4*)(P + (ww * 32 + row) * 64 + c4); if constexpr (MODE == 1) v2 += *(const LAS f32x4*)(P2 + (ww * 32 + row) * 64 + c4); }
        const int grow = row0 + row; const size_t off = (size_t)grow * 1024 + col0 + c4;
        f32x4 o;
        if (xin) o = *(const f32x4*)(xin + off); else { const v2u hx = *(const v2u*)(hb_in + off); o = (f32x4){bflo(hx.x), bfhi(hx.x), bflo(hx.y), bfhi(hx.y)}; }
        if constexpr (MODE == 0) o += v * alpha;
        else { const float s = pg8::row_scale(rs_in, grow); o[0] += sigm(v[0] * s) * v2[0]; o[1] += sigm(v[1] * s) * v2[1]; o[2] += sigm(v[2] * s) * v2[2]; o[3] += sigm(v[3] * s) * v2[3]; }
        v2u pw; pw.x = pk2(o[0], o[1]); pw.y = pk2(o[2], o[3]); *(v2u*)(hb_out + off) = pw;
        float ss = (o[0] * o[0] + o[1] * o[1]) + (o[2] * o[2] + o[3] * o[3]);
        ss += __shfl_xor(ss, 1); ss += __shfl_xor(ss, 2); ss += __shfl_xor(ss, 4); ss += __shfl_xor(ss, 8);
        if ((tid & 15) == 0) rs_out[(size_t)grow * 16 + ct] = ss;
        BAR_LDS();
    }
}
#define XB_TMO      128
#define XB_XCNT(j)  (256  + 64 * (j))
#define XB_XSUB(j)  (1280 + 64 * (j))
#define XB_XGEN(j)  (2304 + 64 * (j))
#define XB_TOP      3328
#define XB_TOPGEN   3392
#define XCD_BAR_WORDS 3456
#define XB_SPIN_CAP (1u << 18)

__device__ __forceinline__ unsigned xb_ld(unsigned* p)              { return __hip_atomic_load(p, __ATOMIC_RELAXED, __HIP_MEMORY_SCOPE_AGENT); }
__device__ __forceinline__ unsigned xb_add(unsigned* p, unsigned v) { return __hip_atomic_fetch_add(p, v, __ATOMIC_RELAXED, __HIP_MEMORY_SCOPE_AGENT); }
__device__ __forceinline__ unsigned xb_xcc_id() { return (unsigned)__builtin_amdgcn_s_getreg((3 << 11) | 20) & 0xFu; }
#define XB_SPIN(cond, bar) do { unsigned _sp = 0; while (cond) { __builtin_amdgcn_s_sleep(1); \
    if ((++_sp & 255u) == 0u) { if (xb_ld(&(bar)[XB_TMO])) break; if (_sp > XB_SPIN_CAP) { atomicAdd(&(bar)[XB_TMO], 1u); break; } } } } while (0)

struct XcdBarrier {
    unsigned* bar; unsigned x;
    volatile LAS unsigned* st;
};

__device__ __forceinline__ XcdBarrier xcd_barrier_post(unsigned* bar, volatile LAS unsigned* st) {
    XcdBarrier b; b.bar = bar; b.x = xb_xcc_id(); b.st = st;
    if (threadIdx.x == 0) (void)xb_add(&bar[XB_XCNT(b.x)], 1u);
    return b;
}
__device__ __forceinline__ void xcd_barrier_complete(unsigned* bar, unsigned x, unsigned& nloc, unsigned& nx) {
    const unsigned G = gridDim.x * gridDim.y * gridDim.z;
    unsigned sum, cnt, mine, sp = 0u;
    for (;;) {
        sum = 0u; cnt = 0u; mine = 0u;
#pragma unroll
        for (unsigned j = 0; j < 16; ++j) { const unsigned c = xb_ld(&bar[XB_XCNT(j)]); sum += c; cnt += (c > 0u) ? 1u : 0u; mine = (j == x) ? c : mine; }
        if (sum == G) break;
        __builtin_amdgcn_s_sleep(1);
        if ((++sp & 255u) == 0u) { if (xb_ld(&bar[XB_TMO])) break; if (sp > XB_SPIN_CAP) { atomicAdd(&bar[XB_TMO], 1u); break; } }
    }
    nloc = mine > 0u ? mine : 1u; nx = cnt > 0u ? cnt : 1u;
}

__device__ __forceinline__ void xcd_barrier(const XcdBarrier& b) {
    asm volatile("s_waitcnt vmcnt(0)" ::: "memory");
    __syncthreads();
    if (threadIdx.x == 0) {
        unsigned* bar = b.bar;
        __builtin_amdgcn_s_waitcnt(0);
        unsigned nloc = b.st[0], nx = b.st[1];
        if (nloc == 0u) { xcd_barrier_complete(bar, b.x, nloc, nx); b.st[0] = nloc; b.st[1] = nx; }
        const unsigned old = xb_add(&bar[XB_XSUB(b.x)], 1u);
        const unsigned gen = old / nloc;
        if (old + 1u == (gen + 1u) * nloc) {
            __builtin_amdgcn_fence(__ATOMIC_RELEASE, "agent");
            asm volatile("s_waitcnt vmcnt(0)" ::: "memory");
            const unsigned og = xb_add(&bar[XB_TOP], 1u);
            const unsigned tg = og / nx;
            if (og + 1u == (tg + 1u) * nx) xb_add(&bar[XB_TOPGEN], 1u);
            else XB_SPIN(xb_ld(&bar[XB_TOPGEN]) == tg, bar);
            __builtin_amdgcn_fence(__ATOMIC_ACQUIRE, "agent");
            xb_add(&bar[XB_XGEN(b.x)], 1u);
            asm volatile("s_waitcnt vmcnt(0)" ::: "memory");
        } else {
            XB_SPIN(xb_ld(&bar[XB_XGEN(b.x)]) == gen, bar);
            __builtin_amdgcn_fence(__ATOMIC_ACQUIRE, "agent");
            asm volatile("s_waitcnt vmcnt(0)" ::: "memory");
        }
    }
    __syncthreads();
}

#define MK_TID() int wave = wave_s; asm volatile("" : "+s"(wave)); unsigned ones_ = ~0u; asm volatile("" : "+s"(ones_)); \
    const int lane = (int)__builtin_amdgcn_mbcnt_hi(ones_, __builtin_amdgcn_mbcnt_lo(ones_, 0u)); const int tid = wave * 64 + lane; const int gw = bid * NWAVES + wave, NGW = G * NWAVES; (void)gw; (void)NGW; (void)tid; (void)lane
__global__ void __launch_bounds__(NWAVES * 64, 2) fwd_kernel(Args a) {
    extern __shared__ __attribute__((aligned(16))) unsigned char lds_raw[];
    LAS unsigned char* lds = (LAS unsigned char*)lds_raw;
    cg::grid_group grid = cg::this_grid();
    const int wave_s = __builtin_amdgcn_readfirstlane((int)threadIdx.x >> 6);
    volatile LAS unsigned* bst = (volatile LAS unsigned*)(lds + LDS_BYTES - 64);
    if (threadIdx.x < 2) bst[threadIdx.x] = 0u;
    __syncthreads();
    const XcdBarrier xbar = xcd_barrier_post((unsigned*)(a.ws + OFF_CTL), bst);
#if PT_ON
#define PT_T0 (blockIdx.x == 0 && wave_s == 0 && __builtin_amdgcn_mbcnt_hi(~0u, __builtin_amdgcn_mbcnt_lo(~0u, 0u)) == 0u)
#define tsl ((volatile LAS unsigned*)(lds + LDS_BYTES - 32))
#endif
    const int ph_lo = a.ph_lo, ph_hi = a.ph_hi;
    for (int ph_ = ph_lo; ph_ < ph_hi; ++ph_) {
#if PROBE_MODE
      const int kk_ = (ph_ - 1) % 10; const bool mid_ = ph_ > 0 && ph_ < NPH - 1;
      const int nrep = (PROBE_MODE == 1 && ph_ == 0) || (PROBE_MODE == 2 && mid_ && (kk_ == 0 || kk_ == 7)) || (PROBE_MODE == 3 && mid_ && kk_ == 2) || (PROBE_MODE == 4 && mid_ && kk_ == 5) ? 2 : 1;
      for (int rep = 0; rep < nrep; ++rep) {
#else
      {
#endif
        int ph = ph_; asm volatile("" : "+s"(ph));
#if PT_ON
        if (ph == PT_LO && PT_T0) { const unsigned long long t_ = __builtin_amdgcn_s_memrealtime(); tsl[0] = (unsigned)t_; tsl[1] = (unsigned)(t_ >> 32); }
        if (ph == PT_HI + 1 && PT_T0) { const unsigned long long t_ = __builtin_amdgcn_s_memrealtime(); tsl[2] = (unsigned)t_; tsl[3] = (unsigned)(t_ >> 32); }
#endif
        CArgs* ap = (CArgs*)__builtin_amdgcn_kernarg_segment_ptr(); asm volatile("" : "+s"(ap));
        int bid = blockIdx.x; asm volatile("" : "+s"(bid));
        int G = gridDim.x; asm volatile("" : "+s"(G));
        unsigned char* ws = ap->ws; float* hbuf = ap->out;
        if (ph == 0) { MK_TID(); prologue(ap, ws, hbuf, lds, tid, bid, G); }
        else if (ph == NPH - 1) {
            MK_TID(); const float* fw = ap->in[25]; const bf16* hfin = (const bf16*)(ws + OFF_HB);
            for (int m = gw; m < M; m += NGW) { const v2u* hr = (const v2u*)(hfin + (size_t)m * D); f32x4 v[4]; float ss = 0.f;
#pragma unroll
                for (int j = 0; j < 4; ++j) { const v2u x = hr[lane + 64 * j]; v[j] = (f32x4){bflo(x.x), bfhi(x.x), bflo(x.y), bfhi(x.y)}; ss += (v[j][0] * v[j][0] + v[j][1] * v[j][1]) + (v[j][2] * v[j][2] + v[j][3] * v[j][3]); }
                ss = wave_sum(ss); const float rinv = rsqrtf(ss * (1.0f / D) + 1e-6f);
#pragma unroll
                for (int j = 0; j < 4; ++j) { const f32x4 wv = *((const f32x4*)fw + lane + 64 * j); __builtin_nontemporal_store(v[j] * rinv * wv, (f32x4*)(hbuf + (size_t)m * D) + lane + 64 * j); } }
        } else {
            const int li = (ph - 1) / 10, k = (ph - 1) % 10, cur = li;
            bf16* hb = (bf16*)(ws + OFF_HB + cur * HB_SZ); bf16* ob = (bf16*)(ws + OFF_HB + (cur ^ 1) * HB_SZ);
            float* rs0 = (float*)(ws + OFF_RS); float* rs1 = (float*)(ws + OFF_RS + RS_SZ); float* Rb = (float*)(ws + OFF_R);
            bf16* big = (bf16*)(ws + OFF_BIG);
            if (k == 0 || k == 7) { MK_TID();
                const int f = k == 7; pg8::Gemm g{hb, (const bf16*)(ws + OFF_WGU + (li * 2 + f) * WGU_SZ), M, 2 * FF, D};
                pg8::StaticOrder S; S.init(M, 2 * FF, G, bid); pg8::EpiSwiglu E{big, FF, rs0};
                pg8::gemm_phase<pg8::EpiSwiglu, pg8::StaticOrder, true, true>(lds, g, S, E, tid);
            } else if (k == 1 || k == 8 || k == 6) { MK_TID();
                pg8::Gemm g; float alpha; float* rso;
                if (k == 6) { g = pg8::Gemm{ob, (const bf16*)(ws + OFF_WOUT + li * WSQ_SZ), M, D, D}; alpha = 1.0f; rso = rs0; }
                else { const int f = k == 8; g = pg8::Gemm{big, (const bf16*)(ws + OFF_WDN + (li * 2 + f) * WDN_SZ), M, D, FF}; alpha = 0.5f; rso = rs1; }
                g.M = NPR; pg8::StaticOrder S; S.init(NPR, D, G, bid); const bool first = (li == 0 && k == 1);
                pg8::EpiResid E{first ? ap->in[0] : (const float*)nullptr, hb, rso, alpha};
                pg8::gemm_phase<pg8::EpiResid, pg8::StaticOrder, true, true>(lds, g, S, E, tid);
                unsigned ones2_ = ~0u; asm volatile("" : "+s"(ones2_));
                const int tid2 = wave * 64 + (int)__builtin_amdgcn_mbcnt_hi(ones2_, __builtin_amdgcn_mbcnt_lo(ones2_, 0u));
                const float* xin_s = first ? ap->in[1] - (size_t)NPR * 1024 : (const float*)nullptr;
                if (k == 6) mini_gemm<0, D>(lds, g.A, g.Bt, nullptr, nullptr, xin_s, hb, hb, nullptr, rso, alpha, tid2, bid, G);
                else mini_gemm<0, FF>(lds, g.A, g.Bt, nullptr, nullptr, xin_s, hb, hb, nullptr, rso, alpha, tid2, bid, G);
            } else if (k == 2) { MK_TID();
                const int N = li ? 4096 : 3328; pg8::Gemm g{hb, (const bf16*)(ws + (li ? OFF_WHIN : OFF_WGIN)), M, N, D};
                pg8::StaticOrder S; S.init(M, N, G, bid); pg8::EpiZ E{big, N, rs1, Rb, li ? -1 : 12};
                pg8::gemm_phase<pg8::EpiZ, pg8::StaticOrder, true, true>(lds, g, S, E, tid);
            } else if (k == 3) { MK_TID();
                if (li == 0) prep_phase<false>(lds, big, Rb, ap->in[11], ap->in[12], (const float*)(ws + OFF_LBT), (bf16*)(ws + OFF_AB), (float*)(ws + OFF_DB), (bf16*)(ws + OFF_PSB), tid, bid, G);
                else prep_phase<true>(lds, big, Rb, ap->in[11], ap->in[12], (const float*)(ws + OFF_LBT), (bf16*)(ws + OFF_AB), (float*)(ws + OFF_DB), (bf16*)(ws + OFF_PSB), tid, bid, G);
                __syncthreads();
                for (int rp_ = 0; rp_ < (PROBE_MODE == 6 ? 2 : 1); ++rp_)
                for (int u = bid; u < DB * (li ? 8 : 4); u += G) {
                    if (li == 0) sample_block<false>(lds, big, Rb, ap->in[11], ap->in[12], ap->in[18], ap->in[13], ap->in[2], hbuf + OUT_GS, ob, u, tid, wave);
                    else sample_block<true>(lds, big, Rb, ap->in[11], ap->in[12], ap->in[18], ap->in[16], ap->in[3], hbuf + OUT_HS, ob, u, tid, wave);
                }
            } else if (k == 4) { MK_TID();
                const int gt = bid * (NWAVES * 64) + tid, ngt = G * NWAVES * 64;
                if (li == 0) state_phase<false>((bf16*)(ws + OFF_PSB), (const float*)(ws + OFF_DB), hbuf + OUT_GP, gt, ngt);
                else state_phase<true>((bf16*)(ws + OFF_PSB), (const float*)(ws + OFF_DB), hbuf + OUT_HP, gt, ngt);
            } else if (k == 5) { MK_TID();
                if (li == 0) out_phase<false>(lds, big, (const bf16*)(ws + OFF_AB), (const bf16*)(ws + OFF_PSB), ob, ap->in[13], tid, wave, bid, G);
                else out_phase<true>(lds, big, (const bf16*)(ws + OFF_AB), (const bf16*)(ws + OFF_PSB), ob, ap->in[16], tid, wave, bid, G);
            } else { MK_TID();
                bf16* pp = (bf16*)(ws + OFF_BIG);
                { pg8::Gemm g{(const bf16*)(ws + OFF_PB + li * PB_SZ), (const bf16*)(ws + OFF_WPP + li * WPP_SZ), NPR, D, PLE};
                  pg8::StaticOrder S; S.init(NPR, D, G, bid); pg8::EpiStorePP E{pp};
                  pg8::gemm_phase<pg8::EpiStorePP, pg8::StaticOrder, true, true>(lds, g, S, E, tid); }
                { unsigned ones2_ = ~0u; asm volatile("" : "+s"(ones2_)); const int tid2 = wave * 64 + (int)__builtin_amdgcn_mbcnt_hi(ones2_, __builtin_amdgcn_mbcnt_lo(ones2_, 0u));
                  pg8::Gemm g{hb, (const bf16*)(ws + OFF_WPG + li * WSQ_SZ), NPR, D, D};
                  pg8::StaticOrder S; S.init(NPR, D, G, bid); pg8::EpiPle E{hb, ob, rs1, rs0, pp};
                  pg8::gemm_phase<pg8::EpiPle, pg8::StaticOrder, true, true>(lds, g, S, E, tid2); }
                { unsigned ones3_ = ~0u; asm volatile("" : "+s"(ones3_)); const int tid3 = wave * 64 + (int)__builtin_amdgcn_mbcnt_hi(ones3_, __builtin_amdgcn_mbcnt_lo(ones3_, 0u));
                  mini_gemm<1, D>(lds, hb, (const bf16*)(ws + OFF_WPG + li * WSQ_SZ), (const bf16*)(ws + OFF_PB + li * PB_SZ), (const bf16*)(ws + OFF_WPP + li * WPP_SZ), nullptr, hb, ob, rs1, rs0, 0.f, tid3, bid, G); }
            }
        }
#if PROBE_MODE
        if (ph_ + 1 < ph_hi || rep + 1 < nrep) grid.sync();
#else
        if (ph_ + 1 < ph_hi) {
            if (ph_lo < 0) grid.sync(); else xcd_barrier(xbar);
#if EXTRA_SYNCS
            for (int es = 0; es < EXTRA_SYNCS; ++es) xcd_barrier(xbar);
#endif
        }
#endif
      }
    }
#if PT_ON
    if (PT_T0) { const unsigned long long t0_ = ((unsigned long long)tsl[1] << 32) | tsl[0], t1_ = ((unsigned long long)tsl[3] << 32) | tsl[2], span_ = (t1_ - t0_) * PT_MUL;
        const unsigned long long s_ = __builtin_amdgcn_s_memrealtime(); while (__builtin_amdgcn_s_memrealtime() - s_ < span_) __builtin_amdgcn_s_sleep(8); }
#endif
}

extern "C" void kernel_launch(void* const* d_in, const int* in_sizes, int n_in, void* d_out, int out_size, void* d_ws, size_t ws_size, hipStream_t stream) {
    static int grid = 0;
    if (grid == 0) {
        if (n_in != 26 || (size_t)out_size != OUT_END || ws_size < WS_TOTAL) { fprintf(stderr, "kernel_launch: unexpected shapes (n_in %d out %d ws %zu need %zu); nothing launched\n", n_in, out_size, ws_size, (size_t)WS_TOTAL); grid = -1; return; }
        int dev = 0, cus = 0, per_cu = 0;
        if (hipGetDevice(&dev) != hipSuccess || hipDeviceGetAttribute(&cus, hipDeviceAttributeMultiprocessorCount, dev) != hipSuccess) { grid = -1; return; }
        if (hipFuncSetAttribute((const void*)fwd_kernel, hipFuncAttributeMaxDynamicSharedMemorySize, LDS_BYTES) != hipSuccess) { fprintf(stderr, "kernel_launch: hipFuncSetAttribute failed\n"); grid = -1; return; }
        if (hipOccupancyMaxActiveBlocksPerMultiprocessor(&per_cu, (const void*)fwd_kernel, NWAVES * 64, LDS_BYTES) != hipSuccess || per_cu < 1) per_cu = 1;
        (void)hipGetLastError();
        grid = cus * per_cu;
    }
    if (grid < 0) return;
    if (hipMemsetAsync((char*)d_ws + OFF_CTL, 0, CTL_BYTES, stream) != hipSuccess) { fprintf(stderr, "kernel_launch: memset of the barrier words failed\n"); return; }
    Args a{};
    for (int i = 0; i < 26; ++i) a.in[i] = (const float*)d_in[i];
    a.out = (float*)d_out; a.ws = (unsigned char*)d_ws;
#if MK_N_LAUNCHES == 1
    a.ph_lo = 0; a.ph_hi = NPH;
    void* args[] = {&a};
    hipError_t e = hipLaunchCooperativeKernel((const void*)fwd_kernel, dim3(grid), dim3(NWAVES * 64), args, LDS_BYTES, stream);
    if (e != hipSuccess) fprintf(stderr, "kernel_launch: cooperative launch failed: %s (grid %d)\n", hipGetErrorString(e), grid);
#else
    for (int ph = 0; ph < NPH; ++ph) { a.ph_lo = ph; a.ph_hi = ph + 1; hipLaunchKernelGGL(fwd_kernel, dim3(grid), dim3(NWAVES * 64), LDS_BYTES, stream, a); }
#endif
}
```

```cpp
#include <hip/hip_runtime.h>
#include <cstdio>
#include <cstdint>
#ifndef MK_N_LAUNCHES
#define MK_N_LAUNCHES 1
#endif
#ifndef PROBE_MODE
#define PROBE_MODE 0
#endif
#ifndef EXTRA_SYNCS
#define EXTRA_SYNCS 0
#endif
#ifndef PT_ON
#define PT_ON 0
#define PT_LO 14
#define PT_HI 14
#define PT_MUL 4
#endif
namespace pg8 {
#define PG8_LAS __attribute__((address_space(3)))
typedef unsigned short bf16_t;
typedef short bf16x8 __attribute__((ext_vector_type(8)));
typedef float f32x4 __attribute__((ext_vector_type(4)));
typedef unsigned u32x4 __attribute__((ext_vector_type(4)));
constexpr int BM = 256, BK = 64, HALF = 128, HTB = HALF * BK * 2  , STAGE_BYTES = 8 * HTB, NXCD = 8, WGM = 8;

__host__ __device__ __forceinline__ int lds_byte(int r, int c) { const int st = (r >> 4) * 2 + (c >> 5), rr = r & 15, cc = c & 31, ob = rr * 64 + cc * 2; return st * 1024 + (ob ^ (((ob >> 9) & 1) << 5)); }
__host__ __device__ __forceinline__ void stage_rc(int b, int& R, int& C) { const int st = b / 1024, sb = b % 1024, swz = sb ^ (((sb >> 9) & 1) << 5); R = (st >> 1) * 16 + swz / 64; C = (st & 1) * 32 + (swz % 64) / 2; }
__host__ __device__ __forceinline__ int perm32(int rho) { const int n = rho >> 4, i = rho & 15; return 8 * (i >> 2) + 4 * n + (i & 3); }

struct Unit { int pm, pn; };
struct Gemm { const bf16_t* A; const bf16_t* Bt; int M, N, K; };

struct StaticOrder {
    int nM, nN, nwg, G, c;
    __host__ __device__ void init(int M, int N, int G_, int c_) { nM = M / BM; nN = N / BM; nwg = nM * nN; G = G_; c = c_; }
    __host__ __device__ bool next(int i, Unit& u) const {
        const long L = (long)i * G + c; if (L >= nwg) return false;
        int wgid = (int)L; { const int q = nwg / NXCD, r = nwg % NXCD, xcd = wgid % NXCD, off = wgid / NXCD; wgid = (xcd < r ? xcd * (q + 1) : r * (q + 1) + (xcd - r) * q) + off; }
        const int nig = WGM * nN, gid = wgid / nig, fm = gid * WGM, gsz = (nM - fm) < WGM ? (nM - fm) : WGM;
        u.pm = fm + ((wgid % nig) % gsz); u.pn = (wgid % nig) / gsz; return true;
    }
    __device__ __forceinline__ void a_ready(const Unit&) const {}
    __device__ __forceinline__ void done(const Unit&) const {}
};

typedef float f32x2_ __attribute__((ext_vector_type(2))); typedef __bf16 bf16x2_ __attribute__((ext_vector_type(2)));
__device__ __forceinline__ unsigned cvt_pk_bf16(float lo, float hi) { const f32x2_ v = {lo, hi}; return __builtin_bit_cast(unsigned, __builtin_convertvector(v, bf16x2_)); }
typedef float f32x2 __attribute__((ext_vector_type(2)));
typedef unsigned u32x2 __attribute__((ext_vector_type(2)));
__device__ __forceinline__ float row_scale(const float* rs, int row) {
    const f32x4* p = (const f32x4*)(rs + (size_t)row * 16);
    const f32x4 a = p[0], b = p[1], c = p[2], d = p[3];
    const float s = ((a[0] + a[1]) + (a[2] + a[3])) + ((b[0] + b[1]) + (b[2] + b[3])) + ((c[0] + c[1]) + (c[2] + c[3])) + ((d[0] + d[1]) + (d[2] + d[3]));
    return rsqrtf(s * (1.0f / 1024.0f) + 1e-6f);
}
__device__ __forceinline__ void row_scales8(const float* rs, int row0, float (&sc)[2][4]) {
#pragma unroll
    for (int ai = 0; ai < 2; ++ai)
#pragma unroll
        for (int mh = 0; mh < 2; ++mh) { f32x4 p[2][4];
#pragma unroll
            for (int ml = 0; ml < 2; ++ml)
#pragma unroll
                for (int q = 0; q < 4; ++q) p[ml][q] = *(const f32x4*)(rs + (size_t)(row0 + ai * HALF + (2 * mh + ml) * 16) * 16 + 4 * q);
            __builtin_amdgcn_sched_barrier(0);
#pragma unroll
            for (int ml = 0; ml < 2; ++ml) { const f32x4 t = (p[ml][0] + p[ml][1]) + (p[ml][2] + p[ml][3]); sc[ai][2 * mh + ml] = rsqrtf(((t[0] + t[1]) + (t[2] + t[3])) * (1.0f / 1024.0f) + 1e-6f); }
            __builtin_amdgcn_sched_barrier(0); }
}
__device__ __forceinline__ float sigm(float x) { return __builtin_amdgcn_rcpf(1.0f + __expf(-x)); }
struct EpiSwiglu {
    static constexpr bool PERM = true, AFTER_DRAIN = false;
    bf16_t* O; int ldc; const float* rs;
    __device__ __forceinline__ void operator()(const f32x4 (&acc)[2][2][4][2], const Unit& u, int wr, int wc, int fr_, int fq_) const {
        unsigned on_ = ~0u; asm volatile("" : "+s"(on_)); const int ln_ = (int)__builtin_amdgcn_mbcnt_hi(on_, __builtin_amdgcn_mbcnt_lo(on_, 0u)), fr = ln_ & 15, fq = ln_ >> 4; (void)fr_; (void)fq_;
        const int row0 = u.pm * BM + wr * 64 + fr, col0 = u.pn * HALF + wc * 32 + 8 * fq;
        float sc[2][4]; row_scales8(rs, row0, sc);
#pragma unroll
        for (int ai = 0; ai < 2; ++ai)
#pragma unroll
            for (int m = 0; m < 4; ++m) { const int row = row0 + ai * HALF + m * 16; const float s = sc[ai][m];
                float o[8];
#pragma unroll
                for (int n = 0; n < 2; ++n)
#pragma unroll
                    for (int i = 0; i < 4; ++i) { const float g = acc[ai][0][m][n][i] * s, up = acc[ai][1][m][n][i] * s; o[n * 4 + i] = g * sigm(g) * up; }
                u32x4 w; w.x = cvt_pk_bf16(o[0], o[1]); w.y = cvt_pk_bf16(o[2], o[3]); w.z = cvt_pk_bf16(o[4], o[5]); w.w = cvt_pk_bf16(o[6], o[7]);
                *(u32x4*)(O + (size_t)row * ldc + col0) = w; }
    }
};
struct EpiZ {
    static constexpr bool PERM = true, AFTER_DRAIN = false;
    bf16_t* Z; int ldz; const float* rs; float* R; int r_tile;
    __device__ __forceinline__ void operator()(const f32x4 (&acc)[2][2][4][2], const Unit& u, int wr, int wc, int fr_, int fq_) const {
        unsigned on_ = ~0u; asm volatile("" : "+s"(on_)); const int ln_ = (int)__builtin_amdgcn_mbcnt_hi(on_, __builtin_amdgcn_mbcnt_lo(on_, 0u)), fr = ln_ & 15, fq = ln_ >> 4; (void)fr_; (void)fq_;
        const int row0 = u.pm * BM + wr * 64 + fr, col0 = u.pn * BM + wc * 32 + 8 * fq;
        if (u.pn == r_tile) {
            if (wc == 0 && fq < 2) {
#pragma unroll
                for (int ai = 0; ai < 2; ++ai)
#pragma unroll
                    for (int m = 0; m < 4; ++m) { const int row = row0 + ai * HALF + m * 16; const float s = row_scale(rs, row);
#pragma unroll
                        for (int n = 0; n < 2; ++n) *(f32x4*)(R + (size_t)row * 16 + 8 * fq + 4 * n) = acc[ai][0][m][n] * s; }
            }
            return;
        }
        float sc[2][4]; row_scales8(rs, row0, sc);
#pragma unroll
        for (int ai = 0; ai < 2; ++ai)
#pragma unroll
            for (int m = 0; m < 4; ++m) { const int row = row0 + ai * HALF + m * 16; const float s = sc[ai][m];
#pragma unroll
                for (int bj = 0; bj < 2; ++bj) { const f32x4 v0 = acc[ai][bj][m][0] * s, v1 = acc[ai][bj][m][1] * s;
                    u32x4 w; w.x = cvt_pk_bf16(v0[0], v0[1]); w.y = cvt_pk_bf16(v0[2], v0[3]); w.z = cvt_pk_bf16(v1[0], v1[1]); w.w = cvt_pk_bf16(v1[2], v1[3]);
                    *(u32x4*)(Z + (size_t)row * ldz + col0 + bj * HALF) = w; } }
    }
};
struct EpiResid {
    static constexpr bool PERM = true, AFTER_DRAIN = false;
    const float* xin; bf16_t* hb; float* rs_out; float alpha;
    __device__ __forceinline__ void operator()(const f32x4 (&acc)[2][2][4][2], const Unit& u, int wr, int wc, int fr_, int fq_) const {
        unsigned on_ = ~0u; asm volatile("" : "+s"(on_)); const int ln_ = (int)__builtin_amdgcn_mbcnt_hi(on_, __builtin_amdgcn_mbcnt_lo(on_, 0u)), fr = ln_ & 15, fq = ln_ >> 4; (void)fr_; (void)fq_;
        const int row0 = u.pm * BM + wr * 64 + fr, col0 = u.pn * BM + wc * 32 + 8 * fq;
#pragma unroll
        for (int ai = 0; ai < 2; ++ai)
#pragma unroll
            for (int mh = 0; mh < 2; ++mh) { f32x4 hv[2][2][2];
                if (xin) {
#pragma unroll
                    for (int ml = 0; ml < 2; ++ml)
#pragma unroll
                        for (int bj = 0; bj < 2; ++bj)
#pragma unroll
                            for (int n = 0; n < 2; ++n) hv[ml][bj][n] = *(const f32x4*)(xin + (size_t)(row0 + ai * HALF + (2 * mh + ml) * 16) * 1024 + col0 + bj * HALF + 4 * n);
                } else { u32x4 hw[2][2];
#pragma unroll
                    for (int ml = 0; ml < 2; ++ml)
#pragma unroll
                        for (int bj = 0; bj < 2; ++bj) hw[ml][bj] = *(const u32x4*)(hb + (size_t)(row0 + ai * HALF + (2 * mh + ml) * 16) * 1024 + col0 + bj * HALF);
#pragma unroll
                    for (int ml = 0; ml < 2; ++ml)
#pragma unroll
                        for (int bj = 0; bj < 2; ++bj) { const u32x4 x = hw[ml][bj];
                            hv[ml][bj][0] = (f32x4){__uint_as_float(x.x << 16), __uint_as_float(x.x & 0xffff0000u), __uint_as_float(x.y << 16), __uint_as_float(x.y & 0xffff0000u)};
                            hv[ml][bj][1] = (f32x4){__uint_as_float(x.z << 16), __uint_as_float(x.z & 0xffff0000u), __uint_as_float(x.w << 16), __uint_as_float(x.w & 0xffff0000u)}; } }
                __builtin_amdgcn_sched_barrier(0);
#pragma unroll
                for (int ml = 0; ml < 2; ++ml) { const int m = 2 * mh + ml, row = row0 + ai * HALF + m * 16; float ss = 0.f;
#pragma unroll
                    for (int bj = 0; bj < 2; ++bj) { const f32x4 o0 = hv[ml][bj][0] + acc[ai][bj][m][0] * alpha, o1 = hv[ml][bj][1] + acc[ai][bj][m][1] * alpha;
                        ss += ((o0[0] * o0[0] + o0[1] * o0[1]) + (o0[2] * o0[2] + o0[3] * o0[3])) + ((o1[0] * o1[0] + o1[1] * o1[1]) + (o1[2] * o1[2] + o1[3] * o1[3]));
                        u32x4 w; w.x = cvt_pk_bf16(o0[0], o0[1]); w.y = cvt_pk_bf16(o0[2], o0[3]); w.z = cvt_pk_bf16(o1[0], o1[1]); w.w = cvt_pk_bf16(o1[2], o1[3]);
                        *(u32x4*)(hb + (size_t)row * 1024 + col0 + bj * HALF) = w; }
                    ss += __builtin_bit_cast(float, __builtin_amdgcn_ds_bpermute((ln_ ^ 16) << 2, __builtin_bit_cast(int, ss))); ss += __builtin_bit_cast(float, __builtin_amdgcn_ds_bpermute((ln_ ^ 32) << 2, __builtin_bit_cast(int, ss)));
                    if (fq == 0) rs_out[(size_t)row * 16 + u.pn * 4 + wc] = ss; }
                __builtin_amdgcn_sched_barrier(0); }
    }
};
struct EpiStorePP {
    static constexpr bool PERM = false, AFTER_DRAIN = false;
    bf16_t* O;
    __device__ __forceinline__ void operator()(const f32x4 (&acc)[2][2][4][2], const Unit& u, int wr, int wc, int fr_, int fq_) const {
        unsigned on_ = ~0u; asm volatile("" : "+s"(on_)); const int ln_ = (int)__builtin_amdgcn_mbcnt_hi(on_, __builtin_amdgcn_mbcnt_lo(on_, 0u)), fr = ln_ & 15, fq = ln_ >> 4; (void)fr_; (void)fq_;
        const int row0 = u.pm * BM + wr * 64 + fr, col0 = u.pn * BM + wc * 32 + 4 * fq;
#pragma unroll
        for (int ai = 0; ai < 2; ++ai)
#pragma unroll
            for (int m = 0; m < 4; ++m)
#pragma unroll
                for (int bj = 0; bj < 2; ++bj)
#pragma unroll
                    for (int n = 0; n < 2; ++n) { const f32x4 v = acc[ai][bj][m][n]; u32x2 w; w.x = cvt_pk_bf16(v[0], v[1]); w.y = cvt_pk_bf16(v[2], v[3]);
                        *(u32x2*)(O + (size_t)(row0 + ai * HALF + m * 16) * 1024 + col0 + bj * HALF + n * 16) = w; }
    }
};
struct EpiPle {
    static constexpr bool PERM = false, AFTER_DRAIN = false;
    const bf16_t* hbin; bf16_t* hb; const float* rs_in; float* rs_out; const bf16_t* pp;
    __device__ __forceinline__ void operator()(const f32x4 (&acc)[2][2][4][2], const Unit& u, int wr, int wc, int fr_, int fq_) const {
        unsigned on_ = ~0u; asm volatile("" : "+s"(on_)); const int ln_ = (int)__builtin_amdgcn_mbcnt_hi(on_, __builtin_amdgcn_mbcnt_lo(on_, 0u)), fr = ln_ & 15, fq = ln_ >> 4; (void)fr_; (void)fq_;
        const int row0 = u.pm * BM + wr * 64 + fr, col0 = u.pn * BM + wc * 32 + 4 * fq;
#pragma unroll
        for (int ai = 0; ai < 2; ++ai)
#pragma unroll
            for (int m = 0; m < 4; ++m) { const int row = row0 + ai * HALF + m * 16; const float s = row_scale(rs_in, row); float ss = 0.f;
#pragma unroll
                for (int bj = 0; bj < 2; ++bj)
#pragma unroll
                    for (int n = 0; n < 2; ++n) { const size_t off = (size_t)row * 1024 + col0 + bj * HALF + n * 16;
                        const u32x2 pw = *(const u32x2*)(pp + off); const f32x4 a = acc[ai][bj][m][n] * s, p = {__uint_as_float(pw.x << 16), __uint_as_float(pw.x & 0xffff0000u), __uint_as_float(pw.y << 16), __uint_as_float(pw.y & 0xffff0000u)}; const u32x2 hx = *(const u32x2*)(hbin + off); f32x4 o = {__uint_as_float(hx.x << 16), __uint_as_float(hx.x & 0xffff0000u), __uint_as_float(hx.y << 16), __uint_as_float(hx.y & 0xffff0000u)};
                        o[0] += sigm(a[0]) * p[0]; o[1] += sigm(a[1]) * p[1]; o[2] += sigm(a[2]) * p[2]; o[3] += sigm(a[3]) * p[3];
                        ss += (o[0] * o[0] + o[1] * o[1]) + (o[2] * o[2] + o[3] * o[3]);
                        u32x2 w; w.x = cvt_pk_bf16(o[0], o[1]); w.y = cvt_pk_bf16(o[2], o[3]); *(u32x2*)(hb + off) = w; }
                ss += __builtin_bit_cast(float, __builtin_amdgcn_ds_bpermute((ln_ ^ 16) << 2, __builtin_bit_cast(int, ss))); ss += __builtin_bit_cast(float, __builtin_amdgcn_ds_bpermute((ln_ ^ 32) << 2, __builtin_bit_cast(int, ss)));
                if (fq == 0) rs_out[(size_t)row * 16 + u.pn * 4 + wc] = ss; }
    }
};
template <class Epi, class Sched, bool ALIGN_EPI = false, bool SP2 = false>
__device__ __forceinline__ void gemm_phase(PG8_LAS unsigned char* lds, const Gemm g, const Sched& S, const Epi& E, const int tid) {
    const int wid = __builtin_amdgcn_readfirstlane(tid >> 6), lane = tid & 63, wr = wid >> 2, wc = wid & 3, fr = lane & 15, fq = lane >> 4;
    const int K = g.K, nt = K / BK;
    unsigned voffA[2], voffB[2];
#pragma unroll
    for (int i = 0; i < 2; ++i) { int R, C; stage_rc(tid * 16 + i * 8192, R, C); const int Rb = Epi::PERM ? ((R & ~31) + perm32(R & 31)) : R;
        voffA[i] = (unsigned)(R * K + C) * 2u; voffB[i] = (unsigned)(Rb * K + C) * 2u; }
    const size_t kstep = (size_t)(BK * 2);
    const size_t hstep = (size_t)HALF * K * 2;
    const size_t tstep = 2 * hstep;
    const unsigned ldsw = (unsigned)wid * 1024u;
    const int aoff = lds_byte(wr * 64 + fr, fq * 8), boff = lds_byte(wc * 32 + fr, fq * 8);
#define PG8_SA(b, h) (((b) * 2 + (h)) * HTB)
#define PG8_SB(b, h) ((4 + (b) * 2 + (h)) * HTB)
#define PG8_STAGE(bufoff, gbase, voff) do { _Pragma("unroll") for (int _i = 0; _i < 2; ++_i) \
        __builtin_amdgcn_global_load_lds((const unsigned*)((const char*)(gbase) + (voff)[_i]), (PG8_LAS unsigned*)(lds + (bufoff) + ldsw + _i * 8192), 16, 0, 0); } while (0)
#define PG8_LDA(dst, b, h) do { _Pragma("unroll") for (int m = 0; m < 4; ++m) _Pragma("unroll") for (int k = 0; k < 2; ++k) dst[m][k] = *(const PG8_LAS bf16x8*)(lds + PG8_SA(b, h) + aoff + m * 2048 + k * 1024); } while (0)
#define PG8_LDB(dst, b, h) do { _Pragma("unroll") for (int n = 0; n < 2; ++n) _Pragma("unroll") for (int k = 0; k < 2; ++k) dst[n][k] = *(const PG8_LAS bf16x8*)(lds + PG8_SB(b, h) + boff + n * 2048 + k * 1024); } while (0)
#define PG8_MMA(ai, bj, At, Bt) do { __builtin_amdgcn_s_setprio(1); _Pragma("unroll") for (int m = 0; m < 4; ++m) _Pragma("unroll") for (int n = 0; n < 2; ++n) _Pragma("unroll") for (int k = 0; k < 2; ++k) \
        acc[ai][bj][m][n] = __builtin_amdgcn_mfma_f32_16x16x32_bf16(Bt[n][k], At[m][k], acc[ai][bj][m][n], 0, 0, 0); __builtin_amdgcn_s_setprio(0); } while (0)
#define PG8_WAIT_V(n) asm volatile("s_waitcnt vmcnt(" #n ")" ::: "memory")
#define PG8_WAIT_L(n) asm volatile("s_waitcnt lgkmcnt(" #n ")" ::: "memory")
#define PG8_BAR __builtin_amdgcn_s_barrier()
#define PG8_SCHED __builtin_amdgcn_sched_barrier(0)
    Unit cur, nxt; int ui = 0;
    if (!S.next(0, cur)) return;
    f32x4 acc[2][2][4][2];
#pragma unroll
    for (int a = 0; a < 2; ++a)
#pragma unroll
        for (int b = 0; b < 2; ++b)
#pragma unroll
            for (int m = 0; m < 4; ++m)
#pragma unroll
                for (int n = 0; n < 2; ++n) acc[a][b][m][n] = (f32x4){0.f, 0.f, 0.f, 0.f};
    bf16x8 At[4][2], B0[2][2], B1[2][2];
    const char* cA = (const char*)g.A + (size_t)cur.pm * tstep; const char* cB = (const char*)g.Bt + (size_t)cur.pn * tstep;
    S.a_ready(cur);
    if constexpr (SP2) {
        PG8_STAGE(PG8_SB(0, 0), cB, voffB); PG8_STAGE(PG8_SB(0, 1), cB + hstep, voffB); PG8_STAGE(PG8_SA(0, 0), cA, voffA); PG8_STAGE(PG8_SA(0, 1), cA + hstep, voffA);
        if (wr == 1) PG8_BAR;
        PG8_WAIT_V(2); PG8_BAR;
        PG8_STAGE(PG8_SB(1, 0), cB + kstep, voffB); PG8_STAGE(PG8_SA(1, 0), cA + kstep, voffA); PG8_STAGE(PG8_SB(1, 1), cB + hstep + kstep, voffB);
        PG8_WAIT_V(6); PG8_BAR;
    } else {
        PG8_STAGE(PG8_SB(0, 0), cB, voffB); PG8_STAGE(PG8_SA(0, 0), cA, voffA); PG8_STAGE(PG8_SB(0, 1), cB + hstep, voffB); PG8_STAGE(PG8_SA(0, 1), cA + hstep, voffA);
        if (wr == 1) PG8_BAR;
        PG8_WAIT_V(4); PG8_BAR;
        PG8_STAGE(PG8_SB(1, 0), cB + kstep, voffB); PG8_STAGE(PG8_SA(1, 0), cA + kstep, voffA); PG8_STAGE(PG8_SB(1, 1), cB + hstep + kstep, voffB);
        PG8_WAIT_V(6); PG8_BAR;
    }
    for (;;) {
        const bool has_next = S.next(ui + 1, nxt);
        const char* nA = has_next ? (const char*)g.A + (size_t)nxt.pm * tstep : cA; const char* nB = has_next ? (const char*)g.Bt + (size_t)nxt.pn * tstep : cB;
        for (int t = 0; t < nt; t += 2) {
            const bool last = (t == nt - 2);
            const char* a1 = cA + (size_t)(t + 1) * kstep;
            const char* a2 = last ? nA : cA + (size_t)(t + 2) * kstep; const char* b2 = last ? nB : cB + (size_t)(t + 2) * kstep;
            const char* a3 = a2 + kstep; const char* b3 = b2 + kstep;
            if (last && has_next) S.a_ready(nxt);
            if constexpr (SP2) {
            PG8_LDB(B0, 0, 0); PG8_LDB(B1, 0, 1); PG8_SCHED; PG8_LDA(At, 0, 0); PG8_STAGE(PG8_SA(1, 1), a1 + hstep, voffA);
            PG8_WAIT_V(8); PG8_WAIT_L(0); PG8_BAR; PG8_MMA(0, 0, At, B0); PG8_MMA(0, 1, At, B1); PG8_BAR; PG8_SCHED;
            PG8_LDA(At, 0, 1); PG8_STAGE(PG8_SB(0, 0), b2, voffB); PG8_STAGE(PG8_SB(0, 1), b2 + hstep, voffB); PG8_STAGE(PG8_SA(0, 0), a2, voffA);
            PG8_WAIT_V(8); PG8_WAIT_L(0); PG8_BAR; PG8_MMA(1, 0, At, B0); PG8_MMA(1, 1, At, B1); PG8_BAR; PG8_SCHED;
            PG8_LDB(B0, 1, 0); PG8_LDB(B1, 1, 1); PG8_SCHED; PG8_LDA(At, 1, 0); PG8_STAGE(PG8_SA(0, 1), a2 + hstep, voffA);
            PG8_WAIT_V(8); PG8_WAIT_L(0); PG8_BAR; PG8_MMA(0, 0, At, B0); PG8_MMA(0, 1, At, B1); PG8_BAR; PG8_SCHED;
            PG8_LDA(At, 1, 1); PG8_STAGE(PG8_SB(1, 0), b3, voffB); PG8_STAGE(PG8_SB(1, 1), b3 + hstep, voffB); PG8_STAGE(PG8_SA(1, 0), a3, voffA);
            PG8_WAIT_V(8); PG8_WAIT_L(0); PG8_BAR; PG8_MMA(1, 0, At, B0); PG8_MMA(1, 1, At, B1); PG8_BAR; PG8_SCHED;
            } else {
            PG8_LDB(B0, 0, 0); PG8_SCHED; PG8_LDA(At, 0, 0); PG8_STAGE(PG8_SA(1, 1), a1 + hstep, voffA);
            PG8_WAIT_L(8); PG8_BAR; PG8_WAIT_L(0); PG8_MMA(0, 0, At, B0); PG8_BAR; PG8_SCHED;
            PG8_LDB(B1, 0, 1); PG8_STAGE(PG8_SB(0, 0), b2, voffB);
            PG8_BAR; PG8_WAIT_L(0); PG8_MMA(0, 1, At, B1); PG8_BAR;
            PG8_LDA(At, 0, 1); PG8_STAGE(PG8_SA(0, 0), a2, voffA);
            PG8_BAR; PG8_WAIT_L(0); PG8_MMA(1, 0, At, B0); PG8_BAR; PG8_SCHED;
            PG8_STAGE(PG8_SB(0, 1), b2 + hstep, voffB);
            PG8_WAIT_V(6); PG8_BAR; PG8_MMA(1, 1, At, B1); PG8_BAR;
            PG8_LDB(B0, 1, 0); PG8_SCHED; PG8_LDA(At, 1, 0); PG8_STAGE(PG8_SA(0, 1), a2 + hstep, voffA);
            PG8_WAIT_L(8); PG8_BAR; PG8_WAIT_L(0); PG8_MMA(0, 0, At, B0); PG8_BAR; PG8_SCHED;
            PG8_LDB(B1, 1, 1); PG8_STAGE(PG8_SB(1, 0), b3, voffB);
            PG8_BAR; PG8_WAIT_L(0); PG8_MMA(0, 1, At, B1); PG8_BAR;
            PG8_LDA(At, 1, 1); PG8_STAGE(PG8_SA(1, 0), a3, voffA);
            PG8_BAR; PG8_WAIT_L(0); PG8_MMA(1, 0, At, B0); PG8_BAR; PG8_SCHED;
            PG8_STAGE(PG8_SB(1, 1), b3 + hstep, voffB);
            PG8_WAIT_V(6); PG8_BAR; PG8_MMA(1, 1, At, B1); PG8_BAR;
            }
        }
        if constexpr (ALIGN_EPI) { if (wr == 0) PG8_BAR; }
        if constexpr (!Epi::AFTER_DRAIN) { E(acc, cur, wr, wc, fr, fq); S.done(cur); }
        if (!has_next) break;
#pragma unroll
        for (int a = 0; a < 2; ++a)
#pragma unroll
            for (int b = 0; b < 2; ++b)
#pragma unroll
                for (int m = 0; m < 4; ++m)
#pragma unroll
                    for (int n = 0; n < 2; ++n) acc[a][b][m][n] = (f32x4){0.f, 0.f, 0.f, 0.f};
        cur = nxt; cA = nA; cB = nB; ++ui;
        if constexpr (ALIGN_EPI) { if (wr == 1) PG8_BAR; }
    }
    PG8_WAIT_V(0);
    if constexpr (!ALIGN_EPI) { if (wr == 0) PG8_BAR; }
    PG8_BAR;
    if constexpr (Epi::AFTER_DRAIN) { E.fused(acc, cur, wr, wc, fr, fq, lds, wid, lane); S.done(cur); }
#undef PG8_SA
#undef PG8_SB
#undef PG8_STAGE
#undef PG8_LDA
#undef PG8_LDB
#undef PG8_MMA
#undef PG8_WAIT_V
#undef PG8_WAIT_L
#undef PG8_BAR
#undef PG8_SCHED
}
}
#include <hip/hip_cooperative_groups.h>
namespace cg = cooperative_groups;
#define LAS __attribute__((address_space(3)))
typedef unsigned short bf16;
typedef float f32x4 __attribute__((ext_vector_type(4)));
typedef short bf16x8 __attribute__((ext_vector_type(8)));
typedef unsigned v4u __attribute__((ext_vector_type(4)));
typedef unsigned v2u __attribute__((ext_vector_type(2)));
constexpr int D = 1024, NPR = 16384, NSM = 512, M = NPR + NSM, SEQ = 2048, NB = 8, DB = 128, FF = 2816, PLE = 256, NCH = 32;
constexpr int NWAVES = 8, LDS_BYTES = 147456, NPH = 22;
constexpr size_t WGU_SZ = (size_t)5632 * 1024 * 2, WDN_SZ = (size_t)1024 * 2816 * 2, WSQ_SZ = (size_t)1024 * 1024 * 2, WPP_SZ = (size_t)1024 * 256 * 2;
constexpr size_t OFF_WGU = 0, OFF_WDN = OFF_WGU + 4 * WGU_SZ, OFF_WGIN = OFF_WDN + 4 * WDN_SZ, OFF_WHIN = OFF_WGIN + (size_t)3328 * 1024 * 2,
    OFF_WOUT = OFF_WHIN + (size_t)4096 * 1024 * 2, OFF_WPG = OFF_WOUT + 2 * WSQ_SZ, OFF_WPP = OFF_WPG + 2 * WSQ_SZ, OFF_HB = OFF_WPP + 2 * WPP_SZ;
constexpr size_t HB_SZ = (size_t)M * 1024 * 2;
constexpr size_t OFF_BIG = OFF_HB + 2 * HB_SZ, OFF_PB = OFF_BIG + (size_t)M * 4096 * 2, PB_SZ = (size_t)M * 256 * 2, OFF_AB = OFF_PB + 2 * PB_SZ,
    OFF_DB = OFF_AB + (size_t)2048 * 4096 * 2, OFF_RS = OFF_DB + (size_t)2048 * 128 * 4, RS_SZ = (size_t)M * 16 * 4, OFF_R = OFF_RS + 2 * RS_SZ, OFF_PSB = OFF_R + RS_SZ, OFF_PP = OFF_PSB  , WS_END = OFF_PSB + (size_t)67108864, OFF_LBT = WS_END, OFF_CTL = OFF_LBT + 16384, CTL_BYTES = 16384, WS_TOTAL = OFF_CTL + CTL_BYTES;
constexpr size_t OUT_YS = (size_t)NPR * D, OUT_GP = (size_t)M * D, OUT_GS = OUT_GP + 1048576, OUT_HP = OUT_GS + 16777216, OUT_HS = OUT_HP + 1048576, OUT_END = OUT_HS + 16777216;

__device__ __forceinline__ float bf2f(unsigned short u) { return __uint_as_float((unsigned)u << 16); }
__device__ __forceinline__ float bflo(unsigned u) { return __uint_as_float(u << 16); }
__device__ __forceinline__ float bfhi(unsigned u) { return __uint_as_float(u & 0xffff0000u); }
__device__ __forceinline__ unsigned pk2(float lo, float hi) { return pg8::cvt_pk_bf16(lo, hi); }
__device__ __forceinline__ float sigm(float x) { return __builtin_amdgcn_rcpf(1.0f + __expf(-x)); }
__device__ __forceinline__ float logsig(float x) { return fminf(x, 0.f) - __logf(1.0f + __expf(-fabsf(x))); }
__device__ __forceinline__ float wave_sum(float v) {
#pragma unroll
    for (int o = 1; o < 64; o <<= 1) v += __shfl_xor(v, o);
    return v;
}
#define LDS_WAIT() asm volatile("s_waitcnt lgkmcnt(0)" ::: "memory")
#define BAR_LDS() do { asm volatile("s_waitcnt lgkmcnt(0)" ::: "memory"); __builtin_amdgcn_s_barrier(); asm volatile("" ::: "memory"); } while (0)

__device__ __forceinline__ void tr_item(const float* W, int Nsrc, int K, bf16* WT, const float* sk, int item, int nblk, int mode, int nvalid, LAS float* scr, int lane) {
    const int kb = item / nblk, nb = item % nblk, k0 = 64 * kb, n0 = 64 * nb;
    int src0 = n0, valid = 64;
    if (mode == 1) { const int pn = n0 >> 8, within = n0 & 255, half = within >> 7, j = within & 127; src0 = half * FF + 128 * pn + j; }
    if (mode == 2) { valid = nvalid - n0; valid = valid < 0 ? 0 : (valid > 64 ? 64 : valid); }
    const int c4 = (lane & 15) * 4, kr = lane >> 4;
    const float* wp = W + (size_t)(k0 + kr) * Nsrc + src0 + c4;
    f32x4 v[16];
#pragma unroll
    for (int i = 0; i < 16; ++i) v[i] = (c4 < valid) ? __builtin_nontemporal_load((const f32x4*)(wp + (size_t)(4 * i) * Nsrc)) : (f32x4){0.f, 0.f, 0.f, 0.f};
    __builtin_amdgcn_sched_barrier(0);
#pragma unroll
    for (int i = 0; i < 16; ++i) { const int kk = 4 * i + kr; const float s = sk ? sk[k0 + kk] : 1.0f; LAS float* d = scr + kk * 65 + c4; d[0] = v[i][0] * s; d[1] = v[i][1] * s; d[2] = v[i][2] * s; d[3] = v[i][3] * s; }
    LDS_WAIT();
    const int ch = lane & 7;
#pragma unroll
    for (int j = 0; j < 8; ++j) { const int n = (lane >> 3) + 8 * j; const LAS float* s = scr + (8 * ch) * 65 + n;
        v4u o; o.x = pk2(s[0 * 65], s[1 * 65]); o.y = pk2(s[2 * 65], s[3 * 65]); o.z = pk2(s[4 * 65], s[5 * 65]); o.w = pk2(s[6 * 65], s[7 * 65]);
        *(v4u*)(WT + (size_t)(n0 + n) * K + k0 + 8 * ch) = o; }
    LDS_WAIT();
}
struct Args { const float* in[26]; float* out; unsigned char* ws; int ph_lo, ph_hi; };
typedef const Args __attribute__((address_space(4))) CArgs;

__device__ __forceinline__ void prologue(CArgs* a, unsigned char* ws, float* outp, LAS unsigned char* lds, int tid, int bid, int G) {
    const int lane = tid & 63, wave = tid >> 6;
    LAS float* scr = (LAS float*)(lds + wave * 16640);
    const int gw = bid * NWAVES + wave, NGW = G * NWAVES;
    constexpr int I_GU = 16 * 88, I_DN = 44 * 16, I_GIN = 16 * 52, I_HIN = 16 * 64, I_SQ = 16 * 16, I_PP = 4 * 16;
    constexpr int NITEMS = 4 * I_GU + 4 * I_DN + I_GIN + I_HIN + 4 * I_SQ + 2 * I_PP;
    for (int it = gw; it < NITEMS; it += NGW) {
        int r = it;
        if (r < 4 * I_GU) { const int q = r / I_GU, li = q >> 1, f = q & 1; r -= q * I_GU;
            tr_item((f ? a->in[20] : a->in[7]) + (size_t)li * 1024 * 5632, 5632, 1024, (bf16*)(ws + OFF_WGU + q * WGU_SZ), (f ? a->in[19] : a->in[6]) + li * 1024, r, 88, 1, 0, scr, lane); continue; }
        r -= 4 * I_GU;
        if (r < 4 * I_DN) { const int q = r / I_DN, li = q >> 1, f = q & 1; r -= q * I_DN;
            tr_item((f ? a->in[21] : a->in[8]) + (size_t)li * 2816 * 1024, 1024, 2816, (bf16*)(ws + OFF_WDN + q * WDN_SZ), nullptr, r, 16, 0, 0, scr, lane); continue; }
        r -= 4 * I_DN;
        if (r < I_GIN) { tr_item(a->in[10], 3088, 1024, (bf16*)(ws + OFF_WGIN), a->in[9], r, 52, 2, 3088, scr, lane); continue; }
        r -= I_GIN;
        if (r < I_HIN) { tr_item(a->in[15], 4096, 1024, (bf16*)(ws + OFF_WHIN), a->in[9] + 1024, r, 64, 0, 0, scr, lane); continue; }
        r -= I_HIN;
        if (r < I_SQ) { tr_item(a->in[14], 1024, 1024, (bf16*)(ws + OFF_WOUT), nullptr, r, 16, 0, 0, scr, lane); continue; }
        r -= I_SQ;
        if (r < I_SQ) { tr_item(a->in[17], 1024, 1024, (bf16*)(ws + OFF_WOUT + WSQ_SZ), nullptr, r, 16, 0, 0, scr, lane); continue; }
        r -= I_SQ;
        if (r < 2 * I_SQ) { const int li = r / I_SQ; r -= li * I_SQ;
            tr_item(a->in[23] + (size_t)li * 1024 * 1024, 1024, 1024, (bf16*)(ws + OFF_WPG + li * WSQ_SZ), a->in[22] + li * 1024, r, 16, 0, 0, scr, lane); continue; }
        r -= 2 * I_SQ;
        { const int li = r / I_PP; r -= li * I_PP;
            tr_item(a->in[24] + (size_t)li * 256 * 1024, 1024, 256, (bf16*)(ws + OFF_WPP + li * WPP_SZ), nullptr, r, 16, 0, 0, scr, lane); }
    }
    bf16* hb = (bf16*)(ws + OFF_HB); float* rs = (float*)(ws + OFF_RS);
    for (int m0 = gw; m0 < M; m0 += 2 * NGW) {
        const int m1 = m0 + NGW; const bool has1 = m1 < M;
        const float* xr0 = m0 < NPR ? a->in[0] + (size_t)m0 * D : a->in[1] + (size_t)(m0 - NPR) * D;
        const float* xr1 = !has1 ? xr0 : (m1 < NPR ? a->in[0] + (size_t)m1 * D : a->in[1] + (size_t)(m1 - NPR) * D);
        f32x4 v0[4], v1[4];
#pragma unroll
        for (int j = 0; j < 4; ++j) { v0[j] = __builtin_nontemporal_load((const f32x4*)xr0 + lane + 64 * j); v1[j] = __builtin_nontemporal_load((const f32x4*)xr1 + lane + 64 * j); }
        float s0 = 0.f, s1 = 0.f;
#pragma unroll
        for (int j = 0; j < 4; ++j) { s0 += (v0[j][0] * v0[j][0] + v0[j][1] * v0[j][1]) + (v0[j][2] * v0[j][2] + v0[j][3] * v0[j][3]); s1 += (v1[j][0] * v1[j][0] + v1[j][1] * v1[j][1]) + (v1[j][2] * v1[j][2] + v1[j][3] * v1[j][3]);
            v2u w; w.x = pk2(v0[j][0], v0[j][1]); w.y = pk2(v0[j][2], v0[j][3]); *((v2u*)(hb + (size_t)m0 * D) + lane + 64 * j) = w;
            if (has1) { v2u w1; w1.x = pk2(v1[j][0], v1[j][1]); w1.y = pk2(v1[j][2], v1[j][3]); *((v2u*)(hb + (size_t)m1 * D) + lane + 64 * j) = w1; } }
        s0 = wave_sum(s0); s1 = wave_sum(s1);
        if (lane < 16) { rs[(size_t)m0 * 16 + lane] = lane == 0 ? s0 : 0.f; if (has1) rs[(size_t)m1 * 16 + lane] = lane == 0 ? s1 : 0.f; }
    }
    { const int gt0 = bid * (NWAVES * 64) + tid; if (gt0 < 1024) { const float x0 = a->in[18][gt0], x1 = a->in[18][1024 + gt0];
        *(f32x4*)((float*)(ws + OFF_LBT) + 4 * gt0) = (f32x4){logsig(x1 - x0), logsig(x0 - x1), sigm(x0 - x1), 0.f}; } }
    const int gt = bid * (NWAVES * 64) + tid, NGT = G * NWAVES * 64;
    for (int e = gt; e < 2 * M * 32; e += NGT) { const int li = e / (M * 32), rem = e % (M * 32), m = rem >> 5, c8 = (rem & 31) * 8;
        const float* src = m < NPR ? a->in[4] + ((size_t)li * NPR + m) * 256 + c8 : a->in[5] + ((size_t)li * NSM + (m - NPR)) * 256 + c8;
        const f32x4 v0 = __builtin_nontemporal_load((const f32x4*)src), v1 = __builtin_nontemporal_load((const f32x4*)(src + 4));
        v4u w; w.x = pk2(v0[0], v0[1]); w.y = pk2(v0[2], v0[3]); w.z = pk2(v1[0], v1[1]); w.w = pk2(v1[2], v1[3]);
        *(v4u*)((bf16*)(ws + OFF_PB + li * PB_SZ) + (size_t)m * 256 + c8) = w; }
}
template <bool HG> struct MX {
    static constexpr int H = HG ? 8 : 4, DV = HG ? 128 : 256, LDZ = HG ? 4096 : 3328, KC = HG ? 1024 : 512, VC = HG ? 2048 : 1024, GC = HG ? 3072 : 2048, VR = DV / 64, NVG = DV / 16, NVR = DV / 64;
    static constexpr float scale = HG ? 1.0f : 0.08838834764831845f;
};
template <bool HG> __device__ __forceinline__ void prep_phase(LAS unsigned char* lds, bf16* Z, const float* R, const float* wup, const float* bgk, const float* lbt, bf16* AB, float* DBUF, bf16* PB, int tid, int bid, int G) {
    typedef MX<HG> C; constexpr int H = C::H, DV = C::DV, LDZ = C::LDZ, KC = C::KC, VC = C::VC, VR = C::VR, QP = 136, TP = 72, NG = DV / 128, NGV = DV / 16;
    LAS float* gl = (LAS float*)lds; LAS float* segs = (LAS float*)(lds + 32768);
    LAS bf16* qe_s = (LAS bf16*)(lds + 34816); LAS bf16* kn_s = (LAS bf16*)(lds + 52224); LAS bf16* kdT_s = (LAS bf16*)(lds + 69632); LAS bf16* vT_s = (LAS bf16*)(lds + 88064);
    const int t = tid >> 3, cs = tid & 7, j0 = cs * 16, lane = tid & 63, w = tid >> 6;
    const int tsw = (((t >> 3) ^ cs) << 3) + (t & 7);
    v4u pq0, pq1, pk0, pk1, pv[DV / 64];
#define PREP_LOAD(u_) do { const int n_ = (u_) % NCH, bh_ = (u_) / NCH, h_ = bh_ % H, b_ = bh_ / H; const bf16* zr_ = Z + ((size_t)b_ * SEQ + 64 * n_ + t) * LDZ; \
        pq0 = *(const v4u*)(zr_ + h_ * 128 + j0); pq1 = *(const v4u*)(zr_ + h_ * 128 + j0 + 8); pk0 = *(const v4u*)(zr_ + KC + h_ * 128 + j0); pk1 = *(const v4u*)(zr_ + KC + h_ * 128 + j0 + 8); \
        _Pragma("unroll") for (int q_ = 0; q_ < DV / 64; ++q_) pv[q_] = *(const v4u*)(zr_ + VC + h_ * DV + cs * (DV / 8) + 8 * q_); } while (0)
    const bool hfix = (G % (NCH * H)) == 0; const int h0 = (bid / NCH) % H;
    float br[4][4], bias[4], ca[16], cc[16], com[16];
    if constexpr (!HG) { const int r_ = lane & 15, quad_ = lane >> 4, cbase_ = 4 * (w & 1);
#pragma unroll
        for (int ks = 0; ks < 4; ++ks)
#pragma unroll
            for (int cb = 0; cb < 4; ++cb) br[cb][ks] = wup[(4 * ks + quad_) * 512 + h0 * 128 + 16 * (cbase_ + cb) + r_];
#pragma unroll
        for (int cb = 0; cb < 4; ++cb) bias[cb] = bgk[h0 * 128 + 16 * (cbase_ + cb) + r_];
    } else {
#pragma unroll
        for (int jj = 0; jj < 16; ++jj) { const f32x4 tc = *(const f32x4*)(lbt + (size_t)(h0 * 128 + j0 + jj) * 4); ca[jj] = tc[0]; cc[jj] = tc[1]; com[jj] = tc[2]; }
    }
    if (bid < NB * H * NCH) PREP_LOAD(bid);
    for (int unit = bid; unit < NB * H * NCH; unit += G) {
        const int n = unit % NCH, bh = unit / NCH, h = bh % H, b = bh / H;
        const size_t tok0 = (size_t)b * SEQ + 64 * n, m = tok0 + t;
        float lbc[16];
        if constexpr (!HG) {
            const int r = lane & 15, quad = lane >> 4, tb = w >> 1, cbase = 4 * (w & 1);
            float ar[4];
#pragma unroll
            for (int ks = 0; ks < 4; ++ks) ar[ks] = R[(tok0 + 16 * tb + r) * 16 + 4 * ks + quad];
            if (!hfix) {
#pragma unroll
                for (int ks = 0; ks < 4; ++ks)
#pragma unroll
                    for (int cb = 0; cb < 4; ++cb) br[cb][ks] = wup[(4 * ks + quad) * 512 + h * 128 + 16 * (cbase + cb) + r];
#pragma unroll
                for (int cb = 0; cb < 4; ++cb) bias[cb] = bgk[h * 128 + 16 * (cbase + cb) + r]; }
#pragma unroll
            for (int cb = 0; cb < 4; ++cb) { f32x4 c = {0.f, 0.f, 0.f, 0.f};
#pragma unroll
                for (int ks = 0; ks < 4; ++ks) c = __builtin_amdgcn_mfma_f32_16x16x4f32(ar[ks], br[cb][ks], c, 0, 0, 0);
#pragma unroll
                for (int j = 0; j < 4; ++j) gl[(16 * tb + 4 * quad + j) * 128 + 16 * (cbase + cb) + r] = logsig(c[j] + bias[cb]) * (1.0f / 16.0f); }
#pragma unroll
            for (int jj = 0; jj < 16; ++jj) lbc[jj] = 0.f;
        } else {
            float g[16];
            const unsigned fw[8] = {pk0.x, pk0.y, pk0.z, pk0.w, pk1.x, pk1.y, pk1.z, pk1.w};
#pragma unroll
            for (int jj = 0; jj < 16; ++jj) { const float f = (jj & 1) ? bfhi(fw[jj >> 1]) : bflo(fw[jj >> 1]);
                if (!hfix) { const f32x4 tc = *(const f32x4*)(lbt + (size_t)(h * 128 + j0 + jj) * 4); ca[jj] = tc[0]; cc[jj] = tc[1]; com[jj] = tc[2]; }
                const float a = ca[jj], b2 = cc[jj] + logsig(f), mx = fmaxf(a, b2);
                g[jj] = mx + __logf(1.0f + __expf(-fabsf(a - b2))); lbc[jj] = com[jj]; }
#pragma unroll
            for (int q = 0; q < 4; ++q) *(LAS f32x4*)(gl + t * 128 + j0 + 4 * q) = (f32x4){g[4 * q], g[4 * q + 1], g[4 * q + 2], g[4 * q + 3]};
        }
        BAR_LDS();
        {
            const int j = tid & 127, sg = tid >> 7; float acc = 0.f;
#pragma unroll
            for (int i = 0; i < 16; ++i) { acc += gl[(16 * sg + i) * 128 + j]; gl[(16 * sg + i) * 128 + j] = acc; }
            segs[sg * 128 + j] = acc;
        }
        BAR_LDS();
        {
            bf16* qp = Z + m * LDZ + h * 128 + j0;
            const v4u q0 = pq0, q1 = pq1, k0 = pk0, k1 = pk1;
            const unsigned qw[8] = {q0.x, q0.y, q0.z, q0.w, q1.x, q1.y, q1.z, q1.w}, kw[8] = {k0.x, k0.y, k0.z, k0.w, k1.x, k1.y, k1.z, k1.w};
            float bb[16], bl[16];
#pragma unroll
            for (int q = 0; q < 4; ++q) { f32x4 x = *(const LAS f32x4*)(gl + t * 128 + j0 + 4 * q), y = *(const LAS f32x4*)(gl + 63 * 128 + j0 + 4 * q);
                const f32x4 g0 = *(const LAS f32x4*)(segs + j0 + 4 * q), g1 = *(const LAS f32x4*)(segs + 128 + j0 + 4 * q), g2 = *(const LAS f32x4*)(segs + 256 + j0 + 4 * q);
                const int sgt = t >> 4; const f32x4 z4 = {0.f, 0.f, 0.f, 0.f};
                x += (sgt > 0 ? g0 : z4) + (sgt > 1 ? g1 : z4) + (sgt > 2 ? g2 : z4); y += (g0 + g1) + g2;
                bb[4 * q] = x[0]; bb[4 * q + 1] = x[1]; bb[4 * q + 2] = x[2]; bb[4 * q + 3] = x[3]; bl[4 * q] = y[0]; bl[4 * q + 1] = y[1]; bl[4 * q + 2] = y[2]; bl[4 * q + 3] = y[3]; }
            float qe[16], kn[16], kd[16];
#pragma unroll
            for (int jj = 0; jj < 16; ++jj) { float qv = (jj & 1) ? bfhi(qw[jj >> 1]) : bflo(qw[jj >> 1]); float kv = (jj & 1) ? bfhi(kw[jj >> 1]) : bflo(kw[jj >> 1]);
                if constexpr (HG) { qv = qv * sigm(qv); kv = lbc[jj] * sigm(-kv); }
                qe[jj] = qv * __expf(bb[jj]) * C::scale; kn[jj] = kv * __expf(-bb[jj]); kd[jj] = kv * __expf(bl[jj] - bb[jj]); }
            v4u o0, o1;
            o0.x = pk2(qe[0], qe[1]); o0.y = pk2(qe[2], qe[3]); o0.z = pk2(qe[4], qe[5]); o0.w = pk2(qe[6], qe[7]); o1.x = pk2(qe[8], qe[9]); o1.y = pk2(qe[10], qe[11]); o1.z = pk2(qe[12], qe[13]); o1.w = pk2(qe[14], qe[15]);
            *(v4u*)qp = o0; *(v4u*)(qp + 8) = o1; *(LAS v4u*)(qe_s + t * QP + j0) = o0; *(LAS v4u*)(qe_s + t * QP + j0 + 8) = o1;
            o0.x = pk2(kn[0], kn[1]); o0.y = pk2(kn[2], kn[3]); o0.z = pk2(kn[4], kn[5]); o0.w = pk2(kn[6], kn[7]); o1.x = pk2(kn[8], kn[9]); o1.y = pk2(kn[10], kn[11]); o1.z = pk2(kn[12], kn[13]); o1.w = pk2(kn[14], kn[15]);
            *(LAS v4u*)(kn_s + t * QP + j0) = o0; *(LAS v4u*)(kn_s + t * QP + j0 + 8) = o1;
#pragma unroll
            for (int jj = 0; jj < 16; jj += 2) { const unsigned pw = pk2(kd[jj], kd[jj + 1]); kdT_s[(j0 + jj) * TP + tsw] = (bf16)(pw & 0xffffu); kdT_s[(j0 + jj + 1) * TP + tsw] = (bf16)(pw >> 16); }
            if (t == 63) {
#pragma unroll
                for (int q = 0; q < 4; ++q) *(f32x4*)(DBUF + (size_t)unit * 128 + j0 + 4 * q) = (f32x4){__expf(bl[4 * q]), __expf(bl[4 * q + 1]), __expf(bl[4 * q + 2]), __expf(bl[4 * q + 3])}; }
#pragma unroll
            for (int q = 0; q < DV / 64; ++q) { const v4u x = pv[q]; const unsigned xw[4] = {x.x, x.y, x.z, x.w};
#pragma unroll
                for (int e = 0; e < 4; ++e) { const int v = cs * (DV / 8) + 8 * q + 2 * e; vT_s[v * TP + tsw] = (bf16)(xw[e] & 0xffffu); vT_s[(v + 1) * TP + tsw] = (bf16)(xw[e] >> 16); } }
        }
        BAR_LDS();
        if (unit + G < NB * H * NCH) PREP_LOAD(unit + G);
        {
            const int r = lane & 15, quad = lane >> 4, tb = w >> 1;
#pragma unroll
            for (int e = 0; e < 2; ++e) { const int sb = 2 * (w & 1) + e; f32x4 c = {0.f, 0.f, 0.f, 0.f};
                if (sb <= tb) {
#pragma unroll
                    for (int ks = 0; ks < 4; ++ks) { const bf16x8 av = *(const LAS bf16x8*)(kn_s + (16 * sb + r) * QP + 32 * ks + 8 * quad), bv = *(const LAS bf16x8*)(qe_s + (16 * tb + r) * QP + 32 * ks + 8 * quad);
                        c = __builtin_amdgcn_mfma_f32_16x16x32_bf16(av, bv, c, 0, 0, 0); } }
                const int tc = 16 * tb + r, s0 = 16 * sb + 4 * quad;
                v2u o; o.x = pk2(s0 <= tc ? c[0] : 0.f, s0 + 1 <= tc ? c[1] : 0.f); o.y = pk2(s0 + 2 <= tc ? c[2] : 0.f, s0 + 3 <= tc ? c[3] : 0.f);
                *(v2u*)(AB + (size_t)unit * 4096 + tc * 64 + s0) = o; }
        }
        {
            const int r = lane & 15, quad = lane >> 4;
#pragma unroll
            for (int vg = 0; vg < NG; ++vg) { const int gv = w * NG + vg;
                const int csv = HG ? gv : (gv >> 1);
                const bf16x8 b0 = *(const LAS bf16x8*)(vT_s + (16 * gv + r) * TP + 8 * (quad ^ csv)), b1 = *(const LAS bf16x8*)(vT_s + (16 * gv + r) * TP + 8 * ((4 + quad) ^ csv));
#pragma unroll
                for (int kb = 0; kb < 8; ++kb) { const bf16x8 a0 = *(const LAS bf16x8*)(kdT_s + (16 * kb + r) * TP + 8 * (quad ^ kb)), a1 = *(const LAS bf16x8*)(kdT_s + (16 * kb + r) * TP + 8 * ((4 + quad) ^ kb));
                    f32x4 c = {0.f, 0.f, 0.f, 0.f}; c = __builtin_amdgcn_mfma_f32_16x16x32_bf16(a0, b0, c, 0, 0, 0); c = __builtin_amdgcn_mfma_f32_16x16x32_bf16(a1, b1, c, 0, 0, 0);
                    v2u o; o.x = pk2(c[0], c[1]); o.y = pk2(c[2], c[3]);
                    *(v2u*)(PB + (((size_t)unit * NGV + gv) * 4 + (kb >> 1)) * 512 + lane * 8 + (kb & 1) * 4) = o; } }
        }
        for (int c = tid; c < DV * 4; c += NWAVES * 64) { const int v = c >> 2, sq = c & 3;
            const int csv = v / (DV / 8);
            const v4u x0 = *(const LAS v4u*)(vT_s + v * TP + 8 * ((2 * sq) ^ csv)), x1 = *(const LAS v4u*)(vT_s + v * TP + 8 * ((2 * sq + 1) ^ csv));
            bf16* dst = Z + (tok0 + v / VR) * LDZ + VC + h * DV + (v % VR) * 64 + 16 * sq;
            *(v4u*)dst = x0; *(v4u*)(dst + 8) = x1; }
    }
#undef PREP_LOAD
}
template <bool HG> __device__ __forceinline__ void state_phase(bf16* PSB, const float* DBUF, float* Sout, int gt, int ngt) {
    typedef MX<HG> C; constexpr int H = C::H, DV = C::DV, NGV = DV / 16, TOTAL = NB * H * NGV * 4 * 64;
    for (int idx = gt; idx < TOTAL; idx += ngt) {
        const int lane = idx & 63, ks = (idx >> 6) & 3, gvb = idx >> 8, gv = gvb % NGV, bh = gvb / NGV, quad = lane >> 4, r = lane & 15;
        f32x4 S0 = {0.f, 0.f, 0.f, 0.f}, S1 = {0.f, 0.f, 0.f, 0.f};
        bf16* pp = PSB + (((size_t)bh * NCH * NGV + gv) * 4 + ks) * 512 + lane * 8; const float* dp = DBUF + (size_t)bh * NCH * 128 + 32 * ks + 4 * quad;
        for (int n0 = 0; n0 < NCH; n0 += 8) {
            v4u p[8]; f32x4 d0[8], d1[8];
#pragma unroll
            for (int i = 0; i < 8; ++i) { p[i] = *(const v4u*)(pp + (size_t)(n0 + i) * NGV * 2048); d0[i] = *(const f32x4*)(dp + (n0 + i) * 128); d1[i] = *(const f32x4*)(dp + (n0 + i) * 128 + 16); }
            __builtin_amdgcn_sched_barrier(0);
#pragma unroll
            for (int i = 0; i < 8; ++i) { v4u o; o.x = pk2(S0[0], S0[1]); o.y = pk2(S0[2], S0[3]); o.z = pk2(S1[0], S1[1]); o.w = pk2(S1[2], S1[3]);
                *(v4u*)(pp + (size_t)(n0 + i) * NGV * 2048) = o;
                S0 = S0 * d0[i] + (f32x4){bflo(p[i].x), bfhi(p[i].x), bflo(p[i].y), bfhi(p[i].y)}; S1 = S1 * d1[i] + (f32x4){bflo(p[i].z), bfhi(p[i].z), bflo(p[i].w), bfhi(p[i].w)}; }
        }
        float* so = Sout + ((size_t)bh * 128 + 32 * ks + 4 * quad) * DV + 16 * gv + r;
#pragma unroll
        for (int j = 0; j < 4; ++j) { so[j * DV] = S0[j]; so[(16 + j) * DV] = S1[j]; }
    }
}
template <bool HG> __device__ __forceinline__ void out_phase(LAS unsigned char* lds, const bf16* Z, const bf16* AB, const bf16* PSB, bf16* OG, const float* gn, int tid, int w, int bid, int G) {
    typedef MX<HG> C; constexpr int H = C::H, DV = C::DV, LDZ = C::LDZ, VC = C::VC, GC = C::GC, VR = C::VR, VW = DV / 8, NG = VW / 16, NGV = DV / 16, NU = NB * H * NCH;
    constexpr int QP = 136, AP = 72, OFF_QE = 0, OFF_AA = 64 * QP * 2, BUFSZ = OFF_AA + 64 * AP * 2, OFF_SS = 2 * BUFSZ;
    const int lane = tid & 63, r = lane & 15, quad = lane >> 4, vbase = w * VW;
    f32x4 gnv[NG];
#pragma unroll
    for (int vg = 0; vg < NG; ++vg) gnv[vg] = *(const f32x4*)(gn + vbase + 16 * vg + 4 * quad);
    unsigned oq[2], ov[NG], sq[2];
#pragma unroll
    for (int i = 0; i < 2; ++i) { const int p = tid + 512 * i, row = p >> 4, c16 = p & 15; oq[i] = (unsigned)(row * LDZ + 8 * c16) * 2u; sq[i] = (unsigned)(row * QP + 8 * c16) * 2u; }
#pragma unroll
    for (int vg = 0; vg < NG; ++vg) { const int v = vbase + 16 * vg + r; ov[vg] = (unsigned)((v / VR) * LDZ + (v % VR) * 64 + 8 * quad) * 2u; }
    unsigned oa = (unsigned)tid * 16u, og = (unsigned)(r * LDZ + 4 * quad) * 2u, oo = (unsigned)(r * 1024 + 4 * quad) * 2u, osb = (unsigned)lane * 16u;
    unsigned lq = (unsigned)(r * QP + 4 * quad) * 2u, la = (unsigned)(r * AP + 8 * quad) * 2u, sa = (unsigned)((tid >> 3) * AP + 8 * (tid & 7)) * 2u;
    v4u pq[2], pa; bf16x8 sb[NG][4], vb[NG][2], sbn[NG][4], vbn[NG][2];
#define OP_BASES(u_) const int n_ = (u_) % NCH, bh_ = (u_) / NCH, h_ = bh_ % H, b_ = bh_ / H; const size_t tk_ = (size_t)b_ * SEQ + 64 * n_; \
        const char* zq_ = (const char*)(Z + tk_ * LDZ + h_ * 128); const char* zv_ = (const char*)(Z + tk_ * LDZ + VC + h_ * DV); const char* ab_ = (const char*)(AB + (size_t)(u_) * 4096); \
        const char* sb_ = (const char*)(PSB + ((size_t)(u_) * NGV + w * NG) * 2048)
#define OP_ISSUE(u_) do { OP_BASES(u_); pq[0] = *(const v4u*)(zq_ + oq[0]); pq[1] = *(const v4u*)(zq_ + oq[1]); pa = *(const v4u*)(ab_ + oa); \
        _Pragma("unroll") for (int vg = 0; vg < NG; ++vg) { _Pragma("unroll") for (int ks = 0; ks < 4; ++ks) sbn[vg][ks] = *(const bf16x8*)(sb_ + (vg * 4 + ks) * 1024 + osb); \
            vbn[vg][0] = *(const bf16x8*)(zv_ + ov[vg]); vbn[vg][1] = *(const bf16x8*)(zv_ + ov[vg] + 64); } } while (0)
#define OP_STAGE(buf_) do { LAS unsigned char* bs_ = lds + (buf_) * BUFSZ; *(LAS v4u*)(bs_ + OFF_QE + sq[0]) = pq[0]; *(LAS v4u*)(bs_ + OFF_QE + sq[1]) = pq[1]; *(LAS v4u*)(bs_ + OFF_AA + sa) = pa; } while (0)
#define OP_TAKE() do { _Pragma("unroll") for (int vg = 0; vg < NG; ++vg) { _Pragma("unroll") for (int ks = 0; ks < 4; ++ks) sb[vg][ks] = sbn[vg][ks]; vb[vg][0] = vbn[vg][0]; vb[vg][1] = vbn[vg][1]; } } while (0)
    OP_ISSUE(bid); OP_STAGE(0); OP_TAKE();
    BAR_LDS();
    int par = 0;
    for (int unit = bid; unit < NU; unit += G, par ^= 1) {
        asm volatile("" : "+v"(oq[0]), "+v"(oq[1]), "+v"(oa), "+v"(og), "+v"(oo), "+v"(osb), "+v"(lq), "+v"(la), "+v"(sa), "+v"(sq[0]), "+v"(sq[1]));
#pragma unroll
        for (int vg = 0; vg < NG; ++vg) asm volatile("" : "+v"(ov[vg]));
        const int n = unit % NCH, bh = unit / NCH, h = bh % H, b = bh / H; const size_t tok0 = (size_t)b * SEQ + 64 * n;
        const char* zg = (const char*)(Z + tok0 * LDZ + GC + h * DV + vbase);
        v2u gq[NG][4];
#pragma unroll
        for (int tb = 0; tb < 4; ++tb)
#pragma unroll
            for (int vg = 0; vg < NG; ++vg) gq[vg][tb] = *(const v2u*)(zg + (size_t)tb * 16 * LDZ * 2 + og + 32 * vg);
        const bool more = unit + G < NU;
        if (more) OP_ISSUE(unit + G);
        const LAS unsigned char* bs = lds + par * BUFSZ;
        f32x4 o[NG][4];
#pragma unroll
        for (int vg = 0; vg < NG; ++vg)
#pragma unroll
            for (int tb = 0; tb < 4; ++tb) o[vg][tb] = (f32x4){0.f, 0.f, 0.f, 0.f};
#pragma unroll
        for (int kh = 0; kh < 2; ++kh) { bf16x8 qf[2][4];
#pragma unroll
            for (int kl = 0; kl < 2; ++kl)
#pragma unroll
                for (int tb = 0; tb < 4; ++tb) { const LAS unsigned char* qa = bs + OFF_QE + lq + (16 * tb * QP + 32 * (2 * kh + kl)) * 2;
                    const v2u lo = *(const LAS v2u*)qa, hi = *(const LAS v2u*)(qa + 32); qf[kl][tb] = __builtin_bit_cast(bf16x8, ((v4u){lo.x, lo.y, hi.x, hi.y})); }
            __builtin_amdgcn_sched_barrier(0);
#pragma unroll
            for (int kl = 0; kl < 2; ++kl)
#pragma unroll
                for (int tb = 0; tb < 4; ++tb)
#pragma unroll
                    for (int vg = 0; vg < NG; ++vg) o[vg][tb] = __builtin_amdgcn_mfma_f32_16x16x32_bf16(sb[vg][2 * kh + kl], qf[kl][tb], o[vg][tb], 0, 0, 0);
            __builtin_amdgcn_sched_barrier(0); }
        { bf16x8 af[4][2];
#pragma unroll
            for (int tb = 0; tb < 4; ++tb) { const LAS unsigned char* aa = bs + OFF_AA + la + 16 * tb * AP * 2; af[tb][0] = *(const LAS bf16x8*)aa; af[tb][1] = *(const LAS bf16x8*)(aa + 64); }
            __builtin_amdgcn_sched_barrier(0);
#pragma unroll
            for (int js = 0; js < 2; ++js)
#pragma unroll
                for (int tb = 0; tb < 4; ++tb)
#pragma unroll
                    for (int vg = 0; vg < NG; ++vg) o[vg][tb] = __builtin_amdgcn_mfma_f32_16x16x32_bf16(vb[vg][js], af[tb][js], o[vg][tb], 0, 0, 0);
            __builtin_amdgcn_sched_barrier(0); }
        LAS float* ssb = (LAS float*)(lds + OFF_SS + par * 2048);
#pragma unroll
        for (int tb = 0; tb < 4; ++tb) { float p = 0.f;
#pragma unroll
            for (int vg = 0; vg < NG; ++vg) p += (o[vg][tb][0] * o[vg][tb][0] + o[vg][tb][1] * o[vg][tb][1]) + (o[vg][tb][2] * o[vg][tb][2] + o[vg][tb][3] * o[vg][tb][3]);
            p += __shfl_xor(p, 16); p += __shfl_xor(p, 32);
            if (quad == 0) ssb[(16 * tb + r) * 8 + w] = p; }
        if (more) { OP_STAGE(par ^ 1); OP_TAKE(); }
        BAR_LDS();
        char* ogn = (char*)(OG + tok0 * 1024 + h * DV + vbase);
#pragma unroll
        for (int tb = 0; tb < 4; ++tb) { const f32x4 s0 = *(const LAS f32x4*)(ssb + (16 * tb + r) * 8), s1 = *(const LAS f32x4*)(ssb + (16 * tb + r) * 8 + 4);
            const float tot = ((s0[0] + s0[1]) + (s0[2] + s0[3])) + ((s1[0] + s1[1]) + (s1[2] + s1[3])); const float rinv = rsqrtf(tot * (1.0f / DV) + 1e-6f);
#pragma unroll
            for (int vg = 0; vg < NG; ++vg) { const float g0 = bflo(gq[vg][tb].x), g1 = bfhi(gq[vg][tb].x), g2 = bflo(gq[vg][tb].y), g3 = bfhi(gq[vg][tb].y);
                const f32x4 y = o[vg][tb] * rinv * gnv[vg]; v2u pw; pw.x = pk2(y[0] * g0 * sigm(g0), y[1] * g1 * sigm(g1)); pw.y = pk2(y[2] * g2 * sigm(g2), y[3] * g3 * sigm(g3));
                *(v2u*)(ogn + (size_t)tb * 16 * 1024 * 2 + oo + 32 * vg) = pw; } }
    }
#undef OP_BASES
#undef OP_ISSUE
#undef OP_STAGE
#undef OP_TAKE
}
template <bool HG> __device__ __forceinline__ void sample_block(LAS unsigned char* lds, const bf16* Z, const float* R, const float* wup, const float* bgk, const float* lowb, const float* gn, const float* S0, float* Sout, bf16* OG, int bh, int tid, int w) {
    typedef MX<HG> C; constexpr int H = C::H, DV = C::DV, LDZ = C::LDZ, KC = C::KC, VC = C::VC, GC = C::GC, E = DV / 64;
    const int lane = tid & 63, kk = lane >> 2, t = lane & 3, k = 16 * w + kk, h = bh % H, b = bh / H, hk = h * 128 + k; const size_t m0 = (size_t)NPR + 4 * b;
    LAS float* tab = (LAS float*)lds + w * 192; LAS float* pas = (LAS float*)(lds + 6144); LAS float* red = (LAS float*)(lds + 8192);
    const float* sp = S0 + ((size_t)bh * 128 + 16 * w) * DV + E * lane; float* dp = Sout + ((size_t)bh * 128 + 16 * w) * DV + E * lane;
    float s0[16][E];
#pragma unroll
    for (int i = 0; i < 16; ++i) {
        if constexpr (E == 4) { const f32x4 x = __builtin_nontemporal_load((const f32x4*)(sp + (size_t)i * DV)); s0[i][0] = x[0]; s0[i][1] = x[1]; s0[i][2] = x[2]; s0[i][3] = x[3]; }
        else { const v2u x = __builtin_nontemporal_load((const v2u*)(sp + (size_t)i * DV)); s0[i][0] = __uint_as_float(x.x); s0[i][1] = __uint_as_float(x.y); } }
    float vv[4][E];
#pragma unroll
    for (int s = 0; s < 4; ++s) { const bf16* zv = Z + (m0 + s) * LDZ + VC + h * DV + E * lane;
        if constexpr (E == 4) { const v2u x = *(const v2u*)zv; vv[s][0] = bflo(x.x); vv[s][1] = bfhi(x.x); vv[s][2] = bflo(x.y); vv[s][3] = bfhi(x.y); }
        else { const unsigned x = *(const unsigned*)zv; vv[s][0] = bflo(x); vv[s][1] = bfhi(x); } }
    const bf16* zr = Z + (m0 + t) * LDZ; float q = bf2f(zr[hk]); const float kz = bf2f(zr[KC + hk]); float g, kv;
    if constexpr (!HG) { float x = bgk[hk];
#pragma unroll
        for (int i = 0; i < 16; ++i) x += R[(m0 + t) * 16 + i] * wup[i * 512 + hk];
        g = logsig(x) * (1.0f / 16.0f); kv = kz;
    } else { const float x0 = lowb[hk], x1 = lowb[1024 + hk]; const float a = logsig(x1 - x0), b2 = logsig(x0 - x1) + logsig(kz), mx = fmaxf(a, b2);
        g = mx + __logf(1.0f + __expf(-fabsf(a - b2))); kv = sigm(x0 - x1) * sigm(-kz); q = q * sigm(q); }
    const int l0 = lane & ~3;
    const float g0 = __shfl(g, l0), g1 = __shfl(g, l0 + 1), g2 = __shfl(g, l0 + 2), g3 = __shfl(g, l0 + 3);
    const float b3 = ((g0 + g1) + g2) + g3, bt = t == 0 ? g0 : (t == 1 ? g0 + g1 : (t == 2 ? (g0 + g1) + g2 : b3));
    const float qe = q * __expf(bt) * C::scale, kn = kv * __expf(-bt), kd = kv * __expf(b3 - bt);
    tab[kk * 12 + t] = qe; tab[kk * 12 + 4 + t] = kd; if (t == 0) tab[kk * 12 + 8] = __expf(b3);
    {
        float p[4];
#pragma unroll
        for (int s = 0; s < 4; ++s) { p[s] = qe * __shfl(kn, l0 + s);
            p[s] += __shfl_xor(p[s], 4); p[s] += __shfl_xor(p[s], 8); p[s] += __shfl_xor(p[s], 16); p[s] += __shfl_xor(p[s], 32); }
        if (lane < 4) *(LAS f32x4*)(pas + w * 16 + 4 * lane) = (f32x4){p[0], p[1], p[2], p[3]};
    }
    LDS_WAIT();
    float o[4][E];
#pragma unroll
    for (int tt = 0; tt < 4; ++tt)
#pragma unroll
        for (int e = 0; e < E; ++e) o[tt][e] = 0.f;
#pragma unroll
    for (int i = 0; i < 16; ++i) { const f32x4 q4 = *(const LAS f32x4*)(tab + i * 12), k4 = *(const LAS f32x4*)(tab + i * 12 + 4); const float d = tab[i * 12 + 8]; float sn[E];
#pragma unroll
        for (int e = 0; e < E; ++e) { o[0][e] += q4[0] * s0[i][e]; o[1][e] += q4[1] * s0[i][e]; o[2][e] += q4[2] * s0[i][e]; o[3][e] += q4[3] * s0[i][e];
            sn[e] = d * s0[i][e] + ((k4[0] * vv[0][e] + k4[1] * vv[1][e]) + (k4[2] * vv[2][e] + k4[3] * vv[3][e])); }
        if constexpr (E == 4) __builtin_nontemporal_store(((f32x4){sn[0], sn[1], sn[2], sn[3]}), (f32x4*)(dp + (size_t)i * DV));
        else { v2u x; x.x = __float_as_uint(sn[0]); x.y = __float_as_uint(sn[1]); __builtin_nontemporal_store(x, (v2u*)(dp + (size_t)i * DV)); } }
#pragma unroll
    for (int tt = 0; tt < 4; ++tt) {
        if constexpr (E == 4) *(LAS f32x4*)(red + (w * 4 + tt) * DV + 4 * lane) = (f32x4){o[tt][0], o[tt][1], o[tt][2], o[tt][3]};
        else { red[(w * 4 + tt) * DV + 2 * lane] = o[tt][0]; red[(w * 4 + tt) * DV + 2 * lane + 1] = o[tt][1]; } }
    BAR_LDS();
    if (w < 4) {
        float y[E];
#pragma unroll
        for (int e = 0; e < E; ++e) y[e] = 0.f;
#pragma unroll
        for (int ww = 0; ww < 8; ++ww)
#pragma unroll
            for (int e = 0; e < E; ++e) y[e] += red[(ww * 4 + w) * DV + E * lane + e];
#pragma unroll
        for (int s = 0; s < 4; ++s) if (s <= w) { float a = 0.f;
#pragma unroll
            for (int ww = 0; ww < 8; ++ww) a += pas[ww * 16 + 4 * w + s];
#pragma unroll
            for (int e = 0; e < E; ++e) y[e] += a * vv[s][e]; }
        float ss = 0.f;
#pragma unroll
        for (int e = 0; e < E; ++e) ss += y[e] * y[e];
        ss = wave_sum(ss); const float rinv = rsqrtf(ss * (1.0f / DV) + 1e-6f);
        const bf16* zg = Z + (m0 + w) * LDZ + GC + h * DV + E * lane; bf16* op = OG + (m0 + w) * 1024 + h * DV + E * lane; float gg[E];
        if constexpr (E == 4) { const v2u x = *(const v2u*)zg; gg[0] = bflo(x.x); gg[1] = bfhi(x.x); gg[2] = bflo(x.y); gg[3] = bfhi(x.y); } else { const unsigned x = *(const unsigned*)zg; gg[0] = bflo(x); gg[1] = bfhi(x); }
#pragma unroll
        for (int e = 0; e < E; ++e) y[e] = y[e] * rinv * gn[E * lane + e] * (gg[e] * sigm(gg[e]));
        if constexpr (E == 4) { v2u pw; pw.x = pk2(y[0], y[1]); pw.y = pk2(y[2], y[3]); *(v2u*)op = pw; } else { *(unsigned*)op = pk2(y[0], y[1]); }
    }
    BAR_LDS();
}
template <int NKS> __device__ __forceinline__ void mini_acc(f32x4 (&acc)[2][4], const bf16* ap, size_t lda, const bf16* bp, size_t ldb) {
#pragma unroll
    for (int c = 0; c < NKS; c += 4) {
        bf16x8 af[4][2], bfr[4][4];
#pragma unroll
        for (int ks = 0; ks < 4; ++ks) if (c + ks < NKS) {
#pragma unroll
            for (int rb = 0; rb < 2; ++rb) af[ks][rb] = *(const bf16x8*)(ap + (size_t)(16 * rb) * lda + 32 * (c + ks));
#pragma unroll
            for (int cb = 0; cb < 4; ++cb) bfr[ks][cb] = *(const bf16x8*)(bp + (size_t)(16 * cb) * ldb + 32 * (c + ks)); }
        __builtin_amdgcn_sched_barrier(0);
#pragma unroll
        for (int ks = 0; ks < 4; ++ks) if (c + ks < NKS) {
#pragma unroll
            for (int rb = 0; rb < 2; ++rb)
#pragma unroll
                for (int cb = 0; cb < 4; ++cb) acc[rb][cb] = __builtin_amdgcn_mfma_f32_16x16x32_bf16(bfr[ks][cb], af[ks][rb], acc[rb][cb], 0, 0, 0); }
        __builtin_amdgcn_sched_barrier(0);
    }
}
template <int MODE, int K> __device__ __forceinline__ void mini_gemm(LAS unsigned char* lds, const bf16* A, const bf16* Bt, const bf16* A2, const bf16* Bt2, const float* xin, const bf16* hb_in, bf16* hb_out, const float* rs_in, float* rs_out, float alpha, int tid, int bid, int G) {
    const int lane = tid & 63, w = tid >> 6, r = lane & 15, quad = lane >> 4;
    LAS float* P = (LAS float*)lds; LAS float* P2 = (LAS float*)(lds + 65536);
    for (int mt = bid; mt < 256; mt += G) {
        const int rt = mt >> 4, ct = mt & 15, row0 = NPR + 32 * rt, col0 = 64 * ct;
        f32x4 acc[2][4];
#pragma unroll
        for (int rb = 0; rb < 2; ++rb)
#pragma unroll
            for (int cb = 0; cb < 4; ++cb) acc[rb][cb] = (f32x4){0.f, 0.f, 0.f, 0.f};
        constexpr int KW = K / 8;
        mini_acc<KW / 32>(acc, A + (size_t)(row0 + r) * K + w * KW + 8 * quad, K, Bt + (size_t)(col0 + r) * K + w * KW + 8 * quad, K);
#pragma unroll
        for (int rb = 0; rb < 2; ++rb)
#pragma unroll
            for (int cb = 0; cb < 4; ++cb) *(LAS f32x4*)(P + (w * 32 + 16 * rb + r) * 64 + 16 * cb + 4 * quad) = acc[rb][cb];
        if constexpr (MODE == 1) {
#pragma unroll
            for (int rb = 0; rb < 2; ++rb)
#pragma unroll
                for (int cb = 0; cb < 4; ++cb) acc[rb][cb] = (f32x4){0.f, 0.f, 0.f, 0.f};
            mini_acc<1>(acc, A2 + (size_t)(row0 + r) * 256 + w * 32 + 8 * quad, 256, Bt2 + (size_t)(col0 + r) * 256 + w * 32 + 8 * quad, 256);
#pragma unroll
            for (int rb = 0; rb < 2; ++rb)
#pragma unroll
                for (int cb = 0; cb < 4; ++cb) *(LAS f32x4*)(P2 + (w * 32 + 16 * rb + r) * 64 + 16 * cb + 4 * quad) = acc[rb][cb];
        }
        BAR_LDS();
        const int row = tid >> 4, c4 = (tid & 15) * 4; f32x4 v = {0.f, 0.f, 0.f, 0.f}, v2 = {0.f, 0.f, 0.f, 0.f};
#pragma unroll
        for (int ww = 0; ww < 8; ++ww) { v += *(const LAS f32x4*)(P + (ww * 32 + row) * 64 + c4); if constexpr (MODE == 1) v2 += *(const LAS f32x4*)(P2 + (ww * 32 + row) * 64 + c4); }
        const int grow = row0 + row; const size_t off = (size_t)grow * 1024 + col0 + c4;
        f32x4 o;
        if (xin) o = *(const f32x4*)(xin + off); else { const v2u hx = *(const v2u*)(hb_in + off); o = (f32x4){bflo(hx.x), bfhi(hx.x), bflo(hx.y), bfhi(hx.y)}; }
        if constexpr (MODE == 0) o += v * alpha;
        else { const float s = pg8::row_scale(rs_in, grow); o[0] += sigm(v[0] * s) * v2[0]; o[1] += sigm(v[1] * s) * v2[1]; o[2] += sigm(v[2] * s) * v2[2]; o[3] += sigm(v[3] * s) * v2[3]; }
        v2u pw; pw.x = pk2(o[0], o[1]); pw.y = pk2(o[2], o[3]); *(v2u*)(hb_out + off) = pw;
        float ss = (o[0] * o[0] + o[1] * o[1]) + (o[2] * o[2] + o[3] * o[3]);
        ss += __shfl_xor(ss, 1); ss += __shfl_xor(ss, 2); ss += __shfl_xor(ss, 4); ss += __shfl_xor(ss, 8);
        if ((tid & 15) == 0) rs_out[(size_t)grow * 16 + ct] = ss;
        BAR_LDS();
    }
}
#define XB_TMO      128
#define XB_XCNT(j)  (256  + 64 * (j))
#define XB_XSUB(j)  (1280 + 64 * (j))
#define XB_XGEN(j)  (2304 + 64 * (j))
#define XB_TOP      3328
#define XB_TOPGEN   3392
#define XCD_BAR_WORDS 3456
#define XB_SPIN_CAP (1u << 18)

__device__ __forceinline__ unsigned xb_ld(unsigned* p)              { return __hip_atomic_load(p, __ATOMIC_RELAXED, __HIP_MEMORY_SCOPE_AGENT); }
__device__ __forceinline__ unsigned xb_add(unsigned* p, unsigned v) { return __hip_atomic_fetch_add(p, v, __ATOMIC_RELAXED, __HIP_MEMORY_SCOPE_AGENT); }
__device__ __forceinline__ unsigned xb_xcc_id() { return (unsigned)__builtin_amdgcn_s_getreg((3 << 11) | 20) & 0xFu; }
#define XB_SPIN(cond, bar) do { unsigned _sp = 0; while (cond) { __builtin_amdgcn_s_sleep(1); \
    if ((++_sp & 255u) == 0u) { if (xb_ld(&(bar)[XB_TMO])) break; if (_sp > XB_SPIN_CAP) { atomicAdd(&(bar)[XB_TMO], 1u); break; } } } } while (0)

struct XcdBarrier {
    unsigned* bar; unsigned x;
    volatile LAS unsigned* st;
};

__device__ __forceinline__ XcdBarrier xcd_barrier_post(unsigned* bar, volatile LAS unsigned* st) {
    XcdBarrier b; b.bar = bar; b.x = xb_xcc_id(); b.st = st;
    if (threadIdx.x == 0) (void)xb_add(&bar[XB_XCNT(b.x)], 1u);
    return b;
}
__device__ __forceinline__ void xcd_barrier_complete(unsigned* bar, unsigned x, unsigned& nloc, unsigned& nx) {
    const unsigned G = gridDim.x * gridDim.y * gridDim.z;
    unsigned sum, cnt, mine, sp = 0u;
    for (;;) {
        sum = 0u; cnt = 0u; mine = 0u;
#pragma unroll
        for (unsigned j = 0; j < 16; ++j) { const unsigned c = xb_ld(&bar[XB_XCNT(j)]); sum += c; cnt += (c > 0u) ? 1u : 0u; mine = (j == x) ? c : mine; }
        if (sum == G) break;
        __builtin_amdgcn_s_sleep(1);
        if ((++sp & 255u) == 0u) { if (xb_ld(&bar[XB_TMO])) break; if (sp > XB_SPIN_CAP) { atomicAdd(&bar[XB_TMO], 1u); break; } }
    }
    nloc = mine > 0u ? mine : 1u; nx = cnt > 0u ? cnt : 1u;
}

__device__ __forceinline__ void xcd_barrier(const XcdBarrier& b) {
    asm volatile("s_waitcnt vmcnt(0)" ::: "memory");
    __syncthreads();
    if (threadIdx.x == 0) {
        unsigned* bar = b.bar;
        __builtin_amdgcn_s_waitcnt(0);
        unsigned nloc = b.st[0], nx = b.st[1];
        if (nloc == 0u) { xcd_barrier_complete(bar, b.x, nloc, nx); b.st[0] = nloc; b.st[1] = nx; }
        const unsigned old = xb_add(&bar[XB_XSUB(b.x)], 1u);
        const unsigned gen = old / nloc;
        if (old + 1u == (gen + 1u) * nloc) {
            __builtin_amdgcn_fence(__ATOMIC_RELEASE, "agent");
            asm volatile("s_waitcnt vmcnt(0)" ::: "memory");
            const unsigned og = xb_add(&bar[XB_TOP], 1u);
            const unsigned tg = og / nx;
            if (og + 1u == (tg + 1u) * nx) xb_add(&bar[XB_TOPGEN], 1u);
            else XB_SPIN(xb_ld(&bar[XB_TOPGEN]) == tg, bar);
            __builtin_amdgcn_fence(__ATOMIC_ACQUIRE, "agent");
            xb_add(&bar[XB_XGEN(b.x)], 1u);
            asm volatile("s_waitcnt vmcnt(0)" ::: "memory");
        } else {
            XB_SPIN(xb_ld(&bar[XB_XGEN(b.x)]) == gen, bar);
            __builtin_amdgcn_fence(__ATOMIC_ACQUIRE, "agent");
            asm volatile("s_waitcnt vmcnt(0)" ::: "memory");
        }
    }
    __syncthreads();
}

#define MK_TID() int wave = wave_s; asm volatile("" : "+s"(wave)); unsigned ones_ = ~0u; asm volatile("" : "+s"(ones_)); \
    const int lane = (int)__builtin_amdgcn_mbcnt_hi(ones_, __builtin_amdgcn_mbcnt_lo(ones_, 0u)); const int tid = wave * 64 + lane; const int gw = bid * NWAVES + wave, NGW = G * NWAVES; (void)gw; (void)NGW; (void)tid; (void)lane
__global__ void __launch_bounds__(NWAVES * 64, 2) fwd_kernel(Args a) {
    extern __shared__ __attribute__((aligned(16))) unsigned char lds_raw[];
    LAS unsigned char* lds = (LAS unsigned char*)lds_raw;
    cg::grid_group grid = cg::this_grid();
    const int wave_s = __builtin_amdgcn_readfirstlane((int)threadIdx.x >> 6);
    volatile LAS unsigned* bst = (volatile LAS unsigned*)(lds + LDS_BYTES - 64);
    if (threadIdx.x < 2) bst[threadIdx.x] = 0u;
    __syncthreads();
    const XcdBarrier xbar = xcd_barrier_post((unsigned*)(a.ws + OFF_CTL), bst);
#if PT_ON
#define PT_T0 (blockIdx.x == 0 && wave_s == 0 && __builtin_amdgcn_mbcnt_hi(~0u, __builtin_amdgcn_mbcnt_lo(~0u, 0u)) == 0u)
#define tsl ((volatile LAS unsigned*)(lds + LDS_BYTES - 32))
#endif
    const int ph_lo = a.ph_lo, ph_hi = a.ph_hi;
    for (int ph_ = ph_lo; ph_ < ph_hi; ++ph_) {
#if PROBE_MODE
      const int kk_ = (ph_ - 1) % 10; const bool mid_ = ph_ > 0 && ph_ < NPH - 1;
      const int nrep = (PROBE_MODE == 1 && ph_ == 0) || (PROBE_MODE == 2 && mid_ && (kk_ == 0 || kk_ == 7)) || (PROBE_MODE == 3 && mid_ && kk_ == 2) || (PROBE_MODE == 4 && mid_ && kk_ == 5) ? 2 : 1;
      for (int rep = 0; rep < nrep; ++rep) {
#else
      {
#endif
        int ph = ph_; asm volatile("" : "+s"(ph));
#if PT_ON
        if (ph == PT_LO && PT_T0) { const unsigned long long t_ = __builtin_amdgcn_s_memrealtime(); tsl[0] = (unsigned)t_; tsl[1] = (unsigned)(t_ >> 32); }
        if (ph == PT_HI + 1 && PT_T0) { const unsigned long long t_ = __builtin_amdgcn_s_memrealtime(); tsl[2] = (unsigned)t_; tsl[3] = (unsigned)(t_ >> 32); }
#endif
        CArgs* ap = (CArgs*)__builtin_amdgcn_kernarg_segment_ptr(); asm volatile("" : "+s"(ap));
        int bid = blockIdx.x; asm volatile("" : "+s"(bid));
        int G = gridDim.x; asm volatile("" : "+s"(G));
        unsigned char* ws = ap->ws; float* hbuf = ap->out;
        if (ph == 0) { MK_TID(); prologue(ap, ws, hbuf, lds, tid, bid, G); }
        else if (ph == NPH - 1) {
            MK_TID(); const float* fw = ap->in[25]; const bf16* hfin = (const bf16*)(ws + OFF_HB);
            for (int m = gw; m < M; m += NGW) { const v2u* hr = (const v2u*)(hfin + (size_t)m * D); f32x4 v[4]; float ss = 0.f;
#pragma unroll
                for (int j = 0; j < 4; ++j) { const v2u x = hr[lane + 64 * j]; v[j] = (f32x4){bflo(x.x), bfhi(x.x), bflo(x.y), bfhi(x.y)}; ss += (v[j][0] * v[j][0] + v[j][1] * v[j][1]) + (v[j][2] * v[j][2] + v[j][3] * v[j][3]); }
                ss = wave_sum(ss); const float rinv = rsqrtf(ss * (1.0f / D) + 1e-6f);
#pragma unroll
                for (int j = 0; j < 4; ++j) { const f32x4 wv = *((const f32x4*)fw + lane + 64 * j); __builtin_nontemporal_store(v[j] * rinv * wv, (f32x4*)(hbuf + (size_t)m * D) + lane + 64 * j); } }
        } else {
            const int li = (ph - 1) / 10, k = (ph - 1) % 10, cur = li;
            bf16* hb = (bf16*)(ws + OFF_HB + cur * HB_SZ); bf16* ob = (bf16*)(ws + OFF_HB + (cur ^ 1) * HB_SZ);
            float* rs0 = (float*)(ws + OFF_RS); float* rs1 = (float*)(ws + OFF_RS + RS_SZ); float* Rb = (float*)(ws + OFF_R);
            bf16* big = (bf16*)(ws + OFF_BIG);
            if (k == 0 || k == 7) { MK_TID();
                const int f = k == 7; pg8::Gemm g{hb, (const bf16*)(ws + OFF_WGU + (li * 2 + f) * WGU_SZ), M, 2 * FF, D};
                pg8::StaticOrder S; S.init(M, 2 * FF, G, bid); pg8::EpiSwiglu E{big, FF, rs0};
                pg8::gemm_phase<pg8::EpiSwiglu, pg8::StaticOrder, true, true>(lds, g, S, E, tid);
            } else if (k == 1 || k == 8 || k == 6) { MK_TID();
                pg8::Gemm g; float alpha; float* rso;
                if (k == 6) { g = pg8::Gemm{ob, (const bf16*)(ws + OFF_WOUT + li * WSQ_SZ), M, D, D}; alpha = 1.0f; rso = rs0; }
                else { const int f = k == 8; g = pg8::Gemm{big, (const bf16*)(ws + OFF_WDN + (li * 2 + f) * WDN_SZ), M, D, FF}; alpha = 0.5f; rso = rs1; }
                g.M = NPR; pg8::StaticOrder S; S.init(NPR, D, G, bid); const bool first = (li == 0 && k == 1);
                pg8::EpiResid E{first ? ap->in[0] : (const float*)nullptr, hb, rso, alpha};
                pg8::gemm_phase<pg8::EpiResid, pg8::StaticOrder, true, true>(lds, g, S, E, tid);
                unsigned ones2_ = ~0u; asm volatile("" : "+s"(ones2_));
                const int tid2 = wave * 64 + (int)__builtin_amdgcn_mbcnt_hi(ones2_, __builtin_amdgcn_mbcnt_lo(ones2_, 0u));
                const float* xin_s = first ? ap->in[1] - (size_t)NPR * 1024 : (const float*)nullptr;
                if (k == 6) mini_gemm<0, D>(lds, g.A, g.Bt, nullptr, nullptr, xin_s, hb, hb, nullptr, rso, alpha, tid2, bid, G);
                else mini_gemm<0, FF>(lds, g.A, g.Bt, nullptr, nullptr, xin_s, hb, hb, nullptr, rso, alpha, tid2, bid, G);
            } else if (k == 2) { MK_TID();
                const int N = li ? 4096 : 3328; pg8::Gemm g{hb, (const bf16*)(ws + (li ? OFF_WHIN : OFF_WGIN)), M, N, D};
                pg8::StaticOrder S; S.init(M, N, G, bid); pg8::EpiZ E{big, N, rs1, Rb, li ? -1 : 12};
                pg8::gemm_phase<pg8::EpiZ, pg8::StaticOrder, true, true>(lds, g, S, E, tid);
            } else if (k == 3) { MK_TID();
                if (li == 0) prep_phase<false>(lds, big, Rb, ap->in[11], ap->in[12], (const float*)(ws + OFF_LBT), (bf16*)(ws + OFF_AB), (float*)(ws + OFF_DB), (bf16*)(ws + OFF_PSB), tid, bid, G);
                else prep_phase<true>(lds, big, Rb, ap->in[11], ap->in[12], (const float*)(ws + OFF_LBT), (bf16*)(ws + OFF_AB), (float*)(ws + OFF_DB), (bf16*)(ws + OFF_PSB), tid, bid, G);
                __syncthreads();
                for (int rp_ = 0; rp_ < (PROBE_MODE == 6 ? 2 : 1); ++rp_)
                for (int u = bid; u < DB * (li ? 8 : 4); u += G) {
                    if (li == 0) sample_block<false>(lds, big, Rb, ap->in[11], ap->in[12], ap->in[18], ap->in[13], ap->in[2], hbuf + OUT_GS, ob, u, tid, wave);
                    else sample_block<true>(lds, big, Rb, ap->in[11], ap->in[12], ap->in[18], ap->in[16], ap->in[3], hbuf + OUT_HS, ob, u, tid, wave);
                }
            } else if (k == 4) { MK_TID();
                const int gt = bid * (NWAVES * 64) + tid, ngt = G * NWAVES * 64;
                if (li == 0) state_phase<false>((bf16*)(ws + OFF_PSB), (const float*)(ws + OFF_DB), hbuf + OUT_GP, gt, ngt);
                else state_phase<true>((bf16*)(ws + OFF_PSB), (const float*)(ws + OFF_DB), hbuf + OUT_HP, gt, ngt);
            } else if (k == 5) { MK_TID();
                if (li == 0) out_phase<false>(lds, big, (const bf16*)(ws + OFF_AB), (const bf16*)(ws + OFF_PSB), ob, ap->in[13], tid, wave, bid, G);
                else out_phase<true>(lds, big, (const bf16*)(ws + OFF_AB), (const bf16*)(ws + OFF_PSB), ob, ap->in[16], tid, wave, bid, G);
            } else { MK_TID();
                bf16* pp = (bf16*)(ws + OFF_BIG);
                { pg8::Gemm g{(const bf16*)(ws + OFF_PB + li * PB_SZ), (const bf16*)(ws + OFF_WPP + li * WPP_SZ), NPR, D, PLE};
                  pg8::StaticOrder S; S.init(NPR, D, G, bid); pg8::EpiStorePP E{pp};
                  pg8::gemm_phase<pg8::EpiStorePP, pg8::StaticOrder, true, true>(lds, g, S, E, tid); }
                { unsigned ones2_ = ~0u; asm volatile("" : "+s"(ones2_)); const int tid2 = wave * 64 + (int)__builtin_amdgcn_mbcnt_hi(ones2_, __builtin_amdgcn_mbcnt_lo(ones2_, 0u));
                  pg8::Gemm g{hb, (const bf16*)(ws + OFF_WPG + li * WSQ_SZ), NPR, D, D};
                  pg8::StaticOrder S; S.init(NPR, D, G, bid); pg8::EpiPle E{hb, ob, rs1, rs0, pp};
                  pg8::gemm_phase<pg8::EpiPle, pg8::StaticOrder, true, true>(lds, g, S, E, tid2); }
                { unsigned ones3_ = ~0u; asm volatile("" : "+s"(ones3_)); const int tid3 = wave * 64 + (int)__builtin_amdgcn_mbcnt_hi(ones3_, __builtin_amdgcn_mbcnt_lo(ones3_, 0u));
                  mini_gemm<1, D>(lds, hb, (const bf16*)(ws + OFF_WPG + li * WSQ_SZ), (const bf16*)(ws + OFF_PB + li * PB_SZ), (const bf16*)(ws + OFF_WPP + li * WPP_SZ), nullptr, hb, ob, rs1, rs0, 0.f, tid3, bid, G); }
            }
        }
#if PROBE_MODE
        if (ph_ + 1 < ph_hi || rep + 1 < nrep) grid.sync();
#else
        if (ph_ + 1 < ph_hi) {
            if (ph_lo < 0) grid.sync(); else xcd_barrier(xbar);
#if EXTRA_SYNCS
            for (int es = 0; es < EXTRA_SYNCS; ++es) xcd_barrier(xbar);
#endif
        }
#endif
      }
    }
#if PT_ON
    if (PT_T0) { const unsigned long long t0_ = ((unsigned long long)tsl[1] << 32) | tsl[0], t1_ = ((unsigned long long)tsl[3] << 32) | tsl[2], span_ = (t1_ - t0_) * PT_MUL;
        const unsigned long long s_ = __builtin_amdgcn_s_memrealtime(); while (__builtin_amdgcn_s_memrealtime() - s_ < span_) __builtin_amdgcn_s_sleep(8); }
#endif
}

extern "C" void kernel_launch(void* const* d_in, const int* in_sizes, int n_in, void* d_out, int out_size, void* d_ws, size_t ws_size, hipStream_t stream) {
    static int grid = 0;
    if (grid == 0) {
        if (n_in != 26 || (size_t)out_size != OUT_END || ws_size < WS_TOTAL) { fprintf(stderr, "kernel_launch: unexpected shapes (n_in %d out %d ws %zu need %zu); nothing launched\n", n_in, out_size, ws_size, (size_t)WS_TOTAL); grid = -1; return; }
        int dev = 0, cus = 0, per_cu = 0;
        if (hipGetDevice(&dev) != hipSuccess || hipDeviceGetAttribute(&cus, hipDeviceAttributeMultiprocessorCount, dev) != hipSuccess) { grid = -1; return; }
        if (hipFuncSetAttribute((const void*)fwd_kernel, hipFuncAttributeMaxDynamicSharedMemorySize, LDS_BYTES) != hipSuccess) { fprintf(stderr, "kernel_launch: hipFuncSetAttribute failed\n"); grid = -1; return; }
        if (hipOccupancyMaxActiveBlocksPerMultiprocessor(&per_cu, (const void*)fwd_kernel, NWAVES * 64, LDS_BYTES) != hipSuccess || per_cu < 1) per_cu = 1;
        (void)hipGetLastError();
        grid = cus * per_cu;
    }
    if (grid < 0) return;
    if (hipMemsetAsync((char*)d_ws + OFF_CTL, 0, CTL_BYTES, stream) != hipSuccess) { fprintf(stderr, "kernel_launch: memset of the barrier words failed\n"); return; }
    Args a{};
    for (int i = 0; i < 26; ++i) a.in[i] = (const float*)d_in[i];
    a.out = (float*)d_out; a.ws = (unsigned char*)d_ws;
#if MK_N_LAUNCHES == 1
    a.ph_lo = 0; a.ph_hi = NPH;
    void* args[] = {&a};
    hipError_t e = hipLaunchCooperativeKernel((const void*)fwd_kernel, dim3(grid), dim3(NWAVES * 64), args, LDS_BYTES, stream);
    if (e != hipSuccess) fprintf(stderr, "kernel_launch: cooperative launch failed: %s (grid %d)\n", hipGetErrorString(e), grid);
#else
    for (int ph = 0; ph < NPH; ++ph) { a.ph_lo = ph; a.ph_hi = ph + 1; hipLaunchKernelGGL(fwd_kernel, dim3(grid), dim3(NWAVES * 64), LDS_BYTES, stream, a); }
#endif
}
```
